# Optimizing an MI355X kernel written in HIP

```python
import math
import jax, jax.numpy as jnp
from jax import lax
import numpy as np

D_MODEL = 4096
BATCH = 2
SEQ = 8192
DEPTH = 1
DEC_BATCH = 8
DEC_SEQ = 16
PAST_LEN = 2048

CHUNK = 64
Q_BLOCK = 128
MIX_WIDTH = D_MODEL
ATTN_WIDTH = MIX_WIDTH // 2
V_HEAD_DIM = 128
ATTN_HEADS = ATTN_WIDTH // V_HEAD_DIM
QK_DIM = V_HEAD_DIM // 2
ATTN_SCALE = QK_DIM ** -0.5
SSD_INNER = MIX_WIDTH - ATTN_WIDTH
SSD_HEAD_DIM = 64
SSD_HEADS = SSD_INNER // SSD_HEAD_DIM
SSD_GROUPS = 8
D_STATE = 128
CONV_WIDTH = 4
CONV_DIM = SSD_INNER + 2 * SSD_GROUPS * D_STATE
SSD_CHUNK = CHUNK
D_FF = ((-(-8 * D_MODEL // 3) + 255) // 256) * 256
EPS = 1e-6
IN_DIM = 3 * ATTN_WIDTH + SSD_INNER + CONV_DIM + SSD_HEADS
IN_SPLITS = [ATTN_WIDTH, 2 * ATTN_WIDTH, 3 * ATTN_WIDTH,
             3 * ATTN_WIDTH + SSD_INNER, 3 * ATTN_WIDTH + SSD_INNER + CONV_DIM]

kernel_name = "hybrid_diffattn_ssd_stream_step"


def rms_norm(x, w):
    xf = x.astype(jnp.float32)
    y = xf * lax.rsqrt(jnp.mean(xf * xf, axis=-1, keepdims=True) + EPS)
    return (y * w.astype(jnp.float32)).astype(x.dtype)


def lambda_init(layer):
    return 0.8 - 0.6 * math.exp(-0.3 * layer)


def diff_mix(q1, q2, k1, k2, v, lam, mask):
    s1 = jnp.einsum("bqhd,bkhd->bhqk", q1, k1, preferred_element_type=jnp.float32) * ATTN_SCALE
    s2 = jnp.einsum("bqhd,bkhd->bhqk", q2, k2, preferred_element_type=jnp.float32) * ATTN_SCALE
    if mask is not None:
        s1 = jnp.where(mask, s1, -jnp.inf)
        s2 = jnp.where(mask, s2, -jnp.inf)
    a = jax.nn.softmax(s1, axis=-1) - lam * jax.nn.softmax(s2, axis=-1)
    return jnp.einsum("bhqk,bkhd->bqhd", a.astype(v.dtype), v)


def diff_attention_prompt(q1, q2, k1, k2, v, lam):
    b, s = q1.shape[0], q1.shape[1]
    key_chunk = jnp.arange(s) // CHUNK

    def one_block(start):
        qb1 = lax.dynamic_slice_in_dim(q1, start, Q_BLOCK, axis=1)
        qb2 = lax.dynamic_slice_in_dim(q2, start, Q_BLOCK, axis=1)
        q_chunk = (start + jnp.arange(Q_BLOCK)) // CHUNK
        mask = key_chunk[None, :] <= q_chunk[:, None]
        return diff_mix(qb1, qb2, k1, k2, v, lam, mask)

    out = lax.map(one_block, jnp.arange(0, s, Q_BLOCK))
    return jnp.moveaxis(out, 0, 1).reshape(b, s, ATTN_HEADS, V_HEAD_DIM)


def ssd_scan(x, dt, A, Bm, Cm, init_state, chunk):
    b, l, h, p = x.shape
    g, n = Bm.shape[2], Bm.shape[3]
    r = h // g
    c = l // chunk
    f32 = jnp.float32
    x = x.astype(f32)
    dt = dt.astype(f32)
    Bc = Bm.astype(f32).reshape(b, c, chunk, g, n)
    Cc = Cm.astype(f32).reshape(b, c, chunk, g, n)
    xdt = (x * dt[..., None]).reshape(b, c, chunk, g, r, p)
    dA = jnp.moveaxis((dt * A).reshape(b, c, chunk, g, r), 2, -1)
    a_cs = jnp.cumsum(dA, axis=-1)
    tri = jnp.tril(jnp.ones((chunk, chunk), dtype=bool))
    seg = a_cs[..., :, None] - a_cs[..., None, :]
    decay_in = jnp.exp(jnp.where(tri, seg, -jnp.inf))
    cb = jnp.einsum("bcqgn,bcsgn->bcgqs", Cc, Bc)
    y_diag = jnp.einsum("bcgqs,bcgrqs,bcsgrp->bcqgrp", cb, decay_in, xdt)
    decay_to_end = jnp.exp(a_cs[..., -1:] - a_cs)
    states = jnp.einsum("bcsgn,bcgrs,bcsgrp->bcgrpn", Bc, decay_to_end, xdt)
    chunk_decay = jnp.exp(a_cs[..., -1])

    def step(carry, inp):
        st, dec = inp
        return carry * dec[..., None, None] + st, carry

    init = init_state.astype(f32).reshape(b, g, r, p, n)
    final, prev = lax.scan(step, init, (jnp.moveaxis(states, 1, 0), jnp.moveaxis(chunk_decay, 1, 0)))
    prev = jnp.moveaxis(prev, 0, 1)
    y_off = jnp.einsum("bcqgn,bcgrpn,bcgrq->bcqgrp", Cc, prev, jnp.exp(a_cs))
    y = (y_diag + y_off).reshape(b, l, h, p)
    return y, final.reshape(b, h, p, n)


def ssd_branch(z, xbc, dt_raw, conv_prev, ssm_prev, p, chunk):
    b, l, _ = xbc.shape
    xpad = jnp.concatenate([conv_prev.astype(xbc.dtype), xbc], axis=1)
    conv = p["conv_b"]
    for i in range(CONV_WIDTH):
        conv = conv + p["conv_w"][i] * xpad[:, i:i + l]
    new_conv = xpad[:, xpad.shape[1] - (CONV_WIDTH - 1):]
    act = jax.nn.silu(conv)
    xs, Bm, Cm = jnp.split(act, [SSD_INNER, SSD_INNER + SSD_GROUPS * D_STATE], axis=-1)
    xs = xs.reshape(b, l, SSD_HEADS, SSD_HEAD_DIM)
    Bm = Bm.reshape(b, l, SSD_GROUPS, D_STATE)
    Cm = Cm.reshape(b, l, SSD_GROUPS, D_STATE)
    dt = jax.nn.softplus(dt_raw.astype(jnp.float32) + p["dt_bias"].astype(jnp.float32))
    A = -jnp.exp(p["A_log"].astype(jnp.float32))
    y, final = ssd_scan(xs, dt, A, Bm, Cm, ssm_prev, chunk)
    y = y + p["D_skip"].astype(jnp.float32)[:, None] * xs.astype(jnp.float32)
    y = y.reshape(b, l, SSD_INNER) * jax.nn.silu(z.astype(jnp.float32))
    yg = y.reshape(b, l, SSD_GROUPS, SSD_INNER // SSD_GROUPS)
    yg = yg * lax.rsqrt(jnp.mean(yg * yg, axis=-1, keepdims=True) + EPS)
    y = yg.reshape(b, l, SSD_INNER) * p["ssd_norm_w"].astype(jnp.float32)
    return y.astype(z.dtype), new_conv, final.astype(z.dtype)


def hybrid_layer(x, p, layer, past_k, past_v, conv_prev, ssm_prev, ssd_chunk):
    b, l, _ = x.shape
    h = rms_norm(x, p["norm1_w"])
    proj = h @ p["w_in"]
    q, k, v, z, xbc, dt_raw = jnp.split(proj, IN_SPLITS, axis=-1)
    q = q.reshape(b, l, ATTN_HEADS, 2 * QK_DIM)
    k = k.reshape(b, l, ATTN_HEADS, 2 * QK_DIM)
    v = v.reshape(b, l, ATTN_HEADS, V_HEAD_DIM)
    lam0 = lambda_init(layer)
    f32 = jnp.float32
    lam = (jnp.exp(jnp.sum(p["lambda_q1"].astype(f32) * p["lambda_k1"].astype(f32)))
           - jnp.exp(jnp.sum(p["lambda_q2"].astype(f32) * p["lambda_k2"].astype(f32))) + lam0)
    if past_k is None:
        o = diff_attention_prompt(q[..., :QK_DIM], q[..., QK_DIM:], k[..., :QK_DIM], k[..., QK_DIM:], v, lam)
    else:
        k_all = jnp.concatenate([past_k.astype(k.dtype), k], axis=1)
        v_all = jnp.concatenate([past_v.astype(v.dtype), v], axis=1)
        o = diff_mix(q[..., :QK_DIM], q[..., QK_DIM:], k_all[..., :QK_DIM], k_all[..., QK_DIM:], v_all, lam, None)
    o = rms_norm(o, p["subln_w"]) * (1.0 - lam0)
    attn_out = o.reshape(b, l, ATTN_WIDTH)
    ssd_out, new_conv, new_ssm = ssd_branch(z, xbc, dt_raw, conv_prev, ssm_prev, p, ssd_chunk)
    mix = jnp.concatenate([attn_out, ssd_out.astype(attn_out.dtype)], axis=-1)
    x = x + mix @ p["w_out"]
    h2 = rms_norm(x, p["norm2_w"])
    x = x + (jax.nn.silu(h2 @ p["w_gate"]) * (h2 @ p["w_up"])) @ p["w_down"]
    return x, k, v, new_conv, new_ssm


def setup_inputs(seed: int = 0) -> dict:
    key = jax.random.key(seed)
    ks = jax.random.split(key, 26)
    f32 = jnp.float32
    nrm = lambda k, shape, s: jax.random.normal(k, shape, f32) * s
    dt0 = jnp.exp(jax.random.uniform(ks[15], (DEPTH, SSD_HEADS), f32)
                  * (math.log(0.1) - math.log(0.001)) + math.log(0.001))
    return {
        "x_prompt": nrm(ks[0], (BATCH, SEQ, D_MODEL), 1.0),
        "x_sample": nrm(ks[1], (DEC_BATCH, DEC_SEQ, D_MODEL), 1.0),
        "cache_k": nrm(ks[2], (DEPTH, DEC_BATCH, PAST_LEN, ATTN_HEADS, 2 * QK_DIM), 1.0),
        "cache_v": nrm(ks[3], (DEPTH, DEC_BATCH, PAST_LEN, ATTN_HEADS, V_HEAD_DIM), 1.0),
        "state_conv": nrm(ks[4], (DEPTH, DEC_BATCH, CONV_WIDTH - 1, CONV_DIM), 1.0),
        "state_ssm": nrm(ks[5], (DEPTH, DEC_BATCH, SSD_HEADS, SSD_HEAD_DIM, D_STATE), 0.1),
        "norm1_w": 1.0 + nrm(ks[6], (DEPTH, D_MODEL), 0.01),
        "w_in": nrm(ks[7], (DEPTH, D_MODEL, IN_DIM), D_MODEL ** -0.5),
        "lambda_q1": nrm(ks[8], (DEPTH, QK_DIM), 0.1),
        "lambda_k1": nrm(ks[9], (DEPTH, QK_DIM), 0.1),
        "lambda_q2": nrm(ks[10], (DEPTH, QK_DIM), 0.1),
        "lambda_k2": nrm(ks[11], (DEPTH, QK_DIM), 0.1),
        "subln_w": 1.0 + nrm(ks[12], (DEPTH, V_HEAD_DIM), 0.01),
        "conv_w": nrm(ks[13], (DEPTH, CONV_WIDTH, CONV_DIM), CONV_WIDTH ** -0.5),
        "conv_b": nrm(ks[14], (DEPTH, CONV_DIM), 0.01),
        "dt_bias": dt0 + jnp.log(-jnp.expm1(-dt0)),
        "A_log": jnp.log(jax.random.uniform(ks[16], (DEPTH, SSD_HEADS), f32, 1.0, 16.0)),
        "D_skip": 1.0 + nrm(ks[17], (DEPTH, SSD_HEADS), 0.01),
        "ssd_norm_w": 1.0 + nrm(ks[18], (DEPTH, SSD_INNER), 0.01),
        "w_out": nrm(ks[19], (DEPTH, MIX_WIDTH, D_MODEL), MIX_WIDTH ** -0.5),
        "norm2_w": 1.0 + nrm(ks[20], (DEPTH, D_MODEL), 0.01),
        "w_gate": nrm(ks[21], (DEPTH, D_MODEL, D_FF), D_MODEL ** -0.5),
        "w_up": nrm(ks[22], (DEPTH, D_MODEL, D_FF), D_MODEL ** -0.5),
        "w_down": nrm(ks[23], (DEPTH, D_FF, D_MODEL), D_FF ** -0.5),
        "final_norm_w": 1.0 + nrm(ks[24], (D_MODEL,), 0.01),
    }


def reference(x_prompt, x_sample, cache_k, cache_v, state_conv, state_ssm,
              norm1_w, w_in, lambda_q1, lambda_k1, lambda_q2, lambda_k2, subln_w,
              conv_w, conv_b, dt_bias, A_log, D_skip, ssd_norm_w, w_out,
              norm2_w, w_gate, w_up, w_down, final_norm_w):
    xp, xs = x_prompt, x_sample
    kp_l, vp_l, cp_l, sp_l = [], [], [], []
    ks_l, vs_l, cs_l, ss_l = [], [], [], []
    for layer in range(DEPTH):
        p = {
            "norm1_w": norm1_w[layer], "w_in": w_in[layer],
            "lambda_q1": lambda_q1[layer], "lambda_k1": lambda_k1[layer],
            "lambda_q2": lambda_q2[layer], "lambda_k2": lambda_k2[layer],
            "subln_w": subln_w[layer], "conv_w": conv_w[layer], "conv_b": conv_b[layer],
            "dt_bias": dt_bias[layer], "A_log": A_log[layer], "D_skip": D_skip[layer],
            "ssd_norm_w": ssd_norm_w[layer], "w_out": w_out[layer], "norm2_w": norm2_w[layer],
            "w_gate": w_gate[layer], "w_up": w_up[layer], "w_down": w_down[layer],
        }
        b_p = xp.shape[0]
        conv0 = jnp.zeros((b_p, CONV_WIDTH - 1, CONV_DIM), xp.dtype)
        ssm0 = jnp.zeros((b_p, SSD_HEADS, SSD_HEAD_DIM, D_STATE), jnp.float32)
        xp, kp, vp, cp, sp = hybrid_layer(xp, p, layer, None, None, conv0, ssm0, SSD_CHUNK)
        xs, kn, vn, cn, sn = hybrid_layer(xs, p, layer, cache_k[layer], cache_v[layer],
                                          state_conv[layer], state_ssm[layer], xs.shape[1])
        kp_l.append(kp); vp_l.append(vp); cp_l.append(cp); sp_l.append(sp)
        ks_l.append(kn); vs_l.append(vn); cs_l.append(cn); ss_l.append(sn)
    y_prompt = rms_norm(xp, final_norm_w)
    y_sample = rms_norm(xs, final_norm_w)
    return (y_prompt, y_sample,
            jnp.stack(kp_l), jnp.stack(vp_l), jnp.stack(cp_l), jnp.stack(sp_l),
            jnp.stack(ks_l), jnp.stack(vs_l), jnp.stack(cs_l), jnp.stack(ss_l))
```

```cpp
#include <hip/hip_runtime.h>
#include <cstdio>
#include <cstdint>
namespace pg8 {
#define PG8_LAS __attribute__((address_space(3)))
typedef unsigned short bf16_t;
typedef short bf16x8 __attribute__((ext_vector_type(8)));
typedef float f32x4 __attribute__((ext_vector_type(4)));
typedef unsigned u32x4 __attribute__((ext_vector_type(4)));
constexpr int BM = 256, BK = 64, HALF = 128, HTB = HALF * BK * 2  , STAGE_BYTES = 8 * HTB, NXCD = 8, WGM = 8;

__host__ __device__ __forceinline__ int lds_byte(int r, int c) { const int st = (r >> 4) * 2 + (c >> 5), rr = r & 15, cc = c & 31, ob = rr * 64 + cc * 2; return st * 1024 + (ob ^ (((ob >> 9) & 1) << 5)); }
__host__ __device__ __forceinline__ void stage_rc(int b, int& R, int& C) { const int st = b / 1024, sb = b % 1024, swz = sb ^ (((sb >> 9) & 1) << 5); R = (st >> 1) * 16 + swz / 64; C = (st & 1) * 32 + (swz % 64) / 2; }
__host__ __device__ __forceinline__ int perm32(int rho) { const int n = rho >> 4, i = rho & 15; return 8 * (i >> 2) + 4 * n + (i & 3); }

struct Unit { int pm, pn; };
struct Gemm { const bf16_t* A; const bf16_t* Bt; int M, N, K; };

struct StaticOrder {
    int nM, nN, nwg, G, c;
    __host__ __device__ void init(int M, int N, int G_, int c_) { nM = M / BM; nN = N / BM; nwg = nM * nN; G = G_; c = c_; }
    __host__ __device__ bool next(int i, Unit& u) const {
        const long L = (long)i * G + c; if (L >= nwg) return false;
        int wgid = (int)L; { const int q = nwg / NXCD, r = nwg % NXCD, xcd = wgid % NXCD, off = wgid / NXCD; wgid = (xcd < r ? xcd * (q + 1) : r * (q + 1) + (xcd - r) * q) + off; }
        const int nig = WGM * nN, gid = wgid / nig, fm = gid * WGM, gsz = (nM - fm) < WGM ? (nM - fm) : WGM;
        u.pm = fm + ((wgid % nig) % gsz); u.pn = (wgid % nig) / gsz; return true;
    }
    __device__ __forceinline__ void a_ready(const Unit&) const {}
    __device__ __forceinline__ void done(const Unit&) const {}
};

__device__ __forceinline__ unsigned cvt_pk_bf16(float lo, float hi) { unsigned r; asm volatile("v_cvt_pk_bf16_f32 %0, %1, %2" : "=v"(r) : "v"(lo), "v"(hi)); return r; }
typedef float f32x2 __attribute__((ext_vector_type(2)));
template <class Epi, class Sched, bool ALIGN_EPI = false, bool SP2 = false>
__device__ __forceinline__ void gemm_phase(PG8_LAS unsigned char* lds, const Gemm g, const Sched& S, const Epi& E) {
    const int tid = threadIdx.x, wid = __builtin_amdgcn_readfirstlane(tid >> 6), lane = tid & 63, wr = wid >> 2, wc = wid & 3, fr = lane & 15, fq = lane >> 4;
    const int K = g.K, nt = K / BK;
    unsigned voffA[2], voffB[2];
#pragma unroll
    for (int i = 0; i < 2; ++i) { int R, C; stage_rc(tid * 16 + i * 8192, R, C); const int Rb = Epi::PERM ? ((R & ~31) + perm32(R & 31)) : R;
        voffA[i] = (unsigned)(R * K + C) * 2u; voffB[i] = (unsigned)(Rb * K + C) * 2u; }
    const size_t kstep = (size_t)(BK * 2);
    const size_t hstep = (size_t)HALF * K * 2;
    const size_t tstep = 2 * hstep;
    const unsigned ldsw = (unsigned)wid * 1024u;
    const int aoff = lds_byte(wr * 64 + fr, fq * 8), boff = lds_byte(wc * 32 + fr, fq * 8);
#define PG8_SA(b, h) (((b) * 2 + (h)) * HTB)
#define PG8_SB(b, h) ((4 + (b) * 2 + (h)) * HTB)
#define PG8_STAGE(bufoff, gbase, voff) do { _Pragma("unroll") for (int _i = 0; _i < 2; ++_i) \
        __builtin_amdgcn_global_load_lds((const unsigned*)((const char*)(gbase) + (voff)[_i]), (PG8_LAS unsigned*)(lds + (bufoff) + ldsw + _i * 8192), 16, 0, 0); } while (0)
#define PG8_LDA(dst, b, h) do { _Pragma("unroll") for (int m = 0; m < 4; ++m) _Pragma("unroll") for (int k = 0; k < 2; ++k) dst[m][k] = *(const PG8_LAS bf16x8*)(lds + PG8_SA(b, h) + aoff + m * 2048 + k * 1024); } while (0)
#define PG8_LDB(dst, b, h) do { _Pragma("unroll") for (int n = 0; n < 2; ++n) _Pragma("unroll") for (int k = 0; k < 2; ++k) dst[n][k] = *(const PG8_LAS bf16x8*)(lds + PG8_SB(b, h) + boff + n * 2048 + k * 1024); } while (0)
#define PG8_MMA(ai, bj, At, Bt) do { __builtin_amdgcn_s_setprio(1); _Pragma("unroll") for (int m = 0; m < 4; ++m) _Pragma("unroll") for (int n = 0; n < 2; ++n) _Pragma("unroll") for (int k = 0; k < 2; ++k) \
        acc[ai][bj][m][n] = __builtin_amdgcn_mfma_f32_16x16x32_bf16(Bt[n][k], At[m][k], acc[ai][bj][m][n], 0, 0, 0); __builtin_amdgcn_s_setprio(0); } while (0)
#define PG8_WAIT_V(n) asm volatile("s_waitcnt vmcnt(" #n ")" ::: "memory")
#define PG8_WAIT_L(n) asm volatile("s_waitcnt lgkmcnt(" #n ")" ::: "memory")
#define PG8_BAR __builtin_amdgcn_s_barrier()
#define PG8_SCHED __builtin_amdgcn_sched_barrier(0)
    Unit cur, nxt; int ui = 0;
    if (!S.next(0, cur)) return;
    f32x4 acc[2][2][4][2];
#pragma unroll
    for (int a = 0; a < 2; ++a)
#pragma unroll
        for (int b = 0; b < 2; ++b)
#pragma unroll
            for (int m = 0; m < 4; ++m)
#pragma unroll
                for (int n = 0; n < 2; ++n) acc[a][b][m][n] = (f32x4){0.f, 0.f, 0.f, 0.f};
    bf16x8 At[4][2], B0[2][2], B1[2][2];
    const char* cA = (const char*)g.A + (size_t)cur.pm * tstep; const char* cB = (const char*)g.Bt + (size_t)cur.pn * tstep;
    S.a_ready(cur);
    if constexpr (SP2) {
        PG8_STAGE(PG8_SB(0, 0), cB, voffB); PG8_STAGE(PG8_SB(0, 1), cB + hstep, voffB); PG8_STAGE(PG8_SA(0, 0), cA, voffA); PG8_STAGE(PG8_SA(0, 1), cA + hstep, voffA);
        if (wr == 1) PG8_BAR;
        PG8_WAIT_V(2); PG8_BAR;
        PG8_STAGE(PG8_SB(1, 0), cB + kstep, voffB); PG8_STAGE(PG8_SA(1, 0), cA + kstep, voffA); PG8_STAGE(PG8_SB(1, 1), cB + hstep + kstep, voffB);
        PG8_WAIT_V(6); PG8_BAR;
    } else {
        PG8_STAGE(PG8_SB(0, 0), cB, voffB); PG8_STAGE(PG8_SA(0, 0), cA, voffA); PG8_STAGE(PG8_SB(0, 1), cB + hstep, voffB); PG8_STAGE(PG8_SA(0, 1), cA + hstep, voffA);
        if (wr == 1) PG8_BAR;
        PG8_WAIT_V(4); PG8_BAR;
        PG8_STAGE(PG8_SB(1, 0), cB + kstep, voffB); PG8_STAGE(PG8_SA(1, 0), cA + kstep, voffA); PG8_STAGE(PG8_SB(1, 1), cB + hstep + kstep, voffB);
        PG8_WAIT_V(6); PG8_BAR;
    }
    for (;;) {
        const bool has_next = S.next(ui + 1, nxt);
        const char* nA = has_next ? (const char*)g.A + (size_t)nxt.pm * tstep : cA; const char* nB = has_next ? (const char*)g.Bt + (size_t)nxt.pn * tstep : cB;
        for (int t = 0; t < nt; t += 2) {
            const bool last = (t == nt - 2);
            const char* a1 = cA + (size_t)(t + 1) * kstep;
            const char* a2 = last ? nA : cA + (size_t)(t + 2) * kstep; const char* b2 = last ? nB : cB + (size_t)(t + 2) * kstep;
            const char* a3 = a2 + kstep; const char* b3 = b2 + kstep;
            if (last && has_next) S.a_ready(nxt);
            if constexpr (SP2) {
            PG8_LDB(B0, 0, 0); PG8_LDB(B1, 0, 1); PG8_SCHED; PG8_LDA(At, 0, 0); PG8_STAGE(PG8_SA(1, 1), a1 + hstep, voffA);
            PG8_WAIT_V(8); PG8_WAIT_L(0); PG8_BAR; PG8_MMA(0, 0, At, B0); PG8_MMA(0, 1, At, B1); PG8_BAR; PG8_SCHED;
            PG8_LDA(At, 0, 1); PG8_STAGE(PG8_SB(0, 0), b2, voffB); PG8_STAGE(PG8_SB(0, 1), b2 + hstep, voffB); PG8_STAGE(PG8_SA(0, 0), a2, voffA);
            PG8_WAIT_V(8); PG8_WAIT_L(0); PG8_BAR; PG8_MMA(1, 0, At, B0); PG8_MMA(1, 1, At, B1); PG8_BAR; PG8_SCHED;
            PG8_LDB(B0, 1, 0); PG8_LDB(B1, 1, 1); PG8_SCHED; PG8_LDA(At, 1, 0); PG8_STAGE(PG8_SA(0, 1), a2 + hstep, voffA);
            PG8_WAIT_V(8); PG8_WAIT_L(0); PG8_BAR; PG8_MMA(0, 0, At, B0); PG8_MMA(0, 1, At, B1); PG8_BAR; PG8_SCHED;
            PG8_LDA(At, 1, 1); PG8_STAGE(PG8_SB(1, 0), b3, voffB); PG8_STAGE(PG8_SB(1, 1), b3 + hstep, voffB); PG8_STAGE(PG8_SA(1, 0), a3, voffA);
            PG8_WAIT_V(8); PG8_WAIT_L(0); PG8_BAR; PG8_MMA(1, 0, At, B0); PG8_MMA(1, 1, At, B1); PG8_BAR; PG8_SCHED;
            } else {
            PG8_LDB(B0, 0, 0); PG8_SCHED; PG8_LDA(At, 0, 0); PG8_STAGE(PG8_SA(1, 1), a1 + hstep, voffA);
            PG8_WAIT_L(8); PG8_BAR; PG8_WAIT_L(0); PG8_MMA(0, 0, At, B0); PG8_BAR; PG8_SCHED;
            PG8_LDB(B1, 0, 1); PG8_STAGE(PG8_SB(0, 0), b2, voffB);
            PG8_BAR; PG8_WAIT_L(0); PG8_MMA(0, 1, At, B1); PG8_BAR;
            PG8_LDA(At, 0, 1); PG8_STAGE(PG8_SA(0, 0), a2, voffA);
            PG8_BAR; PG8_WAIT_L(0); PG8_MMA(1, 0, At, B0); PG8_BAR; PG8_SCHED;
            PG8_STAGE(PG8_SB(0, 1), b2 + hstep, voffB);
            PG8_WAIT_V(6); PG8_BAR; PG8_MMA(1, 1, At, B1); PG8_BAR;
            PG8_LDB(B0, 1, 0); PG8_SCHED; PG8_LDA(At, 1, 0); PG8_STAGE(PG8_SA(0, 1), a2 + hstep, voffA);
            PG8_WAIT_L(8); PG8_BAR; PG8_WAIT_L(0); PG8_MMA(0, 0, At, B0); PG8_BAR; PG8_SCHED;
            PG8_LDB(B1, 1, 1); PG8_STAGE(PG8_SB(1, 0), b3, voffB);
            PG8_BAR; PG8_WAIT_L(0); PG8_MMA(0, 1, At, B1); PG8_BAR;
            PG8_LDA(At, 1, 1); PG8_STAGE(PG8_SA(1, 0), a3, voffA);
            PG8_BAR; PG8_WAIT_L(0); PG8_MMA(1, 0, At, B0); PG8_BAR; PG8_SCHED;
            PG8_STAGE(PG8_SB(1, 1), b3 + hstep, voffB);
            PG8_WAIT_V(6); PG8_BAR; PG8_MMA(1, 1, At, B1); PG8_BAR;
            }
        }
        if constexpr (ALIGN_EPI) { if (wr == 0) PG8_BAR; }
        if constexpr (!Epi::AFTER_DRAIN) { E(acc, cur, wr, wc, fr, fq); S.done(cur); }
        if (!has_next) break;
#pragma unroll
        for (int a = 0; a < 2; ++a)
#pragma unroll
            for (int b = 0; b < 2; ++b)
#pragma unroll
                for (int m = 0; m < 4; ++m)
#pragma unroll
                    for (int n = 0; n < 2; ++n) acc[a][b][m][n] = (f32x4){0.f, 0.f, 0.f, 0.f};
        cur = nxt; cA = nA; cB = nB; ++ui;
        if constexpr (ALIGN_EPI) { if (wr == 1) PG8_BAR; }
    }
    PG8_WAIT_V(0);
    if constexpr (!ALIGN_EPI) { if (wr == 0) PG8_BAR; }
    PG8_BAR;
    if constexpr (Epi::AFTER_DRAIN) { E.fused(acc, cur, wr, wc, fr, fq, lds, wid, lane); S.done(cur); }
#undef PG8_SA
#undef PG8_SB
#undef PG8_STAGE
#undef PG8_LDA
#undef PG8_LDB
#undef PG8_MMA
#undef PG8_WAIT_V
#undef PG8_WAIT_L
#undef PG8_BAR
#undef PG8_SCHED
}
}

#ifndef TEST_ALPHA
#define TEST_ALPHA 1.0f
#endif
constexpr int DM = 4096, SEQ = 8192, NB = 2, MP = NB * SEQ  , MS = 128  , MR = MP + MS  , MPAD = 16640  ;
constexpr int DEC_B = 8, DEC_T = 16, PAST = 2048, KVROWS = 2112  ;
constexpr int AW = 2048, NH = 16, HD = 128, QKD = 64, SSDI = 2048, SH = 32, SHD = 64, SG = 8, DS = 128, CONVD = 4096, DFF = 11008;
constexpr int NIN = 12320, NINP = 12544  ;
constexpr float EPS = 1e-6f;
constexpr float LAM0 = 0.2f;
constexpr float QSCALE = 0.125f * 1.4426950408889634f;
constexpr size_t O_YP = 0, O_YS = O_YP + (size_t)MP * DM, O_KP = O_YS + (size_t)MS * DM, O_VP = O_KP + (size_t)MP * AW, O_CP = O_VP + (size_t)MP * AW,
                 O_SP = O_CP + (size_t)NB * 3 * CONVD, O_KS = O_SP + (size_t)NB * SH * SHD * DS, O_VS = O_KS + (size_t)MS * AW, O_CS = O_VS + (size_t)MS * AW,
                 O_SS = O_CS + (size_t)DEC_B * 3 * CONVD, O_END = O_SS + (size_t)DEC_B * SH * SHD * DS;
static_assert(O_END == 138010624ull, "output size");

namespace pg8 {
typedef unsigned u32x2 __attribute__((ext_vector_type(2)));
__device__ __forceinline__ u32x4 pack8(const f32x4 a, const f32x4 b) { u32x4 w; w.x = cvt_pk_bf16(a[0], a[1]); w.y = cvt_pk_bf16(a[2], a[3]); w.z = cvt_pk_bf16(b[0], b[1]); w.w = cvt_pk_bf16(b[2], b[3]); return w; }

struct EpiInProj {
    static constexpr bool PERM = true, AFTER_DRAIN = false;
    bf16_t *Q, *Kb, *Vb, *Z, *XBC, *Kext, *Vext; float* DT; float* out;
    __device__ __forceinline__ void operator()(const f32x4 (&acc)[2][2][4][2], const Unit& u, int wr, int wc, int fr, int fq) const {
        const int pn = u.pn;
        const int sec = pn < 8 ? 0 : pn < 16 ? 1 : pn < 24 ? 2 : pn < 32 ? 3 : pn < 48 ? 4 : 5;
        const int secbase = sec == 0 ? 0 : sec == 1 ? 2048 : sec == 2 ? 4096 : sec == 3 ? 6144 : sec == 4 ? 8192 : 12288;
        const int row0 = u.pm * BM + wr * 64 + fr;
        const int colt = pn * BM - secbase + wc * 32 + 8 * fq;
#pragma unroll
        for (int ai = 0; ai < 2; ++ai) {
            if (u.pm == 64 && ai == 1) continue;
#pragma unroll
            for (int m = 0; m < 4; ++m) {
                const int row = row0 + ai * HALF + m * 16;
                const bool samp = row >= MP; const int rs = row - MP;
#pragma unroll
                for (int bj = 0; bj < 2; ++bj) {
                    const int c = colt + bj * HALF;
                    const f32x4 v0 = acc[ai][bj][m][0], v1 = acc[ai][bj][m][1];
                    if (sec == 0) {
                        *(u32x4*)(Q + (size_t)row * AW + c) = pack8(v0 * QSCALE, v1 * QSCALE);
                    } else if (sec == 1 || sec == 2) {
                        float* o = out + (sec == 1 ? (samp ? O_KS : O_KP) : (samp ? O_VS : O_VP)) + (size_t)(samp ? rs : row) * AW + c;
                        *(f32x4*)o = v0 * TEST_ALPHA; *(f32x4*)(o + 4) = v1 * TEST_ALPHA;
                        bf16_t* b = samp ? (sec == 1 ? Kext : Vext) + ((size_t)(rs >> 4) * KVROWS + PAST + (rs & 15)) * AW + c
                                         : (sec == 1 ? Kb : Vb) + (size_t)row * AW + c;
                        *(u32x4*)b = pack8(v0, v1);
                    } else if (sec == 3) {
                        *(u32x4*)(Z + (size_t)row * SSDI + c) = pack8(v0, v1);
                    } else if (sec == 4) {
                        *(u32x4*)(XBC + (size_t)row * CONVD + c) = pack8(v0, v1);
                        const int t = samp ? (rs & 15) - 13 : (row & (SEQ - 1)) - (SEQ - 3);
                        if (t >= 0) { float* o = out + (samp ? O_CS + (size_t)((rs >> 4) * 3 + t) * CONVD : O_CP + (size_t)((row >> 13) * 3 + t) * CONVD) + c;
                            *(f32x4*)o = v0 * TEST_ALPHA; *(f32x4*)(o + 4) = v1 * TEST_ALPHA; }
                    } else {
                        if (c < SH) { float* o = DT + (size_t)row * SH + c; *(f32x4*)o = v0; *(f32x4*)(o + 4) = v1; }
                    }
                }
            }
        }
    }
};

struct EpiOutProj {
    static constexpr bool PERM = true, AFTER_DRAIN = false;
    const float* xp; const float* xs; float* out; bf16_t* X1B; float* ss;
    __device__ __forceinline__ void operator()(const f32x4 (&acc)[2][2][4][2], const Unit& u, int wr, int wc, int fr, int fq) const {
        const int row0 = u.pm * BM + wr * 64 + fr, col0 = u.pn * BM + wc * 32 + 8 * fq;
#pragma unroll
        for (int ai = 0; ai < 2; ++ai) {
            if (u.pm == 64 && ai == 1) continue;
#pragma unroll
            for (int m = 0; m < 4; ++m) {
                const int row = row0 + ai * HALF + m * 16;
                const float* xr = row < MP ? xp + (size_t)row * DM : xs + (size_t)(row - MP) * DM;
                float* yr = out + (row < MP ? O_YP + (size_t)row * DM : O_YS + (size_t)(row - MP) * DM);
                float sq = 0.f;
#pragma unroll
                for (int bj = 0; bj < 2; ++bj) {
                    const int c = col0 + bj * HALF;
                    const f32x4 v0 = acc[ai][bj][m][0] + *(const f32x4*)(xr + c), v1 = acc[ai][bj][m][1] + *(const f32x4*)(xr + c + 4);
                    *(f32x4*)(yr + c) = v0; *(f32x4*)(yr + c + 4) = v1;
                    *(u32x4*)(X1B + (size_t)row * DM + c) = pack8(v0, v1);
                    sq += (v0[0] * v0[0] + v0[1] * v0[1]) + (v0[2] * v0[2] + v0[3] * v0[3]) + (v1[0] * v1[0] + v1[1] * v1[1]) + (v1[2] * v1[2] + v1[3] * v1[3]);
                }
                sq += __shfl_xor(sq, 16); sq += __shfl_xor(sq, 32);
                if (fq == 0) atomicAdd(ss + row, sq);
            }
        }
    }
};

struct EpiGateUp {
    static constexpr bool PERM = true, AFTER_DRAIN = false;
    bf16_t* H; const float* ss;
    __device__ __forceinline__ void operator()(const f32x4 (&acc)[2][2][4][2], const Unit& u, int wr, int wc, int fr, int fq) const {
        const int row0 = u.pm * BM + wr * 64 + fr, col0 = u.pn * HALF + wc * 32 + 8 * fq;
#pragma unroll
        for (int ai = 0; ai < 2; ++ai) {
            if (u.pm == 64 && ai == 1) continue;
#pragma unroll
            for (int m = 0; m < 4; ++m) {
                const int row = row0 + ai * HALF + m * 16;
                const float r = 1.0f / sqrtf(ss[row] * (1.0f / DM) + EPS);
                f32x4 h[2];
#pragma unroll
                for (int n = 0; n < 2; ++n)
#pragma unroll
                    for (int e = 0; e < 4; ++e) { const float g = acc[ai][0][m][n][e] * r, up = acc[ai][1][m][n][e] * r;
                        h[n][e] = g * up * __builtin_amdgcn_rcpf(1.0f + __builtin_amdgcn_exp2f(-1.4426950408889634f * g)); }
                *(u32x4*)(H + (size_t)row * DFF + col0) = pack8(h[0], h[1]);
            }
        }
    }
};

struct EpiDown {
    static constexpr bool PERM = true, AFTER_DRAIN = false;
    float* out; float* ss;
    __device__ __forceinline__ void operator()(const f32x4 (&acc)[2][2][4][2], const Unit& u, int wr, int wc, int fr, int fq) const {
        const int row0 = u.pm * BM + wr * 64 + fr, col0 = u.pn * BM + wc * 32 + 8 * fq;
#pragma unroll
        for (int ai = 0; ai < 2; ++ai) {
            if (u.pm == 64 && ai == 1) continue;
#pragma unroll
            for (int m = 0; m < 4; ++m) {
                const int row = row0 + ai * HALF + m * 16;
                float* yr = out + (row < MP ? O_YP + (size_t)row * DM : O_YS + (size_t)(row - MP) * DM);
                float sq = 0.f;
#pragma unroll
                for (int bj = 0; bj < 2; ++bj) {
                    const int c = col0 + bj * HALF;
                    const f32x4 v0 = acc[ai][bj][m][0] + *(const f32x4*)(yr + c), v1 = acc[ai][bj][m][1] + *(const f32x4*)(yr + c + 4);
                    *(f32x4*)(yr + c) = v0; *(f32x4*)(yr + c + 4) = v1;
                    sq += (v0[0] * v0[0] + v0[1] * v0[1]) + (v0[2] * v0[2] + v0[3] * v0[3]) + (v1[0] * v1[0] + v1[1] * v1[1]) + (v1[2] * v1[2] + v1[3] * v1[3]);
                }
                sq += __shfl_xor(sq, 16); sq += __shfl_xor(sq, 32);
                if (fq == 0) atomicAdd(ss + row, sq);
            }
        }
    }
};
}
#define GAS __attribute__((address_space(1)))
#define LAS __attribute__((address_space(3)))
typedef unsigned short bf16;
typedef unsigned v4u __attribute__((ext_vector_type(4)));
typedef float f32x4 __attribute__((ext_vector_type(4)));
typedef short bf16x8 __attribute__((ext_vector_type(8)));
typedef GAS unsigned gu32;
typedef GAS unsigned long long gu64;
#define RLX_AGENT __ATOMIC_RELAXED, __HIP_MEMORY_SCOPE_AGENT
#define LDS_WAIT() asm volatile("s_waitcnt lgkmcnt(0)" ::: "memory")
#define VM_WAIT() asm volatile("s_waitcnt vmcnt(0)" ::: "memory")
__device__ __forceinline__ unsigned long long rt() { return __builtin_amdgcn_s_memrealtime(); }
__device__ __forceinline__ unsigned f2bf(float f) { unsigned u = __builtin_bit_cast(unsigned, f); return (u + 0x7fffu + ((u >> 16) & 1u)) >> 16; }
__device__ __forceinline__ unsigned pk2(float lo, float hi) { return f2bf(lo) | (f2bf(hi) << 16); }

#define XB_TMO      128
#define XB_XCNT(j)  (256  + 64 * (j))
#define XB_XSUB(j)  (1280 + 64 * (j))
#define XB_XGEN(j)  (2304 + 64 * (j))
#define XB_TOP      3328
#define XB_TOPGEN   3392
#define XCD_BAR_WORDS 3456
#define XB_SPIN_CAP (1u << 18)

__device__ __forceinline__ unsigned xb_ld(unsigned* p)              { return __hip_atomic_load(p, __ATOMIC_RELAXED, __HIP_MEMORY_SCOPE_AGENT); }
__device__ __forceinline__ unsigned xb_add(unsigned* p, unsigned v) { return __hip_atomic_fetch_add(p, v, __ATOMIC_RELAXED, __HIP_MEMORY_SCOPE_AGENT); }
__device__ __forceinline__ unsigned xb_xcc_id() { return (unsigned)__builtin_amdgcn_s_getreg((3 << 11) | 20) & 0xFu; }
#define XB_SPIN(cond, bar) do { unsigned _sp = 0; while (cond) { __builtin_amdgcn_s_sleep(1); \
    if ((++_sp & 255u) == 0u) { if (xb_ld(&(bar)[XB_TMO])) break; if (_sp > XB_SPIN_CAP) { atomicAdd(&(bar)[XB_TMO], 1u); break; } } } } while (0)

struct XcdBarrier {
    unsigned* bar; unsigned x;
    volatile LAS unsigned* st;
};

__device__ __forceinline__ XcdBarrier xcd_barrier_post(unsigned* bar, volatile LAS unsigned* st) {
    XcdBarrier b; b.bar = bar; b.x = xb_xcc_id(); b.st = st;
    if (threadIdx.x == 0) (void)xb_add(&bar[XB_XCNT(b.x)], 1u);
    return b;
}
__device__ __forceinline__ void xcd_barrier_complete(unsigned* bar, unsigned x, unsigned& nloc, unsigned& nx) {
    const unsigned G = gridDim.x * gridDim.y * gridDim.z;
    unsigned sum, cnt, mine, sp = 0u;
    for (;;) {
        sum = 0u; cnt = 0u; mine = 0u;
#pragma unroll
        for (unsigned j = 0; j < 16; ++j) { const unsigned c = xb_ld(&bar[XB_XCNT(j)]); sum += c; cnt += (c > 0u) ? 1u : 0u; mine = (j == x) ? c : mine; }
        if (sum == G) break;
        __builtin_amdgcn_s_sleep(1);
        if ((++sp & 255u) == 0u) { if (xb_ld(&bar[XB_TMO])) break; if (sp > XB_SPIN_CAP) { atomicAdd(&bar[XB_TMO], 1u); break; } }
    }
    nloc = mine > 0u ? mine : 1u; nx = cnt > 0u ? cnt : 1u;
}

__device__ __forceinline__ void xcd_barrier(const XcdBarrier& b) {
    asm volatile("s_waitcnt vmcnt(0)" ::: "memory");
    __syncthreads();
    if (threadIdx.x == 0) {
        unsigned* bar = b.bar;
        __builtin_amdgcn_s_waitcnt(0);
        unsigned nloc = b.st[0], nx = b.st[1];
        if (nloc == 0u) { xcd_barrier_complete(bar, b.x, nloc, nx); b.st[0] = nloc; b.st[1] = nx; }
        const unsigned old = xb_add(&bar[XB_XSUB(b.x)], 1u);
        const unsigned gen = old / nloc;
        if (old + 1u == (gen + 1u) * nloc) {
            __builtin_amdgcn_fence(__ATOMIC_RELEASE, "agent");
            asm volatile("s_waitcnt vmcnt(0)" ::: "memory");
            const unsigned og = xb_add(&bar[XB_TOP], 1u);
            const unsigned tg = og / nx;
            if (og + 1u == (tg + 1u) * nx) xb_add(&bar[XB_TOPGEN], 1u);
            else XB_SPIN(xb_ld(&bar[XB_TOPGEN]) == tg, bar);
            __builtin_amdgcn_fence(__ATOMIC_ACQUIRE, "agent");
            xb_add(&bar[XB_XGEN(b.x)], 1u);
            asm volatile("s_waitcnt vmcnt(0)" ::: "memory");
        } else {
            XB_SPIN(xb_ld(&bar[XB_XGEN(b.x)]) == gen, bar);
            __builtin_amdgcn_fence(__ATOMIC_ACQUIRE, "agent");
            asm volatile("s_waitcnt vmcnt(0)" ::: "memory");
        }
    }
    __syncthreads();
}

constexpr int NWAVES = 8;
constexpr size_t MiB = 1u << 20;
constexpr size_t WS_CTL = 0, CTL_ZERO_BYTES = 1 * MiB;
constexpr size_t WS_WD = 1 * MiB, WS_WGU = 87 * MiB, WS_WO = 259 * MiB, WS_WIN = 291 * MiB, WS_XN = 389 * MiB, WS_Q = 519 * MiB, WS_KB = 584 * MiB, WS_VB = 649 * MiB,
                 WS_Z = 714 * MiB, WS_XBC = 779 * MiB, WS_DT = 909 * MiB, WS_KEXT = 912 * MiB, WS_VEXT = 978 * MiB, WS_END = 1044 * MiB;
constexpr size_t WS_MIX = WS_XN;
constexpr size_t WS_X1B = WS_KEXT;
constexpr size_t WS_H = WS_Q;
static_assert(WS_WD + (size_t)DM * DFF * 2 <= WS_WGU && WS_WGU + (size_t)2 * DFF * DM * 2 <= WS_WO && WS_WO + (size_t)DM * DM * 2 <= WS_WIN && WS_WIN + (size_t)NINP * DM * 2 <= WS_XN &&
              WS_XN + (size_t)MPAD * DM * 2 <= WS_Q && WS_Q + (size_t)MPAD * AW * 2 <= WS_KB && WS_XBC + (size_t)MPAD * CONVD * 2 <= WS_DT && WS_DT + (size_t)MPAD * SH * 4 <= WS_KEXT &&
              WS_KEXT + (size_t)DEC_B * KVROWS * AW * 2 <= WS_VEXT && WS_VEXT + (size_t)DEC_B * KVROWS * AW * 2 <= WS_END && WS_H + (size_t)MPAD * DFF * 2 <= WS_DT &&
              WS_X1B + (size_t)MPAD * DM * 2 <= WS_END, "d_ws map");
constexpr int CW_TMO = 0, CW_CODE = 1, CW_QUEUE = 64, CW_BAR = 4096, CW_SS2 = 65536, CW_SS3 = 131072;
constexpr int RING_OFF = 0, RING_BYTES = 139264, LDSCTL_OFF = RING_BYTES, MISC_OFF = LDSCTL_OFF + 320, LDS_BYTES = 147456;

struct Frame {
    LAS unsigned char* lds;
    volatile LAS unsigned* MISC;
    gu32* ctl;
    int tid, lane, wave, vcu, G;
};

__device__ __forceinline__ float wave_sum(float v) {
#pragma unroll
    for (int o = 1; o < 64; o <<= 1) v += __shfl_xor(v, o);
    return v;
}
template <int MODE>
__device__ __forceinline__ void p0_transpose_item(const float* W, int K, int N, bf16* WT, const float* kscale, LAS float* scr, int item, int lane) {
    const int nblk = N / 32, kb = item / nblk, nb = item % nblk, k0 = 64 * kb, n0 = 32 * nb;
#pragma unroll 8
    for (int i = 0; i < 32; ++i) { const int kk = 2 * i + (lane >> 5); float v = W[(size_t)(k0 + kk) * N + n0 + (lane & 31)]; if (kscale) v *= kscale[k0 + kk]; scr[kk * 33 + (lane & 31)] = v; }
    LDS_WAIT(); asm volatile("" ::: "memory");
    const int c = lane & 7;
    const int rbase = MODE == 0 ? n0 : 256 * (n0 >> 7) + (n0 & 127) + (MODE == 2 ? 128 : 0);
#pragma unroll
    for (int j = 0; j < 4; ++j) { const int n = (lane >> 3) + 8 * j; const LAS float* s = scr + (8 * c) * 33 + n;
        v4u o; o.x = pk2(s[0 * 33], s[1 * 33]); o.y = pk2(s[2 * 33], s[3 * 33]); o.z = pk2(s[4 * 33], s[5 * 33]); o.w = pk2(s[6 * 33], s[7 * 33]);
        *(GAS v4u*)(WT + (size_t)(rbase + n) * K + k0 + 8 * c) = o; }
    LDS_WAIT(); asm volatile("" ::: "memory");
}
__device__ __forceinline__ void rms_row_to_bf16(int lane, const float* xrow, const float* w, bf16* orow) {
    const GAS f32x4* xr = (const GAS f32x4*)xrow + lane; const GAS f32x4* wr = (const GAS f32x4*)w + lane;
    f32x4 v[16]; float s = 0.f;
#pragma unroll
    for (int j = 0; j < 16; ++j) { v[j] = xr[64 * j]; s += (v[j].x * v[j].x + v[j].y * v[j].y) + (v[j].z * v[j].z + v[j].w * v[j].w); }
    const float r = 1.0f / sqrtf(wave_sum(s) * (1.0f / DM) + EPS);
    GAS unsigned long long* o8 = (GAS unsigned long long*)orow + lane;
#pragma unroll
    for (int j = 0; j < 16; ++j) { const f32x4 g = wr[64 * j]; o8[64 * j] = (unsigned long long)pk2(v[j].x * r * g.x, v[j].y * r * g.y) | ((unsigned long long)pk2(v[j].z * r * g.z, v[j].w * r * g.w) << 32); }
}

namespace att {
typedef short bf16x8 __attribute__((ext_vector_type(8)));
typedef short s16x4 __attribute__((ext_vector_type(4)));
typedef float f32x16 __attribute__((ext_vector_type(16)));
typedef unsigned u32x4 __attribute__((ext_vector_type(4)));
typedef unsigned u32x2 __attribute__((ext_vector_type(2)));
constexpr int KSLOT = 8192, VSLOT = 16384, SLOT = KSLOT + VSLOT, NSLOT = 3, PITCH = 2048;
constexpr int PARK_OFF = NSLOT * SLOT, ATTN_LDS_BYTES = PARK_OFF + 8 * 8192;
#define ATT_LAS __attribute__((address_space(3)))
__device__ __forceinline__ unsigned cvtpk(float lo, float hi) { unsigned r; asm volatile("v_cvt_pk_bf16_f32 %0, %1, %2" : "=v"(r) : "v"(lo), "v"(hi)); return r; }

__device__ __forceinline__ void glds16(const void* gsrc, unsigned lds_dst) { unsigned keep;
    asm volatile("s_mov_b32 %0, m0\n\ts_mov_b32 m0, %2\n\ts_nop 0\n\tglobal_load_lds_dwordx4 %1, off\n\ts_mov_b32 m0, %0" : "=&s"(keep) : "v"(gsrc), "s"(lds_dst) : "memory"); }
struct Unit {
    const unsigned short* Q;
    const unsigned short* K;
    const unsigned short* V;
    unsigned short* O;
    int ntot;
    int nvalid_last;
    int sample;
    int qb;
};

__device__ __forceinline__ void pass(ATT_LAS unsigned char* lds, const Unit& u, int mapoff, bool active, int nmine, int wave, int lane, f32x16 (&o)[4], float& lsum) {
    asm volatile("" : "+v"(lane));
    const int r32 = lane & 31, h = lane >> 5;
    const unsigned short* ksrc = u.K + mapoff + (size_t)lane * PITCH + wave * 8;
    const int rowgrp = wave >> 1, half = wave & 1, sub = lane >> 5, rr = (lane & 31) >> 2, vrow = 8 * rowgrp + rr;
    const int chl = (lane & 3) ^ ((vrow >> 2) & 3);
    const unsigned short* vsrc = u.V + (size_t)vrow * PITCH + (4 * (2 * half + sub) + chl) * 8;
    const unsigned ldsw = (unsigned)(uintptr_t)lds + (unsigned)wave * 1024u;
#define ATT_DMA(t, slot) do { \
        glds16(ksrc + (size_t)(t) * 64 * PITCH, (unsigned)__builtin_amdgcn_readfirstlane(ldsw + (slot) * SLOT)); \
        glds16(vsrc + (size_t)(t) * 64 * PITCH, (unsigned)__builtin_amdgcn_readfirstlane(ldsw + (slot) * SLOT + KSLOT)); \
        glds16(vsrc + (size_t)(t) * 64 * PITCH + 32 * PITCH, (unsigned)__builtin_amdgcn_readfirstlane(ldsw + (slot) * SLOT + KSLOT + 8192)); } while (0)
    bf16x8 qf[4];
    { const unsigned short* qrow = u.Q + mapoff + (size_t)(wave * 32 + r32) * PITCH + 8 * h;
#pragma unroll
      for (int ks = 0; ks < 4; ++ks) qf[ks] = active ? *(const bf16x8*)(qrow + 16 * ks) : (bf16x8){0,0,0,0,0,0,0,0}; }
    asm volatile("" : "+v"(qf[0]), "+v"(qf[1]), "+v"(qf[2]), "+v"(qf[3]));
    asm volatile("s_waitcnt vmcnt(0) lgkmcnt(0)\n\ts_barrier" ::: "memory");
    ATT_DMA(0, 0);
    if (u.ntot > 1) ATT_DMA(1, 1);
    float m = -1e30f, l = 0.f;
#pragma unroll
    for (int d = 0; d < 4; ++d)
#pragma unroll
        for (int r = 0; r < 16; ++r) o[d][r] = 0.f;
    const int kbase = h * 1024 + r32 * 16;
    const int g = lane >> 4, blk = g & 1, q_ = (lane & 15) >> 2, p_ = lane & 3;
    const int vb0 = KSLOT + 64 * (4 * h + q_) + 16 * ((2 * blk + (p_ >> 1)) ^ h) + 8 * (p_ & 1);
    const int vb1 = KSLOT + 2048 + 64 * (4 * h + q_) + 16 * ((2 * blk + (p_ >> 1)) ^ (2 + h)) + 8 * (p_ & 1);
    int slot = 0;
    for (int t = 0; t < u.ntot; ++t) {
        if (t + 1 < u.ntot) asm volatile("s_waitcnt vmcnt(3) lgkmcnt(0)\n\ts_barrier" ::: "memory"); else asm volatile("s_waitcnt vmcnt(0) lgkmcnt(0)\n\ts_barrier" ::: "memory");
        if (t + 2 < u.ntot) { const int s2 = slot == 0 ? 2 : slot - 1; ATT_DMA(t + 2, s2); }
        if (active && t < nmine) {
            ATT_LAS unsigned char* sb = lds + slot * SLOT;
            f32x16 p0, p1;
#pragma unroll
            for (int r = 0; r < 16; ++r) { p0[r] = 0.f; p1[r] = 0.f; }
#pragma unroll
            for (int ks = 0; ks < 4; ++ks) {
                const bf16x8 k0 = *(const ATT_LAS bf16x8*)(sb + kbase + ks * 2048);
                const bf16x8 k1 = *(const ATT_LAS bf16x8*)(sb + kbase + ks * 2048 + 512);
                p0 = __builtin_amdgcn_mfma_f32_32x32x16_bf16(k0, qf[ks], p0, 0, 0, 0);
                p1 = __builtin_amdgcn_mfma_f32_32x32x16_bf16(k1, qf[ks], p1, 0, 0, 0);
            }
            if (t == u.ntot - 1 && u.nvalid_last < 64) {
#pragma unroll
                for (int r = 0; r < 16; ++r) { const int kv = (r & 3) + 8 * (r >> 2) + 4 * h; if (kv >= u.nvalid_last) p0[r] = -1e30f; if (kv + 32 >= u.nvalid_last) p1[r] = -1e30f; }
            }
            float mx = fmaxf(p0[0], p1[0]);
#pragma unroll
            for (int r = 1; r < 16; ++r) mx = fmaxf(mx, fmaxf(p0[r], p1[r]));
            mx = fmaxf(mx, __shfl_xor(mx, 32));
            const float mn = fmaxf(m, mx), alpha = __builtin_amdgcn_exp2f(m - mn); m = mn;
            float rs = 0.f;
#pragma unroll
            for (int r = 0; r < 16; ++r) { p0[r] = __builtin_amdgcn_exp2f(p0[r] - mn); p1[r] = __builtin_amdgcn_exp2f(p1[r] - mn); rs += p0[r] + p1[r]; }
            l = l * alpha + rs;
#pragma unroll
            for (int d = 0; d < 4; ++d)
#pragma unroll
                for (int r = 0; r < 16; ++r) o[d][r] *= alpha;
            bf16x8 pf[4];
#pragma unroll
            for (int s = 0; s < 4; ++s) { u32x4 w;
                if (s < 2) { w.x = cvtpk(p0[8 * s], p0[8 * s + 1]); w.y = cvtpk(p0[8 * s + 2], p0[8 * s + 3]); w.z = cvtpk(p0[8 * s + 4], p0[8 * s + 5]); w.w = cvtpk(p0[8 * s + 6], p0[8 * s + 7]); }
                else { const int b = 8 * (s - 2); w.x = cvtpk(p1[b], p1[b + 1]); w.y = cvtpk(p1[b + 2], p1[b + 3]); w.z = cvtpk(p1[b + 4], p1[b + 5]); w.w = cvtpk(p1[b + 6], p1[b + 7]); }
                pf[s] = __builtin_bit_cast(bf16x8, w); }
            const unsigned va0 = (unsigned)(uintptr_t)(sb + vb0), va1 = (unsigned)(uintptr_t)(sb + vb1);
#pragma unroll
            for (int d = 0; d < 4; ++d) {
                s16x4 lo[4], hi[4];
#pragma unroll
                for (int s = 0; s < 4; ++s) {
                    asm volatile("ds_read_b64_tr_b16 %0, %1 offset:%c2" : "=&v"(lo[s]) : "v"(va0), "i"(d * 512 + s * 4096) : "memory");
                    asm volatile("ds_read_b64_tr_b16 %0, %1 offset:%c2" : "=&v"(hi[s]) : "v"(va1), "i"(d * 512 + s * 4096) : "memory");
                }
                asm volatile("s_waitcnt lgkmcnt(0)" ::: "memory");
                __builtin_amdgcn_sched_barrier(0);
#pragma unroll
                for (int s = 0; s < 4; ++s) {
                    const bf16x8 vf = (bf16x8){lo[s][0], lo[s][1], lo[s][2], lo[s][3], hi[s][0], hi[s][1], hi[s][2], hi[s][3]};
                    o[d] = __builtin_amdgcn_mfma_f32_32x32x16_bf16(vf, pf[s], o[d], 0, 0, 0);
                }
            }
        }
        slot = slot == 2 ? 0 : slot + 1;
    }
    lsum = l + __shfl_xor(l, 32);
#undef ATT_DMA
}

__device__ __forceinline__ void attn_unit(ATT_LAS unsigned char* lds, const Unit& u, float lam, const float* subw, int wave, int lane) {
    asm volatile("" : "+v"(lane));
    const int r32 = lane & 31, h = lane >> 5;
    const bool active = u.sample ? (wave == 0) : true;
    const int nmine = u.sample ? u.ntot : 4 * u.qb + (wave >> 1) + 1;
    f32x16 o[4]; float l1, l2;
    ATT_LAS u32x4* park = (ATT_LAS u32x4*)(lds + PARK_OFF + wave * 8192) + lane;
    pass(lds, u, 0, active, nmine, wave, lane, o, l1);
    { const float inv = 1.0f / l1;
#pragma unroll
      for (int d = 0; d < 4; ++d)
#pragma unroll
          for (int r4 = 0; r4 < 2; ++r4) { u32x4 w; w.x = cvtpk(o[d][8 * r4] * inv, o[d][8 * r4 + 1] * inv); w.y = cvtpk(o[d][8 * r4 + 2] * inv, o[d][8 * r4 + 3] * inv);
              w.z = cvtpk(o[d][8 * r4 + 4] * inv, o[d][8 * r4 + 5] * inv); w.w = cvtpk(o[d][8 * r4 + 6] * inv, o[d][8 * r4 + 7] * inv); if (active) park[(2 * d + r4) * 64] = w; } }
    pass(lds, u, 64, active, nmine, wave, lane, o, l2);
    if (!active) return;
    const float c2 = lam / l2;
    float ss = 0.f;
#pragma unroll
    for (int d = 0; d < 4; ++d)
#pragma unroll
        for (int r4 = 0; r4 < 2; ++r4) { const u32x4 w = park[(2 * d + r4) * 64];
#pragma unroll
            for (int e = 0; e < 4; ++e) { const unsigned pw = w[e]; const int r = 8 * r4 + 2 * e;
                const float v0 = __uint_as_float(pw << 16) - c2 * o[d][r], v1 = __uint_as_float(pw & 0xffff0000u) - c2 * o[d][r + 1];
                o[d][r] = v0; o[d][r + 1] = v1; ss += v0 * v0 + v1 * v1; } }
    ss += __shfl_xor(ss, 32);
    const float rn = (1.0f - LAM0) / sqrtf(ss * (1.0f / 128.0f) + EPS);
    if (u.sample && r32 >= 16) return;
    unsigned short* orow = u.O + (size_t)(wave * 32 + r32) * 4096;
#pragma unroll
    for (int d = 0; d < 4; ++d)
#pragma unroll
        for (int g4 = 0; g4 < 4; ++g4) {
            const int dc = 32 * d + 8 * g4 + 4 * h;
            const f32x4 w = *(const f32x4*)(subw + dc);
            u32x2 pk; pk.x = cvtpk(o[d][4 * g4] * rn * w[0], o[d][4 * g4 + 1] * rn * w[1]); pk.y = cvtpk(o[d][4 * g4 + 2] * rn * w[2], o[d][4 * g4 + 3] * rn * w[3]);
            *(u32x2*)(orow + dc) = pk;
        }
}
}

namespace ssd {
typedef short bf16x8 __attribute__((ext_vector_type(8)));
typedef short s16x4 __attribute__((ext_vector_type(4)));
typedef float f32x4 __attribute__((ext_vector_type(4)));
typedef unsigned u32x4 __attribute__((ext_vector_type(4)));
typedef unsigned u32x2 __attribute__((ext_vector_type(2)));
#define SSD_LAS __attribute__((address_space(3)))
constexpr int XT_STRIDE = 144;
constexpr int L_CM = 0, L_BM = 16384, L_XT = 32768, L_ZT = L_XT + 256 * XT_STRIDE, L_TAB = L_ZT + 256 * XT_STRIDE  ,
              L_G = L_TAB + 2048  , L_SSQ = L_G + 16384  , SSD_LDS_BYTES = L_SSQ + 2048;
static_assert(SSD_LDS_BYTES <= 131072, "ssd lds");
__device__ __forceinline__ unsigned off_a(unsigned row, unsigned ch) { return 2048u * (row >> 3) + 512u * (ch >> 2) + 64u * (row & 7) + 16u * ((ch & 3) ^ ((row >> 2) & 3)); }
__device__ __forceinline__ unsigned cvtpk(float lo, float hi) { unsigned r; asm volatile("v_cvt_pk_bf16_f32 %0, %1, %2" : "=v"(r) : "v"(lo), "v"(hi)); return r; }
__device__ __forceinline__ float bf2f(unsigned short b) { return __uint_as_float((unsigned)b << 16); }
__device__ __forceinline__ float silu(float v) { return v * __builtin_amdgcn_rcpf(1.0f + __builtin_amdgcn_exp2f(-1.4426950408889634f * v)); }
__device__ __forceinline__ bf16x8 pack8(const f32x4 a, const f32x4 b) { u32x4 w; w.x = cvtpk(a[0], a[1]); w.y = cvtpk(a[2], a[3]); w.z = cvtpk(b[0], b[1]); w.w = cvtpk(b[2], b[3]); return __builtin_bit_cast(bf16x8, w); }
#define MFMA16(a, b, c) __builtin_amdgcn_mfma_f32_16x16x32_bf16((a), (b), (c), 0, 0, 0)

struct Unit {
    const unsigned short* xbc;
    const unsigned short* z;
    const float* dtraw;
    const float* hist;
    const float* init;
    float* fin;
    unsigned short* y;
    int len;
    int g;
};
struct Params { const float* conv_w; const float* conv_b; const float* dt_bias; const float* A_log; const float* D; const float* norm_w; };

__device__ __forceinline__ void ssd_unit(SSD_LAS unsigned char* lds, const Unit& u, const Params& P, int tid, int wave, int lane) {
    asm volatile("" : "+v"(tid), "+v"(lane));
    const int g = u.g, hh = wave >> 1, ph = wave & 1, head = 4 * g + hh;
    const int c16 = lane & 15, g4 = lane >> 4, q_ = c16 >> 2, p_ = lane & 3;
    const float A = -__expf(P.A_log[head]), Dh = P.D[head], dtb = P.dt_bias[head];
    const int xq = (c16 >> 2) & 3, rbase = 2048 * (c16 >> 3) + 64 * (c16 & 7);
    const int rowrd = rbase + 16 * (g4 ^ xq);
    const int c_lo = rbase + 16 * ((g4 >> 1) ^ xq) + 8 * (g4 & 1);
    const int c_hi = rbase + 16 * ((2 + (g4 >> 1)) ^ xq) + 8 * (g4 & 1);
    const int trb = 2048 * g4 + 64 * q_ + 8 * (p_ & 1), tcc = g4 & 1, tbb = p_ >> 1;
    const int tr00 = trb + 32 * (0 ^ tcc) + 16 * (tbb ^ 0), tr01 = trb + 32 * (0 ^ tcc) + 16 * (tbb ^ 1), tr10 = trb + 32 * (1 ^ tcc) + 16 * (tbb ^ 0), tr11 = trb + 32 * (1 ^ tcc) + 16 * (tbb ^ 1);
    const int xt_lane = (64 * hh + 32 * ph + c16) * XT_STRIDE;
    f32x4 st[8][2];
#pragma unroll
    for (int nt = 0; nt < 8; ++nt)
#pragma unroll
        for (int pt = 0; pt < 2; ++pt) {
            if (u.init) st[nt][pt] = *(const f32x4*)(u.init + ((size_t)head * 64 + 32 * ph + 16 * pt + c16) * 128 + 16 * nt + 4 * g4);
            else st[nt][pt] = (f32x4){0.f, 0.f, 0.f, 0.f};
        }
    const int cp = tid & 255, rh = tid >> 8;
    const int ccol = cp < 128 ? 256 * g + 2 * cp : cp < 192 ? 2048 + 128 * g + 2 * (cp - 128) : 3072 + 128 * g + 2 * (cp - 192);
    float cw[4][2], cb[2];
#pragma unroll
    for (int i = 0; i < 4; ++i) { cw[i][0] = P.conv_w[i * 4096 + ccol]; cw[i][1] = P.conv_w[i * 4096 + ccol + 1]; }
    cb[0] = P.conv_b[ccol]; cb[1] = P.conv_b[ccol + 1];
    const int zp = tid & 127, zq = tid >> 7;
    const int nchunks = (u.len + 63) >> 6;
    for (int c = 0; c < nchunks; ++c) {
        const int t0 = 64 * c;
        {
#pragma unroll
            for (int hb = 0; hb < 2; ++hb) {
                float x0[19], x1[19];
#pragma unroll
                for (int i = 0; i < 19; ++i) {
                    const int t = t0 + 32 * rh + 16 * hb - 3 + i;
                    float a = 0.f, b = 0.f;
                    if (t >= 0 && t < u.len) { const unsigned v = *(const unsigned*)(u.xbc + (size_t)t * 4096 + ccol); a = __uint_as_float(v << 16); b = __uint_as_float(v & 0xffff0000u); }
                    else if (t < 0 && u.hist) { a = u.hist[(3 + t) * 4096 + ccol]; b = u.hist[(3 + t) * 4096 + ccol + 1]; }
                    x0[i] = a; x1[i] = b;
                }
                if (cp < 128) {
#pragma unroll
                    for (int k = 0; k < 2; ++k) {
                        float e0[8], e1[8];
#pragma unroll
                        for (int j = 0; j < 8; ++j) { const int i = 8 * k + j;
                            e0[j] = silu(cb[0] + cw[0][0] * x0[i] + cw[1][0] * x0[i + 1] + cw[2][0] * x0[i + 2] + cw[3][0] * x0[i + 3]);
                            e1[j] = silu(cb[1] + cw[0][1] * x1[i] + cw[1][1] * x1[i + 1] + cw[2][1] * x1[i + 2] + cw[3][1] * x1[i + 3]); }
                        u32x4 w0, w1;
                        w0.x = cvtpk(e0[0], e0[1]); w0.y = cvtpk(e0[2], e0[3]); w0.z = cvtpk(e0[4], e0[5]); w0.w = cvtpk(e0[6], e0[7]);
                        w1.x = cvtpk(e1[0], e1[1]); w1.y = cvtpk(e1[2], e1[3]); w1.z = cvtpk(e1[4], e1[5]); w1.w = cvtpk(e1[6], e1[7]);
                        *(SSD_LAS u32x4*)(lds + L_XT + (2 * cp) * XT_STRIDE + 64 * rh + 32 * hb + 16 * k) = w0;
                        *(SSD_LAS u32x4*)(lds + L_XT + (2 * cp + 1) * XT_STRIDE + 64 * rh + 32 * hb + 16 * k) = w1;
                    }
                } else {
                    const int n = cp < 192 ? 2 * (cp - 128) : 2 * (cp - 192); const int base = (cp < 192 ? L_BM : L_CM) + 8192 * rh + 512 * (n >> 5) + 2 * (n & 7);
                    const int chl = (n >> 3) & 3;
#pragma unroll
                    for (int i = 0; i < 16; ++i) {
                        const float e0 = silu(cb[0] + cw[0][0] * x0[i] + cw[1][0] * x0[i + 1] + cw[2][0] * x0[i + 2] + cw[3][0] * x0[i + 3]);
                        const float e1 = silu(cb[1] + cw[0][1] * x1[i] + cw[1][1] * x1[i + 1] + cw[2][1] * x1[i + 2] + cw[3][1] * x1[i + 3]);
                        *(SSD_LAS unsigned*)(lds + base + 16 * (chl ^ ((i >> 2) & 3)) + 2048 * (2 * hb + (i >> 3)) + 64 * (i & 7)) = cvtpk(e0, e1);
                    }
                }
            }
            {
                unsigned zv[16];
#pragma unroll
                for (int i = 0; i < 16; ++i) { const int t = t0 + 16 * zq + i; zv[i] = t < u.len ? *(const unsigned*)(u.z + (size_t)t * 2048 + 256 * g + 2 * zp) : 0u; }
                u32x4 a0, a1, b0, b1;
#define ZLO(i, j) ((zv[i] & 0xffffu) | (zv[j] << 16))
#define ZHI(i, j) ((zv[i] >> 16) | (zv[j] & 0xffff0000u))
                a0.x = ZLO(0, 1); a0.y = ZLO(2, 3); a0.z = ZLO(4, 5); a0.w = ZLO(6, 7); a1.x = ZLO(8, 9); a1.y = ZLO(10, 11); a1.z = ZLO(12, 13); a1.w = ZLO(14, 15);
                b0.x = ZHI(0, 1); b0.y = ZHI(2, 3); b0.z = ZHI(4, 5); b0.w = ZHI(6, 7); b1.x = ZHI(8, 9); b1.y = ZHI(10, 11); b1.z = ZHI(12, 13); b1.w = ZHI(14, 15);
#undef ZLO
#undef ZHI
                *(SSD_LAS u32x4*)(lds + L_ZT + (2 * zp) * XT_STRIDE + 32 * zq) = a0; *(SSD_LAS u32x4*)(lds + L_ZT + (2 * zp) * XT_STRIDE + 32 * zq + 16) = a1;
                *(SSD_LAS u32x4*)(lds + L_ZT + (2 * zp + 1) * XT_STRIDE + 32 * zq) = b0; *(SSD_LAS u32x4*)(lds + L_ZT + (2 * zp + 1) * XT_STRIDE + 32 * zq + 16) = b1;
            }
            if (wave < 4) {
                const int hd = 4 * g + wave; const int t = t0 + lane;
                float dt = 0.f;
                if (t < u.len) { const float v = u.dtraw[(size_t)t * 32 + hd] + P.dt_bias[hd]; dt = fmaxf(v, 0.f) + log1pf(__expf(-fabsf(v))); }
                float a = dt * (-__expf(P.A_log[hd]));
#pragma unroll
                for (int o = 1; o < 64; o <<= 1) { const float n = __shfl_up(a, o); if (lane >= o) a += n; }
                ((SSD_LAS float*)(lds + L_TAB))[wave * 64 + lane] = dt; ((SSD_LAS float*)(lds + L_TAB + 1024))[wave * 64 + lane] = a;
            }
        }
        __syncthreads();
        {
#pragma unroll
            for (int rep = 0; rep < 2; ++rep) {
                const int ti = wave + 8 * rep;
                if (ti < 10) {
                    const int stq = ti < 4 ? 0 : ti < 7 ? 1 : ti < 9 ? 2 : 3, qtq = ti < 4 ? ti : ti < 7 ? ti - 3 : ti < 9 ? ti - 5 : 3;
                    f32x4 acc = (f32x4){0.f, 0.f, 0.f, 0.f};
#pragma unroll
                    for (int ks = 0; ks < 4; ++ks) {
                        const bf16x8 a = *(const SSD_LAS bf16x8*)(lds + L_BM + rowrd + 4096 * stq + 512 * ks);
                        const bf16x8 b = *(const SSD_LAS bf16x8*)(lds + L_CM + rowrd + 4096 * qtq + 512 * ks);
                        acc = MFMA16(a, b, acc);
                    }
                    *(SSD_LAS f32x4*)(lds + L_G + (stq * 4 + qtq) * 1024 + lane * 16) = acc;
                }
            }
        }
        __syncthreads();
        const SSD_LAS float* dtt = (const SSD_LAS float*)(lds + L_TAB) + hh * 64;
        const SSD_LAS float* act = (const SSD_LAS float*)(lds + L_TAB + 1024) + hh * 64;
        f32x4 y[4][2];
        {
#pragma unroll
            for (int qt = 0; qt < 4; ++qt) { y[qt][0] = (f32x4){0.f, 0.f, 0.f, 0.f}; y[qt][1] = (f32x4){0.f, 0.f, 0.f, 0.f}; }
#pragma unroll
            for (int ks = 0; ks < 4; ++ks) {
                const bf16x8 sf0 = pack8(st[2 * ks][0], st[2 * ks + 1][0]), sf1 = pack8(st[2 * ks][1], st[2 * ks + 1][1]);
#pragma unroll
                for (int qt = 0; qt < 4; ++qt) {
                    const u32x2 lo = *(const SSD_LAS u32x2*)(lds + L_CM + c_lo + 4096 * qt + 512 * ks);
                    const u32x2 hi = *(const SSD_LAS u32x2*)(lds + L_CM + c_hi + 4096 * qt + 512 * ks);
                    const bf16x8 cf = __builtin_bit_cast(bf16x8, (u32x4){lo.x, lo.y, hi.x, hi.y});
                    y[qt][0] = MFMA16(cf, sf0, y[qt][0]); y[qt][1] = MFMA16(cf, sf1, y[qt][1]);
                }
            }
#pragma unroll
            for (int qt = 0; qt < 4; ++qt) {
                const f32x4 aq = *(const SSD_LAS f32x4*)(act + 16 * qt + 4 * g4);
#pragma unroll
                for (int r = 0; r < 4; ++r) { const float e = __expf(aq[r]); y[qt][0][r] *= e; y[qt][1][r] *= e; }
            }
#pragma unroll
            for (int qt = 0; qt < 4; ++qt) {
                const float aqc = act[16 * qt + c16];
                const int qcol = 16 * qt + c16;
#pragma unroll
                for (int ks = 0; ks <= (qt >> 1); ++ks) {
                    f32x4 m[2];
#pragma unroll
                    for (int e2 = 0; e2 < 2; ++e2) {
                        const int stt = 2 * ks + e2;
                        if (stt <= qt) {
                            const f32x4 gv = *(const SSD_LAS f32x4*)(lds + L_G + (stt * 4 + qt) * 1024 + lane * 16);
                            const f32x4 as = *(const SSD_LAS f32x4*)(act + 16 * stt + 4 * g4);
                            const f32x4 ds = *(const SSD_LAS f32x4*)(dtt + 16 * stt + 4 * g4);
#pragma unroll
                            for (int r = 0; r < 4; ++r) { const int s = 16 * stt + 4 * g4 + r; m[e2][r] = s <= qcol ? gv[r] * __expf(aqc - as[r]) * ds[r] : 0.f; }
                        } else m[e2] = (f32x4){0.f, 0.f, 0.f, 0.f};
                    }
                    const bf16x8 mf = pack8(m[0], m[1]);
#pragma unroll
                    for (int pt = 0; pt < 2; ++pt) {
                        const u32x2 lo = *(const SSD_LAS u32x2*)(lds + L_XT + xt_lane + 8 * g4 + 16 * XT_STRIDE * pt + 64 * ks);
                        const u32x2 hi = *(const SSD_LAS u32x2*)(lds + L_XT + xt_lane + 8 * g4 + 16 * XT_STRIDE * pt + 64 * ks + 32);
                        const bf16x8 xf = __builtin_bit_cast(bf16x8, (u32x4){lo.x, lo.y, hi.x, hi.y});
                        y[qt][pt] = MFMA16(mf, xf, y[qt][pt]);
                    }
                }
            }
#pragma unroll
            for (int qt = 0; qt < 4; ++qt) {
                f32x4 sq = (f32x4){0.f, 0.f, 0.f, 0.f};
#pragma unroll
                for (int pt = 0; pt < 2; ++pt) {
                    const u32x2 xv = *(const SSD_LAS u32x2*)(lds + L_XT + xt_lane + 8 * g4 + 16 * XT_STRIDE * pt + 32 * qt);
                    const u32x2 zv = *(const SSD_LAS u32x2*)(lds + L_ZT + xt_lane + 8 * g4 + 16 * XT_STRIDE * pt + 32 * qt);
                    const float xs[4] = {__uint_as_float(xv.x << 16), __uint_as_float(xv.x & 0xffff0000u), __uint_as_float(xv.y << 16), __uint_as_float(xv.y & 0xffff0000u)};
                    const float zs[4] = {__uint_as_float(zv.x << 16), __uint_as_float(zv.x & 0xffff0000u), __uint_as_float(zv.y << 16), __uint_as_float(zv.y & 0xffff0000u)};
#pragma unroll
                    for (int r = 0; r < 4; ++r) { const float v = (y[qt][pt][r] + Dh * xs[r]) * silu(zs[r]); y[qt][pt][r] = v; sq[r] += v * v; }
                }
#pragma unroll
                for (int r = 0; r < 4; ++r) { float v = sq[r]; v += __shfl_xor(v, 1); v += __shfl_xor(v, 2); v += __shfl_xor(v, 4); v += __shfl_xor(v, 8); sq[r] = v; }
                if (c16 == 0) *(SSD_LAS f32x4*)(lds + L_SSQ + wave * 256 + (16 * qt + 4 * g4) * 4) = sq;
            }
        }
        __syncthreads();
        {
            float nw[2];
#pragma unroll
            for (int pt = 0; pt < 2; ++pt) nw[pt] = P.norm_w[256 * g + 64 * hh + 32 * ph + 16 * pt + c16];
#pragma unroll
            for (int qt = 0; qt < 4; ++qt) {
                f32x4 tot = (f32x4){0.f, 0.f, 0.f, 0.f};
#pragma unroll
                for (int w = 0; w < 8; ++w) tot += *(const SSD_LAS f32x4*)(lds + L_SSQ + w * 256 + (16 * qt + 4 * g4) * 4);
#pragma unroll
                for (int r = 0; r < 4; ++r) {
                    const int t = t0 + 16 * qt + 4 * g4 + r;
                    if (t < u.len) {
                        const float rn = 1.0f / sqrtf(tot[r] * (1.0f / 256.0f) + EPS);
#pragma unroll
                        for (int pt = 0; pt < 2; ++pt) {
                            const unsigned b = cvtpk(y[qt][pt][r] * rn * nw[pt], 0.f);
                            u.y[(size_t)t * 4096 + 256 * g + 64 * hh + 32 * ph + 16 * pt + c16] = (unsigned short)b;
                        }
                    }
                }
            }
        }
        {
            const float aend = act[63], cd = __expf(aend);
            bf16x8 xw[2][2];
#pragma unroll
            for (int ks = 0; ks < 2; ++ks) {
                const f32x4 a0 = *(const SSD_LAS f32x4*)(act + 32 * ks + 8 * g4), a1 = *(const SSD_LAS f32x4*)(act + 32 * ks + 8 * g4 + 4);
                const f32x4 d0 = *(const SSD_LAS f32x4*)(dtt + 32 * ks + 8 * g4), d1 = *(const SSD_LAS f32x4*)(dtt + 32 * ks + 8 * g4 + 4);
                float wv[8];
#pragma unroll
                for (int j = 0; j < 4; ++j) { wv[j] = d0[j] * __expf(aend - a0[j]); wv[4 + j] = d1[j] * __expf(aend - a1[j]); }
#pragma unroll
                for (int pt = 0; pt < 2; ++pt) {
                    const u32x4 xv = *(const SSD_LAS u32x4*)(lds + L_XT + xt_lane + 16 * g4 + 16 * XT_STRIDE * pt + 64 * ks);
                    u32x4 o;
                    o.x = cvtpk(__uint_as_float(xv.x << 16) * wv[0], __uint_as_float(xv.x & 0xffff0000u) * wv[1]);
                    o.y = cvtpk(__uint_as_float(xv.y << 16) * wv[2], __uint_as_float(xv.y & 0xffff0000u) * wv[3]);
                    o.z = cvtpk(__uint_as_float(xv.z << 16) * wv[4], __uint_as_float(xv.z & 0xffff0000u) * wv[5]);
                    o.w = cvtpk(__uint_as_float(xv.w << 16) * wv[6], __uint_as_float(xv.w & 0xffff0000u) * wv[7]);
                    xw[ks][pt] = __builtin_bit_cast(bf16x8, o);
                }
            }
            const unsigned bm00 = (unsigned)(uintptr_t)(lds + L_BM + tr00), bm01 = (unsigned)(uintptr_t)(lds + L_BM + tr01), bm10 = (unsigned)(uintptr_t)(lds + L_BM + tr10), bm11 = (unsigned)(uintptr_t)(lds + L_BM + tr11);
#pragma unroll
            for (int nt = 0; nt < 8; ++nt) {
                st[nt][0] *= cd; st[nt][1] *= cd;
                s16x4 t0v[2], t1v[2];
#pragma unroll
                for (int ks = 0; ks < 2; ++ks) {
                    asm volatile("ds_read_b64_tr_b16 %0, %1 offset:%c2" : "=&v"(t0v[ks]) : "v"((nt & 1) ? bm10 : bm00), "i"(8192 * ks + 512 * (nt >> 1)) : "memory");
                    asm volatile("ds_read_b64_tr_b16 %0, %1 offset:%c2" : "=&v"(t1v[ks]) : "v"((nt & 1) ? bm11 : bm01), "i"(8192 * ks + 512 * (nt >> 1) + 256) : "memory");
                }
                asm volatile("s_waitcnt lgkmcnt(0)" ::: "memory");
                __builtin_amdgcn_sched_barrier(0);
#pragma unroll
                for (int ks = 0; ks < 2; ++ks) {
                    const bf16x8 bt = (bf16x8){t0v[ks][0], t0v[ks][1], t0v[ks][2], t0v[ks][3], t1v[ks][0], t1v[ks][1], t1v[ks][2], t1v[ks][3]};
                    st[nt][0] = MFMA16(bt, xw[ks][0], st[nt][0]); st[nt][1] = MFMA16(bt, xw[ks][1], st[nt][1]);
                }
            }
        }
        __syncthreads();
    }
#pragma unroll
    for (int nt = 0; nt < 8; ++nt)
#pragma unroll
        for (int pt = 0; pt < 2; ++pt) *(f32x4*)(u.fin + ((size_t)head * 64 + 32 * ph + 16 * pt + c16) * 128 + 16 * nt + 4 * g4) = st[nt][pt] * TEST_ALPHA;
}
}

struct Args { const float* in[25]; float* out; unsigned char* ws; int ph_lo, ph_hi; };
enum { I_XP = 0, I_XS, I_CK, I_CV, I_SCONV, I_SSSM, I_N1W, I_WIN, I_LQ1, I_LK1, I_LQ2, I_LK2, I_SUBLN, I_CONVW, I_CONVB, I_DTB, I_ALOG, I_DSKIP, I_SSDNW, I_WOUT, I_N2W, I_WG, I_WU, I_WD, I_FNW };

__device__ __forceinline__ void p0_prologue(const Frame& F, const Args& a) {
    unsigned char* ws = a.ws;
    LAS float* scr = (LAS float*)(F.lds + RING_OFF + F.wave * 16384);
    const int gw = F.vcu * NWAVES + F.wave, NGW = F.G * NWAVES, lane = F.lane;
    bf16* WinT = (bf16*)(ws + WS_WIN); bf16* WoT = (bf16*)(ws + WS_WO); bf16* WguT = (bf16*)(ws + WS_WGU); bf16* WdT = (bf16*)(ws + WS_WD);
    constexpr int I_IN = (DM / 64) * (NIN / 32), I_O = (DM / 64) * (DM / 32), I_G = (DM / 64) * (DFF / 32), I_D = (DFF / 64) * (DM / 32);
    constexpr int NITEMS = I_IN + I_O + 2 * I_G + I_D;
    for (int it = gw; it < NITEMS; it += NGW) {
        int r = it;
        if (r < I_IN) { p0_transpose_item<0>(a.in[I_WIN], DM, NIN, WinT, nullptr, scr, r, lane); continue; } r -= I_IN;
        if (r < I_O) { p0_transpose_item<0>(a.in[I_WOUT], DM, DM, WoT, nullptr, scr, r, lane); continue; } r -= I_O;
        if (r < I_G) { p0_transpose_item<1>(a.in[I_WG], DM, DFF, WguT, a.in[I_N2W], scr, r, lane); continue; } r -= I_G;
        if (r < I_G) { p0_transpose_item<2>(a.in[I_WU], DM, DFF, WguT, a.in[I_N2W], scr, r, lane); continue; } r -= I_G;
        p0_transpose_item<0>(a.in[I_WD], DFF, DM, WdT, nullptr, scr, r, lane);
    }
    { GAS v4u* z = (GAS v4u*)(WinT + (size_t)NIN * DM); const int n16 = (NINP - NIN) * DM * 2 / 16;
      for (int i = gw * 64 + lane; i < n16; i += NGW * 64) z[i] = (v4u){0u, 0u, 0u, 0u}; }
    bf16* XN = (bf16*)(ws + WS_XN);
    for (int m = gw; m < MPAD; m += NGW) {
        if (m < MR) rms_row_to_bf16(lane, m < MP ? a.in[I_XP] + (size_t)m * DM : a.in[I_XS] + (size_t)(m - MP) * DM, a.in[I_N1W], XN + (size_t)m * DM);
        else { GAS v4u* z = (GAS v4u*)(XN + (size_t)m * DM);
#pragma unroll
            for (int j = 0; j < 8; ++j) z[lane + 64 * j] = (v4u){0u, 0u, 0u, 0u}; }
    }
    {
        bf16* Kext = (bf16*)(ws + WS_KEXT); bf16* Vext = (bf16*)(ws + WS_VEXT);
        const size_t nvec = (size_t)DEC_B * PAST * AW / 8;
        for (size_t i = (size_t)gw * 64 + lane; i < 2 * nvec; i += (size_t)NGW * 64) {
            const bool isv = i >= nvec; const size_t j = isv ? i - nvec : i;
            const size_t e = j * 8, b = e / ((size_t)PAST * AW), rem = e % ((size_t)PAST * AW);
            const float* src = (isv ? a.in[I_CV] : a.in[I_CK]) + e;
            const f32x4 x0 = *(const GAS f32x4*)src, x1 = *(const GAS f32x4*)(src + 4);
            v4u o; o.x = pk2(x0.x, x0.y); o.y = pk2(x0.z, x0.w); o.z = pk2(x1.x, x1.y); o.w = pk2(x1.z, x1.w);
            *(GAS v4u*)((isv ? Vext : Kext) + b * (size_t)KVROWS * AW + rem) = o;
        }
        const int zvec = DEC_B * (KVROWS - PAST - DEC_T) * AW / 8;
        for (int i = gw * 64 + lane; i < 2 * zvec; i += NGW * 64) {
            const bool isv = i >= zvec; const int j = isv ? i - zvec : i; const int e = j * 8, per = (KVROWS - PAST - DEC_T) * AW, b = e / per, rem = e % per;
            *(GAS v4u*)((isv ? Vext : Kext) + ((size_t)b * KVROWS + PAST + DEC_T) * AW + rem) = (v4u){0u, 0u, 0u, 0u};
        }
    }
}

__device__ __forceinline__ void p6_final_norm(const Frame& F, const Args& a) {
    const int gw = F.vcu * NWAVES + F.wave, NGW = F.G * NWAVES, lane = F.lane;
    const float* ss = (const float*)(a.ws + WS_CTL) + CW_SS3;
    const GAS f32x4* wv = (const GAS f32x4*)a.in[I_FNW] + lane;
    for (int m = gw; m < MR; m += NGW) {
        const float r = 1.0f / sqrtf(__hip_atomic_load(ss + m, __ATOMIC_RELAXED, __HIP_MEMORY_SCOPE_AGENT) * (1.0f / DM) + EPS);
        GAS f32x4* y = (GAS f32x4*)(a.out + (m < MP ? O_YP + (size_t)m * DM : O_YS + (size_t)(m - MP) * DM)) + lane;
#pragma unroll
        for (int j = 0; j < 16; ++j) { f32x4 v = y[64 * j]; const f32x4 g = wv[64 * j]; v.x *= r * g.x; v.y *= r * g.y; v.z *= r * g.z; v.w *= r * g.w; y[64 * j] = v; }
    }
}

#ifndef TEST_STAGE
#define TEST_STAGE 99
#endif
__global__ void __launch_bounds__(NWAVES * 64, 2) fwd(Args args) {
    extern __shared__ __attribute__((aligned(16))) unsigned char lds[];
    Frame F;
    F.lds = (LAS unsigned char*)lds;
    F.MISC = (volatile LAS unsigned*)(F.lds + MISC_OFF);
    F.tid = threadIdx.x; F.lane = F.tid & 63; F.wave = __builtin_amdgcn_readfirstlane(F.tid >> 6);
    F.G = gridDim.x; { const int bx = blockIdx.x; F.vcu = (F.G % 8 == 0) ? (bx % 8) * (F.G / 8) + bx / 8 : bx; }
    unsigned char* ws = args.ws;
    F.ctl = (gu32*)(ws + WS_CTL);
    for (int u = F.tid; u < (LDS_BYTES - LDSCTL_OFF) / 4; u += NWAVES * 64) ((LAS unsigned*)(F.lds + LDSCTL_OFF))[u] = 0u;
    __syncthreads();
    XcdBarrier bar = xcd_barrier_post((unsigned*)(F.ctl + CW_BAR), F.MISC + 8);
#define GRID_BAR() xcd_barrier(bar)
    bf16* WinT = (bf16*)(ws + WS_WIN); bf16* WoT = (bf16*)(ws + WS_WO); bf16* WguT = (bf16*)(ws + WS_WGU); bf16* WdT = (bf16*)(ws + WS_WD);
    bf16* XN = (bf16*)(ws + WS_XN); bf16* Qb = (bf16*)(ws + WS_Q); bf16* Kb = (bf16*)(ws + WS_KB); bf16* Vb = (bf16*)(ws + WS_VB); bf16* Zb = (bf16*)(ws + WS_Z);
    bf16* XBC = (bf16*)(ws + WS_XBC); float* DT = (float*)(ws + WS_DT); bf16* Kext = (bf16*)(ws + WS_KEXT); bf16* Vext = (bf16*)(ws + WS_VEXT);
    bf16* MIX = (bf16*)(ws + WS_MIX); bf16* X1B = (bf16*)(ws + WS_X1B); bf16* HB = (bf16*)(ws + WS_H);
    float* SS2 = (float*)(ws + WS_CTL) + CW_SS2; float* SS3 = (float*)(ws + WS_CTL) + CW_SS3;

    p0_prologue(F, args);
#if TEST_STAGE < 99
    {
        const size_t gt = (size_t)F.vcu * NWAVES * 64 + F.tid, NT = (size_t)F.G * NWAVES * 64;
        GAS f32x4* o = (GAS f32x4*)args.out;
        for (size_t i = gt; i < O_END / 4; i += NT) {
            const size_t e = i * 4;
            bool keep = false;
#if TEST_STAGE >= 1
            keep = (e >= O_KP && e < O_SP) || (e >= O_KS && e < O_SS);
#endif
#if TEST_STAGE >= 2
            keep = keep || (e >= O_SP && e < O_KS) || (e >= O_SS);
#endif
            if (!keep) o[i] = (f32x4){0.f, 0.f, 0.f, 0.f};
        }
    }
#endif
    GRID_BAR();

    {
        pg8::Gemm g{XN, WinT, MPAD, NINP, DM}; pg8::StaticOrder S; S.init(MPAD, NINP, F.G, (int)blockIdx.x);
        pg8::EpiInProj E{Qb, Kb, Vb, Zb, XBC, Kext, Vext, DT, args.out};
        pg8::gemm_phase<pg8::EpiInProj, pg8::StaticOrder, true, true>(F.lds + RING_OFF, g, S, E);
    }
#if TEST_STAGE >= 2
    GRID_BAR();

    {
        float lam;
        { const float a = F.lane < 64 ? args.in[I_LQ1][F.lane] * args.in[I_LK1][F.lane] : 0.f, b = args.in[I_LQ2][F.lane] * args.in[I_LK2][F.lane];
          lam = __expf(wave_sum(a)) - __expf(wave_sum(b)) + LAM0; }
        const ssd::Params SP{args.in[I_CONVW], args.in[I_CONVB], args.in[I_DTB], args.in[I_ALOG], args.in[I_DSKIP], args.in[I_SSDNW]};
        constexpr int N_SSDP = 16, N_ATTP = 1024, N_SSDS = 64, N_ATTS = 128, NITEMS = N_SSDP + N_ATTP + N_SSDS + N_ATTS;
        for (;;) {
            if (F.tid == 0) F.MISC[0] = __hip_atomic_fetch_add(F.ctl + CW_QUEUE, 1u, RLX_AGENT);
            __syncthreads();
            const int item = (int)F.MISC[0];
            __syncthreads();
            if (item >= NITEMS) break;
            if (item < N_SSDP || (item >= N_SSDP + N_ATTP && item < N_SSDP + N_ATTP + N_SSDS)) {
                ssd::Unit u;
                if (item < N_SSDP) { const int b = item >> 3; u.g = item & 7; const size_t r0 = (size_t)b * SEQ;
                    u.xbc = XBC + r0 * CONVD; u.z = Zb + r0 * SSDI; u.dtraw = DT + r0 * SH; u.hist = nullptr; u.init = nullptr;
                    u.fin = args.out + O_SP + (size_t)b * SH * SHD * DS; u.y = MIX + r0 * DM + AW; u.len = SEQ; }
                else { const int j = item - (N_SSDP + N_ATTP); const int b = j >> 3; u.g = j & 7; const size_t r0 = (size_t)MP + (size_t)b * DEC_T;
                    u.xbc = XBC + r0 * CONVD; u.z = Zb + r0 * SSDI; u.dtraw = DT + r0 * SH; u.hist = args.in[I_SCONV] + (size_t)b * 3 * CONVD; u.init = args.in[I_SSSM] + (size_t)b * SH * SHD * DS;
                    u.fin = args.out + O_SS + (size_t)b * SH * SHD * DS; u.y = MIX + r0 * DM + AW; u.len = DEC_T; }
                ssd::ssd_unit(F.lds + RING_OFF, u, SP, F.tid, F.wave, F.lane);
            } else {
                att::Unit u;
                if (item < N_SSDP + N_ATTP) { const int j = item - N_SSDP; const int qb = 31 - (j >> 5), bh = j & 31, b = bh >> 4, h = bh & 15; const size_t r0 = (size_t)b * SEQ;
                    u.Q = Qb + (r0 + 256 * qb) * AW + h * HD; u.K = Kb + r0 * AW + h * HD; u.V = Vb + r0 * AW + h * HD; u.O = MIX + (r0 + 256 * qb) * DM + h * HD;
                    u.ntot = 4 * qb + 4; u.nvalid_last = 64; u.sample = 0; u.qb = qb; }
                else { const int j = item - (N_SSDP + N_ATTP + N_SSDS); const int b = j >> 4, h = j & 15; const size_t r0 = (size_t)MP + (size_t)b * DEC_T;
                    u.Q = Qb + r0 * AW + h * HD; u.K = Kext + (size_t)b * KVROWS * AW + h * HD; u.V = Vext + (size_t)b * KVROWS * AW + h * HD; u.O = MIX + r0 * DM + h * HD;
                    u.ntot = KVROWS / 64; u.nvalid_last = PAST + DEC_T - (KVROWS / 64 - 1) * 64; u.sample = 1; u.qb = 0; }
                att::attn_unit(F.lds + RING_OFF, u, lam, args.in[I_SUBLN], F.wave, F.lane);
            }
            __syncthreads();
        }
    }
#endif
#if TEST_STAGE >= 3
    GRID_BAR();
    {
        pg8::Gemm g{MIX, WoT, MPAD, DM, DM}; pg8::StaticOrder S; S.init(MPAD, DM, F.G, (int)blockIdx.x);
        pg8::EpiOutProj E{args.in[I_XP], args.in[I_XS], args.out, X1B, SS2};
        pg8::gemm_phase<pg8::EpiOutProj, pg8::StaticOrder, true, true>(F.lds + RING_OFF, g, S, E);
    }
    GRID_BAR();
    {
        pg8::Gemm g{X1B, WguT, MPAD, 2 * DFF, DM}; pg8::StaticOrder S; S.init(MPAD, 2 * DFF, F.G, (int)blockIdx.x);
        pg8::EpiGateUp E{HB, SS2};
        pg8::gemm_phase<pg8::EpiGateUp, pg8::StaticOrder, true, true>(F.lds + RING_OFF, g, S, E);
    }
    GRID_BAR();
    {
        pg8::Gemm g{HB, WdT, MPAD, DM, DFF}; pg8::StaticOrder S; S.init(MPAD, DM, F.G, (int)blockIdx.x);
        pg8::EpiDown E{args.out, SS3};
        pg8::gemm_phase<pg8::EpiDown, pg8::StaticOrder, true, true>(F.lds + RING_OFF, g, S, E);
    }
    GRID_BAR();
    p6_final_norm(F, args);
#endif
}

extern "C" void kernel_launch(void* const* d_in, const int* in_sizes, int n_in, void* d_out, int out_size, void* d_ws, size_t ws_size, hipStream_t stream) {
    static int grid = 0;
    if (grid == 0) {
        if (n_in != 25 || (size_t)out_size != O_END || ws_size < WS_END) { fprintf(stderr, "kernel_launch: unexpected shapes: n_in %d out %d ws %zu; nothing launched\n", n_in, out_size, ws_size); grid = -1; return; }
        int dev = 0, cus = 0, per_cu = 0;
        if (hipGetDevice(&dev) != hipSuccess || hipDeviceGetAttribute(&cus, hipDeviceAttributeMultiprocessorCount, dev) != hipSuccess) { grid = -1; return; }
        if (hipFuncSetAttribute((const void*)fwd, hipFuncAttributeMaxDynamicSharedMemorySize, LDS_BYTES) != hipSuccess) { fprintf(stderr, "kernel_launch: hipFuncSetAttribute failed\n"); grid = -1; return; }
        if (hipOccupancyMaxActiveBlocksPerMultiprocessor(&per_cu, (const void*)fwd, NWAVES * 64, LDS_BYTES) != hipSuccess || per_cu < 1)
            fprintf(stderr, "kernel_launch: note: occupancy query reports %d workgroups per CU\n", per_cu);
        (void)hipGetLastError();
        grid = cus;
    }
    if (grid < 0) return;
    if (hipMemsetAsync((char*)d_ws + WS_CTL, 0, CTL_ZERO_BYTES, stream) != hipSuccess) return;
    Args a{};
    for (int i = 0; i < 25; ++i) a.in[i] = (const float*)d_in[i];
    a.out = (float*)d_out; a.ws = (unsigned char*)d_ws; a.ph_lo = 0; a.ph_hi = 99;
    hipLaunchKernelGGL(fwd, dim3(grid), dim3(NWAVES * 64), LDS_BYTES, stream, a);
}
```

```cpp
#include <hip/hip_runtime.h>
#include <cstdio>
#include <cstdint>
namespace pg8 {
#define PG8_LAS __attribute__((address_space(3)))
typedef unsigned short bf16_t;
typedef short bf16x8 __attribute__((ext_vector_type(8)));
typedef float f32x4 __attribute__((ext_vector_type(4)));
typedef unsigned u32x4 __attribute__((ext_vector_type(4)));
constexpr int BM = 256, BK = 64, HALF = 128, HTB = HALF * BK * 2  , STAGE_BYTES = 8 * HTB, NXCD = 8, WGM = 8;

__host__ __device__ __forceinline__ int lds_byte(int r, int c) { const int st = (r >> 4) * 2 + (c >> 5), rr = r & 15, cc = c & 31, ob = rr * 64 + cc * 2; return st * 1024 + (ob ^ (((ob >> 9) & 1) << 5)); }
__host__ __device__ __forceinline__ void stage_rc(int b, int& R, int& C) { const int st = b / 1024, sb = b % 1024, swz = sb ^ (((sb >> 9) & 1) << 5); R = (st >> 1) * 16 + swz / 64; C = (st & 1) * 32 + (swz % 64) / 2; }
__host__ __device__ __forceinline__ int perm32(int rho) { const int n = rho >> 4, i = rho & 15; return 8 * (i >> 2) + 4 * n + (i & 3); }

struct Unit { int pm, pn; };
struct Gemm { const bf16_t* A; const bf16_t* Bt; int M, N, K; };

struct StaticOrder {
    int nM, nN, nwg, G, c;
    __host__ __device__ void init(int M, int N, int G_, int c_) { nM = M / BM; nN = N / BM; nwg = nM * nN; G = G_; c = c_; }
    __host__ __device__ bool next(int i, Unit& u) const {
        const long L = (long)i * G + c; if (L >= nwg) return false;
        int wgid = (int)L; { const int q = nwg / NXCD, r = nwg % NXCD, xcd = wgid % NXCD, off = wgid / NXCD; wgid = (xcd < r ? xcd * (q + 1) : r * (q + 1) + (xcd - r) * q) + off; }
        const int nig = WGM * nN, gid = wgid / nig, fm = gid * WGM, gsz = (nM - fm) < WGM ? (nM - fm) : WGM;
        u.pm = fm + ((wgid % nig) % gsz); u.pn = (wgid % nig) / gsz; return true;
    }
    __device__ __forceinline__ void a_ready(const Unit&) const {}
    __device__ __forceinline__ void done(const Unit&) const {}
};

__device__ __forceinline__ unsigned cvt_pk_bf16(float lo, float hi) { unsigned r; asm volatile("v_cvt_pk_bf16_f32 %0, %1, %2" : "=v"(r) : "v"(lo), "v"(hi)); return r; }
typedef float f32x2 __attribute__((ext_vector_type(2)));
template <class Epi, class Sched, bool ALIGN_EPI = false, bool SP2 = false, int QM = 0  , bool DIM = false>
__device__ __forceinline__ void gemm_phase(PG8_LAS unsigned char* lds, const Gemm g, const Sched& S, const Epi& E) {
    constexpr bool FP8 = (QM == 1), INT8 = (QM == 2);
    int tid_ = threadIdx.x; asm volatile("" : "+v"(tid_));
    const int tid = tid_, wid = __builtin_amdgcn_readfirstlane(tid >> 6), lane = tid & 63, wr = wid >> 2, wc = wid & 3, fr = lane & 15, fq = lane >> 4;
    const int K = g.K, nt = K / BK;
    unsigned voffA[2], voffB[2];
#pragma unroll
    for (int i = 0; i < 2; ++i) { int R, C; stage_rc(tid * 16 + i * 8192, R, C); const int Rb = Epi::PERM ? ((R & ~31) + perm32(R & 31)) : R;
        voffA[i] = (unsigned)(R * K + C) * 2u; voffB[i] = (unsigned)(Rb * K + C) * 2u; }
    const size_t kstep = (size_t)(BK * 2);
    const size_t hstep = (size_t)HALF * K * 2;
    const size_t tstep = 2 * hstep;
    const unsigned ldsw = (unsigned)wid * 1024u;
    const int aoff = lds_byte(wr * 64 + fr, FP8 ? fq * 16 : fq * 8), boff = lds_byte(wc * 32 + fr, FP8 ? fq * 16 : fq * 8);
    const int aoff1 = FP8 ? aoff + 16 : aoff + 1024, boff1 = FP8 ? boff + 16 : boff + 1024;
    typedef int v8i_t __attribute__((ext_vector_type(8))); typedef int v4i_t __attribute__((ext_vector_type(4)));
#define PG8_SA(b, h) (((b) * 2 + (h)) * HTB)
#define PG8_SB(b, h) ((4 + (b) * 2 + (h)) * HTB)
#define PG8_STAGE(bufoff, gbase, voff) do { _Pragma("unroll") for (int _i = 0; _i < 2; ++_i) \
        __builtin_amdgcn_global_load_lds((const unsigned*)((const char*)(gbase) + (voff)[_i]), (PG8_LAS unsigned*)(lds + (bufoff) + ldsw + _i * 8192), 16, 0, 0); } while (0)
#define PG8_CAT8(x, y) __builtin_shufflevector(__builtin_bit_cast(v4i_t, x), __builtin_bit_cast(v4i_t, y), 0, 1, 2, 3, 4, 5, 6, 7)
#define PG8_LDA(dst, b, h) do { if constexpr (FP8) { _Pragma("unroll") for (int m = 0; m < 4; ++m) dst##8[m] = PG8_CAT8(*(const PG8_LAS bf16x8*)(lds + PG8_SA(b, h) + aoff + m * 2048), *(const PG8_LAS bf16x8*)(lds + PG8_SA(b, h) + aoff1 + m * 2048)); } \
        else { _Pragma("unroll") for (int m = 0; m < 4; ++m) _Pragma("unroll") for (int k = 0; k < 2; ++k) dst[m][k] = *(const PG8_LAS bf16x8*)(lds + PG8_SA(b, h) + (k ? aoff1 : aoff) + m * 2048); } } while (0)
#define PG8_LDB(dst, b, h) do { if constexpr (FP8) { _Pragma("unroll") for (int n = 0; n < 2; ++n) dst##8[n] = PG8_CAT8(*(const PG8_LAS bf16x8*)(lds + PG8_SB(b, h) + boff + n * 2048), *(const PG8_LAS bf16x8*)(lds + PG8_SB(b, h) + boff1 + n * 2048)); } \
        else { _Pragma("unroll") for (int n = 0; n < 2; ++n) _Pragma("unroll") for (int k = 0; k < 2; ++k) dst[n][k] = *(const PG8_LAS bf16x8*)(lds + PG8_SB(b, h) + (k ? boff1 : boff) + n * 2048); } } while (0)
#define PG8_MMA(ai, bj, At, Bt) do { __builtin_amdgcn_s_setprio(1); \
        if constexpr (FP8) { _Pragma("unroll") for (int m = 0; m < 4; ++m) _Pragma("unroll") for (int n = 0; n < 2; ++n) \
            asm volatile("v_mfma_scale_f32_16x16x128_f8f6f4 %0, %1, %2, %0, %3, %3 op_sel_hi:[0,0,0]" : "+v"(acc[ai][bj][m][n]) : "v"(Bt##8[n]), "v"(At##8[m]), "v"(sc8_)); } \
        else if constexpr (INT8) { _Pragma("unroll") for (int m = 0; m < 4; ++m) _Pragma("unroll") for (int n = 0; n < 2; ++n) _Pragma("unroll") for (int k = 0; k < 2; ++k) \
            acc[ai][bj][m][n] = __builtin_bit_cast(f32x4, __builtin_amdgcn_mfma_i32_16x16x64_i8(__builtin_bit_cast(v4i_t, Bt[n][k]), __builtin_bit_cast(v4i_t, At[m][k]), __builtin_bit_cast(v4i_t, acc[ai][bj][m][n]), 0, 0, 0)); } \
        else { _Pragma("unroll") for (int m = 0; m < 4; ++m) _Pragma("unroll") for (int n = 0; n < 2; ++n) _Pragma("unroll") for (int k = 0; k < 2; ++k) \
            acc[ai][bj][m][n] = __builtin_amdgcn_mfma_f32_16x16x32_bf16(Bt[n][k], At[m][k], acc[ai][bj][m][n], 0, 0, 0); } \
        __builtin_amdgcn_s_setprio(0); } while (0)
#define PG8_MMAH(ai, bj, At, Bt, m0) do { \
        if constexpr (FP8) { _Pragma("unroll") for (int m = m0; m < m0 + 2; ++m) _Pragma("unroll") for (int n = 0; n < 2; ++n) \
            asm volatile("v_mfma_scale_f32_16x16x128_f8f6f4 %0, %1, %2, %0, %3, %3 op_sel_hi:[0,0,0]" : "+v"(acc[ai][bj][m][n]) : "v"(Bt##8[n]), "v"(At##8[m]), "v"(sc8_)); } \
        else if constexpr (INT8) { _Pragma("unroll") for (int m = m0; m < m0 + 2; ++m) _Pragma("unroll") for (int n = 0; n < 2; ++n) _Pragma("unroll") for (int k = 0; k < 2; ++k) \
            acc[ai][bj][m][n] = __builtin_bit_cast(f32x4, __builtin_amdgcn_mfma_i32_16x16x64_i8(__builtin_bit_cast(v4i_t, Bt[n][k]), __builtin_bit_cast(v4i_t, At[m][k]), __builtin_bit_cast(v4i_t, acc[ai][bj][m][n]), 0, 0, 0)); } \
        else { _Pragma("unroll") for (int m = m0; m < m0 + 2; ++m) _Pragma("unroll") for (int n = 0; n < 2; ++n) _Pragma("unroll") for (int k = 0; k < 2; ++k) \
            acc[ai][bj][m][n] = __builtin_amdgcn_mfma_f32_16x16x32_bf16(Bt[n][k], At[m][k], acc[ai][bj][m][n], 0, 0, 0); } } while (0)
#define PG8_WAIT_V(n) asm volatile("s_waitcnt vmcnt(" #n ")" ::: "memory")
#define PG8_WAIT_L(n) asm volatile("s_waitcnt lgkmcnt(" #n ")" ::: "memory")
#define PG8_BAR __builtin_amdgcn_s_barrier()
#define PG8_SCHED __builtin_amdgcn_sched_barrier(0)
    Unit cur, nxt; int ui = 0;
    if (!S.next(0, cur)) return;
    f32x4 acc[2][2][4][2];
#pragma unroll
    for (int a = 0; a < 2; ++a)
#pragma unroll
        for (int b = 0; b < 2; ++b)
#pragma unroll
            for (int m = 0; m < 4; ++m)
#pragma unroll
                for (int n = 0; n < 2; ++n) acc[a][b][m][n] = (f32x4){0.f, 0.f, 0.f, 0.f};
    bf16x8 At[4][2], B0[2][2], B1[2][2]; v8i_t At8[4], B08[2], B18[2]; const int sc8_ = 0x7f7f7f7f;
    const char* cA = (const char*)g.A + (size_t)cur.pm * tstep; const char* cB = (const char*)g.Bt + (size_t)cur.pn * tstep;
    S.a_ready(cur);
    if constexpr (SP2) {
        PG8_STAGE(PG8_SB(0, 0), cB, voffB); PG8_STAGE(PG8_SB(0, 1), cB + hstep, voffB); PG8_STAGE(PG8_SA(0, 0), cA, voffA); PG8_STAGE(PG8_SA(0, 1), cA + hstep, voffA);
        if (wr == 1) PG8_BAR;
        PG8_WAIT_V(2); PG8_BAR;
        PG8_STAGE(PG8_SB(1, 0), cB + kstep, voffB); PG8_STAGE(PG8_SA(1, 0), cA + kstep, voffA); PG8_STAGE(PG8_SB(1, 1), cB + hstep + kstep, voffB);
        PG8_WAIT_V(6); PG8_BAR;
    } else {
        PG8_STAGE(PG8_SB(0, 0), cB, voffB); PG8_STAGE(PG8_SA(0, 0), cA, voffA); PG8_STAGE(PG8_SB(0, 1), cB + hstep, voffB); PG8_STAGE(PG8_SA(0, 1), cA + hstep, voffA);
        if (wr == 1) PG8_BAR;
        PG8_WAIT_V(4); PG8_BAR;
        PG8_STAGE(PG8_SB(1, 0), cB + kstep, voffB); PG8_STAGE(PG8_SA(1, 0), cA + kstep, voffA); PG8_STAGE(PG8_SB(1, 1), cB + hstep + kstep, voffB);
        PG8_WAIT_V(6); PG8_BAR;
    }
    for (;;) {
        const bool has_next = S.next(ui + 1, nxt);
        const char* nA = has_next ? (const char*)g.A + (size_t)nxt.pm * tstep : cA; const char* nB = has_next ? (const char*)g.Bt + (size_t)nxt.pn * tstep : cB;
        for (int t = 0; t < nt; t += 2) {
            const bool last = (t == nt - 2);
            const char* a1 = cA + (size_t)(t + 1) * kstep;
            const char* a2 = last ? nA : cA + (size_t)(t + 2) * kstep; const char* b2 = last ? nB : cB + (size_t)(t + 2) * kstep;
            const char* a3 = a2 + kstep; const char* b3 = b2 + kstep;
            if (last && has_next) S.a_ready(nxt);
            if constexpr (SP2 && DIM) {
            PG8_LDB(B0, 0, 0); PG8_LDB(B1, 0, 1); PG8_SCHED; PG8_LDA(At, 0, 0);
            PG8_WAIT_V(6); PG8_WAIT_L(0); PG8_BAR; __builtin_amdgcn_s_setprio(1); PG8_MMAH(0, 0, At, B0, 0); PG8_MMAH(0, 0, At, B0, 2); PG8_SCHED; PG8_STAGE(PG8_SA(1, 1), a1 + hstep, voffA); PG8_SCHED; PG8_MMAH(0, 1, At, B1, 0); PG8_MMAH(0, 1, At, B1, 2); __builtin_amdgcn_s_setprio(0); PG8_BAR; PG8_SCHED;
            PG8_LDA(At, 0, 1);
            PG8_WAIT_V(2); PG8_WAIT_L(0); PG8_BAR; __builtin_amdgcn_s_setprio(1); PG8_MMAH(1, 0, At, B0, 0); PG8_SCHED; PG8_STAGE(PG8_SB(0, 0), b2, voffB); PG8_SCHED; PG8_MMAH(1, 0, At, B0, 2); PG8_SCHED; PG8_STAGE(PG8_SB(0, 1), b2 + hstep, voffB); PG8_SCHED;
            PG8_MMAH(1, 1, At, B1, 0); PG8_SCHED; PG8_STAGE(PG8_SA(0, 0), a2, voffA); PG8_SCHED; PG8_MMAH(1, 1, At, B1, 2); __builtin_amdgcn_s_setprio(0); PG8_BAR; PG8_SCHED;
            PG8_LDB(B0, 1, 0); PG8_LDB(B1, 1, 1); PG8_SCHED; PG8_LDA(At, 1, 0);
            PG8_WAIT_V(6); PG8_WAIT_L(0); PG8_BAR; __builtin_amdgcn_s_setprio(1); PG8_MMAH(0, 0, At, B0, 0); PG8_MMAH(0, 0, At, B0, 2); PG8_SCHED; PG8_STAGE(PG8_SA(0, 1), a2 + hstep, voffA); PG8_SCHED; PG8_MMAH(0, 1, At, B1, 0); PG8_MMAH(0, 1, At, B1, 2); __builtin_amdgcn_s_setprio(0); PG8_BAR; PG8_SCHED;
            PG8_LDA(At, 1, 1);
            PG8_WAIT_V(2); PG8_WAIT_L(0); PG8_BAR; __builtin_amdgcn_s_setprio(1); PG8_MMAH(1, 0, At, B0, 0); PG8_SCHED; PG8_STAGE(PG8_SB(1, 0), b3, voffB); PG8_SCHED; PG8_MMAH(1, 0, At, B0, 2); PG8_SCHED; PG8_STAGE(PG8_SB(1, 1), b3 + hstep, voffB); PG8_SCHED;
            PG8_MMAH(1, 1, At, B1, 0); PG8_SCHED; PG8_STAGE(PG8_SA(1, 0), a3, voffA); PG8_SCHED; PG8_MMAH(1, 1, At, B1, 2); __builtin_amdgcn_s_setprio(0); PG8_BAR; PG8_SCHED;
            } else if constexpr (SP2) {
            PG8_LDB(B0, 0, 0); PG8_LDB(B1, 0, 1); PG8_SCHED; PG8_LDA(At, 0, 0); PG8_STAGE(PG8_SA(1, 1), a1 + hstep, voffA);
            PG8_WAIT_V(8); PG8_WAIT_L(0); PG8_BAR; PG8_MMA(0, 0, At, B0); PG8_MMA(0, 1, At, B1); PG8_BAR; PG8_SCHED;
            PG8_LDA(At, 0, 1); PG8_STAGE(PG8_SB(0, 0), b2, voffB); PG8_STAGE(PG8_SB(0, 1), b2 + hstep, voffB); PG8_STAGE(PG8_SA(0, 0), a2, voffA);
            PG8_WAIT_V(8); PG8_WAIT_L(0); PG8_BAR; PG8_MMA(1, 0, At, B0); PG8_MMA(1, 1, At, B1); PG8_BAR; PG8_SCHED;
            PG8_LDB(B0, 1, 0); PG8_LDB(B1, 1, 1); PG8_SCHED; PG8_LDA(At, 1, 0); PG8_STAGE(PG8_SA(0, 1), a2 + hstep, voffA);
            PG8_WAIT_V(8); PG8_WAIT_L(0); PG8_BAR; PG8_MMA(0, 0, At, B0); PG8_MMA(0, 1, At, B1); PG8_BAR; PG8_SCHED;
            PG8_LDA(At, 1, 1); PG8_STAGE(PG8_SB(1, 0), b3, voffB); PG8_STAGE(PG8_SB(1, 1), b3 + hstep, voffB); PG8_STAGE(PG8_SA(1, 0), a3, voffA);
            PG8_WAIT_V(8); PG8_WAIT_L(0); PG8_BAR; PG8_MMA(1, 0, At, B0); PG8_MMA(1, 1, At, B1); PG8_BAR; PG8_SCHED;
            } else {
            PG8_LDB(B0, 0, 0); PG8_SCHED; PG8_LDA(At, 0, 0); PG8_STAGE(PG8_SA(1, 1), a1 + hstep, voffA);
            PG8_WAIT_L(8); PG8_BAR; PG8_WAIT_L(0); PG8_MMA(0, 0, At, B0); PG8_BAR; PG8_SCHED;
            PG8_LDB(B1, 0, 1); PG8_STAGE(PG8_SB(0, 0), b2, voffB);
            PG8_BAR; PG8_WAIT_L(0); PG8_MMA(0, 1, At, B1); PG8_BAR;
            PG8_LDA(At, 0, 1); PG8_STAGE(PG8_SA(0, 0), a2, voffA);
            PG8_BAR; PG8_WAIT_L(0); PG8_MMA(1, 0, At, B0); PG8_BAR; PG8_SCHED;
            PG8_STAGE(PG8_SB(0, 1), b2 + hstep, voffB);
            PG8_WAIT_V(6); PG8_BAR; PG8_MMA(1, 1, At, B1); PG8_BAR;
            PG8_LDB(B0, 1, 0); PG8_SCHED; PG8_LDA(At, 1, 0); PG8_STAGE(PG8_SA(0, 1), a2 + hstep, voffA);
            PG8_WAIT_L(8); PG8_BAR; PG8_WAIT_L(0); PG8_MMA(0, 0, At, B0); PG8_BAR; PG8_SCHED;
            PG8_LDB(B1, 1, 1); PG8_STAGE(PG8_SB(1, 0), b3, voffB);
            PG8_BAR; PG8_WAIT_L(0); PG8_MMA(0, 1, At, B1); PG8_BAR;
            PG8_LDA(At, 1, 1); PG8_STAGE(PG8_SA(1, 0), a3, voffA);
            PG8_BAR; PG8_WAIT_L(0); PG8_MMA(1, 0, At, B0); PG8_BAR; PG8_SCHED;
            PG8_STAGE(PG8_SB(1, 1), b3 + hstep, voffB);
            PG8_WAIT_V(6); PG8_BAR; PG8_MMA(1, 1, At, B1); PG8_BAR;
            }
        }
        if constexpr (ALIGN_EPI) { if (wr == 0) PG8_BAR; }
        if constexpr (FP8) asm volatile("s_nop 15\n\ts_nop 7" ::: "memory");
        if constexpr (!Epi::AFTER_DRAIN) { E(acc, cur, wr, wc, fr, fq); S.done(cur); }
        if (!has_next) break;
#pragma unroll
        for (int a = 0; a < 2; ++a)
#pragma unroll
            for (int b = 0; b < 2; ++b)
#pragma unroll
                for (int m = 0; m < 4; ++m)
#pragma unroll
                    for (int n = 0; n < 2; ++n) acc[a][b][m][n] = (f32x4){0.f, 0.f, 0.f, 0.f};
        cur = nxt; cA = nA; cB = nB; ++ui;
        if constexpr (ALIGN_EPI) { if (wr == 1) PG8_BAR; }
    }
    PG8_WAIT_V(0);
    if constexpr (!ALIGN_EPI) { if (wr == 0) PG8_BAR; }
    PG8_BAR;
    if constexpr (Epi::AFTER_DRAIN) { E.fused(acc, cur, wr, wc, fr, fq, lds, wid, lane); S.done(cur); }
#undef PG8_SA
#undef PG8_SB
#undef PG8_STAGE
#undef PG8_LDA
#undef PG8_LDB
#undef PG8_MMA
#undef PG8_MMAH
#undef PG8_CAT8
#undef PG8_WAIT_V
#undef PG8_WAIT_L
#undef PG8_BAR
#undef PG8_SCHED
}
}

#ifndef TEST_ALPHA
#define TEST_ALPHA 1.0f
#endif
constexpr int DM = 4096, SEQ = 8192, NB = 2, MP = NB * SEQ  , MS = 128  , MR = MP + MS  , MPAD = 16640  ;
constexpr int DEC_B = 8, DEC_T = 16, PAST = 2048, KVROWS = 2112  ;
constexpr int AW = 2048, NH = 16, HD = 128, QKD = 64, SSDI = 2048, SH = 32, SHD = 64, SG = 8, DS = 128, CONVD = 4096, DFF = 11008;
constexpr int NIN = 12320, NINP = 12544  ;
constexpr float EPS = 1e-6f;
constexpr float LAM0 = 0.2f;
constexpr float QSCALE = 0.125f * 1.4426950408889634f;
constexpr size_t O_YP = 0, O_YS = O_YP + (size_t)MP * DM, O_KP = O_YS + (size_t)MS * DM, O_VP = O_KP + (size_t)MP * AW, O_CP = O_VP + (size_t)MP * AW,
                 O_SP = O_CP + (size_t)NB * 3 * CONVD, O_KS = O_SP + (size_t)NB * SH * SHD * DS, O_VS = O_KS + (size_t)MS * AW, O_CS = O_VS + (size_t)MS * AW,
                 O_SS = O_CS + (size_t)DEC_B * 3 * CONVD, O_END = O_SS + (size_t)DEC_B * SH * SHD * DS;
static_assert(O_END == 138010624ull, "output size");

namespace pg8 {
typedef unsigned u32x2 __attribute__((ext_vector_type(2)));
__device__ __forceinline__ u32x4 pack8(const f32x4 a, const f32x4 b) { u32x4 w; w.x = cvt_pk_bf16(a[0], a[1]); w.y = cvt_pk_bf16(a[2], a[3]); w.z = cvt_pk_bf16(b[0], b[1]); w.w = cvt_pk_bf16(b[2], b[3]); return w; }

__device__ __forceinline__ unsigned pk4_fp8(float a, float b, float c, float d) { int p = 0; p = __builtin_amdgcn_cvt_pk_fp8_f32(a, b, p, false); p = __builtin_amdgcn_cvt_pk_fp8_f32(c, d, p, true); return (unsigned)p; }
__device__ __forceinline__ unsigned pk4_i8(float a, float b, float c, float d) {
    const int ia = (int)__builtin_rintf(__builtin_fminf(__builtin_fmaxf(a, -127.f), 127.f)), ib = (int)__builtin_rintf(__builtin_fminf(__builtin_fmaxf(b, -127.f), 127.f));
    const int ic = (int)__builtin_rintf(__builtin_fminf(__builtin_fmaxf(c, -127.f), 127.f)), id = (int)__builtin_rintf(__builtin_fminf(__builtin_fmaxf(d, -127.f), 127.f));
    return (unsigned)(ia & 255) | ((unsigned)(ib & 255) << 8) | ((unsigned)(ic & 255) << 16) | ((unsigned)id << 24);
}
constexpr float W8I_CLIP = 32.0f;
constexpr float H8_SCALE = 4.0f, WD8_SCALE = 128.0f;

struct EpiInProj {
    static constexpr bool PERM = true, AFTER_DRAIN = false;
    bf16_t *Q, *Kb, *Vb, *Z, *XBC, *Kext, *Vext; float* DT; float* out;
    template <int MODE  >
    __device__ __forceinline__ void tile(const f32x4 (&acc)[2][2][4][2], bf16_t* B, int ldb, float* O32, int ld32, int row0, int c0) const {
#pragma unroll
        for (int ai = 0; ai < 2; ++ai)
#pragma unroll
            for (int m = 0; m < 4; ++m) {
                const int row = row0 + ai * HALF + m * 16;
#pragma unroll
                for (int bj = 0; bj < 2; ++bj) {
                    const int c = c0 + bj * HALF;
                    const f32x4 v0 = acc[ai][bj][m][0], v1 = acc[ai][bj][m][1];
                    if (MODE == 1) *(u32x4*)(B + (size_t)row * ldb + c) = pack8(v0 * QSCALE, v1 * QSCALE);
                    else *(u32x4*)(B + (size_t)row * ldb + c) = pack8(v0, v1);
                    if (MODE == 2) { float* o = O32 + (size_t)row * ld32 + c; *(f32x4*)o = v0 * TEST_ALPHA; *(f32x4*)(o + 4) = v1 * TEST_ALPHA; }
                }
            }
    }
    __device__ __forceinline__ void operator()(const f32x4 (&acc)[2][2][4][2], const Unit& u, int wr, int wc, int fr, int fq) const {
        const int pn = u.pn, row0 = u.pm * BM + wr * 64 + fr, cl = wc * 32 + 8 * fq;
        if (pn < 8) tile<1>(acc, Q, AW, nullptr, 0, row0, pn * BM + cl);
        else if (pn < 16) tile<2>(acc, Kb, AW, out + O_KP, AW, row0, (pn - 8) * BM + cl);
        else if (pn < 24) tile<2>(acc, Vb, AW, out + O_VP, AW, row0, (pn - 16) * BM + cl);
        else if (pn < 32) tile<0>(acc, Z, SSDI, nullptr, 0, row0, (pn - 24) * BM + cl);
        else {
            tile<0>(acc, XBC, CONVD, nullptr, 0, row0, (pn - 32) * BM + cl);
            if ((u.pm & 31) == 31 && wr == 1) {
#pragma unroll
                for (int bj = 0; bj < 2; ++bj) { const int c = (pn - 32) * BM + cl + bj * HALF; const int row = row0 + HALF + 48, t = (row & (SEQ - 1)) - (SEQ - 3);
                    if (t >= 0) { float* o = out + O_CP + (size_t)((row >> 13) * 3 + t) * CONVD + c; *(f32x4*)o = acc[1][bj][3][0] * TEST_ALPHA; *(f32x4*)(o + 4) = acc[1][bj][3][1] * TEST_ALPHA; } }
            }
        }
    }
};

struct EpiOutProj {
    static constexpr bool PERM = true, AFTER_DRAIN = false;
    const float* xp; const float* xs; float* out; bf16_t* X1B; float* ss;
    __device__ __forceinline__ void operator()(const f32x4 (&acc)[2][2][4][2], const Unit& u, int wr, int wc, int fr, int fq) const {
        const int row0 = u.pm * BM + wr * 64 + fr, col0 = u.pn * BM + wc * 32 + 8 * fq;
#pragma unroll
        for (int ai = 0; ai < 2; ++ai) {
#pragma unroll
            for (int m = 0; m < 4; ++m) {
                const int row = row0 + ai * HALF + m * 16;
                const float* xr = xp + (size_t)row * DM;
                float sq = 0.f;
#pragma unroll
                for (int bj = 0; bj < 2; ++bj) {
                    const int c = col0 + bj * HALF;
                    const f32x4 v0 = acc[ai][bj][m][0] + *(const f32x4*)(xr + c), v1 = acc[ai][bj][m][1] + *(const f32x4*)(xr + c + 4);
                    *(u32x4*)(X1B + (size_t)row * DM + c) = pack8(v0, v1);
                    sq += (v0[0] * v0[0] + v0[1] * v0[1]) + (v0[2] * v0[2] + v0[3] * v0[3]) + (v1[0] * v1[0] + v1[1] * v1[1]) + (v1[2] * v1[2] + v1[3] * v1[3]);
                }
                sq += __shfl_xor(sq, 16); sq += __shfl_xor(sq, 32);
                if (fq == 0) atomicAdd(ss + row, sq);
            }
        }
    }
};

struct EpiProbe {
    static constexpr bool PERM = true, AFTER_DRAIN = false;
    bf16_t* O; int ldc;
    __device__ __forceinline__ void operator()(const f32x4 (&acc)[2][2][4][2], const Unit& u, int wr, int wc, int fr, int fq) const {
        const int row0 = u.pm * BM + wr * 64 + fr, col0 = u.pn * BM + wc * 32 + 8 * fq;
#pragma unroll
        for (int ai = 0; ai < 2; ++ai)
#pragma unroll
            for (int m = 0; m < 4; ++m)
#pragma unroll
                for (int bj = 0; bj < 2; ++bj) *(u32x4*)(O + (size_t)(row0 + ai * HALF + m * 16) * ldc + col0 + bj * HALF) = pack8(acc[ai][bj][m][0], acc[ai][bj][m][1]);
    }
};

template <bool Q8>
struct EpiGateUpT {
    static constexpr bool PERM = true, AFTER_DRAIN = false;
    bf16_t* H; const float* ss; float wqg, wqu; bf16_t* HS;
    __device__ __forceinline__ void operator()(const f32x4 (&acc)[2][2][4][2], const Unit& u, int wr, int wc, int fr, int fq) const {
        if constexpr (Q8) asm volatile("" : "+v"(fr), "+v"(fq));
        const int row0 = u.pm * BM + wr * 64 + fr, col0 = u.pn * HALF + wc * 32 + 8 * fq;
#pragma unroll
        for (int ai = 0; ai < 2; ++ai) {
            if (u.pm == 64 && ai == 1) continue;
#pragma unroll
            for (int m = 0; m < 4; ++m) {
                const int row = row0 + ai * HALF + m * 16;
                const float r = Q8 ? ss[row] * wqg : 1.0f / sqrtf(ss[row] * (1.0f / DM) + EPS);
                const float r2 = Q8 ? ss[row] * wqu : r;
                f32x4 h[2];
#pragma unroll
                for (int n = 0; n < 2; ++n)
#pragma unroll
                    for (int e = 0; e < 4; ++e) { const float g = (Q8 ? (float)__float_as_int(acc[ai][0][m][n][e]) : acc[ai][0][m][n][e]) * r, up = (Q8 ? (float)__float_as_int(acc[ai][1][m][n][e]) : acc[ai][1][m][n][e]) * r2;
                        h[n][e] = g * up * __builtin_amdgcn_rcpf(1.0f + __builtin_amdgcn_exp2f(-1.4426950408889634f * g)); }
                if (Q8 && u.pm == 64) { *(u32x4*)(HS + (size_t)(row - MP) * DFF + col0) = pack8(h[0], h[1]); continue; }
                u32x2 w8; w8.x = pk4_fp8(h[0][0] * H8_SCALE, h[0][1] * H8_SCALE, h[0][2] * H8_SCALE, h[0][3] * H8_SCALE); w8.y = pk4_fp8(h[1][0] * H8_SCALE, h[1][1] * H8_SCALE, h[1][2] * H8_SCALE, h[1][3] * H8_SCALE);
                *(u32x2*)((unsigned char*)H + (size_t)row * DFF + col0) = w8;
            }
        }
    }
};
using EpiGateUp = EpiGateUpT<false>;

__device__ __forceinline__ float bflo(unsigned w) { return __uint_as_float(w << 16); }
__device__ __forceinline__ float bfhi(unsigned w) { return __uint_as_float(w & 0xffff0000u); }
struct EpiDown {
    static constexpr bool PERM = true, AFTER_DRAIN = false;
    const bf16_t* X1B; bf16_t* X2B; float* ss;
    static constexpr float ASC = 1.0f / (H8_SCALE * WD8_SCALE);
    __device__ __forceinline__ void operator()(const f32x4 (&acc)[2][2][4][2], const Unit& u, int wr, int wc, int fr, int fq) const {
        asm volatile("" : "+v"(fr), "+v"(fq));
        const int row0 = u.pm * BM + wr * 64 + fr, col0 = u.pn * BM + wc * 32 + 8 * fq;
#pragma unroll
        for (int ai = 0; ai < 2; ++ai) {
#pragma unroll
            for (int m = 0; m < 4; ++m) {
                const int row = row0 + ai * HALF + m * 16;
                float sq = 0.f;
#pragma unroll
                for (int bj = 0; bj < 2; ++bj) {
                    const int c = col0 + bj * HALF;
                    const u32x4 xw = *(const u32x4*)(X1B + (size_t)row * DM + c);
                    const f32x4 v0 = acc[ai][bj][m][0] * ASC + (f32x4){bflo(xw.x), bfhi(xw.x), bflo(xw.y), bfhi(xw.y)}, v1 = acc[ai][bj][m][1] * ASC + (f32x4){bflo(xw.z), bfhi(xw.z), bflo(xw.w), bfhi(xw.w)};
                    *(u32x4*)(X2B + (size_t)row * DM + c) = pack8(v0, v1);
                    sq += (v0[0] * v0[0] + v0[1] * v0[1]) + (v0[2] * v0[2] + v0[3] * v0[3]) + (v1[0] * v1[0] + v1[1] * v1[1]) + (v1[2] * v1[2] + v1[3] * v1[3]);
                }
                sq += __shfl_xor(sq, 16); sq += __shfl_xor(sq, 32);
                if (fq == 0) atomicAdd(ss + row, sq);
            }
        }
    }
};
struct PanelOrder {
    int pm, q4, nu; unsigned* cnt;
    __device__ void init(int c, unsigned* cnt_) { const int x = c & 7, j = c >> 3; pm = x * 8 + (j >> 2); q4 = j & 3; cnt = cnt_; nu = 4; asm volatile("" : "+s"(nu)); }
    __device__ __forceinline__ bool next(int i, Unit& u) const { if (i >= nu) return false; int p = pm; asm volatile("" : "+s"(p)); u.pm = p; u.pn = 4 * q4 + i; return true; }
    __device__ __forceinline__ void a_ready(const Unit&) const {}
    __device__ __forceinline__ void done(const Unit& u) const {
        asm volatile("s_waitcnt vmcnt(0)" ::: "memory");
        if ((threadIdx.x & 63) == 0) __hip_atomic_fetch_add(cnt + 64 * u.pm, 1u, __ATOMIC_RELAXED, __HIP_MEMORY_SCOPE_AGENT);
    }
};
}
#define GAS __attribute__((address_space(1)))
#define LAS __attribute__((address_space(3)))
typedef unsigned short bf16;
typedef unsigned v4u __attribute__((ext_vector_type(4)));
typedef float f32x4 __attribute__((ext_vector_type(4)));
typedef short bf16x8 __attribute__((ext_vector_type(8)));
typedef GAS unsigned gu32;
typedef GAS unsigned long long gu64;
#define RLX_AGENT __ATOMIC_RELAXED, __HIP_MEMORY_SCOPE_AGENT
#define LDS_WAIT() asm volatile("s_waitcnt lgkmcnt(0)" ::: "memory")
#define VM_WAIT() asm volatile("s_waitcnt vmcnt(0)" ::: "memory")
__device__ __forceinline__ unsigned long long rt() { return __builtin_amdgcn_s_memrealtime(); }
__device__ __forceinline__ unsigned f2bf(float f) { unsigned u = __builtin_bit_cast(unsigned, f); return (u + 0x7fffu + ((u >> 16) & 1u)) >> 16; }
__device__ __forceinline__ unsigned pk2(float lo, float hi) { return f2bf(lo) | (f2bf(hi) << 16); }

#define XB_TMO      128
#define XB_XCNT(j)  (256  + 64 * (j))
#define XB_XSUB(j)  (1280 + 64 * (j))
#define XB_XGEN(j)  (2304 + 64 * (j))
#define XB_TOP      3328
#define XB_TOPGEN   3392
#define XCD_BAR_WORDS 3456
#define XB_SPIN_CAP (1u << 18)

__device__ __forceinline__ unsigned xb_ld(unsigned* p)              { return __hip_atomic_load(p, __ATOMIC_RELAXED, __HIP_MEMORY_SCOPE_AGENT); }
__device__ __forceinline__ unsigned xb_add(unsigned* p, unsigned v) { return __hip_atomic_fetch_add(p, v, __ATOMIC_RELAXED, __HIP_MEMORY_SCOPE_AGENT); }
__device__ __forceinline__ unsigned xb_xcc_id() { return (unsigned)__builtin_amdgcn_s_getreg((3 << 11) | 20) & 0xFu; }
#define XB_SPIN(cond, bar) do { unsigned _sp = 0; while (cond) { __builtin_amdgcn_s_sleep(1); \
    if ((++_sp & 255u) == 0u) { if (xb_ld(&(bar)[XB_TMO])) break; if (_sp > XB_SPIN_CAP) { atomicAdd(&(bar)[XB_TMO], 1u); break; } } } } while (0)

struct XcdBarrier {
    unsigned* bar; unsigned x;
    volatile LAS unsigned* st;
};

__device__ __forceinline__ XcdBarrier xcd_barrier_post(unsigned* bar, volatile LAS unsigned* st) {
    XcdBarrier b; b.bar = bar; b.x = xb_xcc_id(); b.st = st;
    if (threadIdx.x == 0) (void)xb_add(&bar[XB_XCNT(b.x)], 1u);
    return b;
}
__device__ __forceinline__ void xcd_barrier_complete(unsigned* bar, unsigned x, unsigned& nloc, unsigned& nx) {
    const unsigned G = gridDim.x * gridDim.y * gridDim.z;
    unsigned sum, cnt, mine, sp = 0u;
    for (;;) {
        sum = 0u; cnt = 0u; mine = 0u;
#pragma unroll
        for (unsigned j = 0; j < 16; ++j) { const unsigned c = xb_ld(&bar[XB_XCNT(j)]); sum += c; cnt += (c > 0u) ? 1u : 0u; mine = (j == x) ? c : mine; }
        if (sum == G) break;
        __builtin_amdgcn_s_sleep(1);
        if ((++sp & 255u) == 0u) { if (xb_ld(&bar[XB_TMO])) break; if (sp > XB_SPIN_CAP) { atomicAdd(&bar[XB_TMO], 1u); break; } }
    }
    nloc = mine > 0u ? mine : 1u; nx = cnt > 0u ? cnt : 1u;
}

__device__ __forceinline__ void xcd_barrier(const XcdBarrier& b) {
    asm volatile("s_waitcnt vmcnt(0)" ::: "memory");
    __syncthreads();
    if (threadIdx.x == 0) {
        unsigned* bar = b.bar;
        __builtin_amdgcn_s_waitcnt(0);
        unsigned nloc = b.st[0], nx = b.st[1];
        if (nloc == 0u) { xcd_barrier_complete(bar, b.x, nloc, nx); b.st[0] = nloc; b.st[1] = nx; }
        const unsigned old = xb_add(&bar[XB_XSUB(b.x)], 1u);
        const unsigned gen = old / nloc;
        if (old + 1u == (gen + 1u) * nloc) {
            __builtin_amdgcn_fence(__ATOMIC_RELEASE, "agent");
            asm volatile("s_waitcnt vmcnt(0)" ::: "memory");
            const unsigned og = xb_add(&bar[XB_TOP], 1u);
            const unsigned tg = og / nx;
            if (og + 1u == (tg + 1u) * nx) xb_add(&bar[XB_TOPGEN], 1u);
            else XB_SPIN(xb_ld(&bar[XB_TOPGEN]) == tg, bar);
            __builtin_amdgcn_fence(__ATOMIC_ACQUIRE, "agent");
            xb_add(&bar[XB_XGEN(b.x)], 1u);
            asm volatile("s_waitcnt vmcnt(0)" ::: "memory");
        } else {
            XB_SPIN(xb_ld(&bar[XB_XGEN(b.x)]) == gen, bar);
            __builtin_amdgcn_fence(__ATOMIC_ACQUIRE, "agent");
            asm volatile("s_waitcnt vmcnt(0)" ::: "memory");
        }
    }
    __syncthreads();
}

constexpr int NWAVES = 8;
constexpr size_t MiB = 1u << 20;
constexpr size_t WS_CTL = 0, CTL_ZERO_BYTES = 1 * MiB;
constexpr size_t WS_WD = 1 * MiB, WS_WGU = 87 * MiB, WS_WO = 259 * MiB, WS_WIN = 291 * MiB, WS_XN = 389 * MiB, WS_Q = 519 * MiB, WS_KB = 584 * MiB, WS_VB = 649 * MiB,
                 WS_Z = 714 * MiB, WS_XBC = 779 * MiB, WS_DT = 909 * MiB, WS_KEXT = 912 * MiB, WS_VEXT = 978 * MiB, WS_WD8 = WS_WIN  , WS_HS = WS_Q + 256 * MiB  , WS_F = 1044 * MiB  , WS_PARK = 1052 * MiB  , WS_DUMMY = 1068 * MiB  , WS_WGUQ = 1068 * MiB  , WS_X1Q = 1154 * MiB  , WS_END = 1219 * MiB;
constexpr size_t WS_MIX = WS_XN;
constexpr size_t WS_X1B = WS_KEXT;
constexpr size_t WS_H = WS_Q;
static_assert(WS_WD + (size_t)DM * DFF * 2 <= WS_WGU && WS_WGU + (size_t)2 * DFF * DM * 2 <= WS_WO && WS_WO + (size_t)DM * DM * 2 <= WS_WIN && WS_WIN + (size_t)NINP * DM * 2 <= WS_XN &&
              WS_XN + (size_t)MPAD * DM * 2 <= WS_Q && WS_Q + (size_t)MPAD * AW * 2 <= WS_KB && WS_XBC + (size_t)MPAD * CONVD * 2 <= WS_DT && WS_DT + (size_t)MPAD * SH * 4 <= WS_KEXT &&
              WS_KEXT + (size_t)DEC_B * KVROWS * AW * 2 <= WS_VEXT && WS_VEXT + (size_t)DEC_B * KVROWS * AW * 2 <= WS_F && WS_H + (size_t)MPAD * DFF * 2 <= WS_DT &&
              WS_X1B + (size_t)MPAD * DM * 2 <= WS_END, "d_ws map");
constexpr int CW_TMO = 0, CW_CODE = 1, CW_WSTAT = 8  , CW_QUEUE = 64, CW_DEFQ = 3328  , CW_SMPC = 512  , CW_P5C = 12288  , CW_SSDF = 2048  , CW_BAR = 4096, CW_SS2 = 65536, CW_SS3 = 131072, CW_RQ = 196608  ;
constexpr int RING_OFF = 0, RING_BYTES = 139264, LDSCTL_OFF = RING_BYTES, MISC_OFF = LDSCTL_OFF + 320, LDS_BYTES = 147456;

struct Frame {
    LAS unsigned char* lds;
    volatile LAS unsigned* MISC;
    gu32* ctl;
    int tid, lane, wave, vcu, G;
};

__device__ __forceinline__ float wave_sum(float v) {
#pragma unroll
    for (int o = 1; o < 64; o <<= 1) v += __shfl_xor(v, o);
    return v;
}
struct TpRegs { f32x4 v[2][8]; float ks[2][8]; };
__device__ __forceinline__ void p0_tp_load(TpRegs& R, const float* W, int N, const float* kscale, int item0, int nitems, int lane) {
    const int nblk = N / 32; const int kq = lane >> 3, n4 = lane & 7;
#pragma unroll
    for (int t = 0; t < 2; ++t) { const int item = item0 + t < nitems ? item0 + t : (item0 < nitems ? item0 : nitems - 1); const int kb = item / nblk, nb = item % nblk, k0 = 64 * kb, n0 = 32 * nb;
#pragma unroll
        for (int i = 0; i < 8; ++i) { const int kk = 2 * kq + (i & 1) + 16 * (i >> 1); R.v[t][i] = *(const GAS f32x4*)(W + (size_t)(k0 + kk) * N + n0 + 4 * n4); R.ks[t][i] = kscale ? kscale[k0 + kk] : 1.0f; } }
}
template <int MODE>
__device__ __forceinline__ void p0_tp_store(const TpRegs& R, int K, int N, bf16* WT, LAS float* scr, int item0, int nitems, int lane, unsigned char* W8, float s8, bool as_int8) {
    const int nblk = N / 32;
    constexpr int S = 36;
    LAS unsigned* scu = (LAS unsigned*)scr;
    const int kq = lane >> 3, n4 = lane & 7;
#pragma unroll
    for (int t = 0; t < 2; ++t) {
        if (item0 + t >= nitems) break;
        const int item = item0 + t; const int kb = item / nblk, nb = item % nblk, k0 = 64 * kb, n0 = 32 * nb;
        LAS unsigned* s0 = scu + t * (32 * S);
#pragma unroll
        for (int m = 0; m < 4; ++m) { const f32x4 x = R.v[t][2 * m] * R.ks[t][2 * m], y = R.v[t][2 * m + 1] * R.ks[t][2 * m + 1]; LAS unsigned* d = s0 + (4 * n4) * S + 8 * m + kq;
            d[0] = pk2(x.x, y.x); d[S] = pk2(x.y, y.y); d[2 * S] = pk2(x.z, y.z); d[3 * S] = pk2(x.w, y.w); }
        LDS_WAIT(); asm volatile("" ::: "memory");
        const int c = lane & 7;
        const int rbase = MODE == 0 ? n0 : 256 * (n0 >> 7) + (n0 & 127) + (MODE == 2 ? 128 : 0);
#pragma unroll
        for (int j = 0; j < 4; ++j) { const int n = (lane >> 3) + 8 * j;
            const v4u o = *(const LAS v4u*)(s0 + n * S + 4 * c);
            if (WT) *(GAS v4u*)(WT + (size_t)(rbase + n) * K + k0 + 8 * c) = o;
            if (W8) {
                typedef unsigned u32x2g __attribute__((ext_vector_type(2))); u32x2g o8;
                const float f0 = pg8::bflo(o.x) * s8, f1 = pg8::bfhi(o.x) * s8, f2 = pg8::bflo(o.y) * s8, f3 = pg8::bfhi(o.y) * s8, f4 = pg8::bflo(o.z) * s8, f5 = pg8::bfhi(o.z) * s8, f6 = pg8::bflo(o.w) * s8, f7 = pg8::bfhi(o.w) * s8;
                int p0 = 0, p1 = 0;
                if (as_int8) { p0 = (int)pg8::pk4_i8(f0, f1, f2, f3); p1 = (int)pg8::pk4_i8(f4, f5, f6, f7); }
                else { p0 = __builtin_amdgcn_cvt_pk_fp8_f32(f0, f1, p0, false); p0 = __builtin_amdgcn_cvt_pk_fp8_f32(f2, f3, p0, true);
                       p1 = __builtin_amdgcn_cvt_pk_fp8_f32(f4, f5, p1, false); p1 = __builtin_amdgcn_cvt_pk_fp8_f32(f6, f7, p1, true); }
                o8.x = (unsigned)p0; o8.y = (unsigned)p1;
                *(GAS u32x2g*)(W8 + (size_t)(rbase + n) * K + k0 + 8 * c) = o8; } }
        LDS_WAIT(); asm volatile("" ::: "memory");
    }
}
template <int MODE>
__device__ __forceinline__ void p0_transpose_pair(const float* W, int K, int N, bf16* WT, const float* kscale, LAS float* scr, int item0, int nitems, int lane, unsigned char* W8 = nullptr, float s8 = 1.0f, bool as_int8 = false) {
    TpRegs R; p0_tp_load(R, W, N, kscale, item0, nitems, lane); p0_tp_store<MODE>(R, K, N, WT, scr, item0, nitems, lane, W8, s8, as_int8);
}
template <int MODE>
__device__ __forceinline__ void p0_transpose_8pairs(const float* W, int K, int N, bf16* WT, const float* kscale, LAS float* scr, int first2, int nitems, int lane, unsigned char* W8 = nullptr, float s8 = 1.0f, bool as_int8 = false) {
    TpRegs A, B;
    p0_tp_load(A, W, N, kscale, first2, nitems, lane);
#pragma unroll 1
    for (int i = 0; i < 8; i += 2) {
        p0_tp_load(B, W, N, kscale, first2 + 2 * (i + 1), nitems, lane);
        p0_tp_store<MODE>(A, K, N, WT, scr, first2 + 2 * i, nitems, lane, W8, s8, as_int8);
        if (i + 2 < 8) p0_tp_load(A, W, N, kscale, first2 + 2 * (i + 2), nitems, lane);
        p0_tp_store<MODE>(B, K, N, WT, scr, first2 + 2 * (i + 1), nitems, lane, W8, s8, as_int8);
    }
}
__device__ __forceinline__ void rms_row2_to_bf16(int lane, const float* xrow0, const float* xrow1, const float* w, bf16* orow0, bf16* orow1) {
    const GAS f32x4* xr0 = (const GAS f32x4*)xrow0 + lane; const GAS f32x4* xr1 = (const GAS f32x4*)xrow1 + lane; const GAS f32x4* wr = (const GAS f32x4*)w + lane;
    f32x4 v0[16], v1[16]; float s0 = 0.f, s1 = 0.f;
#pragma unroll
    for (int j = 0; j < 16; ++j) v0[j] = xr0[64 * j];
#pragma unroll
    for (int j = 0; j < 16; ++j) v1[j] = xr1[64 * j];
#pragma unroll
    for (int j = 0; j < 16; ++j) s0 += (v0[j].x * v0[j].x + v0[j].y * v0[j].y) + (v0[j].z * v0[j].z + v0[j].w * v0[j].w);
#pragma unroll
    for (int j = 0; j < 16; ++j) s1 += (v1[j].x * v1[j].x + v1[j].y * v1[j].y) + (v1[j].z * v1[j].z + v1[j].w * v1[j].w);
    const float r0 = 1.0f / sqrtf(wave_sum(s0) * (1.0f / DM) + EPS), r1 = 1.0f / sqrtf(wave_sum(s1) * (1.0f / DM) + EPS);
    GAS unsigned long long* o0 = (GAS unsigned long long*)orow0 + lane; GAS unsigned long long* o1 = (GAS unsigned long long*)orow1 + lane;
#pragma unroll
    for (int j = 0; j < 16; ++j) { const f32x4 g = wr[64 * j];
        o0[64 * j] = (unsigned long long)pk2(v0[j].x * r0 * g.x, v0[j].y * r0 * g.y) | ((unsigned long long)pk2(v0[j].z * r0 * g.z, v0[j].w * r0 * g.w) << 32);
        o1[64 * j] = (unsigned long long)pk2(v1[j].x * r1 * g.x, v1[j].y * r1 * g.y) | ((unsigned long long)pk2(v1[j].z * r1 * g.z, v1[j].w * r1 * g.w) << 32); }
}
__device__ __forceinline__ void rms_row_to_bf16(int lane, const float* xrow, const float* w, bf16* orow) {
    const GAS f32x4* xr = (const GAS f32x4*)xrow + lane; const GAS f32x4* wr = (const GAS f32x4*)w + lane;
    f32x4 v[16]; float s = 0.f;
#pragma unroll
    for (int j = 0; j < 16; ++j) { v[j] = xr[64 * j]; s += (v[j].x * v[j].x + v[j].y * v[j].y) + (v[j].z * v[j].z + v[j].w * v[j].w); }
    const float r = 1.0f / sqrtf(wave_sum(s) * (1.0f / DM) + EPS);
    GAS unsigned long long* o8 = (GAS unsigned long long*)orow + lane;
#pragma unroll
    for (int j = 0; j < 16; ++j) { const f32x4 g = wr[64 * j]; o8[64 * j] = (unsigned long long)pk2(v[j].x * r * g.x, v[j].y * r * g.y) | ((unsigned long long)pk2(v[j].z * r * g.z, v[j].w * r * g.w) << 32); }
}

namespace att {
typedef short bf16x8 __attribute__((ext_vector_type(8)));
typedef short s16x4 __attribute__((ext_vector_type(4)));
typedef float f32x16 __attribute__((ext_vector_type(16)));
typedef unsigned u32x4 __attribute__((ext_vector_type(4)));
typedef unsigned u32x2 __attribute__((ext_vector_type(2)));
constexpr int KSLOT = 8192, VSLOT = 16384, SLOT = KSLOT + VSLOT, NSLOT = 3, PITCH = 2048;
constexpr int PARK_OFF = NSLOT * SLOT, ATTN_LDS_BYTES = PARK_OFF + 8 * 8192;
#define ATT_LAS __attribute__((address_space(3)))
#ifdef PROBE_ATT_VARIANT
#define ATT_VAR(u) ((u).variant)
#else
#define ATT_VAR(u) 0
#endif
__device__ __forceinline__ unsigned cvtpk(float lo, float hi) { unsigned r; asm volatile("v_cvt_pk_bf16_f32 %0, %1, %2" : "=v"(r) : "v"(lo), "v"(hi)); return r; }

__device__ __forceinline__ void glds16(const void* gsrc, unsigned lds_dst) { unsigned keep;
    asm volatile("s_mov_b32 %0, m0\n\ts_mov_b32 m0, %2\n\ts_nop 0\n\tglobal_load_lds_dwordx4 %1, off\n\ts_mov_b32 m0, %0" : "=&s"(keep) : "v"(gsrc), "s"(lds_dst) : "memory"); }
__device__ __forceinline__ float max3f(float a, float b, float c) { float r; asm("v_max3_f32 %0, %1, %2, %3" : "=v"(r) : "v"(a), "v"(b), "v"(c)); return r; }
struct Unit {
    const unsigned short* Q;
    const unsigned short* K;
    const unsigned short* V;
    unsigned short* O;
    int ntot;
    int nvalid_last;
    int sample;
    int qb;
    unsigned char* park;
    int variant;
};

__device__ __forceinline__ void pass(ATT_LAS unsigned char* lds, const Unit& u, int mapoff, bool active, int nmine, int wave, int lane, f32x16 (&o)[4], float& lsum) {
    asm volatile("" : "+v"(lane));
    const int r32 = lane & 31, h = lane >> 5;
    const unsigned short* ksrc = u.K + mapoff + (size_t)lane * PITCH + wave * 8;
    const int rowgrp = wave >> 1, half = wave & 1, sub = lane >> 5, rr = (lane & 31) >> 2, vrow = 8 * rowgrp + rr;
    const int chl = (lane & 3) ^ ((vrow >> 2) & 3);
    const unsigned short* vsrc = u.V + (size_t)vrow * PITCH + (4 * (2 * half + sub) + chl) * 8;
    const unsigned ldsw = (unsigned)(uintptr_t)lds + (unsigned)wave * 1024u;
#define ATT_DMA(t, slot) do { if (ATT_VAR(u) & 1) break; \
        glds16(ksrc + (size_t)(t) * 64 * PITCH, (unsigned)__builtin_amdgcn_readfirstlane(ldsw + (slot) * SLOT)); \
        glds16(vsrc + (size_t)(t) * 64 * PITCH, (unsigned)__builtin_amdgcn_readfirstlane(ldsw + (slot) * SLOT + KSLOT)); \
        glds16(vsrc + (size_t)(t) * 64 * PITCH + 32 * PITCH, (unsigned)__builtin_amdgcn_readfirstlane(ldsw + (slot) * SLOT + KSLOT + 8192)); } while (0)
    asm volatile("s_waitcnt lgkmcnt(0)\n\ts_barrier" ::: "memory");
    ATT_DMA(0, 0);
    if (u.ntot > 1) ATT_DMA(1, 1);
    bf16x8 qf[4];
    { const unsigned short* qrow = u.Q + mapoff + (size_t)(wave * 32 + r32) * PITCH + 8 * h;
#pragma unroll
      for (int ks = 0; ks < 4; ++ks) qf[ks] = active ? *(const bf16x8*)(qrow + 16 * ks) : (bf16x8){0,0,0,0,0,0,0,0}; }
    asm volatile("" : "+v"(qf[0]), "+v"(qf[1]), "+v"(qf[2]), "+v"(qf[3]));
    if (wave >= 4) __builtin_amdgcn_s_setprio(1);
    float l = 0.f, negm_s = 0.f; bool first_ = true;
    f32x16 negm;
#pragma unroll
    for (int r = 0; r < 16; ++r) negm[r] = 0.f;
#pragma unroll
    for (int d = 0; d < 4; ++d)
#pragma unroll
        for (int r = 0; r < 16; ++r) o[d][r] = 0.f;
    const int kbase = h * 1024 + r32 * 16;
    const int g = lane >> 4, blk = g & 1, q_ = (lane & 15) >> 2, p_ = lane & 3;
    const int vb0 = KSLOT + 64 * (4 * h + q_) + 16 * ((2 * blk + (p_ >> 1)) ^ h) + 8 * (p_ & 1);
    const int vb1 = KSLOT + 2048 + 64 * (4 * h + q_) + 16 * ((2 * blk + (p_ >> 1)) ^ (2 + h)) + 8 * (p_ & 1);
#define ATT_QK0(D0, D1, SB) do { _Pragma("unroll") for (int r = 0; r < 16; ++r) { D0[r] = 0.f; D1[r] = 0.f; } \
        _Pragma("unroll") for (int ks = 0; ks < 4; ++ks) { \
            const bf16x8 k0 = *(const ATT_LAS bf16x8*)((SB) + kbase + ks * 2048), k1 = *(const ATT_LAS bf16x8*)((SB) + kbase + ks * 2048 + 512); \
            D0 = __builtin_amdgcn_mfma_f32_32x32x16_bf16(k0, qf[ks], D0, 0, 0, 0); D1 = __builtin_amdgcn_mfma_f32_32x32x16_bf16(k1, qf[ks], D1, 0, 0, 0); } } while (0)
#define ATT_TILE(C0, C1, N0, N1, SC, SN, TT) do { \
        ATT_LAS unsigned char* sc_ = lds + (SC) * SLOT; ATT_LAS unsigned char* sn_ = lds + (SN) * SLOT; \
        if ((TT) == u.ntot - 1 && u.nvalid_last < 64) { \
            _Pragma("unroll") for (int r = 0; r < 16; ++r) { const int kv = (r & 3) + 8 * (r >> 2) + 4 * h; if (kv >= u.nvalid_last) C0[r] = -1e30f; if (kv + 32 >= u.nvalid_last) C1[r] = -1e30f; } } \
        float mx; { float t_[8]; \
            _Pragma("unroll") for (int r = 0; r < 8; ++r) t_[r] = max3f(C0[2 * r], C0[2 * r + 1], C1[2 * r]); \
            _Pragma("unroll") for (int r = 0; r < 8; ++r) t_[r] = max3f(t_[r], C1[2 * r + 1], t_[r]); \
            const float u0_ = max3f(t_[0], t_[1], t_[2]), u1_ = max3f(t_[3], t_[4], t_[5]), u2_ = max3f(t_[6], t_[7], t_[7]); mx = max3f(u0_, u1_, u2_); } \
        mx = max3f(mx, __shfl_xor(mx, 32), mx); \
        if (first_ || __any(mx > 8.0f)) {       \
            const float dd = first_ ? mx : fmaxf(mx, 0.f), alpha = __builtin_amdgcn_exp2f(-dd); first_ = false; l *= alpha; negm_s -= dd; \
            _Pragma("unroll") for (int d = 0; d < 4; ++d) _Pragma("unroll") for (int r = 0; r < 16; ++r) o[d][r] *= alpha; \
            _Pragma("unroll") for (int r = 0; r < 16; ++r) { C0[r] -= dd; C1[r] -= dd; negm[r] = negm_s; } } \
        const unsigned va0 = (unsigned)(uintptr_t)(sc_ + vb0), va1 = (unsigned)(uintptr_t)(sc_ + vb1); \
        float rsa_[4] = {0.f, 0.f, 0.f, 0.f}; \
        _Pragma("unroll") for (int s = 0; s < 4; ++s) { \
            s16x4 lo[4], hi[4]; \
            if (!(ATT_VAR(u) & 2)) _Pragma("unroll") for (int d = 0; d < 4; ++d) { \
                asm volatile("ds_read_b64_tr_b16 %0, %1 offset:%c2" : "=&v"(lo[d]) : "v"(va0), "i"(d * 512 + s * 4096) : "memory"); \
                asm volatile("ds_read_b64_tr_b16 %0, %1 offset:%c2" : "=&v"(hi[d]) : "v"(va1), "i"(d * 512 + s * 4096) : "memory"); } \
            const bf16x8 k0 = *(const ATT_LAS bf16x8*)(sn_ + kbase + s * 2048), k1 = *(const ATT_LAS bf16x8*)(sn_ + kbase + s * 2048 + 512); \
            u32x4 w; \
            if (s < 2) { _Pragma("unroll") for (int e = 0; e < 8; ++e) { C0[8 * s + e] = (ATT_VAR(u) & 4) ? C0[8 * s + e] : __builtin_amdgcn_exp2f(C0[8 * s + e]); rsa_[e & 3] += C0[8 * s + e]; } \
                w.x = cvtpk(C0[8 * s], C0[8 * s + 1]); w.y = cvtpk(C0[8 * s + 2], C0[8 * s + 3]); w.z = cvtpk(C0[8 * s + 4], C0[8 * s + 5]); w.w = cvtpk(C0[8 * s + 6], C0[8 * s + 7]); } \
            else { const int b_ = 8 * (s - 2); _Pragma("unroll") for (int e = 0; e < 8; ++e) { C1[b_ + e] = (ATT_VAR(u) & 4) ? C1[b_ + e] : __builtin_amdgcn_exp2f(C1[b_ + e]); rsa_[e & 3] += C1[b_ + e]; } \
                w.x = cvtpk(C1[b_], C1[b_ + 1]); w.y = cvtpk(C1[b_ + 2], C1[b_ + 3]); w.z = cvtpk(C1[b_ + 4], C1[b_ + 5]); w.w = cvtpk(C1[b_ + 6], C1[b_ + 7]); } \
            const bf16x8 pf = __builtin_bit_cast(bf16x8, w); \
            if (s == 0) { N0 = __builtin_amdgcn_mfma_f32_32x32x16_bf16(k0, qf[0], negm, 0, 0, 0); N1 = __builtin_amdgcn_mfma_f32_32x32x16_bf16(k1, qf[0], negm, 0, 0, 0); } \
            else { N0 = __builtin_amdgcn_mfma_f32_32x32x16_bf16(k0, qf[s], N0, 0, 0, 0); N1 = __builtin_amdgcn_mfma_f32_32x32x16_bf16(k1, qf[s], N1, 0, 0, 0); } \
            asm volatile("s_waitcnt lgkmcnt(0)" ::: "memory"); \
            if (!(ATT_VAR(u) & 2)) _Pragma("unroll") for (int d = 0; d < 4; ++d) { \
                const bf16x8 vf = (bf16x8){lo[d][0], lo[d][1], lo[d][2], lo[d][3], hi[d][0], hi[d][1], hi[d][2], hi[d][3]}; \
                o[d] = __builtin_amdgcn_mfma_f32_32x32x16_bf16(vf, pf, o[d], 0, 0, 0); } \
        } \
        l += (rsa_[0] + rsa_[1]) + (rsa_[2] + rsa_[3]); } while (0)
    f32x16 sA0, sA1, sB0, sB1;
#define ATT_WAITBAR(N) do { if (ATT_VAR(u) & 8) asm volatile("s_waitcnt vmcnt(" #N ") lgkmcnt(0)" ::: "memory"); else asm volatile("s_waitcnt vmcnt(" #N ") lgkmcnt(0)\n\ts_barrier" ::: "memory"); } while (0)
    if (u.ntot > 1) ATT_WAITBAR(3); else ATT_WAITBAR(0);
    if (active) ATT_QK0(sA0, sA1, lds);
    int slot = 0;
#define ATT_HALF(TT, C0, C1, N0, N1) do { const int sn = slot == 2 ? 0 : slot + 1; \
        if ((TT) + 1 < u.ntot) ATT_WAITBAR(0); \
        if ((TT) + 2 < u.ntot) ATT_DMA((TT) + 2, slot == 0 ? 2 : slot - 1); \
        if (active && (TT) < nmine && !(ATT_VAR(u) & 16)) ATT_TILE(C0, C1, N0, N1, slot, sn, (TT)); \
        slot = sn; } while (0)
    for (int t = 0; t < u.ntot; t += 2) {
        ATT_HALF(t, sA0, sA1, sB0, sB1);
        if (t + 1 < u.ntot) ATT_HALF(t + 1, sB0, sB1, sA0, sA1);
    }
#undef ATT_HALF
#undef ATT_WAITBAR
#undef ATT_TILE
#undef ATT_QK0
    __builtin_amdgcn_s_setprio(0);
    lsum = l + __shfl_xor(l, 32);
#undef ATT_DMA
}

__device__ __forceinline__ void attn_unit(ATT_LAS unsigned char* lds, const Unit& u, float lam, const float* subw, int wave, int lane) {
    asm volatile("" : "+v"(lane));
    const int r32 = lane & 31, h = lane >> 5;
    const bool active = u.sample ? (wave == 0) : true;
    const int nmine = u.sample ? u.ntot : 4 * u.qb + (wave >> 1) + 1;
    f32x16 o[4]; float l1, l2;
    ATT_LAS u32x4* park = (ATT_LAS u32x4*)(lds + PARK_OFF + wave * 8192) + lane;
    pass(lds, u, 0, active, nmine, wave, lane, o, l1);
    { const float inv = 1.0f / l1;
#pragma unroll
      for (int d = 0; d < 4; ++d)
#pragma unroll
          for (int r4 = 0; r4 < 2; ++r4) { u32x4 w; w.x = cvtpk(o[d][8 * r4] * inv, o[d][8 * r4 + 1] * inv); w.y = cvtpk(o[d][8 * r4 + 2] * inv, o[d][8 * r4 + 3] * inv);
              w.z = cvtpk(o[d][8 * r4 + 4] * inv, o[d][8 * r4 + 5] * inv); w.w = cvtpk(o[d][8 * r4 + 6] * inv, o[d][8 * r4 + 7] * inv); if (active) park[(2 * d + r4) * 64] = w; } }
    pass(lds, u, 64, active, nmine, wave, lane, o, l2);
    if (!active) return;
    const float c2 = lam / l2;
    float ss = 0.f;
#pragma unroll
    for (int d = 0; d < 4; ++d)
#pragma unroll
        for (int r4 = 0; r4 < 2; ++r4) { const u32x4 w = park[(2 * d + r4) * 64];
#pragma unroll
            for (int e = 0; e < 4; ++e) { const unsigned pw = w[e]; const int r = 8 * r4 + 2 * e;
                const float v0 = __uint_as_float(pw << 16) - c2 * o[d][r], v1 = __uint_as_float(pw & 0xffff0000u) - c2 * o[d][r + 1];
                o[d][r] = v0; o[d][r + 1] = v1; ss += v0 * v0 + v1 * v1; } }
    ss += __shfl_xor(ss, 32);
    const float rn = (1.0f - LAM0) / sqrtf(ss * (1.0f / 128.0f) + EPS);
    unsigned short* orow = u.O + (size_t)(wave * 32 + r32) * 4096 + 8 * h;
    const bool st_ok = !(u.sample && r32 >= 16);
#pragma unroll
    for (int d = 0; d < 4; ++d)
#pragma unroll
        for (int kp = 0; kp < 4; kp += 2) {
            u32x2 pa, pb;
            { const int dc = 32 * d + 8 * kp + 4 * h; const f32x4 w = *(const f32x4*)(subw + dc);
              pa.x = cvtpk(o[d][4 * kp] * rn * w[0], o[d][4 * kp + 1] * rn * w[1]); pa.y = cvtpk(o[d][4 * kp + 2] * rn * w[2], o[d][4 * kp + 3] * rn * w[3]); }
            { const int dc = 32 * d + 8 * (kp + 1) + 4 * h; const f32x4 w = *(const f32x4*)(subw + dc);
              pb.x = cvtpk(o[d][4 * kp + 4] * rn * w[0], o[d][4 * kp + 5] * rn * w[1]); pb.y = cvtpk(o[d][4 * kp + 6] * rn * w[2], o[d][4 * kp + 7] * rn * w[3]); }
            const auto rx = __builtin_amdgcn_permlane32_swap(pa.x, pb.x, false, false); const auto ry = __builtin_amdgcn_permlane32_swap(pa.y, pb.y, false, false);
            const u32x4 v = (u32x4){rx[0], ry[0], rx[1], ry[1]};
            if (st_ok) *(u32x4*)(orow + 32 * d + 8 * kp) = v;
        }
}
}

namespace ssd {
typedef short bf16x8 __attribute__((ext_vector_type(8)));
typedef short s16x4 __attribute__((ext_vector_type(4)));
typedef float f32x4 __attribute__((ext_vector_type(4)));
typedef unsigned u32x4 __attribute__((ext_vector_type(4)));
typedef unsigned u32x2 __attribute__((ext_vector_type(2)));
#define SSD_LAS __attribute__((address_space(3)))
constexpr int XT_STRIDE = 144;
constexpr int L_CM = 0, L_BM = 16384, L_XT = 32768, L_ZT = L_XT + 256 * XT_STRIDE  , L_TAB = L_ZT + 32768  ,
              L_G = L_TAB + 2048  , L_SSQ = L_G + 16384  , L_CW = L_SSQ + 2048  , SSD_LDS_BYTES = L_CW + 10240;
static_assert(SSD_LDS_BYTES <= 139264, "ssd lds");
__device__ __forceinline__ unsigned off_a(unsigned row, unsigned ch) { return 2048u * (row >> 3) + 512u * (ch >> 2) + 64u * (row & 7) + 16u * ((ch & 3) ^ ((row >> 2) & 3)); }
__device__ __forceinline__ unsigned cvtpk(float lo, float hi) { unsigned r; asm volatile("v_cvt_pk_bf16_f32 %0, %1, %2" : "=v"(r) : "v"(lo), "v"(hi)); return r; }
__device__ __forceinline__ float bf2f(unsigned short b) { return __uint_as_float((unsigned)b << 16); }
__device__ __forceinline__ float silu(float v) { return v * __builtin_amdgcn_rcpf(1.0f + __builtin_amdgcn_exp2f(-1.4426950408889634f * v)); }
__device__ __forceinline__ bf16x8 pack8(const f32x4 a, const f32x4 b) { u32x4 w; w.x = cvtpk(a[0], a[1]); w.y = cvtpk(a[2], a[3]); w.z = cvtpk(b[0], b[1]); w.w = cvtpk(b[2], b[3]); return __builtin_bit_cast(bf16x8, w); }
__device__ __forceinline__ void glds16(const void* gsrc, unsigned lds_dst) { unsigned keep;
    asm volatile("s_mov_b32 %0, m0\n\ts_mov_b32 m0, %2\n\ts_nop 0\n\tglobal_load_lds_dwordx4 %1, off\n\ts_mov_b32 m0, %0" : "=&s"(keep) : "v"(gsrc), "s"(lds_dst) : "memory"); }
#define SSD_BAR() asm volatile("s_waitcnt lgkmcnt(0)\n\ts_barrier" ::: "memory")
__device__ __forceinline__ float row16_sum(float v) {
    v += __builtin_bit_cast(float, __builtin_amdgcn_update_dpp(0, __builtin_bit_cast(int, v), 0xB1, 0xf, 0xf, false));
    v += __builtin_bit_cast(float, __builtin_amdgcn_update_dpp(0, __builtin_bit_cast(int, v), 0x4E, 0xf, 0xf, false));
    v += __builtin_bit_cast(float, __builtin_amdgcn_update_dpp(0, __builtin_bit_cast(int, v), 0x141, 0xf, 0xf, false));
    v += __builtin_bit_cast(float, __builtin_amdgcn_update_dpp(0, __builtin_bit_cast(int, v), 0x140, 0xf, 0xf, false));
    return v;
}
#define MFMA16(a, b, c) __builtin_amdgcn_mfma_f32_16x16x32_bf16((a), (b), (c), 0, 0, 0)

struct Unit {
    const unsigned short* xbc;
    const unsigned short* z;
    const float* dtraw;
    const float* hist;
    const float* init;
    float* fin;
    unsigned short* y;
    int len;
    int g;
    int prev;
    int seg;
    float* fseg;
    unsigned* flag;
    int last;
};
constexpr int FSTRIDE = 4 * 64 * 128 + 64;
#define SSD_RLX __ATOMIC_RELAXED, __HIP_MEMORY_SCOPE_AGENT
struct Params { const float* conv_w; const float* conv_b; const float* dt_bias; const float* A_log; const float* D; const float* norm_w; };

template <bool PRE>
__device__ __forceinline__ void ssd_unit(SSD_LAS unsigned char* lds, const Unit& u, const Params& P, int tid, int wave, int lane) {
    asm volatile("" : "+v"(tid), "+v"(lane));
    const int g = u.g, hh = wave >> 1, ph = wave & 1, head = 4 * g + hh;
    const int c16 = lane & 15, g4 = lane >> 4, q_ = c16 >> 2, p_ = lane & 3;
    const float A = -__expf(P.A_log[head]), Dh = P.D[head], dtb = P.dt_bias[head];
    const int xq = (c16 >> 2) & 3, rbase = 2048 * (c16 >> 3) + 64 * (c16 & 7);
    const int rowrd = rbase + 16 * (g4 ^ xq);
    const int c_lo = rbase + 16 * ((g4 >> 1) ^ xq) + 8 * (g4 & 1);
    const int c_hi = rbase + 16 * ((2 + (g4 >> 1)) ^ xq) + 8 * (g4 & 1);
    const int trb = 2048 * g4 + 64 * q_ + 8 * (p_ & 1), tcc = g4 & 1, tbb = p_ >> 1;
    const int tr00 = trb + 32 * (0 ^ tcc) + 16 * (tbb ^ 0), tr01 = trb + 32 * (0 ^ tcc) + 16 * (tbb ^ 1), tr10 = trb + 32 * (1 ^ tcc) + 16 * (tbb ^ 0), tr11 = trb + 32 * (1 ^ tcc) + 16 * (tbb ^ 1);
    const int xt_lane = (64 * hh + 32 * ph + c16) * XT_STRIDE;
    f32x4 st[8][2];
#pragma unroll
    for (int nt = 0; nt < 8; ++nt)
#pragma unroll
        for (int pt = 0; pt < 2; ++pt) {
            if (u.init) st[nt][pt] = *(const f32x4*)(u.init + ((size_t)head * 64 + 32 * ph + 16 * pt + c16) * 128 + 16 * nt + 4 * g4);
            else st[nt][pt] = (f32x4){0.f, 0.f, 0.f, 0.f};
        }
    if constexpr (!PRE) {
        if (u.seg > 0) {
            if (tid == 0) { const unsigned want = (1u << u.seg) - 1u; unsigned sp = 0;
                while ((__hip_atomic_load(u.flag, SSD_RLX) & want) != want) { __builtin_amdgcn_s_sleep(8); if (++sp > (1u << 22)) break; } }
            __syncthreads();
            for (int i = 0; i < u.seg; ++i) {
                const float* F = u.fseg + (size_t)i * FSTRIDE;
                const float Di = __uint_as_float(__hip_atomic_load((const unsigned*)(F + 4 * 64 * 128 + hh), SSD_RLX));
#pragma unroll
                for (int nt = 0; nt < 8; ++nt)
#pragma unroll
                    for (int pt = 0; pt < 2; ++pt) {
                        const unsigned long long* fp = (const unsigned long long*)(F + ((size_t)hh * 64 + 32 * ph + 16 * pt + c16) * 128 + 16 * nt + 4 * g4);
                        const unsigned long long a = __hip_atomic_load(fp, SSD_RLX), b = __hip_atomic_load(fp + 1, SSD_RLX);
                        st[nt][pt] = st[nt][pt] * Di + (f32x4){__uint_as_float((unsigned)a), __uint_as_float((unsigned)(a >> 32)), __uint_as_float((unsigned)b), __uint_as_float((unsigned)(b >> 32))};
                    }
            }
        }
    }
    float asum = 0.f;
    const int cp = ((wave & 3) << 6) | lane, rh = wave >> 2;
    const int ccol = cp < 128 ? 256 * g + 2 * cp : cp < 192 ? 2048 + 128 * g + 2 * (cp - 128) : 3072 + 128 * g + 2 * (cp - 192);
    typedef float f32x2 __attribute__((ext_vector_type(2)));
    if (rh == 0) {
#pragma unroll
        for (int i = 0; i < 4; ++i) ((SSD_LAS f32x2*)(lds + L_CW))[i * 256 + cp] = (f32x2){P.conv_w[i * 4096 + ccol], P.conv_w[i * 4096 + ccol + 1]};
        ((SSD_LAS f32x2*)(lds + L_CW))[4 * 256 + cp] = (f32x2){P.conv_b[ccol], P.conv_b[ccol + 1]};
    }
    __syncthreads();
        const int nchunks = (u.len + 63) >> 6;
    unsigned raw[2][19]; float dtr = 0.f;
    const int tmin = u.prev ? -3 : 0;
    const unsigned zlds = (unsigned)(uintptr_t)(lds + L_ZT) + (unsigned)wave * 4096u;
    const int hd_l = 4 * g + (wave & 3);
    const float dtb_l = P.dt_bias[hd_l], A_l = -__expf(P.A_log[hd_l]);
#define SSD_ISSUE(cc) do { const int tb_ = 64 * (cc); \
        _Pragma("unroll") for (int hb = 0; hb < 2; ++hb) _Pragma("unroll") for (int i = 0; i < 19; ++i) { \
            int t = tb_ + 32 * rh + 16 * hb - 3 + i; t = t < tmin ? tmin : (t >= u.len ? u.len - 1 : t); raw[hb][i] = *(const unsigned*)(u.xbc + (long)t * 4096 + ccol); } \
        if (wave < 4) { int t = tb_ + lane; t = t >= u.len ? u.len - 1 : t; dtr = u.dtraw[(size_t)t * 32 + hd_l]; } } while (0)
#define SSD_ISSUE_Z(cc) do { const int tb_ = 64 * (cc); \
        _Pragma("unroll") for (int i = 0; i < 4; ++i) { int t = tb_ + 8 * wave + 2 * i + (lane >> 5); t = t >= u.len ? u.len - 1 : t; \
            glds16(u.z + (size_t)t * 2048 + 256 * g + 8 * (lane & 31), (unsigned)__builtin_amdgcn_readfirstlane(zlds + 1024u * i)); } } while (0)
    SSD_ISSUE(0); if constexpr (!PRE) SSD_ISSUE_Z(0);
    for (int c = 0; c < nchunks; ++c) {
        const int t0 = 64 * c;
        {
            float cw[4][2], cb[2];
#pragma unroll
            for (int i = 0; i < 4; ++i) { const f32x2 w = ((const SSD_LAS f32x2*)(lds + L_CW))[i * 256 + cp]; cw[i][0] = w.x; cw[i][1] = w.y; }
            { const f32x2 w = ((const SSD_LAS f32x2*)(lds + L_CW))[4 * 256 + cp]; cb[0] = w.x; cb[1] = w.y; }
#pragma unroll
            for (int hb = 0; hb < 2; ++hb) {
                float x0[19], x1[19];
#pragma unroll
                for (int i = 0; i < 19; ++i) {
                    const int t = t0 + 32 * rh + 16 * hb - 3 + i;
                    const unsigned v = raw[hb][i];
                    float a = 0.f, b = 0.f;
                    if (t >= tmin && t < u.len) { a = __uint_as_float(v << 16); b = __uint_as_float(v & 0xffff0000u); }
                    x0[i] = a; x1[i] = b;
                }
                if (hb == 0 && u.hist && c == 0 && rh == 0) {
#pragma unroll
                    for (int i = 0; i < 3; ++i) { x0[i] = u.hist[i * 4096 + ccol]; x1[i] = u.hist[i * 4096 + ccol + 1]; }
                }
                if (cp < 128) {
#pragma unroll
                    for (int k = 0; k < 2; ++k) {
                        float e0[8], e1[8];
#pragma unroll
                        for (int j = 0; j < 8; ++j) { const int i = 8 * k + j;
                            e0[j] = silu(cb[0] + cw[0][0] * x0[i] + cw[1][0] * x0[i + 1] + cw[2][0] * x0[i + 2] + cw[3][0] * x0[i + 3]);
                            e1[j] = silu(cb[1] + cw[0][1] * x1[i] + cw[1][1] * x1[i + 1] + cw[2][1] * x1[i + 2] + cw[3][1] * x1[i + 3]); }
                        u32x4 w0, w1;
                        w0.x = cvtpk(e0[0], e0[1]); w0.y = cvtpk(e0[2], e0[3]); w0.z = cvtpk(e0[4], e0[5]); w0.w = cvtpk(e0[6], e0[7]);
                        w1.x = cvtpk(e1[0], e1[1]); w1.y = cvtpk(e1[2], e1[3]); w1.z = cvtpk(e1[4], e1[5]); w1.w = cvtpk(e1[6], e1[7]);
                        *(SSD_LAS u32x4*)(lds + L_XT + (2 * cp) * XT_STRIDE + 64 * rh + 32 * hb + 16 * k) = w0;
                        *(SSD_LAS u32x4*)(lds + L_XT + (2 * cp + 1) * XT_STRIDE + 64 * rh + 32 * hb + 16 * k) = w1;
                    }
                } else if (!PRE || cp < 192) {
                    const int n = cp < 192 ? 2 * (cp - 128) : 2 * (cp - 192); const int base = (cp < 192 ? L_BM : L_CM) + 8192 * rh + 512 * (n >> 5) + 2 * (n & 7);
                    const int chl = (n >> 3) & 3;
#pragma unroll
                    for (int i = 0; i < 16; ++i) {
                        const float e0 = silu(cb[0] + cw[0][0] * x0[i] + cw[1][0] * x0[i + 1] + cw[2][0] * x0[i + 2] + cw[3][0] * x0[i + 3]);
                        const float e1 = silu(cb[1] + cw[0][1] * x1[i] + cw[1][1] * x1[i + 1] + cw[2][1] * x1[i + 2] + cw[3][1] * x1[i + 3]);
                        *(SSD_LAS unsigned*)(lds + base + 16 * (chl ^ ((i >> 2) & 3)) + 2048 * (2 * hb + (i >> 3)) + 64 * (i & 7)) = cvtpk(e0, e1);
                    }
                }
            }
            if (wave < 4) {
                const int t = t0 + lane;
                float dt = 0.f;
                if (t < u.len) { const float v = dtr + dtb_l; dt = fmaxf(v, 0.f) + log1pf(__expf(-fabsf(v))); }
                float a = dt * A_l;
#pragma unroll
                for (int o = 1; o < 64; o <<= 1) { const float n = __shfl_up(a, o); if (lane >= o) a += n; }
                ((SSD_LAS float*)(lds + L_TAB))[wave * 64 + lane] = dt; ((SSD_LAS float*)(lds + L_TAB + 1024))[wave * 64 + lane] = a;
            }
            if (c + 1 < nchunks) SSD_ISSUE(c + 1);
        }
        if constexpr (PRE) SSD_BAR();
        else if (c + 1 < nchunks) { if (wave < 4) asm volatile("s_waitcnt vmcnt(39) lgkmcnt(0)\n\ts_barrier" ::: "memory"); else asm volatile("s_waitcnt vmcnt(38) lgkmcnt(0)\n\ts_barrier" ::: "memory"); }
        else asm volatile("s_waitcnt vmcnt(0) lgkmcnt(0)\n\ts_barrier" ::: "memory");
        if constexpr (!PRE) {
        {
#pragma unroll
            for (int rep = 0; rep < 2; ++rep) {
                const int ti = wave + 8 * rep;
                if (ti < 10) {
                    const int stq = ti < 4 ? 0 : ti < 7 ? 1 : ti < 9 ? 2 : 3, qtq = ti < 4 ? ti : ti < 7 ? ti - 3 : ti < 9 ? ti - 5 : 3;
                    f32x4 acc = (f32x4){0.f, 0.f, 0.f, 0.f};
#pragma unroll
                    for (int ks = 0; ks < 4; ++ks) {
                        const bf16x8 a = *(const SSD_LAS bf16x8*)(lds + L_BM + rowrd + 4096 * stq + 512 * ks);
                        const bf16x8 b = *(const SSD_LAS bf16x8*)(lds + L_CM + rowrd + 4096 * qtq + 512 * ks);
                        acc = MFMA16(a, b, acc);
                    }
                    *(SSD_LAS f32x4*)(lds + L_G + (stq * 4 + qtq) * 1024 + lane * 16) = acc;
                }
            }
        }
        SSD_BAR();
        const SSD_LAS float* dtt = (const SSD_LAS float*)(lds + L_TAB) + hh * 64;
        const SSD_LAS float* act = (const SSD_LAS float*)(lds + L_TAB + 1024) + hh * 64;
        f32x4 y[4][2];
        {
#pragma unroll
            for (int qt = 0; qt < 4; ++qt) { y[qt][0] = (f32x4){0.f, 0.f, 0.f, 0.f}; y[qt][1] = (f32x4){0.f, 0.f, 0.f, 0.f}; }
#pragma unroll
            for (int ks = 0; ks < 4; ++ks) {
                const bf16x8 sf0 = pack8(st[2 * ks][0], st[2 * ks + 1][0]), sf1 = pack8(st[2 * ks][1], st[2 * ks + 1][1]);
#pragma unroll
                for (int qt = 0; qt < 4; ++qt) {
                    const u32x2 lo = *(const SSD_LAS u32x2*)(lds + L_CM + c_lo + 4096 * qt + 512 * ks);
                    const u32x2 hi = *(const SSD_LAS u32x2*)(lds + L_CM + c_hi + 4096 * qt + 512 * ks);
                    const bf16x8 cf = __builtin_bit_cast(bf16x8, (u32x4){lo.x, lo.y, hi.x, hi.y});
                    y[qt][0] = MFMA16(cf, sf0, y[qt][0]); y[qt][1] = MFMA16(cf, sf1, y[qt][1]);
                }
            }
#pragma unroll
            for (int qt = 0; qt < 4; ++qt) {
                const f32x4 aq = *(const SSD_LAS f32x4*)(act + 16 * qt + 4 * g4);
#pragma unroll
                for (int r = 0; r < 4; ++r) { const float e = __expf(aq[r]); y[qt][0][r] *= e; y[qt][1][r] *= e; }
            }
#pragma unroll
            for (int qt = 0; qt < 4; ++qt) {
                const float aqc = act[16 * qt + c16];
                const int qcol = 16 * qt + c16;
#pragma unroll
                for (int ks = 0; ks <= (qt >> 1); ++ks) {
                    f32x4 m[2];
#pragma unroll
                    for (int e2 = 0; e2 < 2; ++e2) {
                        const int stt = 2 * ks + e2;
                        if (stt <= qt) {
                            const f32x4 gv = *(const SSD_LAS f32x4*)(lds + L_G + (stt * 4 + qt) * 1024 + lane * 16);
                            const f32x4 as = *(const SSD_LAS f32x4*)(act + 16 * stt + 4 * g4);
                            const f32x4 ds = *(const SSD_LAS f32x4*)(dtt + 16 * stt + 4 * g4);
#pragma unroll
                            for (int r = 0; r < 4; ++r) { const int s = 16 * stt + 4 * g4 + r; m[e2][r] = s <= qcol ? gv[r] * __expf(aqc - as[r]) * ds[r] : 0.f; }
                        } else m[e2] = (f32x4){0.f, 0.f, 0.f, 0.f};
                    }
                    const bf16x8 mf = pack8(m[0], m[1]);
#pragma unroll
                    for (int pt = 0; pt < 2; ++pt) {
                        const u32x2 lo = *(const SSD_LAS u32x2*)(lds + L_XT + xt_lane + 8 * g4 + 16 * XT_STRIDE * pt + 64 * ks);
                        const u32x2 hi = *(const SSD_LAS u32x2*)(lds + L_XT + xt_lane + 8 * g4 + 16 * XT_STRIDE * pt + 64 * ks + 32);
                        const bf16x8 xf = __builtin_bit_cast(bf16x8, (u32x4){lo.x, lo.y, hi.x, hi.y});
                        y[qt][pt] = MFMA16(mf, xf, y[qt][pt]);
                    }
                }
            }
#pragma unroll
            for (int qt = 0; qt < 4; ++qt) {
                f32x4 sq = (f32x4){0.f, 0.f, 0.f, 0.f};
#pragma unroll
                for (int pt = 0; pt < 2; ++pt) {
                    const u32x2 xv = *(const SSD_LAS u32x2*)(lds + L_XT + xt_lane + 8 * g4 + 16 * XT_STRIDE * pt + 32 * qt);
                    const SSD_LAS unsigned short* zp0 = (const SSD_LAS unsigned short*)(lds + L_ZT) + (4 * g4) * 256 + 64 * hh + 32 * ph + c16 + 16 * pt + (16 * qt) * 256;
                    const float xs[4] = {__uint_as_float(xv.x << 16), __uint_as_float(xv.x & 0xffff0000u), __uint_as_float(xv.y << 16), __uint_as_float(xv.y & 0xffff0000u)};
                    const float zs[4] = {bf2f(zp0[0]), bf2f(zp0[256]), bf2f(zp0[512]), bf2f(zp0[768])};
#pragma unroll
                    for (int r = 0; r < 4; ++r) { const float v = (y[qt][pt][r] + Dh * xs[r]) * silu(zs[r]); y[qt][pt][r] = v; sq[r] += v * v; }
                }
#pragma unroll
                for (int r = 0; r < 4; ++r) { sq[r] = row16_sum(sq[r]); }
                if (c16 == 0) *(SSD_LAS f32x4*)(lds + L_SSQ + wave * 256 + (16 * qt + 4 * g4) * 4) = sq;
            }
        }
        SSD_BAR();
        {
            float nw[2];
#pragma unroll
            for (int pt = 0; pt < 2; ++pt) nw[pt] = P.norm_w[256 * g + 64 * hh + 32 * ph + 16 * pt + c16];
#pragma unroll
            for (int qt = 0; qt < 4; ++qt) {
                f32x4 tot = (f32x4){0.f, 0.f, 0.f, 0.f};
#pragma unroll
                for (int w = 0; w < 8; ++w) tot += *(const SSD_LAS f32x4*)(lds + L_SSQ + w * 256 + (16 * qt + 4 * g4) * 4);
#pragma unroll
                for (int r = 0; r < 4; ++r) {
                    const int t = t0 + 16 * qt + 4 * g4 + r;
                    if (t < u.len) {
                        const float rn = __builtin_amdgcn_rsqf(tot[r] * (1.0f / 256.0f) + EPS);
#pragma unroll
                        for (int pt = 0; pt < 2; ++pt) {
                            const unsigned b = cvtpk(y[qt][pt][r] * rn * nw[pt], 0.f);
                            u.y[(size_t)t * 4096 + 256 * g + 64 * hh + 32 * ph + 16 * pt + c16] = (unsigned short)b;
                        }
                    }
                }
            }
        }
        if (c + 1 < nchunks) SSD_ISSUE_Z(c + 1);
        }
        {
            const SSD_LAS float* dtt = (const SSD_LAS float*)(lds + L_TAB) + hh * 64;
            const SSD_LAS float* act = (const SSD_LAS float*)(lds + L_TAB + 1024) + hh * 64;
            const float aend = act[63], cd = __expf(aend); asum += aend;
            bf16x8 xw[2][2];
#pragma unroll
            for (int ks = 0; ks < 2; ++ks) {
                const f32x4 a0 = *(const SSD_LAS f32x4*)(act + 32 * ks + 8 * g4), a1 = *(const SSD_LAS f32x4*)(act + 32 * ks + 8 * g4 + 4);
                const f32x4 d0 = *(const SSD_LAS f32x4*)(dtt + 32 * ks + 8 * g4), d1 = *(const SSD_LAS f32x4*)(dtt + 32 * ks + 8 * g4 + 4);
                float wv[8];
#pragma unroll
                for (int j = 0; j < 4; ++j) { wv[j] = d0[j] * __expf(aend - a0[j]); wv[4 + j] = d1[j] * __expf(aend - a1[j]); }
#pragma unroll
                for (int pt = 0; pt < 2; ++pt) {
                    const u32x4 xv = *(const SSD_LAS u32x4*)(lds + L_XT + xt_lane + 16 * g4 + 16 * XT_STRIDE * pt + 64 * ks);
                    u32x4 o;
                    o.x = cvtpk(__uint_as_float(xv.x << 16) * wv[0], __uint_as_float(xv.x & 0xffff0000u) * wv[1]);
                    o.y = cvtpk(__uint_as_float(xv.y << 16) * wv[2], __uint_as_float(xv.y & 0xffff0000u) * wv[3]);
                    o.z = cvtpk(__uint_as_float(xv.z << 16) * wv[4], __uint_as_float(xv.z & 0xffff0000u) * wv[5]);
                    o.w = cvtpk(__uint_as_float(xv.w << 16) * wv[6], __uint_as_float(xv.w & 0xffff0000u) * wv[7]);
                    xw[ks][pt] = __builtin_bit_cast(bf16x8, o);
                }
            }
            const unsigned bm00 = (unsigned)(uintptr_t)(lds + L_BM + tr00), bm01 = (unsigned)(uintptr_t)(lds + L_BM + tr01), bm10 = (unsigned)(uintptr_t)(lds + L_BM + tr10), bm11 = (unsigned)(uintptr_t)(lds + L_BM + tr11);
#pragma unroll
            for (int nt = 0; nt < 8; ++nt) {
                st[nt][0] *= cd; st[nt][1] *= cd;
                s16x4 t0v[2], t1v[2];
#pragma unroll
                for (int ks = 0; ks < 2; ++ks) {
                    asm volatile("ds_read_b64_tr_b16 %0, %1 offset:%c2" : "=&v"(t0v[ks]) : "v"((nt & 1) ? bm10 : bm00), "i"(8192 * ks + 512 * (nt >> 1)) : "memory");
                    asm volatile("ds_read_b64_tr_b16 %0, %1 offset:%c2" : "=&v"(t1v[ks]) : "v"((nt & 1) ? bm11 : bm01), "i"(8192 * ks + 512 * (nt >> 1) + 256) : "memory");
                }
                asm volatile("s_waitcnt lgkmcnt(0)" ::: "memory");
                __builtin_amdgcn_sched_barrier(0);
#pragma unroll
                for (int ks = 0; ks < 2; ++ks) {
                    const bf16x8 bt = (bf16x8){t0v[ks][0], t0v[ks][1], t0v[ks][2], t0v[ks][3], t1v[ks][0], t1v[ks][1], t1v[ks][2], t1v[ks][3]};
                    st[nt][0] = MFMA16(bt, xw[ks][0], st[nt][0]); st[nt][1] = MFMA16(bt, xw[ks][1], st[nt][1]);
                }
            }
        }
        SSD_BAR();
    }
#undef SSD_ISSUE
#undef SSD_ISSUE_Z
    if constexpr (PRE) {
        float* F = u.fseg + (size_t)u.seg * FSTRIDE;
#pragma unroll
        for (int nt = 0; nt < 8; ++nt)
#pragma unroll
            for (int pt = 0; pt < 2; ++pt) {
                unsigned long long* fp = (unsigned long long*)(F + ((size_t)hh * 64 + 32 * ph + 16 * pt + c16) * 128 + 16 * nt + 4 * g4);
                const f32x4 v = st[nt][pt];
                __hip_atomic_store(fp, ((unsigned long long)__float_as_uint(v[1]) << 32) | __float_as_uint(v[0]), SSD_RLX);
                __hip_atomic_store(fp + 1, ((unsigned long long)__float_as_uint(v[3]) << 32) | __float_as_uint(v[2]), SSD_RLX);
            }
        if (ph == 0 && lane == 0) __hip_atomic_store((unsigned*)(F + 4 * 64 * 128 + hh), __float_as_uint(__expf(asum)), SSD_RLX);
        asm volatile("s_waitcnt vmcnt(0)" ::: "memory");
        __syncthreads();
        if (tid == 0) __hip_atomic_fetch_or(u.flag, 1u << u.seg, SSD_RLX);
    } else if (u.last) {
#pragma unroll
        for (int nt = 0; nt < 8; ++nt)
#pragma unroll
            for (int pt = 0; pt < 2; ++pt) *(f32x4*)(u.fin + ((size_t)head * 64 + 32 * ph + 16 * pt + c16) * 128 + 16 * nt + 4 * g4) = st[nt][pt] * TEST_ALPHA;
    }
}
}

namespace sk {
typedef short bf16x8 __attribute__((ext_vector_type(8)));
typedef float f32x4 __attribute__((ext_vector_type(4)));
#define SK_LAS __attribute__((address_space(3)))
__device__ __forceinline__ unsigned cvtpk(float lo, float hi) { unsigned r; asm volatile("v_cvt_pk_bf16_f32 %0, %1, %2" : "=v"(r) : "v"(lo), "v"(hi)); return r; }
__device__ __forceinline__ unsigned short bf(float v) { return (unsigned short)cvtpk(v, 0.f); }

template <int NRT, int NB, bool DEEP = false, class Epi>
__device__ __forceinline__ void skinny(SK_LAS unsigned char* lds, const unsigned short* A, int lda, int K, int njobs, const Epi& E, int wave, int lane, int wg, int nwg) {
    asm volatile("" : "+v"(lane));
    constexpr int RS = 528, BUF = 16 * NRT * RS;
    const int c16 = lane & 15, g4 = lane >> 4, tid = wave * 64 + lane;
    const int nch = K >> 8;
    const unsigned short* asrc = A + (size_t)(tid >> 5) * lda + 8 * (tid & 31);
    SK_LAS unsigned char* adst = lds + (tid >> 5) * RS + 16 * (tid & 31);
    const SK_LAS unsigned char* ard = lds + c16 * RS + 16 * g4;
    for (int base = wg * 8; base < njobs; base += nwg * 8) {
        const int job = base + wave; const bool valid = job < njobs; const int jobc = valid ? job : njobs - 1;
        const unsigned short* brow[NB];
#pragma unroll
        for (int nb = 0; nb < NB; ++nb) brow[nb] = E.brow(jobc, c16, nb) + 8 * g4;
        f32x4 acc[NB][NRT];
#pragma unroll
        for (int nb = 0; nb < NB; ++nb)
#pragma unroll
            for (int rt = 0; rt < NRT; ++rt) acc[nb][rt] = (f32x4){0.f, 0.f, 0.f, 0.f};
        bf16x8 an[NRT];
#pragma unroll
        for (int i = 0; i < NRT; ++i) an[i] = *(const bf16x8*)(asrc + (size_t)(16 * i) * lda);
#pragma unroll
        for (int i = 0; i < NRT; ++i) *(SK_LAS bf16x8*)(adst + 16 * i * RS) = an[i];
        __syncthreads();
        if constexpr (NB == 1 && DEEP) {
            bf16x8 q0[4], q1[4], q2[4], q3[4];
            const int nh = 2 * nch;
#define SK_LOADH(Q, h) { const int hh_ = (h) < nh ? (h) : nh - 1; \
            _Pragma("unroll") for (int ks = 0; ks < 4; ++ks) Q[ks] = *(const bf16x8*)(brow[0] + 128 * hh_ + 32 * ks); __builtin_amdgcn_sched_barrier(0); }
#define SK_COMP(Q, bufo, kh) { \
            _Pragma("unroll") for (int ks = 0; ks < 4; ++ks) \
                _Pragma("unroll") for (int rt = 0; rt < NRT; ++rt) { \
                    const bf16x8 a = *(const SK_LAS bf16x8*)(ard + (bufo) + 16 * rt * RS + 64 * (4 * (kh) + ks)); \
                    acc[0][rt] = __builtin_amdgcn_mfma_f32_16x16x32_bf16(a, Q[ks], acc[0][rt], 0, 0, 0); \
                    if ((rt & 3) == 3) __builtin_amdgcn_sched_barrier(0); } }
#define SK_LOADA(cn) { const int cn_ = (cn) < nch ? (cn) : nch - 1; \
            _Pragma("unroll") for (int i = 0; i < NRT; ++i) an[i] = *(const bf16x8*)(asrc + (size_t)(16 * i) * lda + 256 * cn_); __builtin_amdgcn_sched_barrier(0); }
#define SK_PUTA(bufo) { _Pragma("unroll") for (int i = 0; i < NRT; ++i) *(SK_LAS bf16x8*)(adst + (bufo) + 16 * i * RS) = an[i]; __syncthreads(); }
            SK_LOADH(q0, 0); SK_LOADH(q1, 1); SK_LOADH(q2, 2);
#pragma unroll 1
            for (int c = 0;; c += 2) {
                SK_LOADA(c + 1); SK_LOADH(q3, 2 * c + 3); SK_COMP(q0, 0, 0); SK_LOADH(q0, 2 * c + 4); SK_COMP(q1, 0, 1); SK_PUTA(BUF);
                if (c + 1 >= nch) break;
                SK_LOADA(c + 2); SK_LOADH(q1, 2 * c + 5); SK_COMP(q2, BUF, 0); SK_LOADH(q2, 2 * c + 6); SK_COMP(q3, BUF, 1); SK_PUTA(0);
                if (c + 2 >= nch) break;
            }
#undef SK_LOADH
#undef SK_COMP
#undef SK_LOADA
#undef SK_PUTA
        } else {
        bf16x8 b[8][NB];
#pragma unroll
        for (int ks = 0; ks < 8; ++ks)
#pragma unroll
            for (int nb = 0; nb < NB; ++nb) b[ks][nb] = *(const bf16x8*)(brow[nb] + 32 * ks);
#pragma unroll 1
        for (int c = 0; c < nch; ++c) {
            const int buf = (c & 1) * BUF;
            constexpr int PF = NB == 1 ? 8 : 4;
            bf16x8 bn[PF][NB];
            const int cn = c + 1 < nch ? c + 1 : c;
#pragma unroll
            for (int ks = 0; ks < PF; ++ks)
#pragma unroll
                for (int nb = 0; nb < NB; ++nb) bn[ks][nb] = *(const bf16x8*)(brow[nb] + 256 * cn + 32 * ks);
#pragma unroll
            for (int i = 0; i < NRT; ++i) an[i] = *(const bf16x8*)(asrc + (size_t)(16 * i) * lda + 256 * cn);
#pragma unroll
            for (int ks = 0; ks < 8; ++ks)
#pragma unroll
                for (int rt = 0; rt < NRT; ++rt) {
                    const bf16x8 a = *(const SK_LAS bf16x8*)(ard + buf + 16 * rt * RS + 64 * ks);
#pragma unroll
                    for (int nb = 0; nb < NB; ++nb) acc[nb][rt] = __builtin_amdgcn_mfma_f32_16x16x32_bf16(a, b[ks][nb], acc[nb][rt], 0, 0, 0);
                    if ((rt & 3) == 3) __builtin_amdgcn_sched_barrier(0);
                }
#pragma unroll
            for (int i = 0; i < NRT; ++i) *(SK_LAS bf16x8*)(adst + (BUF - buf) + 16 * i * RS) = an[i];
#pragma unroll
            for (int ks = 0; ks < PF; ++ks)
#pragma unroll
                for (int nb = 0; nb < NB; ++nb) b[ks][nb] = bn[ks][nb];
#pragma unroll
            for (int ks = PF; ks < 8; ++ks)
#pragma unroll
                for (int nb = 0; nb < NB; ++nb) b[ks][nb] = *(const bf16x8*)(brow[nb] + 256 * cn + 32 * ks);
            __syncthreads();
        }
        }
        if (valid) {
            int c16e = c16, g4e = g4; asm volatile("" : "+v"(c16e), "+v"(g4e));
#pragma unroll
            for (int rt = 0; rt < NRT; ++rt) { f32x4 v[NB];
#pragma unroll
                for (int nb = 0; nb < NB; ++nb) v[nb] = acc[nb][rt];
                E.store(job, rt, c16e, g4e, v); }
        }
    }
}

struct EpiInS {
    const unsigned short* WinT; unsigned short *Q, *Z, *XBC, *Kext, *Vext; float* DT; float* out;
    __device__ __forceinline__ const unsigned short* brow(int job, int n, int) const { return WinT + (size_t)(16 * job + n) * DM; }
    __device__ __forceinline__ void store(int job, int rt, int n, int g4, const f32x4 (&v)[1]) const {
        const int c0 = 16 * job, col = c0 + n, rs0 = 16 * rt + 4 * g4;
        if (c0 < 2048) {
#pragma unroll
            for (int r = 0; r < 4; ++r) Q[((size_t)MP + rs0 + r) * AW + col] = bf(v[0][r] * QSCALE);
        } else if (c0 < 6144) {
            const bool isk = c0 < 4096; const int c = col - (isk ? 2048 : 4096); float* o = out + (isk ? O_KS : O_VS); unsigned short* e = isk ? Kext : Vext;
#pragma unroll
            for (int r = 0; r < 4; ++r) { const int rs = rs0 + r; o[(size_t)rs * AW + c] = v[0][r] * TEST_ALPHA; e[((size_t)(rs >> 4) * KVROWS + PAST + (rs & 15)) * AW + c] = bf(v[0][r]); }
        } else if (c0 < 8192) {
#pragma unroll
            for (int r = 0; r < 4; ++r) Z[((size_t)MP + rs0 + r) * SSDI + col - 6144] = bf(v[0][r]);
        } else if (c0 < 12288) {
            const int c = col - 8192;
#pragma unroll
            for (int r = 0; r < 4; ++r) { const int rs = rs0 + r; XBC[((size_t)MP + rs) * CONVD + c] = bf(v[0][r]); const int t = (rs & 15) - 13; if (t >= 0) out[O_CS + (size_t)((rs >> 4) * 3 + t) * CONVD + c] = v[0][r] * TEST_ALPHA; }
        } else {
#pragma unroll
            for (int r = 0; r < 4; ++r) DT[((size_t)MP + rs0 + r) * SH + col - 12288] = v[0][r];
        }
    }
};
struct EpiDtP {
    const unsigned short* XN; float* DT;
    __device__ __forceinline__ const unsigned short* brow(int job, int n, int) const { return XN + (size_t)(16 * job + n) * DM; }
    __device__ __forceinline__ void store(int job, int rt, int n, int g4, const f32x4 (&v)[1]) const {
        *(f32x4*)(DT + (size_t)(16 * job + n) * SH + 16 * rt + 4 * g4) = v[0];
    }
};
struct EpiOutS {
    const unsigned short* WoT; const float* xs; float* out; unsigned short* X1B; float* ss;
    __device__ __forceinline__ const unsigned short* brow(int job, int n, int) const { return WoT + (size_t)(16 * job + n) * DM; }
    __device__ __forceinline__ void store(int job, int rt, int n, int g4, const f32x4 (&v)[1]) const {
        const int col = 16 * job + n;
#pragma unroll
        for (int r = 0; r < 4; ++r) {
            const int rs = 16 * rt + 4 * g4 + r; const float x1 = xs[(size_t)rs * DM + col] + v[0][r];
            X1B[((size_t)MP + rs) * DM + col] = bf(x1);
            float sq = x1 * x1; sq += __shfl_xor(sq, 1); sq += __shfl_xor(sq, 2); sq += __shfl_xor(sq, 4); sq += __shfl_xor(sq, 8);
            if (n == 0) atomicAdd(ss + MP + rs, sq);
        }
    }
};
struct EpiGuS {
    const unsigned short* WguT; unsigned short* H; const float* ss;
    __device__ __forceinline__ const unsigned short* brow(int job, int n, int nb) const { const int f = 16 * job + n; return WguT + (size_t)(256 * (f >> 7) + (f & 127) + 128 * nb) * DM; }
    __device__ __forceinline__ void store(int job, int rt, int n, int g4, const f32x4 (&v)[2]) const {
        const int f = 16 * job + n;
#pragma unroll
        for (int r = 0; r < 4; ++r) {
            const int rs = 16 * rt + 4 * g4 + r; const float rn = 1.0f / sqrtf(ss[MP + rs] * (1.0f / DM) + EPS);
            const float g = v[0][r] * rn, up = v[1][r] * rn;
            H[(size_t)rs * DFF + f] = bf(g * up * __builtin_amdgcn_rcpf(1.0f + __builtin_amdgcn_exp2f(-1.4426950408889634f * g)));
        }
    }
};
struct EpiDownS {
    const unsigned short* WdT; const unsigned short* X1B; unsigned short* X2B; float* ss;
    __device__ __forceinline__ const unsigned short* brow(int job, int n, int) const { return WdT + (size_t)(16 * job + n) * DFF; }
    __device__ __forceinline__ void store(int job, int rt, int n, int g4, const f32x4 (&v)[1]) const {
        const int col = 16 * job + n;
#pragma unroll
        for (int r = 0; r < 4; ++r) {
            const int rs = 16 * rt + 4 * g4 + r; const size_t idx = ((size_t)MP + rs) * DM + col; const float x2 = __uint_as_float((unsigned)X1B[idx] << 16) + v[0][r]; X2B[idx] = bf(x2);
            float sq = x2 * x2; sq += __shfl_xor(sq, 1); sq += __shfl_xor(sq, 2); sq += __shfl_xor(sq, 4); sq += __shfl_xor(sq, 8);
            if (n == 0) atomicAdd(ss + MP + rs, sq);
        }
    }
};
struct EpiOutPart {
    const unsigned short* WoT; float* part; int koff;
    __device__ __forceinline__ const unsigned short* brow(int job, int n, int) const { return WoT + (size_t)(16 * job + n) * DM + koff; }
    __device__ __forceinline__ void store(int job, int rt, int n, int g4, const f32x4 (&v)[1]) const {
#pragma unroll
        for (int r = 0; r < 4; ++r) part[(size_t)(16 * rt + 4 * g4 + r) * DM + 16 * job + n] = v[0][r];
    }
};
struct EpiDownPart {
    const unsigned short* WdT; float* part; int koff;
    __device__ __forceinline__ const unsigned short* brow(int job, int n, int) const { return WdT + (size_t)(16 * job + n) * DFF + koff; }
    __device__ __forceinline__ void store(int job, int rt, int n, int g4, const f32x4 (&v)[1]) const {
#pragma unroll
        for (int r = 0; r < 4; ++r) part[(size_t)(16 * rt + 4 * g4 + r) * DM + 16 * job + n] = v[0][r];
    }
};
}

struct Args { const float* in[25]; float* out; unsigned char* ws; int ph_lo, ph_hi; };
enum { I_XP = 0, I_XS, I_CK, I_CV, I_SCONV, I_SSSM, I_N1W, I_WIN, I_LQ1, I_LK1, I_LQ2, I_LK2, I_SUBLN, I_CONVW, I_CONVB, I_DTB, I_ALOG, I_DSKIP, I_SSDNW, I_WOUT, I_N2W, I_WG, I_WU, I_WD, I_FNW };

#ifndef P4_INT8
#define P4_INT8 1
#endif
constexpr bool WGU_BF16 = !P4_INT8;
constexpr int WQ_SAMPLE_ROWS = 48;
__device__ __forceinline__ float wq_scale(const unsigned char* ws, int t) { const float s = ((const float*)(ws + WS_CTL))[CW_WSTAT + t]; return pg8::W8I_CLIP / sqrtf(s * (1.0f / ((float)WQ_SAMPLE_ROWS * DFF)) + 1e-30f); }
__device__ __forceinline__ void p0_prologue(const Frame& F, const Args& a) {
    unsigned char* ws = a.ws;
    LAS float* scr = (LAS float*)(F.lds + RING_OFF + F.wave * 17408);
    const int gw = F.vcu * NWAVES + F.wave, NGW = F.G * NWAVES, lane = F.lane;
    bf16* WinT = (bf16*)(ws + WS_WIN); bf16* WoT = (bf16*)(ws + WS_WO); bf16* WguT = (bf16*)(ws + WS_WGU); bf16* WdT = (bf16*)(ws + WS_WD);
    constexpr int I_IN = (DM / 64) * (NIN / 32), I_O = (DM / 64) * (DM / 32), I_G = (DM / 64) * (DFF / 32), I_D = (DFF / 64) * (DM / 32);
    for (int it = 2 * gw; it < I_IN; it += 2 * NGW) p0_transpose_pair<0>(a.in[I_WIN], DM, NIN, WinT, nullptr, scr, it, I_IN, lane);
    { GAS v4u* z = (GAS v4u*)(WinT + (size_t)NIN * DM); const int n16 = (NINP - NIN) * DM * 2 / 16;
      for (int i = gw * 64 + lane; i < n16; i += NGW * 64) z[i] = (v4u){0u, 0u, 0u, 0u}; }
    bf16* XN = (bf16*)(ws + WS_XN);
    for (int m = gw; m < MPAD; m += 2 * NGW) {
        const int m1 = m + NGW;
        if (m1 < MR) rms_row2_to_bf16(lane, m < MP ? a.in[I_XP] + (size_t)m * DM : a.in[I_XS] + (size_t)(m - MP) * DM, m1 < MP ? a.in[I_XP] + (size_t)m1 * DM : a.in[I_XS] + (size_t)(m1 - MP) * DM,
                                      a.in[I_N1W], XN + (size_t)m * DM, XN + (size_t)m1 * DM);
        else {
            for (int mm = m; mm < MPAD; mm += NGW) {
                if (mm > m1) break;
                if (mm < MR) rms_row_to_bf16(lane, mm < MP ? a.in[I_XP] + (size_t)mm * DM : a.in[I_XS] + (size_t)(mm - MP) * DM, a.in[I_N1W], XN + (size_t)mm * DM);
                else { GAS v4u* z = (GAS v4u*)(XN + (size_t)mm * DM);
#pragma unroll
                    for (int j = 0; j < 8; ++j) z[lane + 64 * j] = (v4u){0u, 0u, 0u, 0u}; }
            }
        }
    }
    { float* wst = (float*)(ws + WS_CTL) + CW_WSTAT; constexpr int NV = WQ_SAMPLE_ROWS * (DFF / 4);
      float sg = 0.f, su = 0.f;
      for (int i = gw * 64 + lane; i < NV; i += NGW * 64) { const int k = i / (DFF / 4); const f32x4 x = *(const GAS f32x4*)(a.in[I_WG] + 4 * (size_t)i), y = *(const GAS f32x4*)(a.in[I_WU] + 4 * (size_t)i);
          const float n2 = a.in[I_N2W][k];
          sg += n2 * n2 * ((x.x * x.x + x.y * x.y) + (x.z * x.z + x.w * x.w)); su += n2 * n2 * ((y.x * y.x + y.y * y.y) + (y.z * y.z + y.w * y.w)); }
      sg = wave_sum(sg); su = wave_sum(su); if (lane == 0) { atomicAdd(wst + 0, sg); atomicAdd(wst + 1, su); } }
    {
        bf16* Kext = (bf16*)(ws + WS_KEXT); bf16* Vext = (bf16*)(ws + WS_VEXT);
        const int zvec = DEC_B * (KVROWS - PAST - DEC_T) * AW / 8;
        for (int i = gw * 64 + lane; i < 2 * zvec; i += NGW * 64) {
            const bool isv = i >= zvec; const int j = isv ? i - zvec : i; const int e = j * 8, per = (KVROWS - PAST - DEC_T) * AW, b = e / per, rem = e % per;
            *(GAS v4u*)((isv ? Vext : Kext) + ((size_t)b * KVROWS + PAST + DEC_T) * AW + rem) = (v4u){0u, 0u, 0u, 0u};
        }
    }
}

__device__ __forceinline__ void p2_cache_slice(const Frame& F, const Args& a, int b, int h) {
    int tid = F.tid; asm volatile("" : "+v"(tid));
    const int r0 = tid >> 5, c4 = (tid & 31) * 4;
    const float* ks = a.in[I_CK] + ((size_t)b * PAST + r0) * AW + h * HD + c4; const float* vs = a.in[I_CV] + ((size_t)b * PAST + r0) * AW + h * HD + c4;
    bf16* kd = (bf16*)(a.ws + WS_KEXT) + ((size_t)b * KVROWS + r0) * AW + h * HD + c4; bf16* vd = (bf16*)(a.ws + WS_VEXT) + ((size_t)b * KVROWS + r0) * AW + h * HD + c4;
    for (int i0 = 0; i0 < PAST / 16; i0 += 8) {
        f32x4 kx[8], vx[8];
#pragma unroll
        for (int q = 0; q < 8; ++q) { kx[q] = *(const GAS f32x4*)(ks + (size_t)(i0 + q) * 16 * AW); vx[q] = *(const GAS f32x4*)(vs + (size_t)(i0 + q) * 16 * AW); }
#pragma unroll
        for (int q = 0; q < 8; ++q) { typedef unsigned u32x2g __attribute__((ext_vector_type(2)));
            *(GAS u32x2g*)(kd + (size_t)(i0 + q) * 16 * AW) = (u32x2g){pk2(kx[q].x, kx[q].y), pk2(kx[q].z, kx[q].w)};
            *(GAS u32x2g*)(vd + (size_t)(i0 + q) * 16 * AW) = (u32x2g){pk2(vx[q].x, vx[q].y), pk2(vx[q].z, vx[q].w)}; }
    }
    asm volatile("s_waitcnt vmcnt(0)" ::: "memory");
    __syncthreads();
}

constexpr int CONV_PAIRS_O = (DM / 64) * (DM / 32) / 2, CONV_PAIRS_G = (DM / 64) * (DFF / 32) / 2, CONV_PAIRS_D = (DFF / 64) * (DM / 32) / 2;
constexpr int CONV_ITEMS = (CONV_PAIRS_O + 2 * CONV_PAIRS_G + CONV_PAIRS_D) / 64;
constexpr int CONV_ITEMS_A = (CONV_PAIRS_O + 2 * CONV_PAIRS_G) / 64;
static_assert(CONV_PAIRS_O % 64 == 0 && CONV_PAIRS_G % 64 == 0 && CONV_PAIRS_D % 64 == 0, "a queue item stays inside one matrix");
__device__ __forceinline__ void p0_deferred_item(const Frame& F, const Args& a, int k) {
    unsigned char* ws = a.ws;
    LAS float* scr = (LAS float*)(F.lds + RING_OFF + F.wave * 17408);
    bf16* WoT = (bf16*)(ws + WS_WO); bf16* WguT = (bf16*)(ws + WS_WGU); bf16* WdT = (bf16*)(ws + WS_WD);
    int lane = F.lane; asm volatile("" : "+v"(lane));
    int p = k * 64 + F.wave * 8;
    if (p < CONV_PAIRS_O) { p0_transpose_8pairs<0>(a.in[I_WOUT], DM, DM, WoT, nullptr, scr, 2 * p, 2 * CONV_PAIRS_O, lane); return; }
    p -= CONV_PAIRS_O;
    if (p < CONV_PAIRS_G) { const float sq = wq_scale(ws, 0); p0_transpose_8pairs<1>(a.in[I_WG], DM, DFF, WGU_BF16 ? WguT : (bf16*)nullptr, a.in[I_N2W], scr, 2 * p, 2 * CONV_PAIRS_G, lane, ws + WS_WGUQ, sq, true); return; }
    p -= CONV_PAIRS_G;
    if (p < CONV_PAIRS_G) { const float sq = wq_scale(ws, 1); p0_transpose_8pairs<2>(a.in[I_WU], DM, DFF, WGU_BF16 ? WguT : (bf16*)nullptr, a.in[I_N2W], scr, 2 * p, 2 * CONV_PAIRS_G, lane, ws + WS_WGUQ, sq, true); return; }
    p -= CONV_PAIRS_G;
    p0_transpose_8pairs<0>(a.in[I_WD], DFF, DM, WdT, nullptr, scr, 2 * p, 2 * CONV_PAIRS_D, lane, ws + WS_WD8, pg8::WD8_SCALE);
}

__device__ __forceinline__ void p3b_quant_rows(const Frame& F, const Args& a) {
    const int gw = F.vcu * NWAVES + F.wave, NGW = F.G * NWAVES; int lane = F.lane; asm volatile("" : "+v"(lane));
    const float* ss = (const float*)(a.ws + WS_CTL) + CW_SS2; float* RQ = (float*)(a.ws + WS_CTL) + CW_RQ;
    const bf16* X1B = (const bf16*)(a.ws + WS_KEXT); unsigned char* X1Q = a.ws + WS_X1Q;
    typedef unsigned u32x2g __attribute__((ext_vector_type(2)));
    for (int m0 = gw; m0 < MR; m0 += 2 * NGW) {
      v4u vv[2][8];
#pragma unroll
      for (int t = 0; t < 2; ++t) { const int mt = m0 + t * NGW < MR ? m0 + t * NGW : m0; const GAS v4u* xr = (const GAS v4u*)(X1B + (size_t)mt * DM) + lane;
#pragma unroll
          for (int j = 0; j < 8; ++j) vv[t][j] = xr[64 * j]; }
#pragma unroll
      for (int t = 0; t < 2; ++t) {
        const int m = m0 + t * NGW; if (m >= MR) break;
        v4u v[8]; float mx = 0.f;
#pragma unroll
        for (int j = 0; j < 8; ++j) v[j] = vv[t][j];
#pragma unroll
        for (int j = 0; j < 8; ++j) {
            mx = fmaxf(mx, fmaxf(fmaxf(fabsf(pg8::bflo(v[j].x)), fabsf(pg8::bfhi(v[j].x))), fmaxf(fabsf(pg8::bflo(v[j].y)), fabsf(pg8::bfhi(v[j].y)))));
            mx = fmaxf(mx, fmaxf(fmaxf(fabsf(pg8::bflo(v[j].z)), fabsf(pg8::bfhi(v[j].z))), fmaxf(fabsf(pg8::bflo(v[j].w)), fabsf(pg8::bfhi(v[j].w))))); }
#pragma unroll
        for (int o = 1; o < 64; o <<= 1) mx = fmaxf(mx, __shfl_xor(mx, o));
        mx = fmaxf(mx, 1e-30f);
        const float sc = 127.0f / mx;
        GAS u32x2g* o8 = (GAS u32x2g*)(X1Q + (size_t)m * DM) + lane;
#pragma unroll
        for (int j = 0; j < 8; ++j) { u32x2g o;
            o.x = pg8::pk4_i8(pg8::bflo(v[j].x) * sc, pg8::bfhi(v[j].x) * sc, pg8::bflo(v[j].y) * sc, pg8::bfhi(v[j].y) * sc);
            o.y = pg8::pk4_i8(pg8::bflo(v[j].z) * sc, pg8::bfhi(v[j].z) * sc, pg8::bflo(v[j].w) * sc, pg8::bfhi(v[j].w) * sc);
            o8[64 * j] = o; }
        if (lane == 0) RQ[m] = mx * (1.0f / 127.0f) / sqrtf(ss[m] * (1.0f / DM) + EPS);
      }
    }
}

__device__ __forceinline__ void p3_sample_final(const Frame& F, const Args& a, int row, const unsigned* cnt, unsigned want) {
    int lane = F.lane; asm volatile("" : "+v"(lane));
    { unsigned sp = 0; while (__hip_atomic_load(cnt, RLX_AGENT) < want) { __builtin_amdgcn_s_sleep(4); if (++sp > (1u << 22)) break; } }
    __builtin_amdgcn_fence(__ATOMIC_ACQUIRE, "agent");
    const float* xs = a.in[I_XS] + (size_t)row * DM; const float* part = (const float*)(a.ws + WS_PARK) + (size_t)row * DM;
    bf16* X1B = (bf16*)(a.ws + WS_KEXT) + ((size_t)MP + row) * DM;
    float s = 0.f;
#pragma unroll 4
    for (int j = 0; j < 16; ++j) { const int c = 4 * (lane + 64 * j);
        f32x4 t = *(const GAS f32x4*)(xs + c);
#pragma unroll
        for (int q = 0; q < 8; ++q) t += *(const GAS f32x4*)(part + (size_t)q * MS * DM + c);
        s += (t.x * t.x + t.y * t.y) + (t.z * t.z + t.w * t.w);
        typedef unsigned u32x2g __attribute__((ext_vector_type(2)));
        *(GAS u32x2g*)(X1B + c) = (u32x2g){pk2(t.x, t.y), pk2(t.z, t.w)}; }
    s = wave_sum(s);
    if (lane == 0) ((float*)(a.ws + WS_CTL))[CW_SS2 + MP + row] = s;
}

constexpr int SMP_SLICES = 8;
__device__ __forceinline__ void p5_sample_final(const Frame& F, const Args& a, int row, const unsigned* cnt, unsigned want) {
    int lane = F.lane; asm volatile("" : "+v"(lane));
    { unsigned sp = 0; while (__hip_atomic_load(cnt, RLX_AGENT) < want) { __builtin_amdgcn_s_sleep(4); if (++sp > (1u << 22)) break; } }
    __builtin_amdgcn_fence(__ATOMIC_ACQUIRE, "agent");
    const bf16* X1B = (const bf16*)(a.ws + WS_KEXT) + ((size_t)MP + row) * DM; const float* part = (const float*)(a.ws + WS_PARK) + (size_t)row * DM;
    f32x4 v[16]; float s = 0.f;
#pragma unroll
    for (int j = 0; j < 16; ++j) { const int c = 4 * (lane + 64 * j);
        typedef unsigned u32x2g __attribute__((ext_vector_type(2)));
        const u32x2g xw = *(const GAS u32x2g*)(X1B + c);
        f32x4 t = (f32x4){__uint_as_float(xw.x << 16), __uint_as_float(xw.x & 0xffff0000u), __uint_as_float(xw.y << 16), __uint_as_float(xw.y & 0xffff0000u)};
#pragma unroll
        for (int q = 0; q < SMP_SLICES; ++q) t += *(const GAS f32x4*)(part + (size_t)q * MS * DM + c);
        v[j] = t; s += (t.x * t.x + t.y * t.y) + (t.z * t.z + t.w * t.w); }
    const float r = 1.0f / sqrtf(wave_sum(s) * (1.0f / DM) + EPS);
    float* y = a.out + O_YS + (size_t)row * DM;
#pragma unroll
    for (int j = 0; j < 16; ++j) { const int c = 4 * (lane + 64 * j); const f32x4 g = *(const GAS f32x4*)(a.in[I_FNW] + c);
        *(GAS f32x4*)(y + c) = (f32x4){v[j].x * r * g.x, v[j].y * r * g.y, v[j].z * r * g.z, v[j].w * r * g.w}; }
}

__device__ __forceinline__ void p6_final_norm(const Frame& F, const Args& a) {
    const int gw = F.vcu * NWAVES + F.wave, NGW = F.G * NWAVES, lane = F.lane;
    const float* ss = (const float*)(a.ws + WS_CTL) + CW_SS3;
    const bf16* X2B = (const bf16*)(a.ws + WS_XN);
    for (int m = gw; m < MR; m += NGW) {
        const float r = 1.0f / sqrtf(__hip_atomic_load(ss + m, __ATOMIC_RELAXED, __HIP_MEMORY_SCOPE_AGENT) * (1.0f / DM) + EPS);
        const GAS v4u* xr = (const GAS v4u*)(X2B + (size_t)m * DM) + lane;
        GAS f32x4* y = (GAS f32x4*)(a.out + (m < MP ? O_YP + (size_t)m * DM : O_YS + (size_t)(m - MP) * DM)) + 2 * lane;
        const GAS f32x4* wv = (const GAS f32x4*)a.in[I_FNW] + 2 * lane;
#pragma unroll
        for (int j = 0; j < 8; ++j) { const v4u x = xr[64 * j]; const f32x4 g0 = wv[128 * j], g1 = wv[128 * j + 1];
            f32x4 o0, o1;
            o0.x = __uint_as_float(x.x << 16) * r * g0.x; o0.y = __uint_as_float(x.x & 0xffff0000u) * r * g0.y; o0.z = __uint_as_float(x.y << 16) * r * g0.z; o0.w = __uint_as_float(x.y & 0xffff0000u) * r * g0.w;
            o1.x = __uint_as_float(x.z << 16) * r * g1.x; o1.y = __uint_as_float(x.z & 0xffff0000u) * r * g1.y; o1.z = __uint_as_float(x.w << 16) * r * g1.z; o1.w = __uint_as_float(x.w & 0xffff0000u) * r * g1.w;
            y[128 * j] = o0; y[128 * j + 1] = o1; }
    }
}

__device__ __forceinline__ void p5_norm_own(const Frame& F, const Args& a, int pm, int col0, int ncols, int row0g, int nrows, unsigned* cnt, unsigned want) {
    int tid = F.tid; asm volatile("" : "+v"(tid));
    if (F.tid == 0) { unsigned sp = 0; while (__hip_atomic_load(cnt, RLX_AGENT) < want) { __builtin_amdgcn_s_sleep(4); if (++sp > (1u << 22)) break; } }
    asm volatile("s_waitcnt vmcnt(0)" ::: "memory");
    __syncthreads();
    LAS float* rs = (LAS float*)(F.lds + RING_OFF);
    const float* ss = (const float*)(a.ws + WS_CTL) + CW_SS3;
    if (tid < nrows) rs[tid] = 1.0f / sqrtf(__uint_as_float(__hip_atomic_load((const unsigned*)(ss + row0g + tid), RLX_AGENT)) * (1.0f / DM) + EPS);
    __syncthreads();
    const bf16* X2B = (const bf16*)(a.ws + WS_XN);
    const int pcs = ncols >> 3;
    if (ncols == 1024 && (nrows & 31) == 0) {
        const int cp = tid & 127, rb = tid >> 7, c = col0 + 8 * cp;
        const f32x4 g0 = *(const GAS f32x4*)(a.in[I_FNW] + c), g1 = *(const GAS f32x4*)(a.in[I_FNW] + c + 4);
        for (int j0 = 0; j0 < nrows / 4; j0 += 8) {
            v4u x[8];
#pragma unroll
            for (int q = 0; q < 8; ++q) x[q] = *(const GAS v4u*)(X2B + (size_t)(row0g + rb + 4 * (j0 + q)) * DM + c);
#pragma unroll
            for (int q = 0; q < 8; ++q) { const int r = rb + 4 * (j0 + q), row = row0g + r; const float rr = rs[r];
                f32x4 o0, o1;
                o0.x = __uint_as_float(x[q].x << 16) * rr * g0.x; o0.y = __uint_as_float(x[q].x & 0xffff0000u) * rr * g0.y; o0.z = __uint_as_float(x[q].y << 16) * rr * g0.z; o0.w = __uint_as_float(x[q].y & 0xffff0000u) * rr * g0.w;
                o1.x = __uint_as_float(x[q].z << 16) * rr * g1.x; o1.y = __uint_as_float(x[q].z & 0xffff0000u) * rr * g1.y; o1.z = __uint_as_float(x[q].w << 16) * rr * g1.z; o1.w = __uint_as_float(x[q].w & 0xffff0000u) * rr * g1.w;
                float* y = a.out + (row < MP ? O_YP + (size_t)row * DM : O_YS + (size_t)(row - MP) * DM) + c;
                *(GAS f32x4*)y = o0; *(GAS f32x4*)(y + 4) = o1; }
        }
    } else
    for (int i = tid; i < nrows * pcs; i += NWAVES * 64) {
        const int r = i / pcs, c = col0 + 8 * (i - r * pcs); const int row = row0g + r;
        const v4u x = *(const GAS v4u*)(X2B + (size_t)row * DM + c);
        const f32x4 g0 = *(const GAS f32x4*)(a.in[I_FNW] + c), g1 = *(const GAS f32x4*)(a.in[I_FNW] + c + 4); const float rr = rs[r];
        f32x4 o0, o1;
        o0.x = __uint_as_float(x.x << 16) * rr * g0.x; o0.y = __uint_as_float(x.x & 0xffff0000u) * rr * g0.y; o0.z = __uint_as_float(x.y << 16) * rr * g0.z; o0.w = __uint_as_float(x.y & 0xffff0000u) * rr * g0.w;
        o1.x = __uint_as_float(x.z << 16) * rr * g1.x; o1.y = __uint_as_float(x.z & 0xffff0000u) * rr * g1.y; o1.z = __uint_as_float(x.w << 16) * rr * g1.z; o1.w = __uint_as_float(x.w & 0xffff0000u) * rr * g1.w;
        float* y = a.out + (row < MP ? O_YP + (size_t)row * DM : O_YS + (size_t)(row - MP) * DM) + c;
        *(GAS f32x4*)y = o0; *(GAS f32x4*)(y + 4) = o1;
    }
    __syncthreads();
}

#ifndef P4_INT8
#define P4_INT8 1
#endif
#ifndef GEMM_ALIGN
#define GEMM_ALIGN true
#endif
#ifndef GEMM_SP2
#define GEMM_SP2 true
#endif
#ifndef GEMM_DIM16
#define GEMM_DIM16 false
#endif
#ifndef GEMM_SP2_8BIT
#define GEMM_SP2_8BIT true
#endif
#ifndef GEMM_ALIGN_P4
#define GEMM_ALIGN_P4 true
#endif
#ifdef PROBE_DEFER2
#define PROBE_DEFER_TWICE __syncthreads(); p0_deferred_item(F, args, (int)g);
#else
#define PROBE_DEFER_TWICE
#endif
#ifndef P1_TAIL_THRESH
#define P1_TAIL_THRESH 144
#endif
#ifndef GEMM_DIM
#define GEMM_DIM false
#endif
#ifndef TEST_STAGE
#define TEST_STAGE 99
#endif
__global__ void __launch_bounds__(NWAVES * 64, 2) fwd(Args args) {
    extern __shared__ __attribute__((aligned(16))) unsigned char lds[];
    Frame F;
    F.lds = (LAS unsigned char*)lds;
    F.MISC = (volatile LAS unsigned*)(F.lds + MISC_OFF);
    F.tid = threadIdx.x; F.lane = F.tid & 63; F.wave = __builtin_amdgcn_readfirstlane(F.tid >> 6);
    F.G = gridDim.x; { const int bx = blockIdx.x; F.vcu = (F.G % 8 == 0) ? (bx % 8) * (F.G / 8) + bx / 8 : bx; }
    unsigned char* ws = args.ws;
    F.ctl = (gu32*)(ws + WS_CTL);
    for (int u = F.tid; u < (LDS_BYTES - LDSCTL_OFF) / 4; u += NWAVES * 64) ((LAS unsigned*)(F.lds + LDSCTL_OFF))[u] = 0u;
    __syncthreads();
    XcdBarrier bar = xcd_barrier_post((unsigned*)(F.ctl + CW_BAR), F.MISC + 8);
#define GRID_BAR() xcd_barrier(bar)
    bf16* WinT = (bf16*)(ws + WS_WIN); bf16* WoT = (bf16*)(ws + WS_WO); bf16* WguT = (bf16*)(ws + WS_WGU); bf16* WdT = (bf16*)(ws + WS_WD);
    bf16* XN = (bf16*)(ws + WS_XN); bf16* Qb = (bf16*)(ws + WS_Q); bf16* Kb = (bf16*)(ws + WS_KB); bf16* Vb = (bf16*)(ws + WS_VB); bf16* Zb = (bf16*)(ws + WS_Z);
    bf16* XBC = (bf16*)(ws + WS_XBC); float* DT = (float*)(ws + WS_DT); bf16* Kext = (bf16*)(ws + WS_KEXT); bf16* Vext = (bf16*)(ws + WS_VEXT);
    bf16* MIX = (bf16*)(ws + WS_MIX); bf16* X1B = (bf16*)(ws + WS_X1B); bf16* HB = (bf16*)(ws + WS_H); bf16* X2B = (bf16*)(ws + WS_XN);
    float* SS2 = (float*)(ws + WS_CTL) + CW_SS2; float* SS3 = (float*)(ws + WS_CTL) + CW_SS3;

#if defined(PROBE_SPIN_A) && !defined(PROBE_TIMING)
#define PROBE_TIMING 1
#endif
#ifdef PROBE_TIMING
#define STAMP(k) do { if (blockIdx.x == 0 && F.tid == 0) { const unsigned long long t_ = __builtin_amdgcn_s_memrealtime(); F.MISC[16 + 2 * (k)] = (unsigned)t_; F.MISC[17 + 2 * (k)] = (unsigned)(t_ >> 32); } } while (0)
#else
#define STAMP(k) do { } while (0)
#endif
    unsigned long long sp_t0 = 0; (void)sp_t0;
#ifdef PROBE_SPREAD
#define SPREAD_T0(k) do { if ((k) == PROBE_SPREAD) sp_t0 = __builtin_amdgcn_s_memrealtime(); } while (0)
#define SPREAD_T1(k) do { if ((k) == PROBE_SPREAD && F.tid == 0) { const unsigned d_ = (unsigned)(__builtin_amdgcn_s_memrealtime() - sp_t0); __hip_atomic_fetch_add(F.ctl + CW_TMO + 4, d_, RLX_AGENT); __hip_atomic_fetch_add(F.ctl + CW_TMO + 32 + (blockIdx.x & 7), d_, RLX_AGENT); } } while (0)
#define SPREAD_T2(k) do { if ((k) == PROBE_SPREAD && blockIdx.x == 0 && F.tid == 0) { F.MISC[16 + 2 * 21] = __hip_atomic_load(F.ctl + CW_TMO + 4, RLX_AGENT) / (unsigned)F.G; F.MISC[17 + 2 * 21] = 0u; \
        F.MISC[16 + 2 * 22] = (unsigned)(__builtin_amdgcn_s_memrealtime() - sp_t0); F.MISC[17 + 2 * 22] = 0u; \
        unsigned mx_ = 0u, mn_ = 0xffffffffu; for (int x_ = 0; x_ < 8; ++x_) { const unsigned v_ = __hip_atomic_load(F.ctl + CW_TMO + 32 + x_, RLX_AGENT) / (unsigned)(F.G / 8); mx_ = v_ > mx_ ? v_ : mx_; mn_ = v_ < mn_ ? v_ : mn_; } \
        F.MISC[16 + 2 * 23] = mn_; F.MISC[17 + 2 * 23] = 0u; F.MISC[16 + 2 * 24] = mx_; F.MISC[17 + 2 * 24] = 0u; } } while (0)
#else
#define SPREAD_T0(k) do { } while (0)
#define SPREAD_T1(k) do { } while (0)
#define SPREAD_T2(k) do { } while (0)
#endif
    STAMP(0);
    p0_prologue(F, args);
#ifdef PROBE_P0_REPS
    for (int rep = 1; rep < PROBE_P0_REPS; ++rep) { GRID_BAR(); p0_prologue(F, args); }
#endif
#if TEST_STAGE < 99
    {
        const size_t gt = (size_t)F.vcu * NWAVES * 64 + F.tid, NT = (size_t)F.G * NWAVES * 64;
        GAS f32x4* o = (GAS f32x4*)args.out;
        for (size_t i = gt; i < O_END / 4; i += NT) {
            const size_t e = i * 4;
            bool keep = false;
#if TEST_STAGE >= 1
            keep = (e >= O_KP && e < O_SP) || (e >= O_KS && e < O_SS);
#endif
#if TEST_STAGE >= 2
            keep = keep || (e >= O_SP && e < O_KS) || (e >= O_SS);
#endif
            if (!keep) o[i] = (f32x4){0.f, 0.f, 0.f, 0.f};
        }
    }
#endif
    GRID_BAR();
    STAMP(1); SPREAD_T0(1);

#ifndef PROBE_P1_REPS
#define PROBE_P1_REPS 1
#endif
#ifndef PROBE_P4_REPS
#define PROBE_P4_REPS 1
#endif
    for (int rep = 0; rep < PROBE_P1_REPS; ++rep) {
        if (rep > 0) GRID_BAR();
        pg8::Gemm g{XN, WinT, MP, 12288, DM}; pg8::StaticOrder S; S.init(MP, 12288, F.G, (int)blockIdx.x);
        pg8::EpiInProj E{Qb, Kb, Vb, Zb, XBC, Kext, Vext, DT, args.out};
#ifdef PROBE_P1_LIGHT
        if (rep > 0) { pg8::EpiProbe EP{(bf16*)(ws + WS_DUMMY), 12288}; pg8::gemm_phase<pg8::EpiProbe, pg8::StaticOrder, GEMM_ALIGN, GEMM_SP2, 0, GEMM_DIM16>(F.lds + RING_OFF, g, S, EP); } else
#endif
        pg8::gemm_phase<pg8::EpiInProj, pg8::StaticOrder, GEMM_ALIGN, GEMM_SP2, 0, GEMM_DIM16>(F.lds + RING_OFF, g, S, E);
    }
    STAMP(11); SPREAD_T1(1);
#ifndef PROBE_SK1_REPS
#define PROBE_SK1_REPS 1
#endif
#ifndef PROBE_SK4_REPS
#define PROBE_SK4_REPS 1
#endif
    for (int rep = 0; rep < PROBE_SK1_REPS; ++rep) {
        const sk::EpiInS E1{WinT, Qb, Zb, XBC, Kext, Vext, DT, args.out};
        sk::skinny<8, 1, true>(F.lds + RING_OFF, XN + (size_t)MP * DM, DM, DM, NIN / 16, E1, F.wave, F.lane, (int)blockIdx.x, F.G);
        STAMP(13);
        const sk::EpiDtP E2{XN, DT};
        sk::skinny<2, 1, true>(F.lds + RING_OFF, WinT + (size_t)12288 * DM, DM, DM, MP / 16, E2, F.wave, F.lane, (int)((blockIdx.x + F.G / 2) % F.G), F.G);
    }
#if TEST_STAGE >= 2
    if (F.G == 256) {
        if (F.tid == 0) __hip_atomic_fetch_add(F.ctl + CW_DEFQ + 32, 1u, RLX_AGENT);
        for (;;) {
            if (F.tid == 0) { unsigned g_ = 0xffffffffu;
                if (__hip_atomic_load(F.ctl + CW_DEFQ + 32, RLX_AGENT) < (unsigned)P1_TAIL_THRESH) { g_ = __hip_atomic_fetch_add(F.ctl + CW_DEFQ, 1u, RLX_AGENT); if (g_ >= (unsigned)CONV_ITEMS_A) g_ = 0xffffffffu; }
                F.MISC[1] = g_; }
            __syncthreads();
            const unsigned g = F.MISC[1];
            __syncthreads();
            if (g >= (unsigned)CONV_ITEMS_A) break;
            p0_deferred_item(F, args, (int)g);
            __syncthreads();
        }
    }
    GRID_BAR();
    STAMP(2); SPREAD_T2(1);

    {
        float lam;
        { const float a = F.lane < 64 ? args.in[I_LQ1][F.lane] * args.in[I_LK1][F.lane] : 0.f, b = args.in[I_LQ2][F.lane] * args.in[I_LK2][F.lane];
          lam = __expf(wave_sum(a)) - __expf(wave_sum(b)) + LAM0; }
        const ssd::Params SP{args.in[I_CONVW], args.in[I_CONVB], args.in[I_DTB], args.in[I_ALOG], args.in[I_DSKIP], args.in[I_SSDNW]};
        constexpr int NSEG = 4, SEGLEN = SEQ / NSEG, NBG = NB * SG;
        constexpr int JS = 736  ;
        constexpr int E0 = (NSEG - 1) * NBG, E1 = E0 + NBG, E2 = E1 + 192, E3 = E2 + (NSEG - 1) * NBG, E4 = E3 + (JS - 192), E5 = E4 + DEC_B * NH, E6 = E5 + (1024 - JS), E7 = E6 + DEC_B * SG, NITEMS = E7;
        float* FSEG = (float*)(ws + WS_F);
#ifndef PROBE_MIX_REPS
#define PROBE_MIX_REPS 1
#define PROBE_MIX_SKIP 0
#endif
        for (int rep = 0; rep < PROBE_MIX_REPS; ++rep) {
        if (rep > 0) GRID_BAR();
        for (;;) {
            if (F.tid == 0) F.MISC[0] = __hip_atomic_fetch_add(F.ctl + CW_QUEUE + 64 * rep, 1u, RLX_AGENT);
            __syncthreads();
            const int pos = (int)F.MISC[0];
            __syncthreads();
            constexpr int NPOS = 256 + 3 * CONV_ITEMS;
            if (pos >= NPOS) break;
            int item = pos;
            if (pos >= 256) { const int q = pos - 256, grp = q / 3, r = q - 3 * grp;
                if (r == 2) {
                    if (rep == 0) {
                        if (F.tid == 0) { unsigned g_ = __hip_atomic_fetch_add(F.ctl + CW_DEFQ, 1u, RLX_AGENT);
                            if (g_ >= (unsigned)CONV_ITEMS_A) { g_ = __hip_atomic_fetch_add(F.ctl + CW_DEFQ + 16, 1u, RLX_AGENT); g_ = g_ < (unsigned)(CONV_ITEMS - CONV_ITEMS_A) ? g_ + CONV_ITEMS_A : 0xffffffffu; }
                            F.MISC[1] = g_; }
                        __syncthreads();
                        const unsigned g = F.MISC[1];
                        __syncthreads();
                        if (g < (unsigned)CONV_ITEMS) { p0_deferred_item(F, args, (int)g); PROBE_DEFER_TWICE }
                    }
                    __syncthreads(); continue; }
                item = 256 + 2 * grp + r; }
            if (item >= NITEMS) continue;
            const bool is_ssd = item < E1 || (item >= E2 && item < E3) || item >= E6;
            if (rep > 0 && ((PROBE_MIX_SKIP == 1 && is_ssd) || (PROBE_MIX_SKIP == 2 && !is_ssd))) continue;
            if (is_ssd) {
                ssd::Unit u; bool pre = false;
                if (item < E6) {
                    int seg, bg;
                    if (item < E0) { pre = true; seg = item / NBG; bg = item % NBG; }
                    else if (item < E1) { seg = 0; bg = item - E0; }
                    else { const int k = item - E2; seg = 1 + k / NBG; bg = k % NBG; }
                    const int b = bg >> 3; u.g = bg & 7; const size_t r0 = (size_t)b * SEQ + (size_t)seg * SEGLEN;
                    u.xbc = XBC + r0 * CONVD; u.z = Zb + r0 * SSDI; u.dtraw = DT + r0 * SH; u.hist = nullptr; u.init = nullptr;
                    u.fin = args.out + O_SP + (size_t)b * SH * SHD * DS; u.y = MIX + r0 * DM + AW; u.len = SEGLEN;
                    u.prev = seg > 0; u.seg = seg; u.fseg = FSEG + (size_t)bg * (NSEG - 1) * ssd::FSTRIDE; u.flag = (unsigned*)(F.ctl + CW_SSDF + 64 * bg) + 16 * rep; u.last = seg == NSEG - 1;
                } else { const int j = item - E6; const int b = j >> 3; u.g = j & 7; const size_t r0 = (size_t)MP + (size_t)b * DEC_T;
                    u.xbc = XBC + r0 * CONVD; u.z = Zb + r0 * SSDI; u.dtraw = DT + r0 * SH; u.hist = args.in[I_SCONV] + (size_t)b * 3 * CONVD; u.init = args.in[I_SSSM] + (size_t)b * SH * SHD * DS;
                    u.fin = args.out + O_SS + (size_t)b * SH * SHD * DS; u.y = MIX + r0 * DM + AW; u.len = DEC_T;
                    u.prev = 0; u.seg = 0; u.fseg = nullptr; u.flag = nullptr; u.last = 1; }
                if (pre) ssd::ssd_unit<true>(F.lds + RING_OFF, u, SP, F.tid, F.wave, F.lane);
                else ssd::ssd_unit<false>(F.lds + RING_OFF, u, SP, F.tid, F.wave, F.lane);
            } else {
                att::Unit u;
                if (item < E4 || item >= E5) { const int j = item < E2 ? item - E1 : item < E4 ? item - E3 + 192 : item - E5 + JS; const int qb = 31 - (j >> 5), bh = j & 31, b = bh >> 4, h = bh & 15; const size_t r0 = (size_t)b * SEQ;
                    u.Q = Qb + (r0 + 256 * qb) * AW + h * HD; u.K = Kb + r0 * AW + h * HD; u.V = Vb + r0 * AW + h * HD; u.O = MIX + (r0 + 256 * qb) * DM + h * HD;
                    u.ntot = 4 * qb + 4; u.nvalid_last = 64; u.sample = 0; u.qb = qb; u.park = nullptr; u.variant = 0;
#ifdef PROBE_ATT_VARIANT
                    if (rep > 0) { u.variant = PROBE_ATT_VARIANT; u.O = (bf16*)(ws + WS_DUMMY) + (r0 + 256 * qb) * DM + h * HD; }
#endif
                    }
                else { const int j = item - E4; const int b = j >> 4, h = j & 15; const size_t r0 = (size_t)MP + (size_t)b * DEC_T;
                    u.Q = Qb + r0 * AW + h * HD; u.K = Kext + (size_t)b * KVROWS * AW + h * HD; u.V = Vext + (size_t)b * KVROWS * AW + h * HD; u.O = MIX + r0 * DM + h * HD;
                    u.ntot = KVROWS / 64; u.nvalid_last = PAST + DEC_T - (KVROWS / 64 - 1) * 64; u.sample = 1; u.qb = 0; u.park = nullptr; u.variant = 0;
                    p2_cache_slice(F, args, b, h);
#ifdef PROBE_ATT_VARIANT
                    if (rep > 0) { u.variant = PROBE_ATT_VARIANT; u.O = (bf16*)(ws + WS_DUMMY) + r0 * DM + h * HD; }
#endif
                    }
                att::attn_unit(F.lds + RING_OFF, u, lam, args.in[I_SUBLN], F.wave, F.lane);
            }
            __syncthreads();
        }
        }
    }
#endif
#if TEST_STAGE >= 3
#ifdef PROBE_TIMING
    if (F.tid == 0) __hip_atomic_fetch_max(F.ctl + CW_TMO + 2, ~(unsigned)__builtin_amdgcn_s_memrealtime(), RLX_AGENT);
#endif
    GRID_BAR();
    STAMP(3); SPREAD_T0(3);
#ifdef PROBE_TIMING
    if (blockIdx.x == 0 && F.tid == 0) { F.MISC[16 + 2 * 20] = ~__hip_atomic_load(F.ctl + CW_TMO + 2, RLX_AGENT); F.MISC[17 + 2 * 20] = F.MISC[17 + 2 * 3]; }
#endif
    {
        if (F.G == 256) {
            const int sl = (int)blockIdx.x & 7;
            const sk::EpiOutPart E1{WoT, (float*)(ws + WS_PARK) + (size_t)sl * MS * DM, 512 * sl};
            sk::skinny<8, 1>(F.lds + RING_OFF, MIX + (size_t)MP * DM + 512 * sl, DM, 512, DM / 16, E1, F.wave, F.lane, (int)blockIdx.x >> 3, 32);
            asm volatile("s_waitcnt vmcnt(0)" ::: "memory"); __syncthreads();
            if (F.tid == 0) { __builtin_amdgcn_fence(__ATOMIC_RELEASE, "agent"); __hip_atomic_fetch_add(F.ctl + CW_SMPC + 64, 1u, RLX_AGENT); }
        }
        pg8::Gemm g{MIX, WoT, MP, DM, DM}; pg8::StaticOrder S; S.init(MP, DM, F.G, (int)blockIdx.x);
        pg8::EpiOutProj E{args.in[I_XP], args.in[I_XS], args.out, X1B, SS2};
        pg8::gemm_phase<pg8::EpiOutProj, pg8::StaticOrder, GEMM_ALIGN, GEMM_SP2, 0, GEMM_DIM16>(F.lds + RING_OFF, g, S, E);
        STAMP(12); SPREAD_T1(3);
#ifdef PROBE_P3_REPS
        for (int rep = 1; rep < PROBE_P3_REPS; ++rep) { GRID_BAR(); pg8::EpiProbe EP{HB, DM}; pg8::gemm_phase<pg8::EpiProbe, pg8::StaticOrder, GEMM_ALIGN, GEMM_SP2, 0, GEMM_DIM16>(F.lds + RING_OFF, g, S, EP); }
#endif
        if (F.G == 256) { if (blockIdx.x < 16) p3_sample_final(F, args, 8 * (int)blockIdx.x + F.wave, (const unsigned*)(F.ctl + CW_SMPC + 64), 256u); }
        else {
            const sk::EpiOutS E1{WoT, args.in[I_XS], args.out, X1B, SS2};
            sk::skinny<8, 1>(F.lds + RING_OFF, MIX + (size_t)MP * DM, DM, DM, DM / 16, E1, F.wave, F.lane, (int)blockIdx.x, F.G);
        }
    }
    GRID_BAR();
#ifdef PROBE_EXTRA_BARS
    for (int i = 0; i < PROBE_EXTRA_BARS; ++i) GRID_BAR();
#endif
    STAMP(4); SPREAD_T2(3);
#if P4_INT8
    p3b_quant_rows(F, args);
    GRID_BAR();
    STAMP(7); SPREAD_T0(4);
#endif
    for (int rep = 0; rep < PROBE_P4_REPS; ++rep) {
        if (rep > 0) GRID_BAR();
#if P4_INT8
        pg8::Gemm g{(const bf16*)(ws + WS_X1Q), (const bf16*)(ws + WS_WGUQ), MPAD, 2 * DFF, DM / 2}; pg8::StaticOrder S; S.init(MPAD, 2 * DFF, F.G, (int)blockIdx.x);
        pg8::EpiGateUpT<true> E{HB, (const float*)(F.ctl + CW_RQ), 1.0f / wq_scale(ws, 0), 1.0f / wq_scale(ws, 1), (bf16*)(ws + WS_HS)};
        pg8::gemm_phase<pg8::EpiGateUpT<true>, pg8::StaticOrder, GEMM_ALIGN_P4, GEMM_SP2_8BIT, 2, GEMM_DIM>(F.lds + RING_OFF, g, S, E);
#else
        pg8::Gemm g{X1B, WguT, MP, 2 * DFF, DM}; pg8::StaticOrder S; S.init(MP, 2 * DFF, F.G, (int)blockIdx.x);
        pg8::EpiGateUp E{HB, SS2};
        pg8::gemm_phase<pg8::EpiGateUp, pg8::StaticOrder, GEMM_ALIGN, GEMM_SP2, 0, GEMM_DIM16>(F.lds + RING_OFF, g, S, E);
#endif
    }
    SPREAD_T1(4);
#if !P4_INT8
    for (int rep = 0; rep < PROBE_SK4_REPS; ++rep) {
        const sk::EpiGuS E1{WguT, (bf16*)(ws + WS_HS), SS2};
        if (F.G == 256) { if (blockIdx.x >= 128) sk::skinny<8, 2>(F.lds + RING_OFF, X1B + (size_t)MP * DM, DM, DM, DFF / 16, E1, F.wave, F.lane, (int)blockIdx.x - 128, 128); }
        else sk::skinny<8, 2>(F.lds + RING_OFF, X1B + (size_t)MP * DM, DM, DM, DFF / 16, E1, F.wave, F.lane, (int)blockIdx.x, F.G);
    }
#endif
    GRID_BAR();
    STAMP(5); SPREAD_T2(4); SPREAD_T0(5);
    if (F.G == 256) {
        {
            const int sl = (int)blockIdx.x & 7, c0 = sl * 5 + (sl < 3 ? sl : 3), ncs = sl < 3 ? 6 : 5;
            const sk::EpiDownPart E1{WdT, (float*)(ws + WS_PARK) + (size_t)sl * MS * DM, 256 * c0};
            sk::skinny<8, 1>(F.lds + RING_OFF, (const bf16*)(ws + WS_HS) + 256 * c0, DFF, 256 * ncs, DM / 16, E1, F.wave, F.lane, (int)blockIdx.x >> 3, 32);
            asm volatile("s_waitcnt vmcnt(0)" ::: "memory"); __syncthreads();
            if (F.tid == 0) { __builtin_amdgcn_fence(__ATOMIC_RELEASE, "agent"); __hip_atomic_fetch_add(F.ctl + CW_SMPC, 1u, RLX_AGENT); }
        }
        STAMP(10);
        pg8::Gemm g{HB, (const bf16*)(ws + WS_WD8), MP, DM, DFF / 2}; pg8::PanelOrder S; S.init((int)blockIdx.x, (unsigned*)(F.ctl + CW_P5C));
        pg8::EpiDown E{X1B, X2B, SS3};
        pg8::gemm_phase<pg8::EpiDown, pg8::PanelOrder, GEMM_ALIGN, GEMM_SP2_8BIT, 1, GEMM_DIM>(F.lds + RING_OFF, g, S, E);
        STAMP(8); SPREAD_T1(5);
        p5_norm_own(F, args, S.pm, 1024 * S.q4, 1024, 256 * S.pm, 256, (unsigned*)(F.ctl + CW_P5C) + 64 * S.pm, 128u);
        STAMP(9);
        if (blockIdx.x < 16) p5_sample_final(F, args, 8 * (int)blockIdx.x + F.wave, (const unsigned*)(F.ctl + CW_SMPC), 256u);
    } else {
        {
            pg8::Gemm g{HB, (const bf16*)(ws + WS_WD8), MP, DM, DFF / 2}; pg8::StaticOrder S; S.init(MP, DM, F.G, (int)blockIdx.x);
            pg8::EpiDown E{X1B, X2B, SS3};
            pg8::gemm_phase<pg8::EpiDown, pg8::StaticOrder, GEMM_ALIGN, GEMM_SP2_8BIT, 1, GEMM_DIM>(F.lds + RING_OFF, g, S, E);
            const sk::EpiDownS E1{WdT, X1B, X2B, SS3};
            sk::skinny<8, 1>(F.lds + RING_OFF, (const bf16*)(ws + WS_HS), DFF, DFF, DM / 16, E1, F.wave, F.lane, (int)blockIdx.x, F.G);
        }
        GRID_BAR();
        p6_final_norm(F, args);
    }
#endif
#ifdef PROBE_SPIN_A
    STAMP(6);
    if (blockIdx.x == 0 && F.tid == 0) {
        const unsigned long long ta = (unsigned long long)F.MISC[16 + 2 * (PROBE_SPIN_A)] | ((unsigned long long)F.MISC[17 + 2 * (PROBE_SPIN_A)] << 32);
        const unsigned long long tb = (unsigned long long)F.MISC[16 + 2 * (PROBE_SPIN_B)] | ((unsigned long long)F.MISC[17 + 2 * (PROBE_SPIN_B)] << 32);
        const unsigned long long d = 4ull * (tb - ta), t0 = __builtin_amdgcn_s_memrealtime();
        while (__builtin_amdgcn_s_memrealtime() - t0 < d) __builtin_amdgcn_s_sleep(32);
    }
#endif
}

extern "C" void kernel_launch(void* const* d_in, const int* in_sizes, int n_in, void* d_out, int out_size, void* d_ws, size_t ws_size, hipStream_t stream) {
    static int grid = 0;
    if (grid == 0) {
        if (n_in != 25 || (size_t)out_size != O_END || ws_size < WS_END) { fprintf(stderr, "kernel_launch: unexpected shapes: n_in %d out %d ws %zu; nothing launched\n", n_in, out_size, ws_size); grid = -1; return; }
        int dev = 0, cus = 0, per_cu = 0;
        if (hipGetDevice(&dev) != hipSuccess || hipDeviceGetAttribute(&cus, hipDeviceAttributeMultiprocessorCount, dev) != hipSuccess) { grid = -1; return; }
        if (hipFuncSetAttribute((const void*)fwd, hipFuncAttributeMaxDynamicSharedMemorySize, LDS_BYTES) != hipSuccess) { fprintf(stderr, "kernel_launch: hipFuncSetAttribute failed\n"); grid = -1; return; }
        if (hipOccupancyMaxActiveBlocksPerMultiprocessor(&per_cu, (const void*)fwd, NWAVES * 64, LDS_BYTES) != hipSuccess || per_cu < 1)
            fprintf(stderr, "kernel_launch: note: occupancy query reports %d workgroups per CU\n", per_cu);
        (void)hipGetLastError();
        grid = cus;
    }
    if (grid < 0) return;
    if (hipMemsetAsync((char*)d_ws + WS_CTL, 0, CTL_ZERO_BYTES, stream) != hipSuccess) return;
    Args a{};
    for (int i = 0; i < 25; ++i) a.in[i] = (const float*)d_in[i];
    a.out = (float*)d_out; a.ws = (unsigned char*)d_ws; a.ph_lo = 0; a.ph_hi = 99;
    hipLaunchKernelGGL(fwd, dim3(grid), dim3(NWAVES * 64), LDS_BYTES, stream, a);
}
```

```cpp
#include <hip/hip_runtime.h>
#include <cstdio>
#include <cstdint>
namespace pg8 {
#define PG8_LAS __attribute__((address_space(3)))
typedef unsigned short bf16_t;
typedef short bf16x8 __attribute__((ext_vector_type(8)));
typedef float f32x4 __attribute__((ext_vector_type(4)));
typedef unsigned u32x4 __attribute__((ext_vector_type(4)));
constexpr int BM = 256, BK = 64, HALF = 128, HTB = HALF * BK * 2  , STAGE_BYTES = 8 * HTB, NXCD = 8, WGM = 8;

__host__ __device__ __forceinline__ int lds_byte(int r, int c) { const int st = (r >> 4) * 2 + (c >> 5), rr = r & 15, cc = c & 31, ob = rr * 64 + cc * 2; return st * 1024 + (ob ^ (((ob >> 9) & 1) << 5)); }
__host__ __device__ __forceinline__ void stage_rc(int b, int& R, int& C) { const int st = b / 1024, sb = b % 1024, swz = sb ^ (((sb >> 9) & 1) << 5); R = (st >> 1) * 16 + swz / 64; C = (st & 1) * 32 + (swz % 64) / 2; }
__host__ __device__ __forceinline__ int perm32(int rho) { const int n = rho >> 4, i = rho & 15; return 8 * (i >> 2) + 4 * n + (i & 3); }

struct Unit { int pm, pn; };
struct Gemm { const bf16_t* A; const bf16_t* Bt; int M, N, K; };

struct StaticOrder {
    int nM, nN, nwg, G, c;
    __host__ __device__ void init(int M, int N, int G_, int c_) { nM = M / BM; nN = N / BM; nwg = nM * nN; G = G_; c = c_; }
    __host__ __device__ bool next(int i, Unit& u) const {
        const long L = (long)i * G + c; if (L >= nwg) return false;
        int wgid = (int)L; { const int q = nwg / NXCD, r = nwg % NXCD, xcd = wgid % NXCD, off = wgid / NXCD; wgid = (xcd < r ? xcd * (q + 1) : r * (q + 1) + (xcd - r) * q) + off; }
        const int nig = WGM * nN, gid = wgid / nig, fm = gid * WGM, gsz = (nM - fm) < WGM ? (nM - fm) : WGM;
        u.pm = fm + ((wgid % nig) % gsz); u.pn = (wgid % nig) / gsz; return true;
    }
    __device__ __forceinline__ void a_ready(const Unit&) const {}
    __device__ __forceinline__ void done(const Unit&) const {}
};

__device__ __forceinline__ unsigned cvt_pk_bf16(float lo, float hi) { unsigned r; asm volatile("v_cvt_pk_bf16_f32 %0, %1, %2" : "=v"(r) : "v"(lo), "v"(hi)); return r; }
typedef float f32x2 __attribute__((ext_vector_type(2)));
template <class Epi, class Sched, bool ALIGN_EPI = false, bool SP2 = false, int QM = 0  , bool DIM = false>
__device__ __forceinline__ void gemm_phase(PG8_LAS unsigned char* lds, const Gemm g, const Sched& S, const Epi& E) {
    constexpr bool FP8 = (QM == 1), INT8 = (QM == 2);
    int tid_ = threadIdx.x; asm volatile("" : "+v"(tid_));
    const int tid = tid_, wid = __builtin_amdgcn_readfirstlane(tid >> 6), lane = tid & 63, wr = wid >> 2, wc = wid & 3, fr = lane & 15, fq = lane >> 4;
    const int K = g.K, nt = K / BK;
    unsigned voffA[2], voffB[2];
#pragma unroll
    for (int i = 0; i < 2; ++i) { int R, C; stage_rc(tid * 16 + i * 8192, R, C); const int Rb = Epi::PERM ? ((R & ~31) + perm32(R & 31)) : R;
        voffA[i] = (unsigned)(R * K + C) * 2u; voffB[i] = (unsigned)(Rb * K + C) * 2u; }
    const size_t kstep = (size_t)(BK * 2);
    const size_t hstep = (size_t)HALF * K * 2;
    const size_t tstep = 2 * hstep;
    const unsigned ldsw = (unsigned)wid * 1024u;
    const int aoff = lds_byte(wr * 64 + fr, FP8 ? fq * 16 : fq * 8), boff = lds_byte(wc * 32 + fr, FP8 ? fq * 16 : fq * 8);
    const int aoff1 = FP8 ? aoff + 16 : aoff + 1024, boff1 = FP8 ? boff + 16 : boff + 1024;
    typedef int v8i_t __attribute__((ext_vector_type(8))); typedef int v4i_t __attribute__((ext_vector_type(4)));
#define PG8_SA(b, h) (((b) * 2 + (h)) * HTB)
#define PG8_SB(b, h) ((4 + (b) * 2 + (h)) * HTB)
#define PG8_STAGE(bufoff, gbase, voff) do { _Pragma("unroll") for (int _i = 0; _i < 2; ++_i) \
        __builtin_amdgcn_global_load_lds((const unsigned*)((const char*)(gbase) + (voff)[_i]), (PG8_LAS unsigned*)(lds + (bufoff) + ldsw + _i * 8192), 16, 0, 0); } while (0)
#define PG8_CAT8(x, y) __builtin_shufflevector(__builtin_bit_cast(v4i_t, x), __builtin_bit_cast(v4i_t, y), 0, 1, 2, 3, 4, 5, 6, 7)
#define PG8_LDA(dst, b, h) do { if constexpr (FP8) { _Pragma("unroll") for (int m = 0; m < 4; ++m) dst##8[m] = PG8_CAT8(*(const PG8_LAS bf16x8*)(lds + PG8_SA(b, h) + aoff + m * 2048), *(const PG8_LAS bf16x8*)(lds + PG8_SA(b, h) + aoff1 + m * 2048)); } \
        else { _Pragma("unroll") for (int m = 0; m < 4; ++m) _Pragma("unroll") for (int k = 0; k < 2; ++k) dst[m][k] = *(const PG8_LAS bf16x8*)(lds + PG8_SA(b, h) + (k ? aoff1 : aoff) + m * 2048); } } while (0)
#define PG8_LDB(dst, b, h) do { if constexpr (FP8) { _Pragma("unroll") for (int n = 0; n < 2; ++n) dst##8[n] = PG8_CAT8(*(const PG8_LAS bf16x8*)(lds + PG8_SB(b, h) + boff + n * 2048), *(const PG8_LAS bf16x8*)(lds + PG8_SB(b, h) + boff1 + n * 2048)); } \
        else { _Pragma("unroll") for (int n = 0; n < 2; ++n) _Pragma("unroll") for (int k = 0; k < 2; ++k) dst[n][k] = *(const PG8_LAS bf16x8*)(lds + PG8_SB(b, h) + (k ? boff1 : boff) + n * 2048); } } while (0)
#define PG8_MMA(ai, bj, At, Bt) do { __builtin_amdgcn_s_setprio(1); \
        if constexpr (FP8) { _Pragma("unroll") for (int m = 0; m < 4; ++m) _Pragma("unroll") for (int n = 0; n < 2; ++n) \
            asm volatile("v_mfma_scale_f32_16x16x128_f8f6f4 %0, %1, %2, %0, %3, %3 op_sel_hi:[0,0,0]" : "+v"(acc[ai][bj][m][n]) : "v"(Bt##8[n]), "v"(At##8[m]), "v"(sc8_)); } \
        else if constexpr (INT8) { _Pragma("unroll") for (int m = 0; m < 4; ++m) _Pragma("unroll") for (int n = 0; n < 2; ++n) _Pragma("unroll") for (int k = 0; k < 2; ++k) \
            acc[ai][bj][m][n] = __builtin_bit_cast(f32x4, __builtin_amdgcn_mfma_i32_16x16x64_i8(__builtin_bit_cast(v4i_t, Bt[n][k]), __builtin_bit_cast(v4i_t, At[m][k]), __builtin_bit_cast(v4i_t, acc[ai][bj][m][n]), 0, 0, 0)); } \
        else { _Pragma("unroll") for (int m = 0; m < 4; ++m) _Pragma("unroll") for (int n = 0; n < 2; ++n) _Pragma("unroll") for (int k = 0; k < 2; ++k) \
            acc[ai][bj][m][n] = __builtin_amdgcn_mfma_f32_16x16x32_bf16(Bt[n][k], At[m][k], acc[ai][bj][m][n], 0, 0, 0); } \
        __builtin_amdgcn_s_setprio(0); } while (0)
#define PG8_MMAH(ai, bj, At, Bt, m0) do { \
        if constexpr (FP8) { _Pragma("unroll") for (int m = m0; m < m0 + 2; ++m) _Pragma("unroll") for (int n = 0; n < 2; ++n) \
            asm volatile("v_mfma_scale_f32_16x16x128_f8f6f4 %0, %1, %2, %0, %3, %3 op_sel_hi:[0,0,0]" : "+v"(acc[ai][bj][m][n]) : "v"(Bt##8[n]), "v"(At##8[m]), "v"(sc8_)); } \
        else if constexpr (INT8) { _Pragma("unroll") for (int m = m0; m < m0 + 2; ++m) _Pragma("unroll") for (int n = 0; n < 2; ++n) _Pragma("unroll") for (int k = 0; k < 2; ++k) \
            acc[ai][bj][m][n] = __builtin_bit_cast(f32x4, __builtin_amdgcn_mfma_i32_16x16x64_i8(__builtin_bit_cast(v4i_t, Bt[n][k]), __builtin_bit_cast(v4i_t, At[m][k]), __builtin_bit_cast(v4i_t, acc[ai][bj][m][n]), 0, 0, 0)); } \
        else { _Pragma("unroll") for (int m = m0; m < m0 + 2; ++m) _Pragma("unroll") for (int n = 0; n < 2; ++n) _Pragma("unroll") for (int k = 0; k < 2; ++k) \
            acc[ai][bj][m][n] = __builtin_amdgcn_mfma_f32_16x16x32_bf16(Bt[n][k], At[m][k], acc[ai][bj][m][n], 0, 0, 0); } } while (0)
#define PG8_WAIT_V(n) asm volatile("s_waitcnt vmcnt(" #n ")" ::: "memory")
#define PG8_WAIT_L(n) asm volatile("s_waitcnt lgkmcnt(" #n ")" ::: "memory")
#define PG8_BAR __builtin_amdgcn_s_barrier()
#define PG8_SCHED __builtin_amdgcn_sched_barrier(0)
    Unit cur, nxt; int ui = 0;
    if (!S.next(0, cur)) return;
    f32x4 acc[2][2][4][2];
#pragma unroll
    for (int a = 0; a < 2; ++a)
#pragma unroll
        for (int b = 0; b < 2; ++b)
#pragma unroll
            for (int m = 0; m < 4; ++m)
#pragma unroll
                for (int n = 0; n < 2; ++n) acc[a][b][m][n] = (f32x4){0.f, 0.f, 0.f, 0.f};
    bf16x8 At[4][2], B0[2][2], B1[2][2]; v8i_t At8[4], B08[2], B18[2]; const int sc8_ = 0x7f7f7f7f;
    const char* cA = (const char*)g.A + (size_t)cur.pm * tstep; const char* cB = (const char*)g.Bt + (size_t)cur.pn * tstep;
    S.a_ready(cur);
    if constexpr (SP2) {
        PG8_STAGE(PG8_SB(0, 0), cB, voffB); PG8_STAGE(PG8_SB(0, 1), cB + hstep, voffB); PG8_STAGE(PG8_SA(0, 0), cA, voffA); PG8_STAGE(PG8_SA(0, 1), cA + hstep, voffA);
        if (wr == 1) PG8_BAR;
        PG8_WAIT_V(2); PG8_BAR;
        PG8_STAGE(PG8_SB(1, 0), cB + kstep, voffB); PG8_STAGE(PG8_SA(1, 0), cA + kstep, voffA); PG8_STAGE(PG8_SB(1, 1), cB + hstep + kstep, voffB);
        PG8_WAIT_V(6); PG8_BAR;
    } else {
        PG8_STAGE(PG8_SB(0, 0), cB, voffB); PG8_STAGE(PG8_SA(0, 0), cA, voffA); PG8_STAGE(PG8_SB(0, 1), cB + hstep, voffB); PG8_STAGE(PG8_SA(0, 1), cA + hstep, voffA);
        if (wr == 1) PG8_BAR;
        PG8_WAIT_V(4); PG8_BAR;
        PG8_STAGE(PG8_SB(1, 0), cB + kstep, voffB); PG8_STAGE(PG8_SA(1, 0), cA + kstep, voffA); PG8_STAGE(PG8_SB(1, 1), cB + hstep + kstep, voffB);
        PG8_WAIT_V(6); PG8_BAR;
    }
    for (;;) {
        const bool has_next = S.next(ui + 1, nxt);
        const char* nA = has_next ? (const char*)g.A + (size_t)nxt.pm * tstep : cA; const char* nB = has_next ? (const char*)g.Bt + (size_t)nxt.pn * tstep : cB;
        for (int t = 0; t < nt; t += 2) {
            const bool last = (t == nt - 2);
            const char* a1 = cA + (size_t)(t + 1) * kstep;
            const char* a2 = last ? nA : cA + (size_t)(t + 2) * kstep; const char* b2 = last ? nB : cB + (size_t)(t + 2) * kstep;
            const char* a3 = a2 + kstep; const char* b3 = b2 + kstep;
            if (last && has_next) S.a_ready(nxt);
            if constexpr (SP2 && DIM) {
            PG8_LDB(B0, 0, 0); PG8_LDB(B1, 0, 1); PG8_SCHED; PG8_LDA(At, 0, 0);
            PG8_WAIT_V(6); PG8_WAIT_L(0); PG8_BAR; __builtin_amdgcn_s_setprio(1); PG8_MMAH(0, 0, At, B0, 0); PG8_MMAH(0, 0, At, B0, 2); PG8_SCHED; PG8_STAGE(PG8_SA(1, 1), a1 + hstep, voffA); PG8_SCHED; PG8_MMAH(0, 1, At, B1, 0); PG8_MMAH(0, 1, At, B1, 2); __builtin_amdgcn_s_setprio(0); PG8_BAR; PG8_SCHED;
            PG8_LDA(At, 0, 1);
            PG8_WAIT_V(2); PG8_WAIT_L(0); PG8_BAR; __builtin_amdgcn_s_setprio(1); PG8_MMAH(1, 0, At, B0, 0); PG8_SCHED; PG8_STAGE(PG8_SB(0, 0), b2, voffB); PG8_SCHED; PG8_MMAH(1, 0, At, B0, 2); PG8_SCHED; PG8_STAGE(PG8_SB(0, 1), b2 + hstep, voffB); PG8_SCHED;
            PG8_MMAH(1, 1, At, B1, 0); PG8_SCHED; PG8_STAGE(PG8_SA(0, 0), a2, voffA); PG8_SCHED; PG8_MMAH(1, 1, At, B1, 2); __builtin_amdgcn_s_setprio(0); PG8_BAR; PG8_SCHED;
            PG8_LDB(B0, 1, 0); PG8_LDB(B1, 1, 1); PG8_SCHED; PG8_LDA(At, 1, 0);
            PG8_WAIT_V(6); PG8_WAIT_L(0); PG8_BAR; __builtin_amdgcn_s_setprio(1); PG8_MMAH(0, 0, At, B0, 0); PG8_MMAH(0, 0, At, B0, 2); PG8_SCHED; PG8_STAGE(PG8_SA(0, 1), a2 + hstep, voffA); PG8_SCHED; PG8_MMAH(0, 1, At, B1, 0); PG8_MMAH(0, 1, At, B1, 2); __builtin_amdgcn_s_setprio(0); PG8_BAR; PG8_SCHED;
            PG8_LDA(At, 1, 1);
            PG8_WAIT_V(2); PG8_WAIT_L(0); PG8_BAR; __builtin_amdgcn_s_setprio(1); PG8_MMAH(1, 0, At, B0, 0); PG8_SCHED; PG8_STAGE(PG8_SB(1, 0), b3, voffB); PG8_SCHED; PG8_MMAH(1, 0, At, B0, 2); PG8_SCHED; PG8_STAGE(PG8_SB(1, 1), b3 + hstep, voffB); PG8_SCHED;
            PG8_MMAH(1, 1, At, B1, 0); PG8_SCHED; PG8_STAGE(PG8_SA(1, 0), a3, voffA); PG8_SCHED; PG8_MMAH(1, 1, At, B1, 2); __builtin_amdgcn_s_setprio(0); PG8_BAR; PG8_SCHED;
            } else if constexpr (SP2) {
            PG8_LDB(B0, 0, 0); PG8_LDB(B1, 0, 1); PG8_SCHED; PG8_LDA(At, 0, 0); PG8_STAGE(PG8_SA(1, 1), a1 + hstep, voffA);
            PG8_WAIT_V(8); PG8_WAIT_L(0); PG8_BAR; PG8_MMA(0, 0, At, B0); PG8_MMA(0, 1, At, B1); PG8_BAR; PG8_SCHED;
            PG8_LDA(At, 0, 1); PG8_STAGE(PG8_SB(0, 0), b2, voffB); PG8_STAGE(PG8_SB(0, 1), b2 + hstep, voffB); PG8_STAGE(PG8_SA(0, 0), a2, voffA);
            PG8_WAIT_V(8); PG8_WAIT_L(0); PG8_BAR; PG8_MMA(1, 0, At, B0); PG8_MMA(1, 1, At, B1); PG8_BAR; PG8_SCHED;
            PG8_LDB(B0, 1, 0); PG8_LDB(B1, 1, 1); PG8_SCHED; PG8_LDA(At, 1, 0); PG8_STAGE(PG8_SA(0, 1), a2 + hstep, voffA);
            PG8_WAIT_V(8); PG8_WAIT_L(0); PG8_BAR; PG8_MMA(0, 0, At, B0); PG8_MMA(0, 1, At, B1); PG8_BAR; PG8_SCHED;
            PG8_LDA(At, 1, 1); PG8_STAGE(PG8_SB(1, 0), b3, voffB); PG8_STAGE(PG8_SB(1, 1), b3 + hstep, voffB); PG8_STAGE(PG8_SA(1, 0), a3, voffA);
            PG8_WAIT_V(8); PG8_WAIT_L(0); PG8_BAR; PG8_MMA(1, 0, At, B0); PG8_MMA(1, 1, At, B1); PG8_BAR; PG8_SCHED;
            } else {
            PG8_LDB(B0, 0, 0); PG8_SCHED; PG8_LDA(At, 0, 0); PG8_STAGE(PG8_SA(1, 1), a1 + hstep, voffA);
            PG8_WAIT_L(8); PG8_BAR; PG8_WAIT_L(0); PG8_MMA(0, 0, At, B0); PG8_BAR; PG8_SCHED;
            PG8_LDB(B1, 0, 1); PG8_STAGE(PG8_SB(0, 0), b2, voffB);
            PG8_BAR; PG8_WAIT_L(0); PG8_MMA(0, 1, At, B1); PG8_BAR;
            PG8_LDA(At, 0, 1); PG8_STAGE(PG8_SA(0, 0), a2, voffA);
            PG8_BAR; PG8_WAIT_L(0); PG8_MMA(1, 0, At, B0); PG8_BAR; PG8_SCHED;
            PG8_STAGE(PG8_SB(0, 1), b2 + hstep, voffB);
            PG8_WAIT_V(6); PG8_BAR; PG8_MMA(1, 1, At, B1); PG8_BAR;
            PG8_LDB(B0, 1, 0); PG8_SCHED; PG8_LDA(At, 1, 0); PG8_STAGE(PG8_SA(0, 1), a2 + hstep, voffA);
            PG8_WAIT_L(8); PG8_BAR; PG8_WAIT_L(0); PG8_MMA(0, 0, At, B0); PG8_BAR; PG8_SCHED;
            PG8_LDB(B1, 1, 1); PG8_STAGE(PG8_SB(1, 0), b3, voffB);
            PG8_BAR; PG8_WAIT_L(0); PG8_MMA(0, 1, At, B1); PG8_BAR;
            PG8_LDA(At, 1, 1); PG8_STAGE(PG8_SA(1, 0), a3, voffA);
            PG8_BAR; PG8_WAIT_L(0); PG8_MMA(1, 0, At, B0); PG8_BAR; PG8_SCHED;
            PG8_STAGE(PG8_SB(1, 1), b3 + hstep, voffB);
            PG8_WAIT_V(6); PG8_BAR; PG8_MMA(1, 1, At, B1); PG8_BAR;
            }
        }
        if constexpr (ALIGN_EPI) { if (wr == 0) PG8_BAR; }
        if constexpr (FP8) asm volatile("s_nop 15\n\ts_nop 7" ::: "memory");
        if constexpr (!Epi::AFTER_DRAIN) { E(acc, cur, wr, wc, fr, fq); S.done(cur); }
        if (!has_next) break;
#pragma unroll
        for (int a = 0; a < 2; ++a)
#pragma unroll
            for (int b = 0; b < 2; ++b)
#pragma unroll
                for (int m = 0; m < 4; ++m)
#pragma unroll
                    for (int n = 0; n < 2; ++n) acc[a][b][m][n] = (f32x4){0.f, 0.f, 0.f, 0.f};
        cur = nxt; cA = nA; cB = nB; ++ui;
        if constexpr (ALIGN_EPI) { if (wr == 1) PG8_BAR; }
    }
    PG8_WAIT_V(0);
    if constexpr (!ALIGN_EPI) { if (wr == 0) PG8_BAR; }
    PG8_BAR;
    if constexpr (Epi::AFTER_DRAIN) { E.fused(acc, cur, wr, wc, fr, fq, lds, wid, lane); S.done(cur); }
#undef PG8_SA
#undef PG8_SB
#undef PG8_STAGE
#undef PG8_LDA
#undef PG8_LDB
#undef PG8_MMA
#undef PG8_MMAH
#undef PG8_CAT8
#undef PG8_WAIT_V
#undef PG8_WAIT_L
#undef PG8_BAR
#undef PG8_SCHED
}
}

#ifndef TEST_ALPHA
#define TEST_ALPHA 1.0f
#endif
constexpr int DM = 4096, SEQ = 8192, NB = 2, MP = NB * SEQ  , MS = 128  , MR = MP + MS  , MPAD = 16640  ;
constexpr int DEC_B = 8, DEC_T = 16, PAST = 2048, KVROWS = 2112  ;
constexpr int AW = 2048, NH = 16, HD = 128, QKD = 64, SSDI = 2048, SH = 32, SHD = 64, SG = 8, DS = 128, CONVD = 4096, DFF = 11008;
constexpr int NIN = 12320, NINP = 12544  ;
constexpr float EPS = 1e-6f;
constexpr float LAM0 = 0.2f;
constexpr float QSCALE = 0.125f * 1.4426950408889634f;
constexpr size_t O_YP = 0, O_YS = O_YP + (size_t)MP * DM, O_KP = O_YS + (size_t)MS * DM, O_VP = O_KP + (size_t)MP * AW, O_CP = O_VP + (size_t)MP * AW,
                 O_SP = O_CP + (size_t)NB * 3 * CONVD, O_KS = O_SP + (size_t)NB * SH * SHD * DS, O_VS = O_KS + (size_t)MS * AW, O_CS = O_VS + (size_t)MS * AW,
                 O_SS = O_CS + (size_t)DEC_B * 3 * CONVD, O_END = O_SS + (size_t)DEC_B * SH * SHD * DS;
static_assert(O_END == 138010624ull, "output size");

namespace pg8 {
typedef unsigned u32x2 __attribute__((ext_vector_type(2)));
__device__ __forceinline__ u32x4 pack8(const f32x4 a, const f32x4 b) { u32x4 w; w.x = cvt_pk_bf16(a[0], a[1]); w.y = cvt_pk_bf16(a[2], a[3]); w.z = cvt_pk_bf16(b[0], b[1]); w.w = cvt_pk_bf16(b[2], b[3]); return w; }

__device__ __forceinline__ unsigned pk4_fp8(float a, float b, float c, float d) { int p = 0; p = __builtin_amdgcn_cvt_pk_fp8_f32(a, b, p, false); p = __builtin_amdgcn_cvt_pk_fp8_f32(c, d, p, true); return (unsigned)p; }
__device__ __forceinline__ unsigned pk4_i8(float a, float b, float c, float d) {
    const int ia = (int)__builtin_rintf(__builtin_fminf(__builtin_fmaxf(a, -127.f), 127.f)), ib = (int)__builtin_rintf(__builtin_fminf(__builtin_fmaxf(b, -127.f), 127.f));
    const int ic = (int)__builtin_rintf(__builtin_fminf(__builtin_fmaxf(c, -127.f), 127.f)), id = (int)__builtin_rintf(__builtin_fminf(__builtin_fmaxf(d, -127.f), 127.f));
    return (unsigned)(ia & 255) | ((unsigned)(ib & 255) << 8) | ((unsigned)(ic & 255) << 16) | ((unsigned)id << 24);
}
constexpr float W8I_CLIP = 32.0f;
constexpr float H8_SCALE = 4.0f, WD8_SCALE = 128.0f;

struct EpiInProj {
    static constexpr bool PERM = true, AFTER_DRAIN = false;
    bf16_t *Q, *Kb, *Vb, *Z, *XBC, *Kext, *Vext; float* DT; float* out;
    template <int MODE  >
    __device__ __forceinline__ void tile(const f32x4 (&acc)[2][2][4][2], bf16_t* B, int ldb, float* O32, int ld32, int row0, int c0) const {
#pragma unroll
        for (int ai = 0; ai < 2; ++ai)
#pragma unroll
            for (int m = 0; m < 4; ++m) {
                const int row = row0 + ai * HALF + m * 16;
#pragma unroll
                for (int bj = 0; bj < 2; ++bj) {
                    const int c = c0 + bj * HALF;
                    const f32x4 v0 = acc[ai][bj][m][0], v1 = acc[ai][bj][m][1];
                    if (MODE == 1) *(u32x4*)(B + (size_t)row * ldb + c) = pack8(v0 * QSCALE, v1 * QSCALE);
                    else *(u32x4*)(B + (size_t)row * ldb + c) = pack8(v0, v1);
                    if (MODE == 2) { float* o = O32 + (size_t)row * ld32 + c; *(f32x4*)o = v0 * TEST_ALPHA; *(f32x4*)(o + 4) = v1 * TEST_ALPHA; }
                }
            }
    }
    __device__ __forceinline__ void operator()(const f32x4 (&acc)[2][2][4][2], const Unit& u, int wr, int wc, int fr, int fq) const {
        const int pn = u.pn, row0 = u.pm * BM + wr * 64 + fr, cl = wc * 32 + 8 * fq;
        if (pn < 8) tile<1>(acc, Q, AW, nullptr, 0, row0, pn * BM + cl);
        else if (pn < 16) tile<2>(acc, Kb, AW, out + O_KP, AW, row0, (pn - 8) * BM + cl);
        else if (pn < 24) tile<2>(acc, Vb, AW, out + O_VP, AW, row0, (pn - 16) * BM + cl);
        else if (pn < 32) tile<0>(acc, Z, SSDI, nullptr, 0, row0, (pn - 24) * BM + cl);
        else {
            tile<0>(acc, XBC, CONVD, nullptr, 0, row0, (pn - 32) * BM + cl);
            if ((u.pm & 31) == 31 && wr == 1) {
#pragma unroll
                for (int bj = 0; bj < 2; ++bj) { const int c = (pn - 32) * BM + cl + bj * HALF; const int row = row0 + HALF + 48, t = (row & (SEQ - 1)) - (SEQ - 3);
                    if (t >= 0) { float* o = out + O_CP + (size_t)((row >> 13) * 3 + t) * CONVD + c; *(f32x4*)o = acc[1][bj][3][0] * TEST_ALPHA; *(f32x4*)(o + 4) = acc[1][bj][3][1] * TEST_ALPHA; } }
            }
        }
    }
};

struct EpiOutProj {
    static constexpr bool PERM = true, AFTER_DRAIN = false;
    const float* xp; const float* xs; float* out; bf16_t* X1B; float* ss;
    __device__ __forceinline__ void operator()(const f32x4 (&acc)[2][2][4][2], const Unit& u, int wr, int wc, int fr, int fq) const {
        const int row0 = u.pm * BM + wr * 64 + fr, col0 = u.pn * BM + wc * 32 + 8 * fq;
#pragma unroll
        for (int ai = 0; ai < 2; ++ai) {
#pragma unroll
            for (int m = 0; m < 4; ++m) {
                const int row = row0 + ai * HALF + m * 16;
                const float* xr = xp + (size_t)row * DM;
                float sq = 0.f;
#pragma unroll
                for (int bj = 0; bj < 2; ++bj) {
                    const int c = col0 + bj * HALF;
                    const f32x4 v0 = acc[ai][bj][m][0] + __builtin_nontemporal_load((const f32x4*)(xr + c)), v1 = acc[ai][bj][m][1] + __builtin_nontemporal_load((const f32x4*)(xr + c + 4));
                    *(u32x4*)(X1B + (size_t)row * DM + c) = pack8(v0, v1);
                    sq += (v0[0] * v0[0] + v0[1] * v0[1]) + (v0[2] * v0[2] + v0[3] * v0[3]) + (v1[0] * v1[0] + v1[1] * v1[1]) + (v1[2] * v1[2] + v1[3] * v1[3]);
                }
                sq += __shfl_xor(sq, 16); sq += __shfl_xor(sq, 32);
                if (fq == 0) atomicAdd(ss + row, sq);
            }
        }
    }
};

struct EpiProbe {
    static constexpr bool PERM = true, AFTER_DRAIN = false;
    bf16_t* O; int ldc;
    __device__ __forceinline__ void operator()(const f32x4 (&acc)[2][2][4][2], const Unit& u, int wr, int wc, int fr, int fq) const {
        const int row0 = u.pm * BM + wr * 64 + fr, col0 = u.pn * BM + wc * 32 + 8 * fq;
#pragma unroll
        for (int ai = 0; ai < 2; ++ai)
#pragma unroll
            for (int m = 0; m < 4; ++m)
#pragma unroll
                for (int bj = 0; bj < 2; ++bj) *(u32x4*)(O + (size_t)(row0 + ai * HALF + m * 16) * ldc + col0 + bj * HALF) = pack8(acc[ai][bj][m][0], acc[ai][bj][m][1]);
    }
};

template <bool Q8>
struct EpiGateUpT {
    static constexpr bool PERM = true, AFTER_DRAIN = false;
    bf16_t* H; const float* ss; float wqg, wqu; bf16_t* HS;
    __device__ __forceinline__ void operator()(const f32x4 (&acc)[2][2][4][2], const Unit& u, int wr, int wc, int fr, int fq) const {
        if constexpr (Q8) asm volatile("" : "+v"(fr), "+v"(fq));
        const int row0 = u.pm * BM + wr * 64 + fr, col0 = u.pn * HALF + wc * 32 + 8 * fq;
#pragma unroll
        for (int ai = 0; ai < 2; ++ai) {
            if (u.pm == 64 && ai == 1) continue;
#pragma unroll
            for (int m = 0; m < 4; ++m) {
                const int row = row0 + ai * HALF + m * 16;
                const float r = Q8 ? ss[row] * wqg : 1.0f / sqrtf(ss[row] * (1.0f / DM) + EPS);
                const float r2 = Q8 ? ss[row] * wqu : r;
                f32x4 h[2];
#pragma unroll
                for (int n = 0; n < 2; ++n)
#pragma unroll
                    for (int e = 0; e < 4; ++e) { const float g = (Q8 ? (float)__float_as_int(acc[ai][0][m][n][e]) : acc[ai][0][m][n][e]) * r, up = (Q8 ? (float)__float_as_int(acc[ai][1][m][n][e]) : acc[ai][1][m][n][e]) * r2;
                        h[n][e] = g * up * __builtin_amdgcn_rcpf(1.0f + __builtin_amdgcn_exp2f(-1.4426950408889634f * g)); }
                if (Q8 && u.pm == 64) { *(u32x4*)(HS + (size_t)(row - MP) * DFF + col0) = pack8(h[0], h[1]); continue; }
                u32x2 w8; w8.x = pk4_fp8(h[0][0] * H8_SCALE, h[0][1] * H8_SCALE, h[0][2] * H8_SCALE, h[0][3] * H8_SCALE); w8.y = pk4_fp8(h[1][0] * H8_SCALE, h[1][1] * H8_SCALE, h[1][2] * H8_SCALE, h[1][3] * H8_SCALE);
                *(u32x2*)((unsigned char*)H + (size_t)row * DFF + col0) = w8;
            }
        }
    }
};
using EpiGateUp = EpiGateUpT<false>;

__device__ __forceinline__ float bflo(unsigned w) { return __uint_as_float(w << 16); }
__device__ __forceinline__ float bfhi(unsigned w) { return __uint_as_float(w & 0xffff0000u); }
struct EpiDown {
    static constexpr bool PERM = true, AFTER_DRAIN = false;
    const bf16_t* X1B; bf16_t* X2B; float* ss;
    static constexpr float ASC = 1.0f / (H8_SCALE * WD8_SCALE);
    __device__ __forceinline__ void operator()(const f32x4 (&acc)[2][2][4][2], const Unit& u, int wr, int wc, int fr, int fq) const {
        asm volatile("" : "+v"(fr), "+v"(fq));
        const int row0 = u.pm * BM + wr * 64 + fr, col0 = u.pn * BM + wc * 32 + 8 * fq;
#pragma unroll
        for (int ai = 0; ai < 2; ++ai) {
#pragma unroll
            for (int m = 0; m < 4; ++m) {
                const int row = row0 + ai * HALF + m * 16;
                float sq = 0.f;
#pragma unroll
                for (int bj = 0; bj < 2; ++bj) {
                    const int c = col0 + bj * HALF;
                    const u32x4 xw = __builtin_nontemporal_load((const u32x4*)(X1B + (size_t)row * DM + c));
                    const f32x4 v0 = acc[ai][bj][m][0] * ASC + (f32x4){bflo(xw.x), bfhi(xw.x), bflo(xw.y), bfhi(xw.y)}, v1 = acc[ai][bj][m][1] * ASC + (f32x4){bflo(xw.z), bfhi(xw.z), bflo(xw.w), bfhi(xw.w)};
                    *(u32x4*)(X2B + (size_t)row * DM + c) = pack8(v0, v1);
                    sq += (v0[0] * v0[0] + v0[1] * v0[1]) + (v0[2] * v0[2] + v0[3] * v0[3]) + (v1[0] * v1[0] + v1[1] * v1[1]) + (v1[2] * v1[2] + v1[3] * v1[3]);
                }
                sq += __shfl_xor(sq, 16); sq += __shfl_xor(sq, 32);
                if (fq == 0) atomicAdd(ss + row, sq);
            }
        }
    }
};
struct PanelOrder {
    int pm, q4, nu; unsigned* cnt;
    __device__ void init(int c, unsigned* cnt_) { const int x = c & 7, j = c >> 3; pm = x * 8 + (j >> 2); q4 = j & 3; cnt = cnt_; nu = 4; asm volatile("" : "+s"(nu)); }
    __device__ __forceinline__ bool next(int i, Unit& u) const { if (i >= nu) return false; int p = pm; asm volatile("" : "+s"(p)); u.pm = p; u.pn = 4 * q4 + i; return true; }
    __device__ __forceinline__ void a_ready(const Unit&) const {}
    __device__ __forceinline__ void done(const Unit& u) const {
        asm volatile("s_waitcnt vmcnt(0)" ::: "memory");
        if ((threadIdx.x & 63) == 0) __hip_atomic_fetch_add(cnt + 64 * u.pm, 1u, __ATOMIC_RELAXED, __HIP_MEMORY_SCOPE_AGENT);
    }
};
}
#define GAS __attribute__((address_space(1)))
#define LAS __attribute__((address_space(3)))
typedef unsigned short bf16;
typedef unsigned v4u __attribute__((ext_vector_type(4)));
typedef float f32x4 __attribute__((ext_vector_type(4)));
typedef short bf16x8 __attribute__((ext_vector_type(8)));
typedef GAS unsigned gu32;
typedef GAS unsigned long long gu64;
#define RLX_AGENT __ATOMIC_RELAXED, __HIP_MEMORY_SCOPE_AGENT
#define LDS_WAIT() asm volatile("s_waitcnt lgkmcnt(0)" ::: "memory")
#define VM_WAIT() asm volatile("s_waitcnt vmcnt(0)" ::: "memory")
__device__ __forceinline__ unsigned long long rt() { return __builtin_amdgcn_s_memrealtime(); }
__device__ __forceinline__ unsigned f2bf(float f) { unsigned u = __builtin_bit_cast(unsigned, f); return (u + 0x7fffu + ((u >> 16) & 1u)) >> 16; }
__device__ __forceinline__ unsigned pk2(float lo, float hi) { return f2bf(lo) | (f2bf(hi) << 16); }

#define XB_TMO      128
#define XB_XCNT(j)  (256  + 64 * (j))
#define XB_XSUB(j)  (1280 + 64 * (j))
#define XB_XGEN(j)  (2304 + 64 * (j))
#define XB_TOP      3328
#define XB_TOPGEN   3392
#define XCD_BAR_WORDS 3456
#define XB_SPIN_CAP (1u << 18)

__device__ __forceinline__ unsigned xb_ld(unsigned* p)              { return __hip_atomic_load(p, __ATOMIC_RELAXED, __HIP_MEMORY_SCOPE_AGENT); }
__device__ __forceinline__ unsigned xb_add(unsigned* p, unsigned v) { return __hip_atomic_fetch_add(p, v, __ATOMIC_RELAXED, __HIP_MEMORY_SCOPE_AGENT); }
__device__ __forceinline__ unsigned xb_xcc_id() { return (unsigned)__builtin_amdgcn_s_getreg((3 << 11) | 20) & 0xFu; }
#define XB_SPIN(cond, bar) do { unsigned _sp = 0; while (cond) { __builtin_amdgcn_s_sleep(1); \
    if ((++_sp & 255u) == 0u) { if (xb_ld(&(bar)[XB_TMO])) break; if (_sp > XB_SPIN_CAP) { atomicAdd(&(bar)[XB_TMO], 1u); break; } } } } while (0)

struct XcdBarrier {
    unsigned* bar; unsigned x;
    volatile LAS unsigned* st;
};

__device__ __forceinline__ XcdBarrier xcd_barrier_post(unsigned* bar, volatile LAS unsigned* st) {
    XcdBarrier b; b.bar = bar; b.x = xb_xcc_id(); b.st = st;
    if (threadIdx.x == 0) (void)xb_add(&bar[XB_XCNT(b.x)], 1u);
    return b;
}
__device__ __forceinline__ void xcd_barrier_complete(unsigned* bar, unsigned x, unsigned& nloc, unsigned& nx) {
    const unsigned G = gridDim.x * gridDim.y * gridDim.z;
    unsigned sum, cnt, mine, sp = 0u;
    for (;;) {
        sum = 0u; cnt = 0u; mine = 0u;
#pragma unroll
        for (unsigned j = 0; j < 16; ++j) { const unsigned c = xb_ld(&bar[XB_XCNT(j)]); sum += c; cnt += (c > 0u) ? 1u : 0u; mine = (j == x) ? c : mine; }
        if (sum == G) break;
        __builtin_amdgcn_s_sleep(1);
        if ((++sp & 255u) == 0u) { if (xb_ld(&bar[XB_TMO])) break; if (sp > XB_SPIN_CAP) { atomicAdd(&bar[XB_TMO], 1u); break; } }
    }
    nloc = mine > 0u ? mine : 1u; nx = cnt > 0u ? cnt : 1u;
}

__device__ __forceinline__ void xcd_barrier(const XcdBarrier& b) {
    asm volatile("s_waitcnt vmcnt(0)" ::: "memory");
    __syncthreads();
    if (threadIdx.x == 0) {
        unsigned* bar = b.bar;
        __builtin_amdgcn_s_waitcnt(0);
        unsigned nloc = b.st[0], nx = b.st[1];
        if (nloc == 0u) { xcd_barrier_complete(bar, b.x, nloc, nx); b.st[0] = nloc; b.st[1] = nx; }
        const unsigned old = xb_add(&bar[XB_XSUB(b.x)], 1u);
        const unsigned gen = old / nloc;
        if (old + 1u == (gen + 1u) * nloc) {
            __builtin_amdgcn_fence(__ATOMIC_RELEASE, "agent");
            asm volatile("s_waitcnt vmcnt(0)" ::: "memory");
            const unsigned og = xb_add(&bar[XB_TOP], 1u);
            const unsigned tg = og / nx;
            if (og + 1u == (tg + 1u) * nx) xb_add(&bar[XB_TOPGEN], 1u);
            else XB_SPIN(xb_ld(&bar[XB_TOPGEN]) == tg, bar);
            __builtin_amdgcn_fence(__ATOMIC_ACQUIRE, "agent");
            xb_add(&bar[XB_XGEN(b.x)], 1u);
            asm volatile("s_waitcnt vmcnt(0)" ::: "memory");
        } else {
            XB_SPIN(xb_ld(&bar[XB_XGEN(b.x)]) == gen, bar);
            __builtin_amdgcn_fence(__ATOMIC_ACQUIRE, "agent");
            asm volatile("s_waitcnt vmcnt(0)" ::: "memory");
        }
    }
    __syncthreads();
}

constexpr int NWAVES = 8;
constexpr size_t MiB = 1u << 20;
constexpr size_t WS_CTL = 0, CTL_ZERO_BYTES = 1 * MiB;
constexpr size_t WS_WD = 1 * MiB, WS_WGU = 87 * MiB, WS_WO = 259 * MiB, WS_WIN = 291 * MiB, WS_XN = 389 * MiB, WS_Q = 519 * MiB, WS_KB = 584 * MiB, WS_VB = 649 * MiB,
                 WS_Z = 714 * MiB, WS_XBC = 779 * MiB, WS_DT = 909 * MiB, WS_KEXT = 912 * MiB, WS_VEXT = 978 * MiB, WS_WD8 = WS_WIN  , WS_HS = WS_Q + 256 * MiB  , WS_F = 1044 * MiB  , WS_PARK = 1052 * MiB  , WS_DUMMY = 1068 * MiB  , WS_WGUQ = 1068 * MiB  , WS_X1Q = 1154 * MiB  , WS_END = 1219 * MiB;
constexpr size_t WS_MIX = WS_XN;
constexpr size_t WS_X1B = WS_KEXT;
constexpr size_t WS_H = WS_Q;
static_assert(WS_WD + (size_t)DM * DFF * 2 <= WS_WGU && WS_WGU + (size_t)2 * DFF * DM * 2 <= WS_WO && WS_WO + (size_t)DM * DM * 2 <= WS_WIN && WS_WIN + (size_t)NINP * DM * 2 <= WS_XN &&
              WS_XN + (size_t)MPAD * DM * 2 <= WS_Q && WS_Q + (size_t)MPAD * AW * 2 <= WS_KB && WS_XBC + (size_t)MPAD * CONVD * 2 <= WS_DT && WS_DT + (size_t)MPAD * SH * 4 <= WS_KEXT &&
              WS_KEXT + (size_t)DEC_B * KVROWS * AW * 2 <= WS_VEXT && WS_VEXT + (size_t)DEC_B * KVROWS * AW * 2 <= WS_F && WS_H + (size_t)MPAD * DFF * 2 <= WS_DT &&
              WS_X1B + (size_t)MPAD * DM * 2 <= WS_END, "d_ws map");
constexpr int CW_TMO = 0, CW_CODE = 1, CW_WSTAT = 8  , CW_QUEUE = 64, CW_SMPC = 512  , CW_P5C = 12288  , CW_SSDF = 2048  , CW_BAR = 4096, CW_SS2 = 65536, CW_SS3 = 131072, CW_RQ = 196608  ;
constexpr int RING_OFF = 0, RING_BYTES = 139264, LDSCTL_OFF = RING_BYTES, MISC_OFF = LDSCTL_OFF + 320, LDS_BYTES = 147456;

struct Frame {
    LAS unsigned char* lds;
    volatile LAS unsigned* MISC;
    gu32* ctl;
    int tid, lane, wave, vcu, G;
};

__device__ __forceinline__ float wave_sum(float v) {
#pragma unroll
    for (int o = 1; o < 64; o <<= 1) v += __shfl_xor(v, o);
    return v;
}
template <int MODE>
__device__ __forceinline__ void p0_transpose_pair(const float* W, int K, int N, bf16* WT, const float* kscale, LAS float* scr, int item0, int nitems, int lane, unsigned char* W8 = nullptr, float s8 = 1.0f, bool as_int8 = false) {
    const int nblk = N / 32;
    f32x4 v[2][8]; float ks[2][8];
#pragma unroll
    for (int t = 0; t < 2; ++t) { const int item = item0 + t < nitems ? item0 + t : item0; const int kb = item / nblk, nb = item % nblk, k0 = 64 * kb, n0 = 32 * nb;
#pragma unroll
        for (int i = 0; i < 8; ++i) { const int kk = 8 * i + (lane >> 3); v[t][i] = __builtin_nontemporal_load((const GAS f32x4*)(W + (size_t)(k0 + kk) * N + n0 + 4 * (lane & 7)));        ks[t][i] = kscale ? kscale[k0 + kk] : 1.0f; } }
#pragma unroll
    for (int t = 0; t < 2; ++t) {
        if (item0 + t >= nitems) break;
        const int item = item0 + t; const int kb = item / nblk, nb = item % nblk, k0 = 64 * kb, n0 = 32 * nb;
        LAS float* s0 = scr + t * (64 * 33);
#pragma unroll
        for (int i = 0; i < 8; ++i) { const int kk = 8 * i + (lane >> 3); LAS float* d = s0 + kk * 33 + 4 * (lane & 7); const f32x4 x = v[t][i] * ks[t][i]; d[0] = x.x; d[1] = x.y; d[2] = x.z; d[3] = x.w; }
        LDS_WAIT(); asm volatile("" ::: "memory");
        const int c = lane & 7;
        const int rbase = MODE == 0 ? n0 : 256 * (n0 >> 7) + (n0 & 127) + (MODE == 2 ? 128 : 0);
#pragma unroll
        for (int j = 0; j < 4; ++j) { const int n = (lane >> 3) + 8 * j; const LAS float* s = s0 + (8 * c) * 33 + n;
            v4u o; o.x = pk2(s[0 * 33], s[1 * 33]); o.y = pk2(s[2 * 33], s[3 * 33]); o.z = pk2(s[4 * 33], s[5 * 33]); o.w = pk2(s[6 * 33], s[7 * 33]);
            if (WT) *(GAS v4u*)(WT + (size_t)(rbase + n) * K + k0 + 8 * c) = o;
            if (W8) {
                typedef unsigned u32x2g __attribute__((ext_vector_type(2))); u32x2g o8;
                int p0 = 0, p1 = 0;
                if (as_int8) { p0 = (int)pg8::pk4_i8(s[0 * 33] * s8, s[1 * 33] * s8, s[2 * 33] * s8, s[3 * 33] * s8); p1 = (int)pg8::pk4_i8(s[4 * 33] * s8, s[5 * 33] * s8, s[6 * 33] * s8, s[7 * 33] * s8); }
                else {
                p0 = __builtin_amdgcn_cvt_pk_fp8_f32(s[0 * 33] * s8, s[1 * 33] * s8, p0, false); p0 = __builtin_amdgcn_cvt_pk_fp8_f32(s[2 * 33] * s8, s[3 * 33] * s8, p0, true);
                p1 = __builtin_amdgcn_cvt_pk_fp8_f32(s[4 * 33] * s8, s[5 * 33] * s8, p1, false); p1 = __builtin_amdgcn_cvt_pk_fp8_f32(s[6 * 33] * s8, s[7 * 33] * s8, p1, true); }
                o8.x = (unsigned)p0; o8.y = (unsigned)p1;
                *(GAS u32x2g*)(W8 + (size_t)(rbase + n) * K + k0 + 8 * c) = o8; } }
    }
    LDS_WAIT(); asm volatile("" ::: "memory");
}
__device__ __forceinline__ void rms_row2_to_bf16(int lane, const float* xrow0, const float* xrow1, const float* w, bf16* orow0, bf16* orow1) {
    const GAS f32x4* xr0 = (const GAS f32x4*)xrow0 + lane; const GAS f32x4* xr1 = (const GAS f32x4*)xrow1 + lane; const GAS f32x4* wr = (const GAS f32x4*)w + lane;
    f32x4 v0[16], v1[16]; float s0 = 0.f, s1 = 0.f;
#pragma unroll
    for (int j = 0; j < 16; ++j) v0[j] = __builtin_nontemporal_load(xr0 + 64 * j);
#pragma unroll
    for (int j = 0; j < 16; ++j) v1[j] = __builtin_nontemporal_load(xr1 + 64 * j);
#pragma unroll
    for (int j = 0; j < 16; ++j) s0 += (v0[j].x * v0[j].x + v0[j].y * v0[j].y) + (v0[j].z * v0[j].z + v0[j].w * v0[j].w);
#pragma unroll
    for (int j = 0; j < 16; ++j) s1 += (v1[j].x * v1[j].x + v1[j].y * v1[j].y) + (v1[j].z * v1[j].z + v1[j].w * v1[j].w);
    const float r0 = 1.0f / sqrtf(wave_sum(s0) * (1.0f / DM) + EPS), r1 = 1.0f / sqrtf(wave_sum(s1) * (1.0f / DM) + EPS);
    GAS unsigned long long* o0 = (GAS unsigned long long*)orow0 + lane; GAS unsigned long long* o1 = (GAS unsigned long long*)orow1 + lane;
#pragma unroll
    for (int j = 0; j < 16; ++j) { const f32x4 g = wr[64 * j];
        o0[64 * j] = (unsigned long long)pk2(v0[j].x * r0 * g.x, v0[j].y * r0 * g.y) | ((unsigned long long)pk2(v0[j].z * r0 * g.z, v0[j].w * r0 * g.w) << 32);
        o1[64 * j] = (unsigned long long)pk2(v1[j].x * r1 * g.x, v1[j].y * r1 * g.y) | ((unsigned long long)pk2(v1[j].z * r1 * g.z, v1[j].w * r1 * g.w) << 32); }
}
__device__ __forceinline__ void rms_row_to_bf16(int lane, const float* xrow, const float* w, bf16* orow) {
    const GAS f32x4* xr = (const GAS f32x4*)xrow + lane; const GAS f32x4* wr = (const GAS f32x4*)w + lane;
    f32x4 v[16]; float s = 0.f;
#pragma unroll
    for (int j = 0; j < 16; ++j) { v[j] = xr[64 * j]; s += (v[j].x * v[j].x + v[j].y * v[j].y) + (v[j].z * v[j].z + v[j].w * v[j].w); }
    const float r = 1.0f / sqrtf(wave_sum(s) * (1.0f / DM) + EPS);
    GAS unsigned long long* o8 = (GAS unsigned long long*)orow + lane;
#pragma unroll
    for (int j = 0; j < 16; ++j) { const f32x4 g = wr[64 * j]; o8[64 * j] = (unsigned long long)pk2(v[j].x * r * g.x, v[j].y * r * g.y) | ((unsigned long long)pk2(v[j].z * r * g.z, v[j].w * r * g.w) << 32); }
}

namespace att {
typedef short bf16x8 __attribute__((ext_vector_type(8)));
typedef short s16x4 __attribute__((ext_vector_type(4)));
typedef float f32x16 __attribute__((ext_vector_type(16)));
typedef unsigned u32x4 __attribute__((ext_vector_type(4)));
typedef unsigned u32x2 __attribute__((ext_vector_type(2)));
constexpr int KSLOT = 8192, VSLOT = 16384, SLOT = KSLOT + VSLOT, NSLOT = 3, PITCH = 2048;
constexpr int PARK_OFF = NSLOT * SLOT, ATTN_LDS_BYTES = PARK_OFF + 8 * 8192;
#define ATT_LAS __attribute__((address_space(3)))
#ifdef PROBE_ATT_VARIANT
#define ATT_VAR(u) ((u).variant)
#else
#define ATT_VAR(u) 0
#endif
__device__ __forceinline__ unsigned cvtpk(float lo, float hi) { unsigned r; asm volatile("v_cvt_pk_bf16_f32 %0, %1, %2" : "=v"(r) : "v"(lo), "v"(hi)); return r; }

__device__ __forceinline__ void glds16(const void* gsrc, unsigned lds_dst) { unsigned keep;
    asm volatile("s_mov_b32 %0, m0\n\ts_mov_b32 m0, %2\n\ts_nop 0\n\tglobal_load_lds_dwordx4 %1, off\n\ts_mov_b32 m0, %0" : "=&s"(keep) : "v"(gsrc), "s"(lds_dst) : "memory"); }
__device__ __forceinline__ float max3f(float a, float b, float c) { float r; asm("v_max3_f32 %0, %1, %2, %3" : "=v"(r) : "v"(a), "v"(b), "v"(c)); return r; }
struct Unit {
    const unsigned short* Q;
    const unsigned short* K;
    const unsigned short* V;
    unsigned short* O;
    int ntot;
    int nvalid_last;
    int sample;
    int qb;
    unsigned char* park;
    int variant;
};

__device__ __forceinline__ void pass(ATT_LAS unsigned char* lds, const Unit& u, int mapoff, bool active, int nmine, int wave, int lane, f32x16 (&o)[4], float& lsum) {
    asm volatile("" : "+v"(lane));
    const int r32 = lane & 31, h = lane >> 5;
    const unsigned short* ksrc = u.K + mapoff + (size_t)lane * PITCH + wave * 8;
    const int rowgrp = wave >> 1, half = wave & 1, sub = lane >> 5, rr = (lane & 31) >> 2, vrow = 8 * rowgrp + rr;
    const int chl = (lane & 3) ^ ((vrow >> 2) & 3);
    const unsigned short* vsrc = u.V + (size_t)vrow * PITCH + (4 * (2 * half + sub) + chl) * 8;
    const unsigned ldsw = (unsigned)(uintptr_t)lds + (unsigned)wave * 1024u;
#define ATT_DMA(t, slot) do { if (ATT_VAR(u) & 1) break; \
        glds16(ksrc + (size_t)(t) * 64 * PITCH, (unsigned)__builtin_amdgcn_readfirstlane(ldsw + (slot) * SLOT)); \
        glds16(vsrc + (size_t)(t) * 64 * PITCH, (unsigned)__builtin_amdgcn_readfirstlane(ldsw + (slot) * SLOT + KSLOT)); \
        glds16(vsrc + (size_t)(t) * 64 * PITCH + 32 * PITCH, (unsigned)__builtin_amdgcn_readfirstlane(ldsw + (slot) * SLOT + KSLOT + 8192)); } while (0)
    asm volatile("s_waitcnt lgkmcnt(0)\n\ts_barrier" ::: "memory");
    ATT_DMA(0, 0);
    if (u.ntot > 1) ATT_DMA(1, 1);
    bf16x8 qf[4];
    { const unsigned short* qrow = u.Q + mapoff + (size_t)(wave * 32 + r32) * PITCH + 8 * h;
#pragma unroll
      for (int ks = 0; ks < 4; ++ks) qf[ks] = active ? *(const bf16x8*)(qrow + 16 * ks) : (bf16x8){0,0,0,0,0,0,0,0}; }
    asm volatile("" : "+v"(qf[0]), "+v"(qf[1]), "+v"(qf[2]), "+v"(qf[3]));
    if (wave >= 4) __builtin_amdgcn_s_setprio(1);
    float l = 0.f, negm_s = 0.f; bool first_ = true;
    f32x16 negm;
#pragma unroll
    for (int r = 0; r < 16; ++r) negm[r] = 0.f;
#pragma unroll
    for (int d = 0; d < 4; ++d)
#pragma unroll
        for (int r = 0; r < 16; ++r) o[d][r] = 0.f;
    const int kbase = h * 1024 + r32 * 16;
    const int g = lane >> 4, blk = g & 1, q_ = (lane & 15) >> 2, p_ = lane & 3;
    const int vb0 = KSLOT + 64 * (4 * h + q_) + 16 * ((2 * blk + (p_ >> 1)) ^ h) + 8 * (p_ & 1);
    const int vb1 = KSLOT + 2048 + 64 * (4 * h + q_) + 16 * ((2 * blk + (p_ >> 1)) ^ (2 + h)) + 8 * (p_ & 1);
#define ATT_QK0(D0, D1, SB) do { _Pragma("unroll") for (int r = 0; r < 16; ++r) { D0[r] = 0.f; D1[r] = 0.f; } \
        _Pragma("unroll") for (int ks = 0; ks < 4; ++ks) { \
            const bf16x8 k0 = *(const ATT_LAS bf16x8*)((SB) + kbase + ks * 2048), k1 = *(const ATT_LAS bf16x8*)((SB) + kbase + ks * 2048 + 512); \
            D0 = __builtin_amdgcn_mfma_f32_32x32x16_bf16(k0, qf[ks], D0, 0, 0, 0); D1 = __builtin_amdgcn_mfma_f32_32x32x16_bf16(k1, qf[ks], D1, 0, 0, 0); } } while (0)
#define ATT_TILE(C0, C1, N0, N1, SC, SN, TT) do { \
        ATT_LAS unsigned char* sc_ = lds + (SC) * SLOT; ATT_LAS unsigned char* sn_ = lds + (SN) * SLOT; \
        if ((TT) == u.ntot - 1 && u.nvalid_last < 64) { \
            _Pragma("unroll") for (int r = 0; r < 16; ++r) { const int kv = (r & 3) + 8 * (r >> 2) + 4 * h; if (kv >= u.nvalid_last) C0[r] = -1e30f; if (kv + 32 >= u.nvalid_last) C1[r] = -1e30f; } } \
        float mx; { float t_[8]; \
            _Pragma("unroll") for (int r = 0; r < 8; ++r) t_[r] = max3f(C0[2 * r], C0[2 * r + 1], C1[2 * r]); \
            _Pragma("unroll") for (int r = 0; r < 8; ++r) t_[r] = max3f(t_[r], C1[2 * r + 1], t_[r]); \
            const float u0_ = max3f(t_[0], t_[1], t_[2]), u1_ = max3f(t_[3], t_[4], t_[5]), u2_ = max3f(t_[6], t_[7], t_[7]); mx = max3f(u0_, u1_, u2_); } \
        mx = max3f(mx, __shfl_xor(mx, 32), mx); \
        if (first_ || __any(mx > 8.0f)) {       \
            const float dd = first_ ? mx : fmaxf(mx, 0.f), alpha = __builtin_amdgcn_exp2f(-dd); first_ = false; l *= alpha; negm_s -= dd; \
            _Pragma("unroll") for (int d = 0; d < 4; ++d) _Pragma("unroll") for (int r = 0; r < 16; ++r) o[d][r] *= alpha; \
            _Pragma("unroll") for (int r = 0; r < 16; ++r) { C0[r] -= dd; C1[r] -= dd; negm[r] = negm_s; } } \
        const unsigned va0 = (unsigned)(uintptr_t)(sc_ + vb0), va1 = (unsigned)(uintptr_t)(sc_ + vb1); \
        float rsa_[4] = {0.f, 0.f, 0.f, 0.f}; \
        _Pragma("unroll") for (int s = 0; s < 4; ++s) { \
            s16x4 lo[4], hi[4]; \
            if (!(ATT_VAR(u) & 2)) _Pragma("unroll") for (int d = 0; d < 4; ++d) { \
                asm volatile("ds_read_b64_tr_b16 %0, %1 offset:%c2" : "=&v"(lo[d]) : "v"(va0), "i"(d * 512 + s * 4096) : "memory"); \
                asm volatile("ds_read_b64_tr_b16 %0, %1 offset:%c2" : "=&v"(hi[d]) : "v"(va1), "i"(d * 512 + s * 4096) : "memory"); } \
            const bf16x8 k0 = *(const ATT_LAS bf16x8*)(sn_ + kbase + s * 2048), k1 = *(const ATT_LAS bf16x8*)(sn_ + kbase + s * 2048 + 512); \
            u32x4 w; \
            if (s < 2) { _Pragma("unroll") for (int e = 0; e < 8; ++e) { C0[8 * s + e] = (ATT_VAR(u) & 4) ? C0[8 * s + e] : __builtin_amdgcn_exp2f(C0[8 * s + e]); rsa_[e & 3] += C0[8 * s + e]; } \
                w.x = cvtpk(C0[8 * s], C0[8 * s + 1]); w.y = cvtpk(C0[8 * s + 2], C0[8 * s + 3]); w.z = cvtpk(C0[8 * s + 4], C0[8 * s + 5]); w.w = cvtpk(C0[8 * s + 6], C0[8 * s + 7]); } \
            else { const int b_ = 8 * (s - 2); _Pragma("unroll") for (int e = 0; e < 8; ++e) { C1[b_ + e] = (ATT_VAR(u) & 4) ? C1[b_ + e] : __builtin_amdgcn_exp2f(C1[b_ + e]); rsa_[e & 3] += C1[b_ + e]; } \
                w.x = cvtpk(C1[b_], C1[b_ + 1]); w.y = cvtpk(C1[b_ + 2], C1[b_ + 3]); w.z = cvtpk(C1[b_ + 4], C1[b_ + 5]); w.w = cvtpk(C1[b_ + 6], C1[b_ + 7]); } \
            const bf16x8 pf = __builtin_bit_cast(bf16x8, w); \
            if (s == 0) { N0 = __builtin_amdgcn_mfma_f32_32x32x16_bf16(k0, qf[0], negm, 0, 0, 0); N1 = __builtin_amdgcn_mfma_f32_32x32x16_bf16(k1, qf[0], negm, 0, 0, 0); } \
            else { N0 = __builtin_amdgcn_mfma_f32_32x32x16_bf16(k0, qf[s], N0, 0, 0, 0); N1 = __builtin_amdgcn_mfma_f32_32x32x16_bf16(k1, qf[s], N1, 0, 0, 0); } \
            asm volatile("s_waitcnt lgkmcnt(0)" ::: "memory"); \
            if (!(ATT_VAR(u) & 2)) _Pragma("unroll") for (int d = 0; d < 4; ++d) { \
                const bf16x8 vf = (bf16x8){lo[d][0], lo[d][1], lo[d][2], lo[d][3], hi[d][0], hi[d][1], hi[d][2], hi[d][3]}; \
                o[d] = __builtin_amdgcn_mfma_f32_32x32x16_bf16(vf, pf, o[d], 0, 0, 0); } \
        } \
        l += (rsa_[0] + rsa_[1]) + (rsa_[2] + rsa_[3]); } while (0)
    f32x16 sA0, sA1, sB0, sB1;
#define ATT_WAITBAR(N) do { if (ATT_VAR(u) & 8) asm volatile("s_waitcnt vmcnt(" #N ") lgkmcnt(0)" ::: "memory"); else asm volatile("s_waitcnt vmcnt(" #N ") lgkmcnt(0)\n\ts_barrier" ::: "memory"); } while (0)
    if (u.ntot > 1) ATT_WAITBAR(3); else ATT_WAITBAR(0);
    if (active) ATT_QK0(sA0, sA1, lds);
    int slot = 0;
#define ATT_HALF(TT, C0, C1, N0, N1) do { const int sn = slot == 2 ? 0 : slot + 1; \
        if ((TT) + 1 < u.ntot) ATT_WAITBAR(0); \
        if ((TT) + 2 < u.ntot) ATT_DMA((TT) + 2, slot == 0 ? 2 : slot - 1); \
        if (active && (TT) < nmine && !(ATT_VAR(u) & 16)) ATT_TILE(C0, C1, N0, N1, slot, sn, (TT)); \
        slot = sn; } while (0)
    for (int t = 0; t < u.ntot; t += 2) {
        ATT_HALF(t, sA0, sA1, sB0, sB1);
        if (t + 1 < u.ntot) ATT_HALF(t + 1, sB0, sB1, sA0, sA1);
    }
#undef ATT_HALF
#undef ATT_WAITBAR
#undef ATT_TILE
#undef ATT_QK0
    __builtin_amdgcn_s_setprio(0);
    lsum = l + __shfl_xor(l, 32);
#undef ATT_DMA
}

__device__ __forceinline__ void attn_unit(ATT_LAS unsigned char* lds, const Unit& u, float lam, const float* subw, int wave, int lane) {
    asm volatile("" : "+v"(lane));
    const int r32 = lane & 31, h = lane >> 5;
    const bool active = u.sample ? (wave == 0) : true;
    const int nmine = u.sample ? u.ntot : 4 * u.qb + (wave >> 1) + 1;
    f32x16 o[4]; float l1, l2;
    ATT_LAS u32x4* park = (ATT_LAS u32x4*)(lds + PARK_OFF + wave * 8192) + lane;
    pass(lds, u, 0, active, nmine, wave, lane, o, l1);
    { const float inv = 1.0f / l1;
#pragma unroll
      for (int d = 0; d < 4; ++d)
#pragma unroll
          for (int r4 = 0; r4 < 2; ++r4) { u32x4 w; w.x = cvtpk(o[d][8 * r4] * inv, o[d][8 * r4 + 1] * inv); w.y = cvtpk(o[d][8 * r4 + 2] * inv, o[d][8 * r4 + 3] * inv);
              w.z = cvtpk(o[d][8 * r4 + 4] * inv, o[d][8 * r4 + 5] * inv); w.w = cvtpk(o[d][8 * r4 + 6] * inv, o[d][8 * r4 + 7] * inv); if (active) park[(2 * d + r4) * 64] = w; } }
    pass(lds, u, 64, active, nmine, wave, lane, o, l2);
    if (!active) return;
    const float c2 = lam / l2;
    float ss = 0.f;
#pragma unroll
    for (int d = 0; d < 4; ++d)
#pragma unroll
        for (int r4 = 0; r4 < 2; ++r4) { const u32x4 w = park[(2 * d + r4) * 64];
#pragma unroll
            for (int e = 0; e < 4; ++e) { const unsigned pw = w[e]; const int r = 8 * r4 + 2 * e;
                const float v0 = __uint_as_float(pw << 16) - c2 * o[d][r], v1 = __uint_as_float(pw & 0xffff0000u) - c2 * o[d][r + 1];
                o[d][r] = v0; o[d][r + 1] = v1; ss += v0 * v0 + v1 * v1; } }
    ss += __shfl_xor(ss, 32);
    const float rn = (1.0f - LAM0) / sqrtf(ss * (1.0f / 128.0f) + EPS);
    unsigned short* orow = u.O + (size_t)(wave * 32 + r32) * 4096 + 8 * h;
    const bool st_ok = !(u.sample && r32 >= 16);
#pragma unroll
    for (int d = 0; d < 4; ++d)
#pragma unroll
        for (int kp = 0; kp < 4; kp += 2) {
            u32x2 pa, pb;
            { const int dc = 32 * d + 8 * kp + 4 * h; const f32x4 w = *(const f32x4*)(subw + dc);
              pa.x = cvtpk(o[d][4 * kp] * rn * w[0], o[d][4 * kp + 1] * rn * w[1]); pa.y = cvtpk(o[d][4 * kp + 2] * rn * w[2], o[d][4 * kp + 3] * rn * w[3]); }
            { const int dc = 32 * d + 8 * (kp + 1) + 4 * h; const f32x4 w = *(const f32x4*)(subw + dc);
              pb.x = cvtpk(o[d][4 * kp + 4] * rn * w[0], o[d][4 * kp + 5] * rn * w[1]); pb.y = cvtpk(o[d][4 * kp + 6] * rn * w[2], o[d][4 * kp + 7] * rn * w[3]); }
            const auto rx = __builtin_amdgcn_permlane32_swap(pa.x, pb.x, false, false); const auto ry = __builtin_amdgcn_permlane32_swap(pa.y, pb.y, false, false);
            const u32x4 v = (u32x4){rx[0], ry[0], rx[1], ry[1]};
            if (st_ok) *(u32x4*)(orow + 32 * d + 8 * kp) = v;
        }
}
}

namespace ssd {
typedef short bf16x8 __attribute__((ext_vector_type(8)));
typedef short s16x4 __attribute__((ext_vector_type(4)));
typedef float f32x4 __attribute__((ext_vector_type(4)));
typedef unsigned u32x4 __attribute__((ext_vector_type(4)));
typedef unsigned u32x2 __attribute__((ext_vector_type(2)));
#define SSD_LAS __attribute__((address_space(3)))
constexpr int XT_STRIDE = 144;
constexpr int L_CM = 0, L_BM = 16384, L_XT = 32768, L_ZT = L_XT + 256 * XT_STRIDE  , L_TAB = L_ZT + 32768  ,
              L_G = L_TAB + 2048  , L_SSQ = L_G + 16384  , L_CW = L_SSQ + 2048  , SSD_LDS_BYTES = L_CW + 10240;
static_assert(SSD_LDS_BYTES <= 139264, "ssd lds");
__device__ __forceinline__ unsigned off_a(unsigned row, unsigned ch) { return 2048u * (row >> 3) + 512u * (ch >> 2) + 64u * (row & 7) + 16u * ((ch & 3) ^ ((row >> 2) & 3)); }
__device__ __forceinline__ unsigned cvtpk(float lo, float hi) { unsigned r; asm volatile("v_cvt_pk_bf16_f32 %0, %1, %2" : "=v"(r) : "v"(lo), "v"(hi)); return r; }
__device__ __forceinline__ float bf2f(unsigned short b) { return __uint_as_float((unsigned)b << 16); }
__device__ __forceinline__ float silu(float v) { return v * __builtin_amdgcn_rcpf(1.0f + __builtin_amdgcn_exp2f(-1.4426950408889634f * v)); }
__device__ __forceinline__ bf16x8 pack8(const f32x4 a, const f32x4 b) { u32x4 w; w.x = cvtpk(a[0], a[1]); w.y = cvtpk(a[2], a[3]); w.z = cvtpk(b[0], b[1]); w.w = cvtpk(b[2], b[3]); return __builtin_bit_cast(bf16x8, w); }
__device__ __forceinline__ void glds16(const void* gsrc, unsigned lds_dst) { unsigned keep;
    asm volatile("s_mov_b32 %0, m0\n\ts_mov_b32 m0, %2\n\ts_nop 0\n\tglobal_load_lds_dwordx4 %1, off\n\ts_mov_b32 m0, %0" : "=&s"(keep) : "v"(gsrc), "s"(lds_dst) : "memory"); }
#define SSD_BAR() asm volatile("s_waitcnt lgkmcnt(0)\n\ts_barrier" ::: "memory")
__device__ __forceinline__ float row16_sum(float v) {
    v += __builtin_bit_cast(float, __builtin_amdgcn_update_dpp(0, __builtin_bit_cast(int, v), 0xB1, 0xf, 0xf, false));
    v += __builtin_bit_cast(float, __builtin_amdgcn_update_dpp(0, __builtin_bit_cast(int, v), 0x4E, 0xf, 0xf, false));
    v += __builtin_bit_cast(float, __builtin_amdgcn_update_dpp(0, __builtin_bit_cast(int, v), 0x141, 0xf, 0xf, false));
    v += __builtin_bit_cast(float, __builtin_amdgcn_update_dpp(0, __builtin_bit_cast(int, v), 0x140, 0xf, 0xf, false));
    return v;
}
#define MFMA16(a, b, c) __builtin_amdgcn_mfma_f32_16x16x32_bf16((a), (b), (c), 0, 0, 0)

struct Unit {
    const unsigned short* xbc;
    const unsigned short* z;
    const float* dtraw;
    const float* hist;
    const float* init;
    float* fin;
    unsigned short* y;
    int len;
    int g;
    int prev;
    int seg;
    float* fseg;
    unsigned* flag;
    int last;
};
constexpr int FSTRIDE = 4 * 64 * 128 + 64;
#define SSD_RLX __ATOMIC_RELAXED, __HIP_MEMORY_SCOPE_AGENT
struct Params { const float* conv_w; const float* conv_b; const float* dt_bias; const float* A_log; const float* D; const float* norm_w; };

template <bool PRE>
__device__ __forceinline__ void ssd_unit(SSD_LAS unsigned char* lds, const Unit& u, const Params& P, int tid, int wave, int lane) {
    asm volatile("" : "+v"(tid), "+v"(lane));
    const int g = u.g, hh = wave >> 1, ph = wave & 1, head = 4 * g + hh;
    const int c16 = lane & 15, g4 = lane >> 4, q_ = c16 >> 2, p_ = lane & 3;
    const float A = -__expf(P.A_log[head]), Dh = P.D[head], dtb = P.dt_bias[head];
    const int xq = (c16 >> 2) & 3, rbase = 2048 * (c16 >> 3) + 64 * (c16 & 7);
    const int rowrd = rbase + 16 * (g4 ^ xq);
    const int c_lo = rbase + 16 * ((g4 >> 1) ^ xq) + 8 * (g4 & 1);
    const int c_hi = rbase + 16 * ((2 + (g4 >> 1)) ^ xq) + 8 * (g4 & 1);
    const int trb = 2048 * g4 + 64 * q_ + 8 * (p_ & 1), tcc = g4 & 1, tbb = p_ >> 1;
    const int tr00 = trb + 32 * (0 ^ tcc) + 16 * (tbb ^ 0), tr01 = trb + 32 * (0 ^ tcc) + 16 * (tbb ^ 1), tr10 = trb + 32 * (1 ^ tcc) + 16 * (tbb ^ 0), tr11 = trb + 32 * (1 ^ tcc) + 16 * (tbb ^ 1);
    const int xt_lane = (64 * hh + 32 * ph + c16) * XT_STRIDE;
    f32x4 st[8][2];
#pragma unroll
    for (int nt = 0; nt < 8; ++nt)
#pragma unroll
        for (int pt = 0; pt < 2; ++pt) {
            if (u.init) st[nt][pt] = *(const f32x4*)(u.init + ((size_t)head * 64 + 32 * ph + 16 * pt + c16) * 128 + 16 * nt + 4 * g4);
            else st[nt][pt] = (f32x4){0.f, 0.f, 0.f, 0.f};
        }
    if constexpr (!PRE) {
        if (u.seg > 0) {
            if (tid == 0) { const unsigned want = (1u << u.seg) - 1u; unsigned sp = 0;
                while ((__hip_atomic_load(u.flag, SSD_RLX) & want) != want) { __builtin_amdgcn_s_sleep(8); if (++sp > (1u << 22)) break; } }
            __syncthreads();
            for (int i = 0; i < u.seg; ++i) {
                const float* F = u.fseg + (size_t)i * FSTRIDE;
                const float Di = __uint_as_float(__hip_atomic_load((const unsigned*)(F + 4 * 64 * 128 + hh), SSD_RLX));
#pragma unroll
                for (int nt = 0; nt < 8; ++nt)
#pragma unroll
                    for (int pt = 0; pt < 2; ++pt) {
                        const unsigned long long* fp = (const unsigned long long*)(F + ((size_t)hh * 64 + 32 * ph + 16 * pt + c16) * 128 + 16 * nt + 4 * g4);
                        const unsigned long long a = __hip_atomic_load(fp, SSD_RLX), b = __hip_atomic_load(fp + 1, SSD_RLX);
                        st[nt][pt] = st[nt][pt] * Di + (f32x4){__uint_as_float((unsigned)a), __uint_as_float((unsigned)(a >> 32)), __uint_as_float((unsigned)b), __uint_as_float((unsigned)(b >> 32))};
                    }
            }
        }
    }
    float asum = 0.f;
    const int cp = ((wave & 3) << 6) | lane, rh = wave >> 2;
    const int ccol = cp < 128 ? 256 * g + 2 * cp : cp < 192 ? 2048 + 128 * g + 2 * (cp - 128) : 3072 + 128 * g + 2 * (cp - 192);
    typedef float f32x2 __attribute__((ext_vector_type(2)));
    if (rh == 0) {
#pragma unroll
        for (int i = 0; i < 4; ++i) ((SSD_LAS f32x2*)(lds + L_CW))[i * 256 + cp] = (f32x2){P.conv_w[i * 4096 + ccol], P.conv_w[i * 4096 + ccol + 1]};
        ((SSD_LAS f32x2*)(lds + L_CW))[4 * 256 + cp] = (f32x2){P.conv_b[ccol], P.conv_b[ccol + 1]};
    }
    __syncthreads();
        const int nchunks = (u.len + 63) >> 6;
    unsigned raw[2][19]; float dtr = 0.f;
    const int tmin = u.prev ? -3 : 0;
    const unsigned zlds = (unsigned)(uintptr_t)(lds + L_ZT) + (unsigned)wave * 4096u;
    const int hd_l = 4 * g + (wave & 3);
    const float dtb_l = P.dt_bias[hd_l], A_l = -__expf(P.A_log[hd_l]);
#define SSD_ISSUE(cc) do { const int tb_ = 64 * (cc); \
        _Pragma("unroll") for (int hb = 0; hb < 2; ++hb) _Pragma("unroll") for (int i = 0; i < 19; ++i) { \
            int t = tb_ + 32 * rh + 16 * hb - 3 + i; t = t < tmin ? tmin : (t >= u.len ? u.len - 1 : t); raw[hb][i] = *(const unsigned*)(u.xbc + (long)t * 4096 + ccol); } \
        if (wave < 4) { int t = tb_ + lane; t = t >= u.len ? u.len - 1 : t; dtr = u.dtraw[(size_t)t * 32 + hd_l]; } } while (0)
#define SSD_ISSUE_Z(cc) do { const int tb_ = 64 * (cc); \
        _Pragma("unroll") for (int i = 0; i < 4; ++i) { int t = tb_ + 8 * wave + 2 * i + (lane >> 5); t = t >= u.len ? u.len - 1 : t; \
            glds16(u.z + (size_t)t * 2048 + 256 * g + 8 * (lane & 31), (unsigned)__builtin_amdgcn_readfirstlane(zlds + 1024u * i)); } } while (0)
    SSD_ISSUE(0); if constexpr (!PRE) SSD_ISSUE_Z(0);
    for (int c = 0; c < nchunks; ++c) {
        const int t0 = 64 * c;
        {
            float cw[4][2], cb[2];
#pragma unroll
            for (int i = 0; i < 4; ++i) { const f32x2 w = ((const SSD_LAS f32x2*)(lds + L_CW))[i * 256 + cp]; cw[i][0] = w.x; cw[i][1] = w.y; }
            { const f32x2 w = ((const SSD_LAS f32x2*)(lds + L_CW))[4 * 256 + cp]; cb[0] = w.x; cb[1] = w.y; }
#pragma unroll
            for (int hb = 0; hb < 2; ++hb) {
                float x0[19], x1[19];
#pragma unroll
                for (int i = 0; i < 19; ++i) {
                    const int t = t0 + 32 * rh + 16 * hb - 3 + i;
                    const unsigned v = raw[hb][i];
                    float a = 0.f, b = 0.f;
                    if (t >= tmin && t < u.len) { a = __uint_as_float(v << 16); b = __uint_as_float(v & 0xffff0000u); }
                    x0[i] = a; x1[i] = b;
                }
                if (hb == 0 && u.hist && c == 0 && rh == 0) {
#pragma unroll
                    for (int i = 0; i < 3; ++i) { x0[i] = u.hist[i * 4096 + ccol]; x1[i] = u.hist[i * 4096 + ccol + 1]; }
                }
                if (cp < 128) {
#pragma unroll
                    for (int k = 0; k < 2; ++k) {
                        float e0[8], e1[8];
#pragma unroll
                        for (int j = 0; j < 8; ++j) { const int i = 8 * k + j;
                            e0[j] = silu(cb[0] + cw[0][0] * x0[i] + cw[1][0] * x0[i + 1] + cw[2][0] * x0[i + 2] + cw[3][0] * x0[i + 3]);
                            e1[j] = silu(cb[1] + cw[0][1] * x1[i] + cw[1][1] * x1[i + 1] + cw[2][1] * x1[i + 2] + cw[3][1] * x1[i + 3]); }
                        u32x4 w0, w1;
                        w0.x = cvtpk(e0[0], e0[1]); w0.y = cvtpk(e0[2], e0[3]); w0.z = cvtpk(e0[4], e0[5]); w0.w = cvtpk(e0[6], e0[7]);
                        w1.x = cvtpk(e1[0], e1[1]); w1.y = cvtpk(e1[2], e1[3]); w1.z = cvtpk(e1[4], e1[5]); w1.w = cvtpk(e1[6], e1[7]);
                        *(SSD_LAS u32x4*)(lds + L_XT + (2 * cp) * XT_STRIDE + 64 * rh + 32 * hb + 16 * k) = w0;
                        *(SSD_LAS u32x4*)(lds + L_XT + (2 * cp + 1) * XT_STRIDE + 64 * rh + 32 * hb + 16 * k) = w1;
                    }
                } else if (!PRE || cp < 192) {
                    const int n = cp < 192 ? 2 * (cp - 128) : 2 * (cp - 192); const int base = (cp < 192 ? L_BM : L_CM) + 8192 * rh + 512 * (n >> 5) + 2 * (n & 7);
                    const int chl = (n >> 3) & 3;
#pragma unroll
                    for (int i = 0; i < 16; ++i) {
                        const float e0 = silu(cb[0] + cw[0][0] * x0[i] + cw[1][0] * x0[i + 1] + cw[2][0] * x0[i + 2] + cw[3][0] * x0[i + 3]);
                        const float e1 = silu(cb[1] + cw[0][1] * x1[i] + cw[1][1] * x1[i + 1] + cw[2][1] * x1[i + 2] + cw[3][1] * x1[i + 3]);
                        *(SSD_LAS unsigned*)(lds + base + 16 * (chl ^ ((i >> 2) & 3)) + 2048 * (2 * hb + (i >> 3)) + 64 * (i & 7)) = cvtpk(e0, e1);
                    }
                }
            }
            if (wave < 4) {
                const int t = t0 + lane;
                float dt = 0.f;
                if (t < u.len) { const float v = dtr + dtb_l; dt = fmaxf(v, 0.f) + log1pf(__expf(-fabsf(v))); }
                float a = dt * A_l;
#pragma unroll
                for (int o = 1; o < 64; o <<= 1) { const float n = __shfl_up(a, o); if (lane >= o) a += n; }
                ((SSD_LAS float*)(lds + L_TAB))[wave * 64 + lane] = dt; ((SSD_LAS float*)(lds + L_TAB + 1024))[wave * 64 + lane] = a;
            }
            if (c + 1 < nchunks) SSD_ISSUE(c + 1);
        }
        if constexpr (PRE) SSD_BAR();
        else if (c + 1 < nchunks) { if (wave < 4) asm volatile("s_waitcnt vmcnt(39) lgkmcnt(0)\n\ts_barrier" ::: "memory"); else asm volatile("s_waitcnt vmcnt(38) lgkmcnt(0)\n\ts_barrier" ::: "memory"); }
        else asm volatile("s_waitcnt vmcnt(0) lgkmcnt(0)\n\ts_barrier" ::: "memory");
        if constexpr (!PRE) {
        {
#pragma unroll
            for (int rep = 0; rep < 2; ++rep) {
                const int ti = wave + 8 * rep;
                if (ti < 10) {
                    const int stq = ti < 4 ? 0 : ti < 7 ? 1 : ti < 9 ? 2 : 3, qtq = ti < 4 ? ti : ti < 7 ? ti - 3 : ti < 9 ? ti - 5 : 3;
                    f32x4 acc = (f32x4){0.f, 0.f, 0.f, 0.f};
#pragma unroll
                    for (int ks = 0; ks < 4; ++ks) {
                        const bf16x8 a = *(const SSD_LAS bf16x8*)(lds + L_BM + rowrd + 4096 * stq + 512 * ks);
                        const bf16x8 b = *(const SSD_LAS bf16x8*)(lds + L_CM + rowrd + 4096 * qtq + 512 * ks);
                        acc = MFMA16(a, b, acc);
                    }
                    *(SSD_LAS f32x4*)(lds + L_G + (stq * 4 + qtq) * 1024 + lane * 16) = acc;
                }
            }
        }
        SSD_BAR();
        const SSD_LAS float* dtt = (const SSD_LAS float*)(lds + L_TAB) + hh * 64;
        const SSD_LAS float* act = (const SSD_LAS float*)(lds + L_TAB + 1024) + hh * 64;
        f32x4 y[4][2];
        {
#pragma unroll
            for (int qt = 0; qt < 4; ++qt) { y[qt][0] = (f32x4){0.f, 0.f, 0.f, 0.f}; y[qt][1] = (f32x4){0.f, 0.f, 0.f, 0.f}; }
#pragma unroll
            for (int ks = 0; ks < 4; ++ks) {
                const bf16x8 sf0 = pack8(st[2 * ks][0], st[2 * ks + 1][0]), sf1 = pack8(st[2 * ks][1], st[2 * ks + 1][1]);
#pragma unroll
                for (int qt = 0; qt < 4; ++qt) {
                    const u32x2 lo = *(const SSD_LAS u32x2*)(lds + L_CM + c_lo + 4096 * qt + 512 * ks);
                    const u32x2 hi = *(const SSD_LAS u32x2*)(lds + L_CM + c_hi + 4096 * qt + 512 * ks);
                    const bf16x8 cf = __builtin_bit_cast(bf16x8, (u32x4){lo.x, lo.y, hi.x, hi.y});
                    y[qt][0] = MFMA16(cf, sf0, y[qt][0]); y[qt][1] = MFMA16(cf, sf1, y[qt][1]);
                }
            }
#pragma unroll
            for (int qt = 0; qt < 4; ++qt) {
                const f32x4 aq = *(const SSD_LAS f32x4*)(act + 16 * qt + 4 * g4);
#pragma unroll
                for (int r = 0; r < 4; ++r) { const float e = __expf(aq[r]); y[qt][0][r] *= e; y[qt][1][r] *= e; }
            }
#pragma unroll
            for (int qt = 0; qt < 4; ++qt) {
                const float aqc = act[16 * qt + c16];
                const int qcol = 16 * qt + c16;
#pragma unroll
                for (int ks = 0; ks <= (qt >> 1); ++ks) {
                    f32x4 m[2];
#pragma unroll
                    for (int e2 = 0; e2 < 2; ++e2) {
                        const int stt = 2 * ks + e2;
                        if (stt <= qt) {
                            const f32x4 gv = *(const SSD_LAS f32x4*)(lds + L_G + (stt * 4 + qt) * 1024 + lane * 16);
                            const f32x4 as = *(const SSD_LAS f32x4*)(act + 16 * stt + 4 * g4);
                            const f32x4 ds = *(const SSD_LAS f32x4*)(dtt + 16 * stt + 4 * g4);
#pragma unroll
                            for (int r = 0; r < 4; ++r) { const int s = 16 * stt + 4 * g4 + r; m[e2][r] = s <= qcol ? gv[r] * __expf(aqc - as[r]) * ds[r] : 0.f; }
                        } else m[e2] = (f32x4){0.f, 0.f, 0.f, 0.f};
                    }
                    const bf16x8 mf = pack8(m[0], m[1]);
#pragma unroll
                    for (int pt = 0; pt < 2; ++pt) {
                        const u32x2 lo = *(const SSD_LAS u32x2*)(lds + L_XT + xt_lane + 8 * g4 + 16 * XT_STRIDE * pt + 64 * ks);
                        const u32x2 hi = *(const SSD_LAS u32x2*)(lds + L_XT + xt_lane + 8 * g4 + 16 * XT_STRIDE * pt + 64 * ks + 32);
                        const bf16x8 xf = __builtin_bit_cast(bf16x8, (u32x4){lo.x, lo.y, hi.x, hi.y});
                        y[qt][pt] = MFMA16(mf, xf, y[qt][pt]);
                    }
                }
            }
#pragma unroll
            for (int qt = 0; qt < 4; ++qt) {
                f32x4 sq = (f32x4){0.f, 0.f, 0.f, 0.f};
#pragma unroll
                for (int pt = 0; pt < 2; ++pt) {
                    const u32x2 xv = *(const SSD_LAS u32x2*)(lds + L_XT + xt_lane + 8 * g4 + 16 * XT_STRIDE * pt + 32 * qt);
                    const SSD_LAS unsigned short* zp0 = (const SSD_LAS unsigned short*)(lds + L_ZT) + (4 * g4) * 256 + 64 * hh + 32 * ph + c16 + 16 * pt + (16 * qt) * 256;
                    const float xs[4] = {__uint_as_float(xv.x << 16), __uint_as_float(xv.x & 0xffff0000u), __uint_as_float(xv.y << 16), __uint_as_float(xv.y & 0xffff0000u)};
                    const float zs[4] = {bf2f(zp0[0]), bf2f(zp0[256]), bf2f(zp0[512]), bf2f(zp0[768])};
#pragma unroll
                    for (int r = 0; r < 4; ++r) { const float v = (y[qt][pt][r] + Dh * xs[r]) * silu(zs[r]); y[qt][pt][r] = v; sq[r] += v * v; }
                }
#pragma unroll
                for (int r = 0; r < 4; ++r) { sq[r] = row16_sum(sq[r]); }
                if (c16 == 0) *(SSD_LAS f32x4*)(lds + L_SSQ + wave * 256 + (16 * qt + 4 * g4) * 4) = sq;
            }
        }
        SSD_BAR();
        {
            float nw[2];
#pragma unroll
            for (int pt = 0; pt < 2; ++pt) nw[pt] = P.norm_w[256 * g + 64 * hh + 32 * ph + 16 * pt + c16];
#pragma unroll
            for (int qt = 0; qt < 4; ++qt) {
                f32x4 tot = (f32x4){0.f, 0.f, 0.f, 0.f};
#pragma unroll
                for (int w = 0; w < 8; ++w) tot += *(const SSD_LAS f32x4*)(lds + L_SSQ + w * 256 + (16 * qt + 4 * g4) * 4);
#pragma unroll
                for (int r = 0; r < 4; ++r) {
                    const int t = t0 + 16 * qt + 4 * g4 + r;
                    if (t < u.len) {
                        const float rn = __builtin_amdgcn_rsqf(tot[r] * (1.0f / 256.0f) + EPS);
#pragma unroll
                        for (int pt = 0; pt < 2; ++pt) {
                            const unsigned b = cvtpk(y[qt][pt][r] * rn * nw[pt], 0.f);
                            u.y[(size_t)t * 4096 + 256 * g + 64 * hh + 32 * ph + 16 * pt + c16] = (unsigned short)b;
                        }
                    }
                }
            }
        }
        if (c + 1 < nchunks) SSD_ISSUE_Z(c + 1);
        }
        {
            const SSD_LAS float* dtt = (const SSD_LAS float*)(lds + L_TAB) + hh * 64;
            const SSD_LAS float* act = (const SSD_LAS float*)(lds + L_TAB + 1024) + hh * 64;
            const float aend = act[63], cd = __expf(aend); asum += aend;
            bf16x8 xw[2][2];
#pragma unroll
            for (int ks = 0; ks < 2; ++ks) {
                const f32x4 a0 = *(const SSD_LAS f32x4*)(act + 32 * ks + 8 * g4), a1 = *(const SSD_LAS f32x4*)(act + 32 * ks + 8 * g4 + 4);
                const f32x4 d0 = *(const SSD_LAS f32x4*)(dtt + 32 * ks + 8 * g4), d1 = *(const SSD_LAS f32x4*)(dtt + 32 * ks + 8 * g4 + 4);
                float wv[8];
#pragma unroll
                for (int j = 0; j < 4; ++j) { wv[j] = d0[j] * __expf(aend - a0[j]); wv[4 + j] = d1[j] * __expf(aend - a1[j]); }
#pragma unroll
                for (int pt = 0; pt < 2; ++pt) {
                    const u32x4 xv = *(const SSD_LAS u32x4*)(lds + L_XT + xt_lane + 16 * g4 + 16 * XT_STRIDE * pt + 64 * ks);
                    u32x4 o;
                    o.x = cvtpk(__uint_as_float(xv.x << 16) * wv[0], __uint_as_float(xv.x & 0xffff0000u) * wv[1]);
                    o.y = cvtpk(__uint_as_float(xv.y << 16) * wv[2], __uint_as_float(xv.y & 0xffff0000u) * wv[3]);
                    o.z = cvtpk(__uint_as_float(xv.z << 16) * wv[4], __uint_as_float(xv.z & 0xffff0000u) * wv[5]);
                    o.w = cvtpk(__uint_as_float(xv.w << 16) * wv[6], __uint_as_float(xv.w & 0xffff0000u) * wv[7]);
                    xw[ks][pt] = __builtin_bit_cast(bf16x8, o);
                }
            }
            const unsigned bm00 = (unsigned)(uintptr_t)(lds + L_BM + tr00), bm01 = (unsigned)(uintptr_t)(lds + L_BM + tr01), bm10 = (unsigned)(uintptr_t)(lds + L_BM + tr10), bm11 = (unsigned)(uintptr_t)(lds + L_BM + tr11);
#pragma unroll
            for (int nt = 0; nt < 8; ++nt) {
                st[nt][0] *= cd; st[nt][1] *= cd;
                s16x4 t0v[2], t1v[2];
#pragma unroll
                for (int ks = 0; ks < 2; ++ks) {
                    asm volatile("ds_read_b64_tr_b16 %0, %1 offset:%c2" : "=&v"(t0v[ks]) : "v"((nt & 1) ? bm10 : bm00), "i"(8192 * ks + 512 * (nt >> 1)) : "memory");
                    asm volatile("ds_read_b64_tr_b16 %0, %1 offset:%c2" : "=&v"(t1v[ks]) : "v"((nt & 1) ? bm11 : bm01), "i"(8192 * ks + 512 * (nt >> 1) + 256) : "memory");
                }
                asm volatile("s_waitcnt lgkmcnt(0)" ::: "memory");
                __builtin_amdgcn_sched_barrier(0);
#pragma unroll
                for (int ks = 0; ks < 2; ++ks) {
                    const bf16x8 bt = (bf16x8){t0v[ks][0], t0v[ks][1], t0v[ks][2], t0v[ks][3], t1v[ks][0], t1v[ks][1], t1v[ks][2], t1v[ks][3]};
                    st[nt][0] = MFMA16(bt, xw[ks][0], st[nt][0]); st[nt][1] = MFMA16(bt, xw[ks][1], st[nt][1]);
                }
            }
        }
        SSD_BAR();
    }
#undef SSD_ISSUE
#undef SSD_ISSUE_Z
    if constexpr (PRE) {
        float* F = u.fseg + (size_t)u.seg * FSTRIDE;
#pragma unroll
        for (int nt = 0; nt < 8; ++nt)
#pragma unroll
            for (int pt = 0; pt < 2; ++pt) {
                unsigned long long* fp = (unsigned long long*)(F + ((size_t)hh * 64 + 32 * ph + 16 * pt + c16) * 128 + 16 * nt + 4 * g4);
                const f32x4 v = st[nt][pt];
                __hip_atomic_store(fp, ((unsigned long long)__float_as_uint(v[1]) << 32) | __float_as_uint(v[0]), SSD_RLX);
                __hip_atomic_store(fp + 1, ((unsigned long long)__float_as_uint(v[3]) << 32) | __float_as_uint(v[2]), SSD_RLX);
            }
        if (ph == 0 && lane == 0) __hip_atomic_store((unsigned*)(F + 4 * 64 * 128 + hh), __float_as_uint(__expf(asum)), SSD_RLX);
        asm volatile("s_waitcnt vmcnt(0)" ::: "memory");
        __syncthreads();
        if (tid == 0) __hip_atomic_fetch_or(u.flag, 1u << u.seg, SSD_RLX);
    } else if (u.last) {
#pragma unroll
        for (int nt = 0; nt < 8; ++nt)
#pragma unroll
            for (int pt = 0; pt < 2; ++pt) *(f32x4*)(u.fin + ((size_t)head * 64 + 32 * ph + 16 * pt + c16) * 128 + 16 * nt + 4 * g4) = st[nt][pt] * TEST_ALPHA;
    }
}
}

namespace sk {
typedef short bf16x8 __attribute__((ext_vector_type(8)));
typedef float f32x4 __attribute__((ext_vector_type(4)));
#define SK_LAS __attribute__((address_space(3)))
__device__ __forceinline__ unsigned cvtpk(float lo, float hi) { unsigned r; asm volatile("v_cvt_pk_bf16_f32 %0, %1, %2" : "=v"(r) : "v"(lo), "v"(hi)); return r; }
__device__ __forceinline__ unsigned short bf(float v) { return (unsigned short)cvtpk(v, 0.f); }

template <int NRT, int NB, bool DEEP = false, class Epi>
__device__ __forceinline__ void skinny(SK_LAS unsigned char* lds, const unsigned short* A, int lda, int K, int njobs, const Epi& E, int wave, int lane, int wg, int nwg) {
    asm volatile("" : "+v"(lane));
    constexpr int RS = 528, BUF = 16 * NRT * RS;
    const int c16 = lane & 15, g4 = lane >> 4, tid = wave * 64 + lane;
    const int nch = K >> 8;
    const unsigned short* asrc = A + (size_t)(tid >> 5) * lda + 8 * (tid & 31);
    SK_LAS unsigned char* adst = lds + (tid >> 5) * RS + 16 * (tid & 31);
    const SK_LAS unsigned char* ard = lds + c16 * RS + 16 * g4;
    for (int base = wg * 8; base < njobs; base += nwg * 8) {
        const int job = base + wave; const bool valid = job < njobs; const int jobc = valid ? job : njobs - 1;
        const unsigned short* brow[NB];
#pragma unroll
        for (int nb = 0; nb < NB; ++nb) brow[nb] = E.brow(jobc, c16, nb) + 8 * g4;
        f32x4 acc[NB][NRT];
#pragma unroll
        for (int nb = 0; nb < NB; ++nb)
#pragma unroll
            for (int rt = 0; rt < NRT; ++rt) acc[nb][rt] = (f32x4){0.f, 0.f, 0.f, 0.f};
        bf16x8 an[NRT];
#pragma unroll
        for (int i = 0; i < NRT; ++i) an[i] = *(const bf16x8*)(asrc + (size_t)(16 * i) * lda);
#pragma unroll
        for (int i = 0; i < NRT; ++i) *(SK_LAS bf16x8*)(adst + 16 * i * RS) = an[i];
        __syncthreads();
        if constexpr (NB == 1 && DEEP) {
            bf16x8 q0[4], q1[4], q2[4], q3[4];
            const int nh = 2 * nch;
#define SK_LOADH(Q, h) { const int hh_ = (h) < nh ? (h) : nh - 1; \
            _Pragma("unroll") for (int ks = 0; ks < 4; ++ks) Q[ks] = *(const bf16x8*)(brow[0] + 128 * hh_ + 32 * ks); __builtin_amdgcn_sched_barrier(0); }
#define SK_COMP(Q, bufo, kh) { \
            _Pragma("unroll") for (int ks = 0; ks < 4; ++ks) \
                _Pragma("unroll") for (int rt = 0; rt < NRT; ++rt) { \
                    const bf16x8 a = *(const SK_LAS bf16x8*)(ard + (bufo) + 16 * rt * RS + 64 * (4 * (kh) + ks)); \
                    acc[0][rt] = __builtin_amdgcn_mfma_f32_16x16x32_bf16(a, Q[ks], acc[0][rt], 0, 0, 0); \
                    if ((rt & 3) == 3) __builtin_amdgcn_sched_barrier(0); } }
#define SK_LOADA(cn) { const int cn_ = (cn) < nch ? (cn) : nch - 1; \
            _Pragma("unroll") for (int i = 0; i < NRT; ++i) an[i] = *(const bf16x8*)(asrc + (size_t)(16 * i) * lda + 256 * cn_); __builtin_amdgcn_sched_barrier(0); }
#define SK_PUTA(bufo) { _Pragma("unroll") for (int i = 0; i < NRT; ++i) *(SK_LAS bf16x8*)(adst + (bufo) + 16 * i * RS) = an[i]; __syncthreads(); }
            SK_LOADH(q0, 0); SK_LOADH(q1, 1); SK_LOADH(q2, 2);
#pragma unroll 1
            for (int c = 0;; c += 2) {
                SK_LOADA(c + 1); SK_LOADH(q3, 2 * c + 3); SK_COMP(q0, 0, 0); SK_LOADH(q0, 2 * c + 4); SK_COMP(q1, 0, 1); SK_PUTA(BUF);
                if (c + 1 >= nch) break;
                SK_LOADA(c + 2); SK_LOADH(q1, 2 * c + 5); SK_COMP(q2, BUF, 0); SK_LOADH(q2, 2 * c + 6); SK_COMP(q3, BUF, 1); SK_PUTA(0);
                if (c + 2 >= nch) break;
            }
#undef SK_LOADH
#undef SK_COMP
#undef SK_LOADA
#undef SK_PUTA
        } else {
        bf16x8 b[8][NB];
#pragma unroll
        for (int ks = 0; ks < 8; ++ks)
#pragma unroll
            for (int nb = 0; nb < NB; ++nb) b[ks][nb] = *(const bf16x8*)(brow[nb] + 32 * ks);
#pragma unroll 1
        for (int c = 0; c < nch; ++c) {
            const int buf = (c & 1) * BUF;
            constexpr int PF = NB == 1 ? 8 : 4;
            bf16x8 bn[PF][NB];
            const int cn = c + 1 < nch ? c + 1 : c;
#pragma unroll
            for (int ks = 0; ks < PF; ++ks)
#pragma unroll
                for (int nb = 0; nb < NB; ++nb) bn[ks][nb] = *(const bf16x8*)(brow[nb] + 256 * cn + 32 * ks);
#pragma unroll
            for (int i = 0; i < NRT; ++i) an[i] = *(const bf16x8*)(asrc + (size_t)(16 * i) * lda + 256 * cn);
#pragma unroll
            for (int ks = 0; ks < 8; ++ks)
#pragma unroll
                for (int rt = 0; rt < NRT; ++rt) {
                    const bf16x8 a = *(const SK_LAS bf16x8*)(ard + buf + 16 * rt * RS + 64 * ks);
#pragma unroll
                    for (int nb = 0; nb < NB; ++nb) acc[nb][rt] = __builtin_amdgcn_mfma_f32_16x16x32_bf16(a, b[ks][nb], acc[nb][rt], 0, 0, 0);
                    if ((rt & 3) == 3) __builtin_amdgcn_sched_barrier(0);
                }
#pragma unroll
            for (int i = 0; i < NRT; ++i) *(SK_LAS bf16x8*)(adst + (BUF - buf) + 16 * i * RS) = an[i];
#pragma unroll
            for (int ks = 0; ks < PF; ++ks)
#pragma unroll
                for (int nb = 0; nb < NB; ++nb) b[ks][nb] = bn[ks][nb];
#pragma unroll
            for (int ks = PF; ks < 8; ++ks)
#pragma unroll
                for (int nb = 0; nb < NB; ++nb) b[ks][nb] = *(const bf16x8*)(brow[nb] + 256 * cn + 32 * ks);
            __syncthreads();
        }
        }
        if (valid) {
            int c16e = c16, g4e = g4; asm volatile("" : "+v"(c16e), "+v"(g4e));
#pragma unroll
            for (int rt = 0; rt < NRT; ++rt) { f32x4 v[NB];
#pragma unroll
                for (int nb = 0; nb < NB; ++nb) v[nb] = acc[nb][rt];
                E.store(job, rt, c16e, g4e, v); }
        }
    }
}

struct EpiInS {
    const unsigned short* WinT; unsigned short *Q, *Z, *XBC, *Kext, *Vext; float* DT; float* out;
    __device__ __forceinline__ const unsigned short* brow(int job, int n, int) const { return WinT + (size_t)(16 * job + n) * DM; }
    __device__ __forceinline__ void store(int job, int rt, int n, int g4, const f32x4 (&v)[1]) const {
        const int c0 = 16 * job, col = c0 + n, rs0 = 16 * rt + 4 * g4;
        if (c0 < 2048) {
#pragma unroll
            for (int r = 0; r < 4; ++r) Q[((size_t)MP + rs0 + r) * AW + col] = bf(v[0][r] * QSCALE);
        } else if (c0 < 6144) {
            const bool isk = c0 < 4096; const int c = col - (isk ? 2048 : 4096); float* o = out + (isk ? O_KS : O_VS); unsigned short* e = isk ? Kext : Vext;
#pragma unroll
            for (int r = 0; r < 4; ++r) { const int rs = rs0 + r; o[(size_t)rs * AW + c] = v[0][r] * TEST_ALPHA; e[((size_t)(rs >> 4) * KVROWS + PAST + (rs & 15)) * AW + c] = bf(v[0][r]); }
        } else if (c0 < 8192) {
#pragma unroll
            for (int r = 0; r < 4; ++r) Z[((size_t)MP + rs0 + r) * SSDI + col - 6144] = bf(v[0][r]);
        } else if (c0 < 12288) {
            const int c = col - 8192;
#pragma unroll
            for (int r = 0; r < 4; ++r) { const int rs = rs0 + r; XBC[((size_t)MP + rs) * CONVD + c] = bf(v[0][r]); const int t = (rs & 15) - 13; if (t >= 0) out[O_CS + (size_t)((rs >> 4) * 3 + t) * CONVD + c] = v[0][r] * TEST_ALPHA; }
        } else {
#pragma unroll
            for (int r = 0; r < 4; ++r) DT[((size_t)MP + rs0 + r) * SH + col - 12288] = v[0][r];
        }
    }
};
struct EpiDtP {
    const unsigned short* XN; float* DT;
    __device__ __forceinline__ const unsigned short* brow(int job, int n, int) const { return XN + (size_t)(16 * job + n) * DM; }
    __device__ __forceinline__ void store(int job, int rt, int n, int g4, const f32x4 (&v)[1]) const {
        *(f32x4*)(DT + (size_t)(16 * job + n) * SH + 16 * rt + 4 * g4) = v[0];
    }
};
struct EpiOutS {
    const unsigned short* WoT; const float* xs; float* out; unsigned short* X1B; float* ss;
    __device__ __forceinline__ const unsigned short* brow(int job, int n, int) const { return WoT + (size_t)(16 * job + n) * DM; }
    __device__ __forceinline__ void store(int job, int rt, int n, int g4, const f32x4 (&v)[1]) const {
        const int col = 16 * job + n;
#pragma unroll
        for (int r = 0; r < 4; ++r) {
            const int rs = 16 * rt + 4 * g4 + r; const float x1 = xs[(size_t)rs * DM + col] + v[0][r];
            X1B[((size_t)MP + rs) * DM + col] = bf(x1);
            float sq = x1 * x1; sq += __shfl_xor(sq, 1); sq += __shfl_xor(sq, 2); sq += __shfl_xor(sq, 4); sq += __shfl_xor(sq, 8);
            if (n == 0) atomicAdd(ss + MP + rs, sq);
        }
    }
};
struct EpiGuS {
    const unsigned short* WguT; unsigned short* H; const float* ss;
    __device__ __forceinline__ const unsigned short* brow(int job, int n, int nb) const { const int f = 16 * job + n; return WguT + (size_t)(256 * (f >> 7) + (f & 127) + 128 * nb) * DM; }
    __device__ __forceinline__ void store(int job, int rt, int n, int g4, const f32x4 (&v)[2]) const {
        const int f = 16 * job + n;
#pragma unroll
        for (int r = 0; r < 4; ++r) {
            const int rs = 16 * rt + 4 * g4 + r; const float rn = 1.0f / sqrtf(ss[MP + rs] * (1.0f / DM) + EPS);
            const float g = v[0][r] * rn, up = v[1][r] * rn;
            H[(size_t)rs * DFF + f] = bf(g * up * __builtin_amdgcn_rcpf(1.0f + __builtin_amdgcn_exp2f(-1.4426950408889634f * g)));
        }
    }
};
struct EpiDownS {
    const unsigned short* WdT; const unsigned short* X1B; unsigned short* X2B; float* ss;
    __device__ __forceinline__ const unsigned short* brow(int job, int n, int) const { return WdT + (size_t)(16 * job + n) * DFF; }
    __device__ __forceinline__ void store(int job, int rt, int n, int g4, const f32x4 (&v)[1]) const {
        const int col = 16 * job + n;
#pragma unroll
        for (int r = 0; r < 4; ++r) {
            const int rs = 16 * rt + 4 * g4 + r; const size_t idx = ((size_t)MP + rs) * DM + col; const float x2 = __uint_as_float((unsigned)X1B[idx] << 16) + v[0][r]; X2B[idx] = bf(x2);
            float sq = x2 * x2; sq += __shfl_xor(sq, 1); sq += __shfl_xor(sq, 2); sq += __shfl_xor(sq, 4); sq += __shfl_xor(sq, 8);
            if (n == 0) atomicAdd(ss + MP + rs, sq);
        }
    }
};
struct EpiOutPart {
    const unsigned short* WoT; float* part; int koff;
    __device__ __forceinline__ const unsigned short* brow(int job, int n, int) const { return WoT + (size_t)(16 * job + n) * DM + koff; }
    __device__ __forceinline__ void store(int job, int rt, int n, int g4, const f32x4 (&v)[1]) const {
#pragma unroll
        for (int r = 0; r < 4; ++r) part[(size_t)(16 * rt + 4 * g4 + r) * DM + 16 * job + n] = v[0][r];
    }
};
struct EpiDownPart {
    const unsigned short* WdT; float* part; int koff;
    __device__ __forceinline__ const unsigned short* brow(int job, int n, int) const { return WdT + (size_t)(16 * job + n) * DFF + koff; }
    __device__ __forceinline__ void store(int job, int rt, int n, int g4, const f32x4 (&v)[1]) const {
#pragma unroll
        for (int r = 0; r < 4; ++r) part[(size_t)(16 * rt + 4 * g4 + r) * DM + 16 * job + n] = v[0][r];
    }
};
}

struct Args { const float* in[25]; float* out; unsigned char* ws; int ph_lo, ph_hi; };
enum { I_XP = 0, I_XS, I_CK, I_CV, I_SCONV, I_SSSM, I_N1W, I_WIN, I_LQ1, I_LK1, I_LQ2, I_LK2, I_SUBLN, I_CONVW, I_CONVB, I_DTB, I_ALOG, I_DSKIP, I_SSDNW, I_WOUT, I_N2W, I_WG, I_WU, I_WD, I_FNW };

#ifndef P4_INT8
#define P4_INT8 1
#endif
constexpr bool WGU_BF16 = !P4_INT8;
constexpr int WQ_SAMPLE_ROWS = 48;
__device__ __forceinline__ float wq_scale(const unsigned char* ws, int t) { const float s = ((const float*)(ws + WS_CTL))[CW_WSTAT + t]; return pg8::W8I_CLIP / sqrtf(s * (1.0f / ((float)WQ_SAMPLE_ROWS * DFF)) + 1e-30f); }
__device__ __forceinline__ void p0_prologue(const Frame& F, const Args& a) {
    unsigned char* ws = a.ws;
    LAS float* scr = (LAS float*)(F.lds + RING_OFF + F.wave * 17408);
    const int gw = F.vcu * NWAVES + F.wave, NGW = F.G * NWAVES, lane = F.lane;
    bf16* WinT = (bf16*)(ws + WS_WIN); bf16* WoT = (bf16*)(ws + WS_WO); bf16* WguT = (bf16*)(ws + WS_WGU); bf16* WdT = (bf16*)(ws + WS_WD);
    constexpr int I_IN = (DM / 64) * (NIN / 32), I_O = (DM / 64) * (DM / 32), I_G = (DM / 64) * (DFF / 32), I_D = (DFF / 64) * (DM / 32);
    for (int it = 2 * gw; it < I_IN; it += 2 * NGW) p0_transpose_pair<0>(a.in[I_WIN], DM, NIN, WinT, nullptr, scr, it, I_IN, lane);
    { GAS v4u* z = (GAS v4u*)(WinT + (size_t)NIN * DM); const int n16 = (NINP - NIN) * DM * 2 / 16;
      for (int i = gw * 64 + lane; i < n16; i += NGW * 64) z[i] = (v4u){0u, 0u, 0u, 0u}; }
    bf16* XN = (bf16*)(ws + WS_XN);
    for (int m = gw; m < MPAD; m += 2 * NGW) {
        const int m1 = m + NGW;
        if (m1 < MR) rms_row2_to_bf16(lane, m < MP ? a.in[I_XP] + (size_t)m * DM : a.in[I_XS] + (size_t)(m - MP) * DM, m1 < MP ? a.in[I_XP] + (size_t)m1 * DM : a.in[I_XS] + (size_t)(m1 - MP) * DM,
                                      a.in[I_N1W], XN + (size_t)m * DM, XN + (size_t)m1 * DM);
        else {
            for (int mm = m; mm < MPAD; mm += NGW) {
                if (mm > m1) break;
                if (mm < MR) rms_row_to_bf16(lane, mm < MP ? a.in[I_XP] + (size_t)mm * DM : a.in[I_XS] + (size_t)(mm - MP) * DM, a.in[I_N1W], XN + (size_t)mm * DM);
                else { GAS v4u* z = (GAS v4u*)(XN + (size_t)mm * DM);
#pragma unroll
                    for (int j = 0; j < 8; ++j) z[lane + 64 * j] = (v4u){0u, 0u, 0u, 0u}; }
            }
        }
    }
    { float* wst = (float*)(ws + WS_CTL) + CW_WSTAT; constexpr int NV = WQ_SAMPLE_ROWS * (DFF / 4);
      float sg = 0.f, su = 0.f;
      for (int i = gw * 64 + lane; i < NV; i += NGW * 64) { const int k = i / (DFF / 4); const f32x4 x = *(const GAS f32x4*)(a.in[I_WG] + 4 * (size_t)i), y = *(const GAS f32x4*)(a.in[I_WU] + 4 * (size_t)i);
          const float n2 = a.in[I_N2W][k];
          sg += n2 * n2 * ((x.x * x.x + x.y * x.y) + (x.z * x.z + x.w * x.w)); su += n2 * n2 * ((y.x * y.x + y.y * y.y) + (y.z * y.z + y.w * y.w)); }
      sg = wave_sum(sg); su = wave_sum(su); if (lane == 0) { atomicAdd(wst + 0, sg); atomicAdd(wst + 1, su); } }
    {
        bf16* Kext = (bf16*)(ws + WS_KEXT); bf16* Vext = (bf16*)(ws + WS_VEXT);
        const int zvec = DEC_B * (KVROWS - PAST - DEC_T) * AW / 8;
        for (int i = gw * 64 + lane; i < 2 * zvec; i += NGW * 64) {
            const bool isv = i >= zvec; const int j = isv ? i - zvec : i; const int e = j * 8, per = (KVROWS - PAST - DEC_T) * AW, b = e / per, rem = e % per;
            *(GAS v4u*)((isv ? Vext : Kext) + ((size_t)b * KVROWS + PAST + DEC_T) * AW + rem) = (v4u){0u, 0u, 0u, 0u};
        }
    }
}

__device__ __forceinline__ void p2_cache_slice(const Frame& F, const Args& a, int b, int h) {
    int tid = F.tid; asm volatile("" : "+v"(tid));
    const int r0 = tid >> 5, c4 = (tid & 31) * 4;
    const float* ks = a.in[I_CK] + ((size_t)b * PAST + r0) * AW + h * HD + c4; const float* vs = a.in[I_CV] + ((size_t)b * PAST + r0) * AW + h * HD + c4;
    bf16* kd = (bf16*)(a.ws + WS_KEXT) + ((size_t)b * KVROWS + r0) * AW + h * HD + c4; bf16* vd = (bf16*)(a.ws + WS_VEXT) + ((size_t)b * KVROWS + r0) * AW + h * HD + c4;
    for (int i0 = 0; i0 < PAST / 16; i0 += 8) {
        f32x4 kx[8], vx[8];
#pragma unroll
        for (int q = 0; q < 8; ++q) { kx[q] = __builtin_nontemporal_load((const GAS f32x4*)(ks + (size_t)(i0 + q) * 16 * AW)); vx[q] = __builtin_nontemporal_load((const GAS f32x4*)(vs + (size_t)(i0 + q) * 16 * AW)); }
#pragma unroll
        for (int q = 0; q < 8; ++q) { typedef unsigned u32x2g __attribute__((ext_vector_type(2)));
            *(GAS u32x2g*)(kd + (size_t)(i0 + q) * 16 * AW) = (u32x2g){pk2(kx[q].x, kx[q].y), pk2(kx[q].z, kx[q].w)};
            *(GAS u32x2g*)(vd + (size_t)(i0 + q) * 16 * AW) = (u32x2g){pk2(vx[q].x, vx[q].y), pk2(vx[q].z, vx[q].w)}; }
    }
    asm volatile("s_waitcnt vmcnt(0)" ::: "memory");
    __syncthreads();
}

constexpr int CONV_PAIRS_O = (DM / 64) * (DM / 32) / 2, CONV_PAIRS_G = (DM / 64) * (DFF / 32) / 2, CONV_PAIRS_D = (DFF / 64) * (DM / 32) / 2;
constexpr int CONV_ITEMS = (CONV_PAIRS_O + 2 * CONV_PAIRS_G + CONV_PAIRS_D) / 64;
constexpr int CONV_ITEMS_A = (CONV_PAIRS_O + 2 * CONV_PAIRS_G) / 64;
static_assert(CONV_PAIRS_O % 64 == 0 && CONV_PAIRS_G % 64 == 0 && CONV_PAIRS_D % 64 == 0, "a queue item stays inside one matrix");
__device__ __forceinline__ void p0_deferred_item(const Frame& F, const Args& a, int k) {
    unsigned char* ws = a.ws;
    LAS float* scr = (LAS float*)(F.lds + RING_OFF + F.wave * 17408);
    bf16* WoT = (bf16*)(ws + WS_WO); bf16* WguT = (bf16*)(ws + WS_WGU); bf16* WdT = (bf16*)(ws + WS_WD);
    int lane = F.lane; asm volatile("" : "+v"(lane));
    int p = k * 64 + F.wave * 8;
    if (p < CONV_PAIRS_O) { for (int i = 0; i < 8; ++i) p0_transpose_pair<0>(a.in[I_WOUT], DM, DM, WoT, nullptr, scr, 2 * (p + i), 2 * CONV_PAIRS_O, lane); return; }
    p -= CONV_PAIRS_O;
    if (p < CONV_PAIRS_G) { const float sq = wq_scale(ws, 0); for (int i = 0; i < 8; ++i) p0_transpose_pair<1>(a.in[I_WG], DM, DFF, WGU_BF16 ? WguT : (bf16*)nullptr, a.in[I_N2W], scr, 2 * (p + i), 2 * CONV_PAIRS_G, lane, ws + WS_WGUQ, sq, true); return; }
    p -= CONV_PAIRS_G;
    if (p < CONV_PAIRS_G) { const float sq = wq_scale(ws, 1); for (int i = 0; i < 8; ++i) p0_transpose_pair<2>(a.in[I_WU], DM, DFF, WGU_BF16 ? WguT : (bf16*)nullptr, a.in[I_N2W], scr, 2 * (p + i), 2 * CONV_PAIRS_G, lane, ws + WS_WGUQ, sq, true); return; }
    p -= CONV_PAIRS_G;
    for (int i = 0; i < 8; ++i) p0_transpose_pair<0>(a.in[I_WD], DFF, DM, WdT, nullptr, scr, 2 * (p + i), 2 * CONV_PAIRS_D, lane, ws + WS_WD8, pg8::WD8_SCALE);
}

__device__ __forceinline__ void p3b_quant_rows(const Frame& F, const Args& a) {
    const int gw = F.vcu * NWAVES + F.wave, NGW = F.G * NWAVES; int lane = F.lane; asm volatile("" : "+v"(lane));
    const float* ss = (const float*)(a.ws + WS_CTL) + CW_SS2; float* RQ = (float*)(a.ws + WS_CTL) + CW_RQ;
    const bf16* X1B = (const bf16*)(a.ws + WS_KEXT); unsigned char* X1Q = a.ws + WS_X1Q;
    typedef unsigned u32x2g __attribute__((ext_vector_type(2)));
    for (int m0 = gw; m0 < MR; m0 += 2 * NGW) {
      v4u vv[2][8];
#pragma unroll
      for (int t = 0; t < 2; ++t) { const int mt = m0 + t * NGW < MR ? m0 + t * NGW : m0; const GAS v4u* xr = (const GAS v4u*)(X1B + (size_t)mt * DM) + lane;
#pragma unroll
          for (int j = 0; j < 8; ++j) vv[t][j] = xr[64 * j]; }
#pragma unroll
      for (int t = 0; t < 2; ++t) {
        const int m = m0 + t * NGW; if (m >= MR) break;
        v4u v[8]; float mx = 0.f;
#pragma unroll
        for (int j = 0; j < 8; ++j) v[j] = vv[t][j];
#pragma unroll
        for (int j = 0; j < 8; ++j) {
            mx = fmaxf(mx, fmaxf(fmaxf(fabsf(pg8::bflo(v[j].x)), fabsf(pg8::bfhi(v[j].x))), fmaxf(fabsf(pg8::bflo(v[j].y)), fabsf(pg8::bfhi(v[j].y)))));
            mx = fmaxf(mx, fmaxf(fmaxf(fabsf(pg8::bflo(v[j].z)), fabsf(pg8::bfhi(v[j].z))), fmaxf(fabsf(pg8::bflo(v[j].w)), fabsf(pg8::bfhi(v[j].w))))); }
#pragma unroll
        for (int o = 1; o < 64; o <<= 1) mx = fmaxf(mx, __shfl_xor(mx, o));
        mx = fmaxf(mx, 1e-30f);
        const float sc = 127.0f / mx;
        GAS u32x2g* o8 = (GAS u32x2g*)(X1Q + (size_t)m * DM) + lane;
#pragma unroll
        for (int j = 0; j < 8; ++j) { u32x2g o;
            o.x = pg8::pk4_i8(pg8::bflo(v[j].x) * sc, pg8::bfhi(v[j].x) * sc, pg8::bflo(v[j].y) * sc, pg8::bfhi(v[j].y) * sc);
            o.y = pg8::pk4_i8(pg8::bflo(v[j].z) * sc, pg8::bfhi(v[j].z) * sc, pg8::bflo(v[j].w) * sc, pg8::bfhi(v[j].w) * sc);
            o8[64 * j] = o; }
        if (lane == 0) RQ[m] = mx * (1.0f / 127.0f) / sqrtf(ss[m] * (1.0f / DM) + EPS);
      }
    }
}

__device__ __forceinline__ void p3_sample_final(const Frame& F, const Args& a, int row, const unsigned* cnt, unsigned want) {
    int lane = F.lane; asm volatile("" : "+v"(lane));
    { unsigned sp = 0; while (__hip_atomic_load(cnt, RLX_AGENT) < want) { __builtin_amdgcn_s_sleep(4); if (++sp > (1u << 22)) break; } }
    __builtin_amdgcn_fence(__ATOMIC_ACQUIRE, "agent");
    const float* xs = a.in[I_XS] + (size_t)row * DM; const float* part = (const float*)(a.ws + WS_PARK) + (size_t)row * DM;
    bf16* X1B = (bf16*)(a.ws + WS_KEXT) + ((size_t)MP + row) * DM;
    float s = 0.f;
#pragma unroll 4
    for (int j = 0; j < 16; ++j) { const int c = 4 * (lane + 64 * j);
        f32x4 t = *(const GAS f32x4*)(xs + c);
#pragma unroll
        for (int q = 0; q < 8; ++q) t += *(const GAS f32x4*)(part + (size_t)q * MS * DM + c);
        s += (t.x * t.x + t.y * t.y) + (t.z * t.z + t.w * t.w);
        typedef unsigned u32x2g __attribute__((ext_vector_type(2)));
        *(GAS u32x2g*)(X1B + c) = (u32x2g){pk2(t.x, t.y), pk2(t.z, t.w)}; }
    s = wave_sum(s);
    if (lane == 0) ((float*)(a.ws + WS_CTL))[CW_SS2 + MP + row] = s;
}

constexpr int SMP_SLICES = 8;
__device__ __forceinline__ void p5_sample_final(const Frame& F, const Args& a, int row, const unsigned* cnt, unsigned want) {
    int lane = F.lane; asm volatile("" : "+v"(lane));
    { unsigned sp = 0; while (__hip_atomic_load(cnt, RLX_AGENT) < want) { __builtin_amdgcn_s_sleep(4); if (++sp > (1u << 22)) break; } }
    __builtin_amdgcn_fence(__ATOMIC_ACQUIRE, "agent");
    const bf16* X1B = (const bf16*)(a.ws + WS_KEXT) + ((size_t)MP + row) * DM; const float* part = (const float*)(a.ws + WS_PARK) + (size_t)row * DM;
    f32x4 v[16]; float s = 0.f;
#pragma unroll
    for (int j = 0; j < 16; ++j) { const int c = 4 * (lane + 64 * j);
        typedef unsigned u32x2g __attribute__((ext_vector_type(2)));
        const u32x2g xw = *(const GAS u32x2g*)(X1B + c);
        f32x4 t = (f32x4){__uint_as_float(xw.x << 16), __uint_as_float(xw.x & 0xffff0000u), __uint_as_float(xw.y << 16), __uint_as_float(xw.y & 0xffff0000u)};
#pragma unroll
        for (int q = 0; q < SMP_SLICES; ++q) t += *(const GAS f32x4*)(part + (size_t)q * MS * DM + c);
        v[j] = t; s += (t.x * t.x + t.y * t.y) + (t.z * t.z + t.w * t.w); }
    const float r = 1.0f / sqrtf(wave_sum(s) * (1.0f / DM) + EPS);
    float* y = a.out + O_YS + (size_t)row * DM;
#pragma unroll
    for (int j = 0; j < 16; ++j) { const int c = 4 * (lane + 64 * j); const f32x4 g = *(const GAS f32x4*)(a.in[I_FNW] + c);
        *(GAS f32x4*)(y + c) = (f32x4){v[j].x * r * g.x, v[j].y * r * g.y, v[j].z * r * g.z, v[j].w * r * g.w}; }
}

__device__ __forceinline__ void p6_final_norm(const Frame& F, const Args& a) {
    const int gw = F.vcu * NWAVES + F.wave, NGW = F.G * NWAVES, lane = F.lane;
    const float* ss = (const float*)(a.ws + WS_CTL) + CW_SS3;
    const bf16* X2B = (const bf16*)(a.ws + WS_XN);
    for (int m = gw; m < MR; m += NGW) {
        const float r = 1.0f / sqrtf(__hip_atomic_load(ss + m, __ATOMIC_RELAXED, __HIP_MEMORY_SCOPE_AGENT) * (1.0f / DM) + EPS);
        const GAS v4u* xr = (const GAS v4u*)(X2B + (size_t)m * DM) + lane;
        GAS f32x4* y = (GAS f32x4*)(a.out + (m < MP ? O_YP + (size_t)m * DM : O_YS + (size_t)(m - MP) * DM)) + 2 * lane;
        const GAS f32x4* wv = (const GAS f32x4*)a.in[I_FNW] + 2 * lane;
#pragma unroll
        for (int j = 0; j < 8; ++j) { const v4u x = xr[64 * j]; const f32x4 g0 = wv[128 * j], g1 = wv[128 * j + 1];
            f32x4 o0, o1;
            o0.x = __uint_as_float(x.x << 16) * r * g0.x; o0.y = __uint_as_float(x.x & 0xffff0000u) * r * g0.y; o0.z = __uint_as_float(x.y << 16) * r * g0.z; o0.w = __uint_as_float(x.y & 0xffff0000u) * r * g0.w;
            o1.x = __uint_as_float(x.z << 16) * r * g1.x; o1.y = __uint_as_float(x.z & 0xffff0000u) * r * g1.y; o1.z = __uint_as_float(x.w << 16) * r * g1.z; o1.w = __uint_as_float(x.w & 0xffff0000u) * r * g1.w;
            y[128 * j] = o0; y[128 * j + 1] = o1; }
    }
}

__device__ __forceinline__ void p5_norm_own(const Frame& F, const Args& a, int pm, int col0, int ncols, int row0g, int nrows, unsigned* cnt, unsigned want) {
    int tid = F.tid; asm volatile("" : "+v"(tid));
    if (F.tid == 0) { unsigned sp = 0; while (__hip_atomic_load(cnt, RLX_AGENT) < want) { __builtin_amdgcn_s_sleep(4); if (++sp > (1u << 22)) break; } }
    asm volatile("s_waitcnt vmcnt(0)" ::: "memory");
    __syncthreads();
    LAS float* rs = (LAS float*)(F.lds + RING_OFF);
    const float* ss = (const float*)(a.ws + WS_CTL) + CW_SS3;
    if (tid < nrows) rs[tid] = 1.0f / sqrtf(__uint_as_float(__hip_atomic_load((const unsigned*)(ss + row0g + tid), RLX_AGENT)) * (1.0f / DM) + EPS);
    __syncthreads();
    const bf16* X2B = (const bf16*)(a.ws + WS_XN);
    const int pcs = ncols >> 3;
    if (ncols == 1024 && (nrows & 31) == 0) {
        const int cp = tid & 127, rb = tid >> 7, c = col0 + 8 * cp;
        const f32x4 g0 = *(const GAS f32x4*)(a.in[I_FNW] + c), g1 = *(const GAS f32x4*)(a.in[I_FNW] + c + 4);
        for (int j0 = 0; j0 < nrows / 4; j0 += 8) {
            v4u x[8];
#pragma unroll
            for (int q = 0; q < 8; ++q) x[q] = *(const GAS v4u*)(X2B + (size_t)(row0g + rb + 4 * (j0 + q)) * DM + c);
#pragma unroll
            for (int q = 0; q < 8; ++q) { const int r = rb + 4 * (j0 + q), row = row0g + r; const float rr = rs[r];
                f32x4 o0, o1;
                o0.x = __uint_as_float(x[q].x << 16) * rr * g0.x; o0.y = __uint_as_float(x[q].x & 0xffff0000u) * rr * g0.y; o0.z = __uint_as_float(x[q].y << 16) * rr * g0.z; o0.w = __uint_as_float(x[q].y & 0xffff0000u) * rr * g0.w;
                o1.x = __uint_as_float(x[q].z << 16) * rr * g1.x; o1.y = __uint_as_float(x[q].z & 0xffff0000u) * rr * g1.y; o1.z = __uint_as_float(x[q].w << 16) * rr * g1.z; o1.w = __uint_as_float(x[q].w & 0xffff0000u) * rr * g1.w;
                float* y = a.out + (row < MP ? O_YP + (size_t)row * DM : O_YS + (size_t)(row - MP) * DM) + c;
                *(GAS f32x4*)y = o0; *(GAS f32x4*)(y + 4) = o1; }
        }
    } else
    for (int i = tid; i < nrows * pcs; i += NWAVES * 64) {
        const int r = i / pcs, c = col0 + 8 * (i - r * pcs); const int row = row0g + r;
        const v4u x = *(const GAS v4u*)(X2B + (size_t)row * DM + c);
        const f32x4 g0 = *(const GAS f32x4*)(a.in[I_FNW] + c), g1 = *(const GAS f32x4*)(a.in[I_FNW] + c + 4); const float rr = rs[r];
        f32x4 o0, o1;
        o0.x = __uint_as_float(x.x << 16) * rr * g0.x; o0.y = __uint_as_float(x.x & 0xffff0000u) * rr * g0.y; o0.z = __uint_as_float(x.y << 16) * rr * g0.z; o0.w = __uint_as_float(x.y & 0xffff0000u) * rr * g0.w;
        o1.x = __uint_as_float(x.z << 16) * rr * g1.x; o1.y = __uint_as_float(x.z & 0xffff0000u) * rr * g1.y; o1.z = __uint_as_float(x.w << 16) * rr * g1.z; o1.w = __uint_as_float(x.w & 0xffff0000u) * rr * g1.w;
        float* y = a.out + (row < MP ? O_YP + (size_t)row * DM : O_YS + (size_t)(row - MP) * DM) + c;
        *(GAS f32x4*)y = o0; *(GAS f32x4*)(y + 4) = o1;
    }
    __syncthreads();
}

#ifndef P4_INT8
#define P4_INT8 1
#endif
#ifndef GEMM_ALIGN
#define GEMM_ALIGN true
#endif
#ifndef GEMM_SP2
#define GEMM_SP2 true
#endif
#ifndef GEMM_DIM16
#define GEMM_DIM16 false
#endif
#ifndef GEMM_DIM
#define GEMM_DIM false
#endif
#ifndef TEST_STAGE
#define TEST_STAGE 99
#endif
__global__ void __launch_bounds__(NWAVES * 64, 2) fwd(Args args) {
    extern __shared__ __attribute__((aligned(16))) unsigned char lds[];
    Frame F;
    F.lds = (LAS unsigned char*)lds;
    F.MISC = (volatile LAS unsigned*)(F.lds + MISC_OFF);
    F.tid = threadIdx.x; F.lane = F.tid & 63; F.wave = __builtin_amdgcn_readfirstlane(F.tid >> 6);
    F.G = gridDim.x; { const int bx = blockIdx.x; F.vcu = (F.G % 8 == 0) ? (bx % 8) * (F.G / 8) + bx / 8 : bx; }
    unsigned char* ws = args.ws;
    F.ctl = (gu32*)(ws + WS_CTL);
    for (int u = F.tid; u < (LDS_BYTES - LDSCTL_OFF) / 4; u += NWAVES * 64) ((LAS unsigned*)(F.lds + LDSCTL_OFF))[u] = 0u;
    __syncthreads();
    XcdBarrier bar = xcd_barrier_post((unsigned*)(F.ctl + CW_BAR), F.MISC + 8);
#define GRID_BAR() xcd_barrier(bar)
    bf16* WinT = (bf16*)(ws + WS_WIN); bf16* WoT = (bf16*)(ws + WS_WO); bf16* WguT = (bf16*)(ws + WS_WGU); bf16* WdT = (bf16*)(ws + WS_WD);
    bf16* XN = (bf16*)(ws + WS_XN); bf16* Qb = (bf16*)(ws + WS_Q); bf16* Kb = (bf16*)(ws + WS_KB); bf16* Vb = (bf16*)(ws + WS_VB); bf16* Zb = (bf16*)(ws + WS_Z);
    bf16* XBC = (bf16*)(ws + WS_XBC); float* DT = (float*)(ws + WS_DT); bf16* Kext = (bf16*)(ws + WS_KEXT); bf16* Vext = (bf16*)(ws + WS_VEXT);
    bf16* MIX = (bf16*)(ws + WS_MIX); bf16* X1B = (bf16*)(ws + WS_X1B); bf16* HB = (bf16*)(ws + WS_H); bf16* X2B = (bf16*)(ws + WS_XN);
    float* SS2 = (float*)(ws + WS_CTL) + CW_SS2; float* SS3 = (float*)(ws + WS_CTL) + CW_SS3;

#if defined(PROBE_SPIN_A) && !defined(PROBE_TIMING)
#define PROBE_TIMING 1
#endif
#ifdef PROBE_TIMING
#define STAMP(k) do { if (blockIdx.x == 0 && F.tid == 0) { const unsigned long long t_ = __builtin_amdgcn_s_memrealtime(); F.MISC[16 + 2 * (k)] = (unsigned)t_; F.MISC[17 + 2 * (k)] = (unsigned)(t_ >> 32); } } while (0)
#else
#define STAMP(k) do { } while (0)
#endif
    unsigned long long sp_t0 = 0; (void)sp_t0;
#ifdef PROBE_SPREAD
#define SPREAD_T0(k) do { if ((k) == PROBE_SPREAD) sp_t0 = __builtin_amdgcn_s_memrealtime(); } while (0)
#define SPREAD_T1(k) do { if ((k) == PROBE_SPREAD && F.tid == 0) { const unsigned d_ = (unsigned)(__builtin_amdgcn_s_memrealtime() - sp_t0); __hip_atomic_fetch_add(F.ctl + CW_TMO + 4, d_, RLX_AGENT); __hip_atomic_fetch_add(F.ctl + CW_TMO + 32 + (blockIdx.x & 7), d_, RLX_AGENT); } } while (0)
#define SPREAD_T2(k) do { if ((k) == PROBE_SPREAD && blockIdx.x == 0 && F.tid == 0) { F.MISC[16 + 2 * 21] = __hip_atomic_load(F.ctl + CW_TMO + 4, RLX_AGENT) / (unsigned)F.G; F.MISC[17 + 2 * 21] = 0u; \
        F.MISC[16 + 2 * 22] = (unsigned)(__builtin_amdgcn_s_memrealtime() - sp_t0); F.MISC[17 + 2 * 22] = 0u; \
        unsigned mx_ = 0u, mn_ = 0xffffffffu; for (int x_ = 0; x_ < 8; ++x_) { const unsigned v_ = __hip_atomic_load(F.ctl + CW_TMO + 32 + x_, RLX_AGENT) / (unsigned)(F.G / 8); mx_ = v_ > mx_ ? v_ : mx_; mn_ = v_ < mn_ ? v_ : mn_; } \
        F.MISC[16 + 2 * 23] = mn_; F.MISC[17 + 2 * 23] = 0u; F.MISC[16 + 2 * 24] = mx_; F.MISC[17 + 2 * 24] = 0u; } } while (0)
#else
#define SPREAD_T0(k) do { } while (0)
#define SPREAD_T1(k) do { } while (0)
#define SPREAD_T2(k) do { } while (0)
#endif
    STAMP(0);
    p0_prologue(F, args);
#ifdef PROBE_P0_REPS
    for (int rep = 1; rep < PROBE_P0_REPS; ++rep) { GRID_BAR(); p0_prologue(F, args); }
#endif
#if TEST_STAGE < 99
    {
        const size_t gt = (size_t)F.vcu * NWAVES * 64 + F.tid, NT = (size_t)F.G * NWAVES * 64;
        GAS f32x4* o = (GAS f32x4*)args.out;
        for (size_t i = gt; i < O_END / 4; i += NT) {
            const size_t e = i * 4;
            bool keep = false;
#if TEST_STAGE >= 1
            keep = (e >= O_KP && e < O_SP) || (e >= O_KS && e < O_SS);
#endif
#if TEST_STAGE >= 2
            keep = keep || (e >= O_SP && e < O_KS) || (e >= O_SS);
#endif
            if (!keep) o[i] = (f32x4){0.f, 0.f, 0.f, 0.f};
        }
    }
#endif
    GRID_BAR();
    STAMP(1); SPREAD_T0(1);

#ifndef PROBE_P1_REPS
#define PROBE_P1_REPS 1
#endif
#ifndef PROBE_P4_REPS
#define PROBE_P4_REPS 1
#endif
    for (int rep = 0; rep < PROBE_P1_REPS; ++rep) {
        if (rep > 0) GRID_BAR();
        pg8::Gemm g{XN, WinT, MP, 12288, DM}; pg8::StaticOrder S; S.init(MP, 12288, F.G, (int)blockIdx.x);
        pg8::EpiInProj E{Qb, Kb, Vb, Zb, XBC, Kext, Vext, DT, args.out};
#ifdef PROBE_P1_LIGHT
        if (rep > 0) { pg8::EpiProbe EP{(bf16*)(ws + WS_DUMMY), 12288}; pg8::gemm_phase<pg8::EpiProbe, pg8::StaticOrder, GEMM_ALIGN, GEMM_SP2, 0, GEMM_DIM16>(F.lds + RING_OFF, g, S, EP); } else
#endif
        pg8::gemm_phase<pg8::EpiInProj, pg8::StaticOrder, GEMM_ALIGN, GEMM_SP2, 0, GEMM_DIM16>(F.lds + RING_OFF, g, S, E);
    }
    STAMP(11); SPREAD_T1(1);
#ifndef PROBE_SK1_REPS
#define PROBE_SK1_REPS 1
#endif
#ifndef PROBE_SK4_REPS
#define PROBE_SK4_REPS 1
#endif
    for (int rep = 0; rep < PROBE_SK1_REPS; ++rep) {
        const sk::EpiInS E1{WinT, Qb, Zb, XBC, Kext, Vext, DT, args.out};
        sk::skinny<8, 1, true>(F.lds + RING_OFF, XN + (size_t)MP * DM, DM, DM, NIN / 16, E1, F.wave, F.lane, (int)blockIdx.x, F.G);
        STAMP(13);
        const sk::EpiDtP E2{XN, DT};
        sk::skinny<2, 1, true>(F.lds + RING_OFF, WinT + (size_t)12288 * DM, DM, DM, MP / 16, E2, F.wave, F.lane, (int)((blockIdx.x + F.G / 2) % F.G), F.G);
    }
#if TEST_STAGE >= 2
    GRID_BAR();
    STAMP(2); SPREAD_T2(1);

    {
        float lam;
        { const float a = F.lane < 64 ? args.in[I_LQ1][F.lane] * args.in[I_LK1][F.lane] : 0.f, b = args.in[I_LQ2][F.lane] * args.in[I_LK2][F.lane];
          lam = __expf(wave_sum(a)) - __expf(wave_sum(b)) + LAM0; }
        const ssd::Params SP{args.in[I_CONVW], args.in[I_CONVB], args.in[I_DTB], args.in[I_ALOG], args.in[I_DSKIP], args.in[I_SSDNW]};
        constexpr int NSEG = 4, SEGLEN = SEQ / NSEG, NBG = NB * SG;
        constexpr int JS = 736  ;
        constexpr int E0 = (NSEG - 1) * NBG, E1 = E0 + NBG, E2 = E1 + 192, E3 = E2 + (NSEG - 1) * NBG, E4 = E3 + (JS - 192), E5 = E4 + DEC_B * NH, E6 = E5 + (1024 - JS), E7 = E6 + DEC_B * SG, NITEMS = E7;
        float* FSEG = (float*)(ws + WS_F);
#ifndef PROBE_MIX_REPS
#define PROBE_MIX_REPS 1
#define PROBE_MIX_SKIP 0
#endif
        for (int rep = 0; rep < PROBE_MIX_REPS; ++rep) {
        if (rep > 0) GRID_BAR();
        for (;;) {
            if (F.tid == 0) F.MISC[0] = __hip_atomic_fetch_add(F.ctl + CW_QUEUE + 64 * rep, 1u, RLX_AGENT);
            __syncthreads();
            const int pos = (int)F.MISC[0];
            __syncthreads();
            constexpr int NPOS = 256 + 3 * CONV_ITEMS;
            if (pos >= NPOS) break;
            int item = pos;
            if (pos >= 256) { const int q = pos - 256, grp = q / 3, r = q - 3 * grp;
                if (r == 2) { if (rep == 0) p0_deferred_item(F, args, grp); __syncthreads(); continue; }
                item = 256 + 2 * grp + r; }
            if (item >= NITEMS) continue;
            const bool is_ssd = item < E1 || (item >= E2 && item < E3) || item >= E6;
            if (rep > 0 && ((PROBE_MIX_SKIP == 1 && is_ssd) || (PROBE_MIX_SKIP == 2 && !is_ssd))) continue;
            if (is_ssd) {
                ssd::Unit u; bool pre = false;
                if (item < E6) {
                    int seg, bg;
                    if (item < E0) { pre = true; seg = item / NBG; bg = item % NBG; }
                    else if (item < E1) { seg = 0; bg = item - E0; }
                    else { const int k = item - E2; seg = 1 + k / NBG; bg = k % NBG; }
                    const int b = bg >> 3; u.g = bg & 7; const size_t r0 = (size_t)b * SEQ + (size_t)seg * SEGLEN;
                    u.xbc = XBC + r0 * CONVD; u.z = Zb + r0 * SSDI; u.dtraw = DT + r0 * SH; u.hist = nullptr; u.init = nullptr;
                    u.fin = args.out + O_SP + (size_t)b * SH * SHD * DS; u.y = MIX + r0 * DM + AW; u.len = SEGLEN;
                    u.prev = seg > 0; u.seg = seg; u.fseg = FSEG + (size_t)bg * (NSEG - 1) * ssd::FSTRIDE; u.flag = (unsigned*)(F.ctl + CW_SSDF + 64 * bg) + 16 * rep; u.last = seg == NSEG - 1;
                } else { const int j = item - E6; const int b = j >> 3; u.g = j & 7; const size_t r0 = (size_t)MP + (size_t)b * DEC_T;
                    u.xbc = XBC + r0 * CONVD; u.z = Zb + r0 * SSDI; u.dtraw = DT + r0 * SH; u.hist = args.in[I_SCONV] + (size_t)b * 3 * CONVD; u.init = args.in[I_SSSM] + (size_t)b * SH * SHD * DS;
                    u.fin = args.out + O_SS + (size_t)b * SH * SHD * DS; u.y = MIX + r0 * DM + AW; u.len = DEC_T;
                    u.prev = 0; u.seg = 0; u.fseg = nullptr; u.flag = nullptr; u.last = 1; }
                if (pre) ssd::ssd_unit<true>(F.lds + RING_OFF, u, SP, F.tid, F.wave, F.lane);
                else ssd::ssd_unit<false>(F.lds + RING_OFF, u, SP, F.tid, F.wave, F.lane);
            } else {
                att::Unit u;
                if (item < E4 || item >= E5) { const int j = item < E2 ? item - E1 : item < E4 ? item - E3 + 192 : item - E5 + JS; const int qb = 31 - (j >> 5), bh = j & 31, b = bh >> 4, h = bh & 15; const size_t r0 = (size_t)b * SEQ;
                    u.Q = Qb + (r0 + 256 * qb) * AW + h * HD; u.K = Kb + r0 * AW + h * HD; u.V = Vb + r0 * AW + h * HD; u.O = MIX + (r0 + 256 * qb) * DM + h * HD;
                    u.ntot = 4 * qb + 4; u.nvalid_last = 64; u.sample = 0; u.qb = qb; u.park = nullptr; u.variant = 0;
#ifdef PROBE_ATT_VARIANT
                    if (rep > 0) { u.variant = PROBE_ATT_VARIANT; u.O = (bf16*)(ws + WS_DUMMY) + (r0 + 256 * qb) * DM + h * HD; }
#endif
                    }
                else { const int j = item - E4; const int b = j >> 4, h = j & 15; const size_t r0 = (size_t)MP + (size_t)b * DEC_T;
                    u.Q = Qb + r0 * AW + h * HD; u.K = Kext + (size_t)b * KVROWS * AW + h * HD; u.V = Vext + (size_t)b * KVROWS * AW + h * HD; u.O = MIX + r0 * DM + h * HD;
                    u.ntot = KVROWS / 64; u.nvalid_last = PAST + DEC_T - (KVROWS / 64 - 1) * 64; u.sample = 1; u.qb = 0; u.park = nullptr; u.variant = 0;
                    p2_cache_slice(F, args, b, h);
#ifdef PROBE_ATT_VARIANT
                    if (rep > 0) { u.variant = PROBE_ATT_VARIANT; u.O = (bf16*)(ws + WS_DUMMY) + r0 * DM + h * HD; }
#endif
                    }
                att::attn_unit(F.lds + RING_OFF, u, lam, args.in[I_SUBLN], F.wave, F.lane);
            }
            __syncthreads();
        }
        }
    }
#endif
#if TEST_STAGE >= 3
#ifdef PROBE_TIMING
    if (F.tid == 0) __hip_atomic_fetch_max(F.ctl + CW_TMO + 2, ~(unsigned)__builtin_amdgcn_s_memrealtime(), RLX_AGENT);
#endif
    GRID_BAR();
    STAMP(3); SPREAD_T0(3);
#ifdef PROBE_TIMING
    if (blockIdx.x == 0 && F.tid == 0) { F.MISC[16 + 2 * 20] = ~__hip_atomic_load(F.ctl + CW_TMO + 2, RLX_AGENT); F.MISC[17 + 2 * 20] = F.MISC[17 + 2 * 3]; }
#endif
    {
        if (F.G == 256) {
            const int sl = (int)blockIdx.x & 7;
            const sk::EpiOutPart E1{WoT, (float*)(ws + WS_PARK) + (size_t)sl * MS * DM, 512 * sl};
            sk::skinny<8, 1>(F.lds + RING_OFF, MIX + (size_t)MP * DM + 512 * sl, DM, 512, DM / 16, E1, F.wave, F.lane, (int)blockIdx.x >> 3, 32);
            asm volatile("s_waitcnt vmcnt(0)" ::: "memory"); __syncthreads();
            if (F.tid == 0) { __builtin_amdgcn_fence(__ATOMIC_RELEASE, "agent"); __hip_atomic_fetch_add(F.ctl + CW_SMPC + 64, 1u, RLX_AGENT); }
        }
        pg8::Gemm g{MIX, WoT, MP, DM, DM}; pg8::StaticOrder S; S.init(MP, DM, F.G, (int)blockIdx.x);
        pg8::EpiOutProj E{args.in[I_XP], args.in[I_XS], args.out, X1B, SS2};
        pg8::gemm_phase<pg8::EpiOutProj, pg8::StaticOrder, GEMM_ALIGN, GEMM_SP2, 0, GEMM_DIM16>(F.lds + RING_OFF, g, S, E);
        STAMP(12); SPREAD_T1(3);
#ifdef PROBE_P3_REPS
        for (int rep = 1; rep < PROBE_P3_REPS; ++rep) { GRID_BAR(); pg8::EpiProbe EP{HB, DM}; pg8::gemm_phase<pg8::EpiProbe, pg8::StaticOrder, GEMM_ALIGN, GEMM_SP2, 0, GEMM_DIM16>(F.lds + RING_OFF, g, S, EP); }
#endif
        if (F.G == 256) { if (blockIdx.x < 16) p3_sample_final(F, args, 8 * (int)blockIdx.x + F.wave, (const unsigned*)(F.ctl + CW_SMPC + 64), 256u); }
        else {
            const sk::EpiOutS E1{WoT, args.in[I_XS], args.out, X1B, SS2};
            sk::skinny<8, 1>(F.lds + RING_OFF, MIX + (size_t)MP * DM, DM, DM, DM / 16, E1, F.wave, F.lane, (int)blockIdx.x, F.G);
        }
    }
    GRID_BAR();
#ifdef PROBE_EXTRA_BARS
    for (int i = 0; i < PROBE_EXTRA_BARS; ++i) GRID_BAR();
#endif
    STAMP(4); SPREAD_T2(3);
#if P4_INT8
    p3b_quant_rows(F, args);
    GRID_BAR();
    STAMP(7); SPREAD_T0(4);
#endif
    for (int rep = 0; rep < PROBE_P4_REPS; ++rep) {
        if (rep > 0) GRID_BAR();
#if P4_INT8
        pg8::Gemm g{(const bf16*)(ws + WS_X1Q), (const bf16*)(ws + WS_WGUQ), MPAD, 2 * DFF, DM / 2}; pg8::StaticOrder S; S.init(MPAD, 2 * DFF, F.G, (int)blockIdx.x);
        pg8::EpiGateUpT<true> E{HB, (const float*)(F.ctl + CW_RQ), 1.0f / wq_scale(ws, 0), 1.0f / wq_scale(ws, 1), (bf16*)(ws + WS_HS)};
        pg8::gemm_phase<pg8::EpiGateUpT<true>, pg8::StaticOrder, GEMM_ALIGN, GEMM_SP2, 2, GEMM_DIM>(F.lds + RING_OFF, g, S, E);
#else
        pg8::Gemm g{X1B, WguT, MP, 2 * DFF, DM}; pg8::StaticOrder S; S.init(MP, 2 * DFF, F.G, (int)blockIdx.x);
        pg8::EpiGateUp E{HB, SS2};
        pg8::gemm_phase<pg8::EpiGateUp, pg8::StaticOrder, GEMM_ALIGN, GEMM_SP2, 0, GEMM_DIM16>(F.lds + RING_OFF, g, S, E);
#endif
    }
    SPREAD_T1(4);
#if !P4_INT8
    for (int rep = 0; rep < PROBE_SK4_REPS; ++rep) {
        const sk::EpiGuS E1{WguT, (bf16*)(ws + WS_HS), SS2};
        if (F.G == 256) { if (blockIdx.x >= 128) sk::skinny<8, 2>(F.lds + RING_OFF, X1B + (size_t)MP * DM, DM, DM, DFF / 16, E1, F.wave, F.lane, (int)blockIdx.x - 128, 128); }
        else sk::skinny<8, 2>(F.lds + RING_OFF, X1B + (size_t)MP * DM, DM, DM, DFF / 16, E1, F.wave, F.lane, (int)blockIdx.x, F.G);
    }
#endif
    GRID_BAR();
    STAMP(5); SPREAD_T2(4); SPREAD_T0(5);
    if (F.G == 256) {
        {
            const int sl = (int)blockIdx.x & 7, c0 = sl * 5 + (sl < 3 ? sl : 3), ncs = sl < 3 ? 6 : 5;
            const sk::EpiDownPart E1{WdT, (float*)(ws + WS_PARK) + (size_t)sl * MS * DM, 256 * c0};
            sk::skinny<8, 1>(F.lds + RING_OFF, (const bf16*)(ws + WS_HS) + 256 * c0, DFF, 256 * ncs, DM / 16, E1, F.wave, F.lane, (int)blockIdx.x >> 3, 32);
            asm volatile("s_waitcnt vmcnt(0)" ::: "memory"); __syncthreads();
            if (F.tid == 0) { __builtin_amdgcn_fence(__ATOMIC_RELEASE, "agent"); __hip_atomic_fetch_add(F.ctl + CW_SMPC, 1u, RLX_AGENT); }
        }
        STAMP(10);
        pg8::Gemm g{HB, (const bf16*)(ws + WS_WD8), MP, DM, DFF / 2}; pg8::PanelOrder S; S.init((int)blockIdx.x, (unsigned*)(F.ctl + CW_P5C));
        pg8::EpiDown E{X1B, X2B, SS3};
        pg8::gemm_phase<pg8::EpiDown, pg8::PanelOrder, GEMM_ALIGN, GEMM_SP2, 1, GEMM_DIM>(F.lds + RING_OFF, g, S, E);
        STAMP(8); SPREAD_T1(5);
        p5_norm_own(F, args, S.pm, 1024 * S.q4, 1024, 256 * S.pm, 256, (unsigned*)(F.ctl + CW_P5C) + 64 * S.pm, 128u);
        STAMP(9);
        if (blockIdx.x < 16) p5_sample_final(F, args, 8 * (int)blockIdx.x + F.wave, (const unsigned*)(F.ctl + CW_SMPC), 256u);
    } else {
        {
            pg8::Gemm g{HB, (const bf16*)(ws + WS_WD8), MP, DM, DFF / 2}; pg8::StaticOrder S; S.init(MP, DM, F.G, (int)blockIdx.x);
            pg8::EpiDown E{X1B, X2B, SS3};
            pg8::gemm_phase<pg8::EpiDown, pg8::StaticOrder, GEMM_ALIGN, GEMM_SP2, 1, GEMM_DIM>(F.lds + RING_OFF, g, S, E);
            const sk::EpiDownS E1{WdT, X1B, X2B, SS3};
            sk::skinny<8, 1>(F.lds + RING_OFF, (const bf16*)(ws + WS_HS), DFF, DFF, DM / 16, E1, F.wave, F.lane, (int)blockIdx.x, F.G);
        }
        GRID_BAR();
        p6_final_norm(F, args);
    }
#endif
#ifdef PROBE_SPIN_A
    STAMP(6);
    if (blockIdx.x == 0 && F.tid == 0) {
        const unsigned long long ta = (unsigned long long)F.MISC[16 + 2 * (PROBE_SPIN_A)] | ((unsigned long long)F.MISC[17 + 2 * (PROBE_SPIN_A)] << 32);
        const unsigned long long tb = (unsigned long long)F.MISC[16 + 2 * (PROBE_SPIN_B)] | ((unsigned long long)F.MISC[17 + 2 * (PROBE_SPIN_B)] << 32);
        const unsigned long long d = 4ull * (tb - ta), t0 = __builtin_amdgcn_s_memrealtime();
        while (__builtin_amdgcn_s_memrealtime() - t0 < d) __builtin_amdgcn_s_sleep(32);
    }
#endif
}

extern "C" void kernel_launch(void* const* d_in, const int* in_sizes, int n_in, void* d_out, int out_size, void* d_ws, size_t ws_size, hipStream_t stream) {
    static int grid = 0;
    if (grid == 0) {
        if (n_in != 25 || (size_t)out_size != O_END || ws_size < WS_END) { fprintf(stderr, "kernel_launch: unexpected shapes: n_in %d out %d ws %zu; nothing launched\n", n_in, out_size, ws_size); grid = -1; return; }
        int dev = 0, cus = 0, per_cu = 0;
        if (hipGetDevice(&dev) != hipSuccess || hipDeviceGetAttribute(&cus, hipDeviceAttributeMultiprocessorCount, dev) != hipSuccess) { grid = -1; return; }
        if (hipFuncSetAttribute((const void*)fwd, hipFuncAttributeMaxDynamicSharedMemorySize, LDS_BYTES) != hipSuccess) { fprintf(stderr, "kernel_launch: hipFuncSetAttribute failed\n"); grid = -1; return; }
        if (hipOccupancyMaxActiveBlocksPerMultiprocessor(&per_cu, (const void*)fwd, NWAVES * 64, LDS_BYTES) != hipSuccess || per_cu < 1)
            fprintf(stderr, "kernel_launch: note: occupancy query reports %d workgroups per CU\n", per_cu);
        (void)hipGetLastError();
        grid = cus;
    }
    if (grid < 0) return;
    if (hipMemsetAsync((char*)d_ws + WS_CTL, 0, CTL_ZERO_BYTES, stream) != hipSuccess) return;
    Args a{};
    for (int i = 0; i < 25; ++i) a.in[i] = (const float*)d_in[i];
    a.out = (float*)d_out; a.ws = (unsigned char*)d_ws; a.ph_lo = 0; a.ph_hi = 99;
    hipLaunchKernelGGL(fwd, dim3(grid), dim3(NWAVES * 64), LDS_BYTES, stream, a);
}
```

```cpp
#include <hip/hip_runtime.h>
#include <cstdio>
#include <cstdint>
namespace pg8 {
#define PG8_LAS __attribute__((address_space(3)))
typedef unsigned short bf16_t;
typedef short bf16x8 __attribute__((ext_vector_type(8)));
typedef float f32x4 __attribute__((ext_vector_type(4)));
typedef unsigned u32x4 __attribute__((ext_vector_type(4)));
constexpr int BM = 256, BK = 64, HALF = 128, HTB = HALF * BK * 2  , STAGE_BYTES = 8 * HTB, NXCD = 8, WGM = 8;

__host__ __device__ __forceinline__ int lds_byte(int r, int c) { const int st = (r >> 4) * 2 + (c >> 5), rr = r & 15, cc = c & 31, ob = rr * 64 + cc * 2; return st * 1024 + (ob ^ (((ob >> 9) & 1) << 5)); }
__host__ __device__ __forceinline__ void stage_rc(int b, int& R, int& C) { const int st = b / 1024, sb = b % 1024, swz = sb ^ (((sb >> 9) & 1) << 5); R = (st >> 1) * 16 + swz / 64; C = (st & 1) * 32 + (swz % 64) / 2; }
__host__ __device__ __forceinline__ int perm32(int rho) { const int n = rho >> 4, i = rho & 15; return 8 * (i >> 2) + 4 * n + (i & 3); }

struct Unit { int pm, pn; };
struct Gemm { const bf16_t* A; const bf16_t* Bt; int M, N, K; };

struct StaticOrder {
    int nM, nN, nwg, G, c, wgm;
    __host__ __device__ void init(int M, int N, int G_, int c_) { nM = M / BM; nN = N / BM; nwg = nM * nN; G = G_; c = c_; wgm = WGM; }
    __host__ __device__ bool next(int i, Unit& u) const {
        const long L = (long)i * G + c; if (L >= nwg) return false;
        int wgid = (int)L; { const int q = nwg / NXCD, r = nwg % NXCD, xcd = wgid % NXCD, off = wgid / NXCD; wgid = (xcd < r ? xcd * (q + 1) : r * (q + 1) + (xcd - r) * q) + off; }
        const int nig = wgm * nN, gid = wgid / nig, fm = gid * wgm, gsz = (nM - fm) < wgm ? (nM - fm) : wgm;
        u.pm = fm + ((wgid % nig) % gsz); u.pn = (wgid % nig) / gsz; return true;
    }
    __device__ __forceinline__ void a_ready(const Unit&) const {}
    __device__ __forceinline__ void done(const Unit&) const {}
};

__device__ __forceinline__ unsigned cvt_pk_bf16(float lo, float hi) { unsigned r; asm volatile("v_cvt_pk_bf16_f32 %0, %1, %2" : "=v"(r) : "v"(lo), "v"(hi)); return r; }
typedef float f32x2 __attribute__((ext_vector_type(2)));
template <class Epi, class Sched, bool ALIGN_EPI = false, bool SP2 = false, int QM = 0  , bool DIM = false>
__device__ __forceinline__ void gemm_phase(PG8_LAS unsigned char* lds, const Gemm g, const Sched& S, const Epi& E) {
    constexpr bool FP8 = (QM == 1), INT8 = (QM == 2);
    int tid_ = threadIdx.x; asm volatile("" : "+v"(tid_));
    const int tid = tid_, wid = __builtin_amdgcn_readfirstlane(tid >> 6), lane = tid & 63, wr = wid >> 2, wc = wid & 3, fr = lane & 15, fq = lane >> 4;
    const int K = g.K, nt = K / BK;
    unsigned voffA[2], voffB[2];
#pragma unroll
    for (int i = 0; i < 2; ++i) { int R, C; stage_rc(tid * 16 + i * 8192, R, C); const int Rb = Epi::PERM ? ((R & ~31) + perm32(R & 31)) : R;
        voffA[i] = (unsigned)(R * K + C) * 2u; voffB[i] = (unsigned)(Rb * K + C) * 2u; }
    const size_t kstep = (size_t)(BK * 2);
    const size_t hstep = (size_t)HALF * K * 2;
    const size_t tstep = 2 * hstep;
    const unsigned ldsw = (unsigned)wid * 1024u;
    const int aoff = lds_byte(wr * 64 + fr, FP8 ? fq * 16 : fq * 8), boff = lds_byte(wc * 32 + fr, FP8 ? fq * 16 : fq * 8);
    const int aoff1 = FP8 ? aoff + 16 : aoff + 1024, boff1 = FP8 ? boff + 16 : boff + 1024;
    typedef int v8i_t __attribute__((ext_vector_type(8))); typedef int v4i_t __attribute__((ext_vector_type(4)));
#define PG8_SA(b, h) (((b) * 2 + (h)) * HTB)
#define PG8_SB(b, h) ((4 + (b) * 2 + (h)) * HTB)
#define PG8_STAGE(bufoff, gbase, voff) do { _Pragma("unroll") for (int _i = 0; _i < 2; ++_i) \
        __builtin_amdgcn_global_load_lds((const unsigned*)((const char*)(gbase) + (voff)[_i]), (PG8_LAS unsigned*)(lds + (bufoff) + ldsw + _i * 8192), 16, 0, 0); } while (0)
#define PG8_CAT8(x, y) __builtin_shufflevector(__builtin_bit_cast(v4i_t, x), __builtin_bit_cast(v4i_t, y), 0, 1, 2, 3, 4, 5, 6, 7)
#define PG8_LDA(dst, b, h) do { if constexpr (FP8) { _Pragma("unroll") for (int m = 0; m < 4; ++m) dst##8[m] = PG8_CAT8(*(const PG8_LAS bf16x8*)(lds + PG8_SA(b, h) + aoff + m * 2048), *(const PG8_LAS bf16x8*)(lds + PG8_SA(b, h) + aoff1 + m * 2048)); } \
        else { _Pragma("unroll") for (int m = 0; m < 4; ++m) _Pragma("unroll") for (int k = 0; k < 2; ++k) dst[m][k] = *(const PG8_LAS bf16x8*)(lds + PG8_SA(b, h) + (k ? aoff1 : aoff) + m * 2048); } } while (0)
#define PG8_LDB(dst, b, h) do { if constexpr (FP8) { _Pragma("unroll") for (int n = 0; n < 2; ++n) dst##8[n] = PG8_CAT8(*(const PG8_LAS bf16x8*)(lds + PG8_SB(b, h) + boff + n * 2048), *(const PG8_LAS bf16x8*)(lds + PG8_SB(b, h) + boff1 + n * 2048)); } \
        else { _Pragma("unroll") for (int n = 0; n < 2; ++n) _Pragma("unroll") for (int k = 0; k < 2; ++k) dst[n][k] = *(const PG8_LAS bf16x8*)(lds + PG8_SB(b, h) + (k ? boff1 : boff) + n * 2048); } } while (0)
#define PG8_MMA(ai, bj, At, Bt) do { __builtin_amdgcn_s_setprio(1); \
        if constexpr (FP8) { _Pragma("unroll") for (int m = 0; m < 4; ++m) _Pragma("unroll") for (int n = 0; n < 2; ++n) \
            asm volatile("v_mfma_scale_f32_16x16x128_f8f6f4 %0, %1, %2, %0, %3, %3 op_sel_hi:[0,0,0]" : "+v"(acc[ai][bj][m][n]) : "v"(Bt##8[n]), "v"(At##8[m]), "v"(sc8_)); } \
        else if constexpr (INT8) { _Pragma("unroll") for (int m = 0; m < 4; ++m) _Pragma("unroll") for (int n = 0; n < 2; ++n) _Pragma("unroll") for (int k = 0; k < 2; ++k) \
            acc[ai][bj][m][n] = __builtin_bit_cast(f32x4, __builtin_amdgcn_mfma_i32_16x16x64_i8(__builtin_bit_cast(v4i_t, Bt[n][k]), __builtin_bit_cast(v4i_t, At[m][k]), __builtin_bit_cast(v4i_t, acc[ai][bj][m][n]), 0, 0, 0)); } \
        else { _Pragma("unroll") for (int m = 0; m < 4; ++m) _Pragma("unroll") for (int n = 0; n < 2; ++n) _Pragma("unroll") for (int k = 0; k < 2; ++k) \
            acc[ai][bj][m][n] = __builtin_amdgcn_mfma_f32_16x16x32_bf16(Bt[n][k], At[m][k], acc[ai][bj][m][n], 0, 0, 0); } \
        __builtin_amdgcn_s_setprio(0); } while (0)
#define PG8_MMAH(ai, bj, At, Bt, m0) do { \
        if constexpr (FP8) { _Pragma("unroll") for (int m = m0; m < m0 + 2; ++m) _Pragma("unroll") for (int n = 0; n < 2; ++n) \
            asm volatile("v_mfma_scale_f32_16x16x128_f8f6f4 %0, %1, %2, %0, %3, %3 op_sel_hi:[0,0,0]" : "+v"(acc[ai][bj][m][n]) : "v"(Bt##8[n]), "v"(At##8[m]), "v"(sc8_)); } \
        else if constexpr (INT8) { _Pragma("unroll") for (int m = m0; m < m0 + 2; ++m) _Pragma("unroll") for (int n = 0; n < 2; ++n) _Pragma("unroll") for (int k = 0; k < 2; ++k) \
            acc[ai][bj][m][n] = __builtin_bit_cast(f32x4, __builtin_amdgcn_mfma_i32_16x16x64_i8(__builtin_bit_cast(v4i_t, Bt[n][k]), __builtin_bit_cast(v4i_t, At[m][k]), __builtin_bit_cast(v4i_t, acc[ai][bj][m][n]), 0, 0, 0)); } \
        else { _Pragma("unroll") for (int m = m0; m < m0 + 2; ++m) _Pragma("unroll") for (int n = 0; n < 2; ++n) _Pragma("unroll") for (int k = 0; k < 2; ++k) \
            acc[ai][bj][m][n] = __builtin_amdgcn_mfma_f32_16x16x32_bf16(Bt[n][k], At[m][k], acc[ai][bj][m][n], 0, 0, 0); } } while (0)
#define PG8_WAIT_V(n) asm volatile("s_waitcnt vmcnt(" #n ")" ::: "memory")
#define PG8_WAIT_L(n) asm volatile("s_waitcnt lgkmcnt(" #n ")" ::: "memory")
#define PG8_BAR __builtin_amdgcn_s_barrier()
#define PG8_SCHED __builtin_amdgcn_sched_barrier(0)
    Unit cur, nxt; int ui = 0;
    if (!S.next(0, cur)) return;
    f32x4 acc[2][2][4][2];
#pragma unroll
    for (int a = 0; a < 2; ++a)
#pragma unroll
        for (int b = 0; b < 2; ++b)
#pragma unroll
            for (int m = 0; m < 4; ++m)
#pragma unroll
                for (int n = 0; n < 2; ++n) acc[a][b][m][n] = (f32x4){0.f, 0.f, 0.f, 0.f};
    bf16x8 At[4][2], B0[2][2], B1[2][2]; v8i_t At8[4], B08[2], B18[2]; const int sc8_ = 0x7f7f7f7f;
    const char* cA = (const char*)g.A + (size_t)cur.pm * tstep; const char* cB = (const char*)g.Bt + (size_t)cur.pn * tstep;
    S.a_ready(cur);
    if constexpr (SP2) {
        PG8_STAGE(PG8_SB(0, 0), cB, voffB); PG8_STAGE(PG8_SB(0, 1), cB + hstep, voffB); PG8_STAGE(PG8_SA(0, 0), cA, voffA); PG8_STAGE(PG8_SA(0, 1), cA + hstep, voffA);
        if (wr == 1) PG8_BAR;
        PG8_WAIT_V(2); PG8_BAR;
        PG8_STAGE(PG8_SB(1, 0), cB + kstep, voffB); PG8_STAGE(PG8_SA(1, 0), cA + kstep, voffA); PG8_STAGE(PG8_SB(1, 1), cB + hstep + kstep, voffB);
        PG8_WAIT_V(6); PG8_BAR;
    } else {
        PG8_STAGE(PG8_SB(0, 0), cB, voffB); PG8_STAGE(PG8_SA(0, 0), cA, voffA); PG8_STAGE(PG8_SB(0, 1), cB + hstep, voffB); PG8_STAGE(PG8_SA(0, 1), cA + hstep, voffA);
        if (wr == 1) PG8_BAR;
        PG8_WAIT_V(4); PG8_BAR;
        PG8_STAGE(PG8_SB(1, 0), cB + kstep, voffB); PG8_STAGE(PG8_SA(1, 0), cA + kstep, voffA); PG8_STAGE(PG8_SB(1, 1), cB + hstep + kstep, voffB);
        PG8_WAIT_V(6); PG8_BAR;
    }
    for (;;) {
        const bool has_next = S.next(ui + 1, nxt);
        const char* nA = has_next ? (const char*)g.A + (size_t)nxt.pm * tstep : cA; const char* nB = has_next ? (const char*)g.Bt + (size_t)nxt.pn * tstep : cB;
        for (int t = 0; t < nt; t += 2) {
            const bool last = (t == nt - 2);
            const char* a1 = cA + (size_t)(t + 1) * kstep;
            const char* a2 = last ? nA : cA + (size_t)(t + 2) * kstep; const char* b2 = last ? nB : cB + (size_t)(t + 2) * kstep;
            const char* a3 = a2 + kstep; const char* b3 = b2 + kstep;
            if (last && has_next) S.a_ready(nxt);
            if constexpr (SP2 && DIM) {
            PG8_LDB(B0, 0, 0); PG8_LDB(B1, 0, 1); PG8_SCHED; PG8_LDA(At, 0, 0);
            PG8_WAIT_V(6); PG8_WAIT_L(0); PG8_BAR; __builtin_amdgcn_s_setprio(1); PG8_MMAH(0, 0, At, B0, 0); PG8_MMAH(0, 0, At, B0, 2); PG8_SCHED; PG8_STAGE(PG8_SA(1, 1), a1 + hstep, voffA); PG8_SCHED; PG8_MMAH(0, 1, At, B1, 0); PG8_MMAH(0, 1, At, B1, 2); __builtin_amdgcn_s_setprio(0); PG8_BAR; PG8_SCHED;
            PG8_LDA(At, 0, 1);
            PG8_WAIT_V(2); PG8_WAIT_L(0); PG8_BAR; __builtin_amdgcn_s_setprio(1); PG8_MMAH(1, 0, At, B0, 0); PG8_SCHED; PG8_STAGE(PG8_SB(0, 0), b2, voffB); PG8_SCHED; PG8_MMAH(1, 0, At, B0, 2); PG8_SCHED; PG8_STAGE(PG8_SB(0, 1), b2 + hstep, voffB); PG8_SCHED;
            PG8_MMAH(1, 1, At, B1, 0); PG8_SCHED; PG8_STAGE(PG8_SA(0, 0), a2, voffA); PG8_SCHED; PG8_MMAH(1, 1, At, B1, 2); __builtin_amdgcn_s_setprio(0); PG8_BAR; PG8_SCHED;
            PG8_LDB(B0, 1, 0); PG8_LDB(B1, 1, 1); PG8_SCHED; PG8_LDA(At, 1, 0);
            PG8_WAIT_V(6); PG8_WAIT_L(0); PG8_BAR; __builtin_amdgcn_s_setprio(1); PG8_MMAH(0, 0, At, B0, 0); PG8_MMAH(0, 0, At, B0, 2); PG8_SCHED; PG8_STAGE(PG8_SA(0, 1), a2 + hstep, voffA); PG8_SCHED; PG8_MMAH(0, 1, At, B1, 0); PG8_MMAH(0, 1, At, B1, 2); __builtin_amdgcn_s_setprio(0); PG8_BAR; PG8_SCHED;
            PG8_LDA(At, 1, 1);
            PG8_WAIT_V(2); PG8_WAIT_L(0); PG8_BAR; __builtin_amdgcn_s_setprio(1); PG8_MMAH(1, 0, At, B0, 0); PG8_SCHED; PG8_STAGE(PG8_SB(1, 0), b3, voffB); PG8_SCHED; PG8_MMAH(1, 0, At, B0, 2); PG8_SCHED; PG8_STAGE(PG8_SB(1, 1), b3 + hstep, voffB); PG8_SCHED;
            PG8_MMAH(1, 1, At, B1, 0); PG8_SCHED; PG8_STAGE(PG8_SA(1, 0), a3, voffA); PG8_SCHED; PG8_MMAH(1, 1, At, B1, 2); __builtin_amdgcn_s_setprio(0); PG8_BAR; PG8_SCHED;
            } else if constexpr (SP2) {
            PG8_LDB(B0, 0, 0); PG8_LDB(B1, 0, 1); PG8_SCHED; PG8_LDA(At, 0, 0); PG8_STAGE(PG8_SA(1, 1), a1 + hstep, voffA);
            PG8_WAIT_V(8); PG8_WAIT_L(0); PG8_BAR; PG8_MMA(0, 0, At, B0); PG8_MMA(0, 1, At, B1); PG8_BAR; PG8_SCHED;
            PG8_LDA(At, 0, 1); PG8_STAGE(PG8_SB(0, 0), b2, voffB); PG8_STAGE(PG8_SB(0, 1), b2 + hstep, voffB); PG8_STAGE(PG8_SA(0, 0), a2, voffA);
            PG8_WAIT_V(8); PG8_WAIT_L(0); PG8_BAR; PG8_MMA(1, 0, At, B0); PG8_MMA(1, 1, At, B1); PG8_BAR; PG8_SCHED;
            PG8_LDB(B0, 1, 0); PG8_LDB(B1, 1, 1); PG8_SCHED; PG8_LDA(At, 1, 0); PG8_STAGE(PG8_SA(0, 1), a2 + hstep, voffA);
            PG8_WAIT_V(8); PG8_WAIT_L(0); PG8_BAR; PG8_MMA(0, 0, At, B0); PG8_MMA(0, 1, At, B1); PG8_BAR; PG8_SCHED;
            PG8_LDA(At, 1, 1); PG8_STAGE(PG8_SB(1, 0), b3, voffB); PG8_STAGE(PG8_SB(1, 1), b3 + hstep, voffB); PG8_STAGE(PG8_SA(1, 0), a3, voffA);
            PG8_WAIT_V(8); PG8_WAIT_L(0); PG8_BAR; PG8_MMA(1, 0, At, B0); PG8_MMA(1, 1, At, B1); PG8_BAR; PG8_SCHED;
            } else {
            PG8_LDB(B0, 0, 0); PG8_SCHED; PG8_LDA(At, 0, 0); PG8_STAGE(PG8_SA(1, 1), a1 + hstep, voffA);
            PG8_WAIT_L(8); PG8_BAR; PG8_WAIT_L(0); PG8_MMA(0, 0, At, B0); PG8_BAR; PG8_SCHED;
            PG8_LDB(B1, 0, 1); PG8_STAGE(PG8_SB(0, 0), b2, voffB);
            PG8_BAR; PG8_WAIT_L(0); PG8_MMA(0, 1, At, B1); PG8_BAR;
            PG8_LDA(At, 0, 1); PG8_STAGE(PG8_SA(0, 0), a2, voffA);
            PG8_BAR; PG8_WAIT_L(0); PG8_MMA(1, 0, At, B0); PG8_BAR; PG8_SCHED;
            PG8_STAGE(PG8_SB(0, 1), b2 + hstep, voffB);
            PG8_WAIT_V(6); PG8_BAR; PG8_MMA(1, 1, At, B1); PG8_BAR;
            PG8_LDB(B0, 1, 0); PG8_SCHED; PG8_LDA(At, 1, 0); PG8_STAGE(PG8_SA(0, 1), a2 + hstep, voffA);
            PG8_WAIT_L(8); PG8_BAR; PG8_WAIT_L(0); PG8_MMA(0, 0, At, B0); PG8_BAR; PG8_SCHED;
            PG8_LDB(B1, 1, 1); PG8_STAGE(PG8_SB(1, 0), b3, voffB);
            PG8_BAR; PG8_WAIT_L(0); PG8_MMA(0, 1, At, B1); PG8_BAR;
            PG8_LDA(At, 1, 1); PG8_STAGE(PG8_SA(1, 0), a3, voffA);
            PG8_BAR; PG8_WAIT_L(0); PG8_MMA(1, 0, At, B0); PG8_BAR; PG8_SCHED;
            PG8_STAGE(PG8_SB(1, 1), b3 + hstep, voffB);
            PG8_WAIT_V(6); PG8_BAR; PG8_MMA(1, 1, At, B1); PG8_BAR;
            }
        }
        if constexpr (ALIGN_EPI) { if (wr == 0) PG8_BAR; }
        if constexpr (FP8) asm volatile("s_nop 15\n\ts_nop 7" ::: "memory");
        if constexpr (!Epi::AFTER_DRAIN) { E(acc, cur, wr, wc, fr, fq); S.done(cur); }
        if (!has_next) break;
#pragma unroll
        for (int a = 0; a < 2; ++a)
#pragma unroll
            for (int b = 0; b < 2; ++b)
#pragma unroll
                for (int m = 0; m < 4; ++m)
#pragma unroll
                    for (int n = 0; n < 2; ++n) acc[a][b][m][n] = (f32x4){0.f, 0.f, 0.f, 0.f};
        cur = nxt; cA = nA; cB = nB; ++ui;
        if constexpr (ALIGN_EPI) { if (wr == 1) PG8_BAR; }
    }
    PG8_WAIT_V(0);
    if constexpr (!ALIGN_EPI) { if (wr == 0) PG8_BAR; }
    PG8_BAR;
    if constexpr (Epi::AFTER_DRAIN) { E.fused(acc, cur, wr, wc, fr, fq, lds, wid, lane); S.done(cur); }
#undef PG8_SA
#undef PG8_SB
#undef PG8_STAGE
#undef PG8_LDA
#undef PG8_LDB
#undef PG8_MMA
#undef PG8_MMAH
#undef PG8_CAT8
#undef PG8_WAIT_V
#undef PG8_WAIT_L
#undef PG8_BAR
#undef PG8_SCHED
}
}

#ifndef TEST_ALPHA
#define TEST_ALPHA 1.0f
#endif
constexpr int DM = 4096, SEQ = 8192, NB = 2, MP = NB * SEQ  , MS = 128  , MR = MP + MS  , MPAD = 16640  ;
constexpr int DEC_B = 8, DEC_T = 16, PAST = 2048, KVROWS = 2112  ;
constexpr int AW = 2048, NH = 16, HD = 128, QKD = 64, SSDI = 2048, SH = 32, SHD = 64, SG = 8, DS = 128, CONVD = 4096, DFF = 11008;
constexpr int NIN = 12320, NINP = 12544  ;
constexpr float EPS = 1e-6f;
constexpr float LAM0 = 0.2f;
constexpr float QSCALE = 0.125f * 1.4426950408889634f;
constexpr size_t O_YP = 0, O_YS = O_YP + (size_t)MP * DM, O_KP = O_YS + (size_t)MS * DM, O_VP = O_KP + (size_t)MP * AW, O_CP = O_VP + (size_t)MP * AW,
                 O_SP = O_CP + (size_t)NB * 3 * CONVD, O_KS = O_SP + (size_t)NB * SH * SHD * DS, O_VS = O_KS + (size_t)MS * AW, O_CS = O_VS + (size_t)MS * AW,
                 O_SS = O_CS + (size_t)DEC_B * 3 * CONVD, O_END = O_SS + (size_t)DEC_B * SH * SHD * DS;
static_assert(O_END == 138010624ull, "output size");

namespace pg8 {
typedef unsigned u32x2 __attribute__((ext_vector_type(2)));
__device__ __forceinline__ u32x4 pack8(const f32x4 a, const f32x4 b) { u32x4 w; w.x = cvt_pk_bf16(a[0], a[1]); w.y = cvt_pk_bf16(a[2], a[3]); w.z = cvt_pk_bf16(b[0], b[1]); w.w = cvt_pk_bf16(b[2], b[3]); return w; }

__device__ __forceinline__ unsigned pk4_fp8(float a, float b, float c, float d) { int p = 0; p = __builtin_amdgcn_cvt_pk_fp8_f32(a, b, p, false); p = __builtin_amdgcn_cvt_pk_fp8_f32(c, d, p, true); return (unsigned)p; }
__device__ __forceinline__ unsigned pk4_i8(float a, float b, float c, float d) {
    const int ia = (int)__builtin_rintf(__builtin_fminf(__builtin_fmaxf(a, -127.f), 127.f)), ib = (int)__builtin_rintf(__builtin_fminf(__builtin_fmaxf(b, -127.f), 127.f));
    const int ic = (int)__builtin_rintf(__builtin_fminf(__builtin_fmaxf(c, -127.f), 127.f)), id = (int)__builtin_rintf(__builtin_fminf(__builtin_fmaxf(d, -127.f), 127.f));
    return (unsigned)(ia & 255) | ((unsigned)(ib & 255) << 8) | ((unsigned)(ic & 255) << 16) | ((unsigned)id << 24);
}
constexpr float W8I_CLIP = 32.0f;
constexpr float H8_SCALE = 4.0f, WD8_SCALE = 128.0f;

struct EpiInProj {
    static constexpr bool PERM = true, AFTER_DRAIN = false;
    bf16_t *Q, *Kb, *Vb, *Z, *XBC, *Kext, *Vext; float* DT; float* out;
    template <int MODE  >
    __device__ __forceinline__ void tile(const f32x4 (&acc)[2][2][4][2], bf16_t* B, int ldb, float* O32, int ld32, int row0, int c0) const {
#pragma unroll
        for (int ai = 0; ai < 2; ++ai)
#pragma unroll
            for (int m = 0; m < 4; ++m) {
                const int row = row0 + ai * HALF + m * 16;
#pragma unroll
                for (int bj = 0; bj < 2; ++bj) {
                    const int c = c0 + bj * HALF;
                    const f32x4 v0 = acc[ai][bj][m][0], v1 = acc[ai][bj][m][1];
                    if (MODE == 1) *(u32x4*)(B + (size_t)row * ldb + c) = pack8(v0 * QSCALE, v1 * QSCALE);
                    else *(u32x4*)(B + (size_t)row * ldb + c) = pack8(v0, v1);
                    if (MODE == 2) { float* o = O32 + (size_t)row * ld32 + c; *(f32x4*)o = v0 * TEST_ALPHA; *(f32x4*)(o + 4) = v1 * TEST_ALPHA; }
                }
            }
    }
    __device__ __forceinline__ void operator()(const f32x4 (&acc)[2][2][4][2], const Unit& u, int wr, int wc, int fr, int fq) const {
        const int pn = u.pn, row0 = u.pm * BM + wr * 64 + fr, cl = wc * 32 + 8 * fq;
        if (pn < 8) tile<1>(acc, Q, AW, nullptr, 0, row0, pn * BM + cl);
        else if (pn < 16) tile<2>(acc, Kb, AW, out + O_KP, AW, row0, (pn - 8) * BM + cl);
        else if (pn < 24) tile<2>(acc, Vb, AW, out + O_VP, AW, row0, (pn - 16) * BM + cl);
        else if (pn < 32) tile<0>(acc, Z, SSDI, nullptr, 0, row0, (pn - 24) * BM + cl);
        else {
            tile<0>(acc, XBC, CONVD, nullptr, 0, row0, (pn - 32) * BM + cl);
            if ((u.pm & 31) == 31 && wr == 1) {
#pragma unroll
                for (int bj = 0; bj < 2; ++bj) { const int c = (pn - 32) * BM + cl + bj * HALF; const int row = row0 + HALF + 48, t = (row & (SEQ - 1)) - (SEQ - 3);
                    if (t >= 0) { float* o = out + O_CP + (size_t)((row >> 13) * 3 + t) * CONVD + c; *(f32x4*)o = acc[1][bj][3][0] * TEST_ALPHA; *(f32x4*)(o + 4) = acc[1][bj][3][1] * TEST_ALPHA; } }
            }
        }
    }
};

struct EpiOutProj {
    static constexpr bool PERM = true, AFTER_DRAIN = false;
    const float* xp; const float* xs; float* out; bf16_t* X1B; float* ss;
    __device__ __forceinline__ void operator()(const f32x4 (&acc)[2][2][4][2], const Unit& u, int wr, int wc, int fr, int fq) const {
        const int row0 = u.pm * BM + wr * 64 + fr, col0 = u.pn * BM + wc * 32 + 8 * fq;
#pragma unroll
        for (int ai = 0; ai < 2; ++ai) {
#pragma unroll
            for (int m = 0; m < 4; ++m) {
                const int row = row0 + ai * HALF + m * 16;
                const float* xr = xp + (size_t)row * DM;
                float sq = 0.f;
#pragma unroll
                for (int bj = 0; bj < 2; ++bj) {
                    const int c = col0 + bj * HALF;
                    const f32x4 v0 = acc[ai][bj][m][0] + __builtin_nontemporal_load((const f32x4*)(xr + c)), v1 = acc[ai][bj][m][1] + __builtin_nontemporal_load((const f32x4*)(xr + c + 4));
                    *(u32x4*)(X1B + (size_t)row * DM + c) = pack8(v0, v1);
                    sq += (v0[0] * v0[0] + v0[1] * v0[1]) + (v0[2] * v0[2] + v0[3] * v0[3]) + (v1[0] * v1[0] + v1[1] * v1[1]) + (v1[2] * v1[2] + v1[3] * v1[3]);
                }
                sq += __shfl_xor(sq, 16); sq += __shfl_xor(sq, 32);
                if (fq == 0) atomicAdd(ss + row, sq);
            }
        }
    }
};

struct EpiProbe {
    static constexpr bool PERM = true, AFTER_DRAIN = false;
    bf16_t* O; int ldc;
    __device__ __forceinline__ void operator()(const f32x4 (&acc)[2][2][4][2], const Unit& u, int wr, int wc, int fr, int fq) const {
        const int row0 = u.pm * BM + wr * 64 + fr, col0 = u.pn * BM + wc * 32 + 8 * fq;
#pragma unroll
        for (int ai = 0; ai < 2; ++ai)
#pragma unroll
            for (int m = 0; m < 4; ++m)
#pragma unroll
                for (int bj = 0; bj < 2; ++bj) *(u32x4*)(O + (size_t)(row0 + ai * HALF + m * 16) * ldc + col0 + bj * HALF) = pack8(acc[ai][bj][m][0], acc[ai][bj][m][1]);
    }
};

template <bool Q8>
struct EpiGateUpT {
    static constexpr bool PERM = true, AFTER_DRAIN = false;
    bf16_t* H; const float* ss; float wqg, wqu; bf16_t* HS;
    __device__ __forceinline__ void operator()(const f32x4 (&acc)[2][2][4][2], const Unit& u, int wr, int wc, int fr, int fq) const {
        if constexpr (Q8) asm volatile("" : "+v"(fr), "+v"(fq));
        const int row0 = u.pm * BM + wr * 64 + fr, col0 = u.pn * HALF + wc * 32 + 8 * fq;
#pragma unroll
        for (int ai = 0; ai < 2; ++ai) {
            if (u.pm == 64 && ai == 1) continue;
#pragma unroll
            for (int m = 0; m < 4; ++m) {
                const int row = row0 + ai * HALF + m * 16;
                const float r = Q8 ? ss[row] * wqg : 1.0f / sqrtf(ss[row] * (1.0f / DM) + EPS);
                const float r2 = Q8 ? ss[row] * wqu : r;
                f32x4 h[2];
#pragma unroll
                for (int n = 0; n < 2; ++n)
#pragma unroll
                    for (int e = 0; e < 4; ++e) { const float g = (Q8 ? (float)__float_as_int(acc[ai][0][m][n][e]) : acc[ai][0][m][n][e]) * r, up = (Q8 ? (float)__float_as_int(acc[ai][1][m][n][e]) : acc[ai][1][m][n][e]) * r2;
                        h[n][e] = g * up * __builtin_amdgcn_rcpf(1.0f + __builtin_amdgcn_exp2f(-1.4426950408889634f * g)); }
                if (Q8 && u.pm == 64) { *(u32x4*)(HS + (size_t)(row - MP) * DFF + col0) = pack8(h[0], h[1]); continue; }
                u32x2 w8; w8.x = pk4_fp8(h[0][0] * H8_SCALE, h[0][1] * H8_SCALE, h[0][2] * H8_SCALE, h[0][3] * H8_SCALE); w8.y = pk4_fp8(h[1][0] * H8_SCALE, h[1][1] * H8_SCALE, h[1][2] * H8_SCALE, h[1][3] * H8_SCALE);
                *(u32x2*)((unsigned char*)H + (size_t)row * DFF + col0) = w8;
            }
        }
    }
};
using EpiGateUp = EpiGateUpT<false>;

__device__ __forceinline__ float bflo(unsigned w) { return __uint_as_float(w << 16); }
__device__ __forceinline__ float bfhi(unsigned w) { return __uint_as_float(w & 0xffff0000u); }
struct EpiDown {
    static constexpr bool PERM = true, AFTER_DRAIN = false;
    const bf16_t* X1B; bf16_t* X2B; float* ss;
    static constexpr float ASC = 1.0f / (H8_SCALE * WD8_SCALE);
    __device__ __forceinline__ void operator()(const f32x4 (&acc)[2][2][4][2], const Unit& u, int wr, int wc, int fr, int fq) const {
        asm volatile("" : "+v"(fr), "+v"(fq));
        const int row0 = u.pm * BM + wr * 64 + fr, col0 = u.pn * BM + wc * 32 + 8 * fq;
#pragma unroll
        for (int ai = 0; ai < 2; ++ai) {
#pragma unroll
            for (int m = 0; m < 4; ++m) {
                const int row = row0 + ai * HALF + m * 16;
                float sq = 0.f;
#pragma unroll
                for (int bj = 0; bj < 2; ++bj) {
                    const int c = col0 + bj * HALF;
                    const u32x4 xw = __builtin_nontemporal_load((const u32x4*)(X1B + (size_t)row * DM + c));
                    const f32x4 v0 = acc[ai][bj][m][0] * ASC + (f32x4){bflo(xw.x), bfhi(xw.x), bflo(xw.y), bfhi(xw.y)}, v1 = acc[ai][bj][m][1] * ASC + (f32x4){bflo(xw.z), bfhi(xw.z), bflo(xw.w), bfhi(xw.w)};
                    *(u32x4*)(X2B + (size_t)row * DM + c) = pack8(v0, v1);
                    sq += (v0[0] * v0[0] + v0[1] * v0[1]) + (v0[2] * v0[2] + v0[3] * v0[3]) + (v1[0] * v1[0] + v1[1] * v1[1]) + (v1[2] * v1[2] + v1[3] * v1[3]);
                }
                sq += __shfl_xor(sq, 16); sq += __shfl_xor(sq, 32);
                if (fq == 0) atomicAdd(ss + row, sq);
            }
        }
    }
};
struct PanelOrder {
    int pm, q4, nu; unsigned* cnt;
    __device__ void init(int c, unsigned* cnt_) { const int x = c & 7, j = c >> 3; pm = x * 8 + (j >> 2); q4 = j & 3; cnt = cnt_; nu = 4; asm volatile("" : "+s"(nu)); }
    __device__ __forceinline__ bool next(int i, Unit& u) const { if (i >= nu) return false; int p = pm; asm volatile("" : "+s"(p)); u.pm = p; u.pn = 4 * q4 + i; return true; }
    __device__ __forceinline__ void a_ready(const Unit&) const {}
    __device__ __forceinline__ void done(const Unit& u) const {
        asm volatile("s_waitcnt vmcnt(0)" ::: "memory");
        if ((threadIdx.x & 63) == 0) __hip_atomic_fetch_add(cnt + 64 * u.pm, 1u, __ATOMIC_RELAXED, __HIP_MEMORY_SCOPE_AGENT);
    }
};
struct TailOrder {
    StaticOrder so; int nstat; unsigned* cnt; volatile PG8_LAS unsigned* mail;
    __device__ void init(int M, int N, int G_, int c_, unsigned* cnt_, volatile PG8_LAS unsigned* mail_) { so.init(M, N, G_, c_); nstat = so.nwg / G_; cnt = cnt_; mail = mail_; }
    __device__ __forceinline__ bool next(int i, Unit& u) const {
        if (i < nstat) return so.next(i, u);
        if (i > nstat) return false;
        if (threadIdx.x == 0) *mail = __hip_atomic_fetch_add(cnt, 1u, __ATOMIC_RELAXED, __HIP_MEMORY_SCOPE_AGENT);
        asm volatile("s_waitcnt lgkmcnt(0)" ::: "memory"); __builtin_amdgcn_s_barrier();
        const unsigned t = *mail;
        const int ntail = so.nwg - nstat * so.G;
        if (t >= (unsigned)ntail) return false;
        StaticOrder s2 = so; s2.c = (int)t;
        return s2.next(nstat, u);
    }
    __device__ __forceinline__ void a_ready(const Unit&) const {}
    __device__ __forceinline__ void done(const Unit&) const {}
};
}
#define GAS __attribute__((address_space(1)))
#define LAS __attribute__((address_space(3)))
typedef unsigned short bf16;
typedef unsigned v4u __attribute__((ext_vector_type(4)));
typedef float f32x4 __attribute__((ext_vector_type(4)));
typedef short bf16x8 __attribute__((ext_vector_type(8)));
typedef GAS unsigned gu32;
typedef GAS unsigned long long gu64;
#define RLX_AGENT __ATOMIC_RELAXED, __HIP_MEMORY_SCOPE_AGENT
#define LDS_WAIT() asm volatile("s_waitcnt lgkmcnt(0)" ::: "memory")
#define VM_WAIT() asm volatile("s_waitcnt vmcnt(0)" ::: "memory")
__device__ __forceinline__ unsigned long long rt() { return __builtin_amdgcn_s_memrealtime(); }
__device__ __forceinline__ unsigned f2bf(float f) { unsigned u = __builtin_bit_cast(unsigned, f); return (u + 0x7fffu + ((u >> 16) & 1u)) >> 16; }
__device__ __forceinline__ unsigned pk2(float lo, float hi) { return f2bf(lo) | (f2bf(hi) << 16); }

#define XB_TMO      128
#define XB_XCNT(j)  (256  + 64 * (j))
#define XB_XSUB(j)  (1280 + 64 * (j))
#define XB_XGEN(j)  (2304 + 64 * (j))
#define XB_TOP      3328
#define XB_TOPGEN   3392
#define XCD_BAR_WORDS 3456
#define XB_SPIN_CAP (1u << 18)

__device__ __forceinline__ unsigned xb_ld(unsigned* p)              { return __hip_atomic_load(p, __ATOMIC_RELAXED, __HIP_MEMORY_SCOPE_AGENT); }
__device__ __forceinline__ unsigned xb_add(unsigned* p, unsigned v) { return __hip_atomic_fetch_add(p, v, __ATOMIC_RELAXED, __HIP_MEMORY_SCOPE_AGENT); }
__device__ __forceinline__ unsigned xb_xcc_id() { return (unsigned)__builtin_amdgcn_s_getreg((3 << 11) | 20) & 0xFu; }
#define XB_SPIN(cond, bar) do { unsigned _sp = 0; while (cond) { __builtin_amdgcn_s_sleep(1); \
    if ((++_sp & 255u) == 0u) { if (xb_ld(&(bar)[XB_TMO])) break; if (_sp > XB_SPIN_CAP) { atomicAdd(&(bar)[XB_TMO], 1u); break; } } } } while (0)

struct XcdBarrier {
    unsigned* bar; unsigned x;
    volatile LAS unsigned* st;
};

__device__ __forceinline__ XcdBarrier xcd_barrier_post(unsigned* bar, volatile LAS unsigned* st) {
    XcdBarrier b; b.bar = bar; b.x = xb_xcc_id(); b.st = st;
    if (threadIdx.x == 0) (void)xb_add(&bar[XB_XCNT(b.x)], 1u);
    return b;
}
__device__ __forceinline__ void xcd_barrier_complete(unsigned* bar, unsigned x, unsigned& nloc, unsigned& nx) {
    const unsigned G = gridDim.x * gridDim.y * gridDim.z;
    unsigned sum, cnt, mine, sp = 0u;
    for (;;) {
        sum = 0u; cnt = 0u; mine = 0u;
#pragma unroll
        for (unsigned j = 0; j < 16; ++j) { const unsigned c = xb_ld(&bar[XB_XCNT(j)]); sum += c; cnt += (c > 0u) ? 1u : 0u; mine = (j == x) ? c : mine; }
        if (sum == G) break;
        __builtin_amdgcn_s_sleep(1);
        if ((++sp & 255u) == 0u) { if (xb_ld(&bar[XB_TMO])) break; if (sp > XB_SPIN_CAP) { atomicAdd(&bar[XB_TMO], 1u); break; } }
    }
    nloc = mine > 0u ? mine : 1u; nx = cnt > 0u ? cnt : 1u;
}

__device__ __forceinline__ void xcd_barrier(const XcdBarrier& b) {
    asm volatile("s_waitcnt vmcnt(0)" ::: "memory");
    __syncthreads();
    if (threadIdx.x == 0) {
        unsigned* bar = b.bar;
        __builtin_amdgcn_s_waitcnt(0);
        unsigned nloc = b.st[0], nx = b.st[1];
        if (nloc == 0u) { xcd_barrier_complete(bar, b.x, nloc, nx); b.st[0] = nloc; b.st[1] = nx; }
        const unsigned old = xb_add(&bar[XB_XSUB(b.x)], 1u);
        const unsigned gen = old / nloc;
        if (old + 1u == (gen + 1u) * nloc) {
            __builtin_amdgcn_fence(__ATOMIC_RELEASE, "agent");
            asm volatile("s_waitcnt vmcnt(0)" ::: "memory");
            const unsigned og = xb_add(&bar[XB_TOP], 1u);
            const unsigned tg = og / nx;
            if (og + 1u == (tg + 1u) * nx) xb_add(&bar[XB_TOPGEN], 1u);
            else XB_SPIN(xb_ld(&bar[XB_TOPGEN]) == tg, bar);
            __builtin_amdgcn_fence(__ATOMIC_ACQUIRE, "agent");
            xb_add(&bar[XB_XGEN(b.x)], 1u);
            asm volatile("s_waitcnt vmcnt(0)" ::: "memory");
        } else {
            XB_SPIN(xb_ld(&bar[XB_XGEN(b.x)]) == gen, bar);
            __builtin_amdgcn_fence(__ATOMIC_ACQUIRE, "agent");
            asm volatile("s_waitcnt vmcnt(0)" ::: "memory");
        }
    }
    __syncthreads();
}

constexpr int NWAVES = 8;
constexpr size_t MiB = 1u << 20;
constexpr size_t WS_CTL = 0, CTL_ZERO_BYTES = 1 * MiB;
constexpr size_t WS_WD = 1 * MiB, WS_WGU = 87 * MiB, WS_WO = 259 * MiB, WS_WIN = 291 * MiB, WS_XN = 389 * MiB, WS_Q = 519 * MiB, WS_KB = 584 * MiB, WS_VB = 649 * MiB,
                 WS_Z = 714 * MiB, WS_XBC = 779 * MiB, WS_DT = 909 * MiB, WS_KEXT = 912 * MiB, WS_VEXT = 978 * MiB, WS_WD8 = WS_WIN  , WS_HS = WS_Q + 256 * MiB  , WS_F = 1044 * MiB  , WS_PARK = 1052 * MiB  , WS_DUMMY = 1068 * MiB  , WS_WGUQ = 1068 * MiB  , WS_X1Q = 1154 * MiB  , WS_END = 1219 * MiB;
constexpr size_t WS_MIX = WS_XN;
constexpr size_t WS_X1B = WS_KEXT;
constexpr size_t WS_H = WS_Q;
static_assert(WS_WD + (size_t)DM * DFF * 2 <= WS_WGU && WS_WGU + (size_t)2 * DFF * DM * 2 <= WS_WO && WS_WO + (size_t)DM * DM * 2 <= WS_WIN && WS_WIN + (size_t)NINP * DM * 2 <= WS_XN &&
              WS_XN + (size_t)MPAD * DM * 2 <= WS_Q && WS_Q + (size_t)MPAD * AW * 2 <= WS_KB && WS_XBC + (size_t)MPAD * CONVD * 2 <= WS_DT && WS_DT + (size_t)MPAD * SH * 4 <= WS_KEXT &&
              WS_KEXT + (size_t)DEC_B * KVROWS * AW * 2 <= WS_VEXT && WS_VEXT + (size_t)DEC_B * KVROWS * AW * 2 <= WS_F && WS_H + (size_t)MPAD * DFF * 2 <= WS_DT &&
              WS_X1B + (size_t)MPAD * DM * 2 <= WS_END, "d_ws map");
constexpr int CW_TMO = 0, CW_CODE = 1, CW_WSTAT = 8  , CW_QUEUE = 64, CW_P4T = 3584  , CW_SMPC = 512  , CW_P5C = 12288  , CW_SSDF = 2048  , CW_BAR = 4096, CW_SS2 = 65536, CW_SS3 = 131072, CW_RQ = 196608  ;
constexpr int RING_OFF = 0, RING_BYTES = 139264, LDSCTL_OFF = RING_BYTES, MISC_OFF = LDSCTL_OFF + 320, LDS_BYTES = 147456;

struct Frame {
    LAS unsigned char* lds;
    volatile LAS unsigned* MISC;
    gu32* ctl;
    int tid, lane, wave, vcu, G;
};

__device__ __forceinline__ float wave_sum(float v) {
#pragma unroll
    for (int o = 1; o < 64; o <<= 1) v += __shfl_xor(v, o);
    return v;
}
template <int MODE>
__device__ __forceinline__ void p0_transpose_pair(const float* W, int K, int N, bf16* WT, const float* kscale, LAS float* scr, int item0, int nitems, int lane, unsigned char* W8 = nullptr, float s8 = 1.0f, bool as_int8 = false) {
    const int nblk = N / 32;
    f32x4 v[2][8]; float ks[2][8];
#pragma unroll
    for (int t = 0; t < 2; ++t) { const int item = item0 + t < nitems ? item0 + t : item0; const int kb = item / nblk, nb = item % nblk, k0 = 64 * kb, n0 = 32 * nb;
#pragma unroll
        for (int i = 0; i < 8; ++i) { const int kk = 8 * i + (lane >> 3); v[t][i] = __builtin_nontemporal_load((const GAS f32x4*)(W + (size_t)(k0 + kk) * N + n0 + 4 * (lane & 7)));        ks[t][i] = kscale ? kscale[k0 + kk] : 1.0f; } }
#pragma unroll
    for (int t = 0; t < 2; ++t) {
        if (item0 + t >= nitems) break;
        const int item = item0 + t; const int kb = item / nblk, nb = item % nblk, k0 = 64 * kb, n0 = 32 * nb;
        LAS float* s0 = scr + t * (64 * 33);
#pragma unroll
        for (int i = 0; i < 8; ++i) { const int kk = 8 * i + (lane >> 3); LAS float* d = s0 + kk * 33 + 4 * (lane & 7); const f32x4 x = v[t][i] * ks[t][i]; d[0] = x.x; d[1] = x.y; d[2] = x.z; d[3] = x.w; }
        LDS_WAIT(); asm volatile("" ::: "memory");
        const int c = lane & 7;
        const int rbase = MODE == 0 ? n0 : 256 * (n0 >> 7) + (n0 & 127) + (MODE == 2 ? 128 : 0);
#pragma unroll
        for (int j = 0; j < 4; ++j) { const int n = (lane >> 3) + 8 * j; const LAS float* s = s0 + (8 * c) * 33 + n;
            v4u o; o.x = pk2(s[0 * 33], s[1 * 33]); o.y = pk2(s[2 * 33], s[3 * 33]); o.z = pk2(s[4 * 33], s[5 * 33]); o.w = pk2(s[6 * 33], s[7 * 33]);
            if (WT) *(GAS v4u*)(WT + (size_t)(rbase + n) * K + k0 + 8 * c) = o;
            if (W8) {
                typedef unsigned u32x2g __attribute__((ext_vector_type(2))); u32x2g o8;
                int p0 = 0, p1 = 0;
                if (as_int8) { p0 = (int)pg8::pk4_i8(s[0 * 33] * s8, s[1 * 33] * s8, s[2 * 33] * s8, s[3 * 33] * s8); p1 = (int)pg8::pk4_i8(s[4 * 33] * s8, s[5 * 33] * s8, s[6 * 33] * s8, s[7 * 33] * s8); }
                else {
                p0 = __builtin_amdgcn_cvt_pk_fp8_f32(s[0 * 33] * s8, s[1 * 33] * s8, p0, false); p0 = __builtin_amdgcn_cvt_pk_fp8_f32(s[2 * 33] * s8, s[3 * 33] * s8, p0, true);
                p1 = __builtin_amdgcn_cvt_pk_fp8_f32(s[4 * 33] * s8, s[5 * 33] * s8, p1, false); p1 = __builtin_amdgcn_cvt_pk_fp8_f32(s[6 * 33] * s8, s[7 * 33] * s8, p1, true); }
                o8.x = (unsigned)p0; o8.y = (unsigned)p1;
                *(GAS u32x2g*)(W8 + (size_t)(rbase + n) * K + k0 + 8 * c) = o8; } }
    }
    LDS_WAIT(); asm volatile("" ::: "memory");
}
__device__ __forceinline__ void rms_row2_to_bf16(int lane, const float* xrow0, const float* xrow1, const float* w, bf16* orow0, bf16* orow1) {
    const GAS f32x4* xr0 = (const GAS f32x4*)xrow0 + lane; const GAS f32x4* xr1 = (const GAS f32x4*)xrow1 + lane; const GAS f32x4* wr = (const GAS f32x4*)w + lane;
    f32x4 v0[16], v1[16]; float s0 = 0.f, s1 = 0.f;
#pragma unroll
    for (int j = 0; j < 16; ++j) v0[j] = __builtin_nontemporal_load(xr0 + 64 * j);
#pragma unroll
    for (int j = 0; j < 16; ++j) v1[j] = __builtin_nontemporal_load(xr1 + 64 * j);
#pragma unroll
    for (int j = 0; j < 16; ++j) s0 += (v0[j].x * v0[j].x + v0[j].y * v0[j].y) + (v0[j].z * v0[j].z + v0[j].w * v0[j].w);
#pragma unroll
    for (int j = 0; j < 16; ++j) s1 += (v1[j].x * v1[j].x + v1[j].y * v1[j].y) + (v1[j].z * v1[j].z + v1[j].w * v1[j].w);
    const float r0 = 1.0f / sqrtf(wave_sum(s0) * (1.0f / DM) + EPS), r1 = 1.0f / sqrtf(wave_sum(s1) * (1.0f / DM) + EPS);
    GAS unsigned long long* o0 = (GAS unsigned long long*)orow0 + lane; GAS unsigned long long* o1 = (GAS unsigned long long*)orow1 + lane;
#pragma unroll
    for (int j = 0; j < 16; ++j) { const f32x4 g = wr[64 * j];
        o0[64 * j] = (unsigned long long)pk2(v0[j].x * r0 * g.x, v0[j].y * r0 * g.y) | ((unsigned long long)pk2(v0[j].z * r0 * g.z, v0[j].w * r0 * g.w) << 32);
        o1[64 * j] = (unsigned long long)pk2(v1[j].x * r1 * g.x, v1[j].y * r1 * g.y) | ((unsigned long long)pk2(v1[j].z * r1 * g.z, v1[j].w * r1 * g.w) << 32); }
}
__device__ __forceinline__ void rms_row_to_bf16(int lane, const float* xrow, const float* w, bf16* orow) {
    const GAS f32x4* xr = (const GAS f32x4*)xrow + lane; const GAS f32x4* wr = (const GAS f32x4*)w + lane;
    f32x4 v[16]; float s = 0.f;
#pragma unroll
    for (int j = 0; j < 16; ++j) { v[j] = xr[64 * j]; s += (v[j].x * v[j].x + v[j].y * v[j].y) + (v[j].z * v[j].z + v[j].w * v[j].w); }
    const float r = 1.0f / sqrtf(wave_sum(s) * (1.0f / DM) + EPS);
    GAS unsigned long long* o8 = (GAS unsigned long long*)orow + lane;
#pragma unroll
    for (int j = 0; j < 16; ++j) { const f32x4 g = wr[64 * j]; o8[64 * j] = (unsigned long long)pk2(v[j].x * r * g.x, v[j].y * r * g.y) | ((unsigned long long)pk2(v[j].z * r * g.z, v[j].w * r * g.w) << 32); }
}

namespace att {
typedef short bf16x8 __attribute__((ext_vector_type(8)));
typedef short s16x4 __attribute__((ext_vector_type(4)));
typedef float f32x16 __attribute__((ext_vector_type(16)));
typedef unsigned u32x4 __attribute__((ext_vector_type(4)));
typedef unsigned u32x2 __attribute__((ext_vector_type(2)));
constexpr int KSLOT = 8192, VSLOT = 16384, SLOT = KSLOT + VSLOT, NSLOT = 3, PITCH = 2048;
constexpr int PARK_OFF = NSLOT * SLOT, ATTN_LDS_BYTES = PARK_OFF + 8 * 8192;
#define ATT_LAS __attribute__((address_space(3)))
#ifdef PROBE_ATT_VARIANT
#define ATT_VAR(u) ((u).variant)
#else
#define ATT_VAR(u) 0
#endif
__device__ __forceinline__ unsigned cvtpk(float lo, float hi) { unsigned r; asm volatile("v_cvt_pk_bf16_f32 %0, %1, %2" : "=v"(r) : "v"(lo), "v"(hi)); return r; }

__device__ __forceinline__ void glds16(const void* gsrc, unsigned lds_dst) { unsigned keep;
    asm volatile("s_mov_b32 %0, m0\n\ts_mov_b32 m0, %2\n\ts_nop 0\n\tglobal_load_lds_dwordx4 %1, off\n\ts_mov_b32 m0, %0" : "=&s"(keep) : "v"(gsrc), "s"(lds_dst) : "memory"); }
__device__ __forceinline__ float max3f(float a, float b, float c) { float r; asm("v_max3_f32 %0, %1, %2, %3" : "=v"(r) : "v"(a), "v"(b), "v"(c)); return r; }
struct Unit {
    const unsigned short* Q;
    const unsigned short* K;
    const unsigned short* V;
    unsigned short* O;
    int ntot;
    int nvalid_last;
    int sample;
    int qb;
    unsigned char* park;
    int variant;
};

__device__ __forceinline__ void pass(ATT_LAS unsigned char* lds, const Unit& u, int mapoff, bool active, int nmine, int wave, int lane, f32x16 (&o)[4], float& lsum) {
    asm volatile("" : "+v"(lane));
    const int r32 = lane & 31, h = lane >> 5;
    const unsigned short* ksrc = u.K + mapoff + (size_t)lane * PITCH + wave * 8;
    const int rowgrp = wave >> 1, half = wave & 1, sub = lane >> 5, rr = (lane & 31) >> 2, vrow = 8 * rowgrp + rr;
    const int chl = (lane & 3) ^ ((vrow >> 2) & 3);
    const unsigned short* vsrc = u.V + (size_t)vrow * PITCH + (4 * (2 * half + sub) + chl) * 8;
    const unsigned ldsw = (unsigned)(uintptr_t)lds + (unsigned)wave * 1024u;
#define ATT_DMA(t, slot) do { if (ATT_VAR(u) & 1) break; \
        glds16(ksrc + (size_t)(t) * 64 * PITCH, (unsigned)__builtin_amdgcn_readfirstlane(ldsw + (slot) * SLOT)); \
        glds16(vsrc + (size_t)(t) * 64 * PITCH, (unsigned)__builtin_amdgcn_readfirstlane(ldsw + (slot) * SLOT + KSLOT)); \
        glds16(vsrc + (size_t)(t) * 64 * PITCH + 32 * PITCH, (unsigned)__builtin_amdgcn_readfirstlane(ldsw + (slot) * SLOT + KSLOT + 8192)); } while (0)
    asm volatile("s_waitcnt lgkmcnt(0)\n\ts_barrier" ::: "memory");
    ATT_DMA(0, 0);
    if (u.ntot > 1) ATT_DMA(1, 1);
    bf16x8 qf[4];
    { const unsigned short* qrow = u.Q + mapoff + (size_t)(wave * 32 + r32) * PITCH + 8 * h;
#pragma unroll
      for (int ks = 0; ks < 4; ++ks) qf[ks] = active ? *(const bf16x8*)(qrow + 16 * ks) : (bf16x8){0,0,0,0,0,0,0,0}; }
    asm volatile("" : "+v"(qf[0]), "+v"(qf[1]), "+v"(qf[2]), "+v"(qf[3]));
    if (wave >= 4) __builtin_amdgcn_s_setprio(1);
    float l = 0.f, negm_s = 0.f; bool first_ = true;
    f32x16 negm;
#pragma unroll
    for (int r = 0; r < 16; ++r) negm[r] = 0.f;
#pragma unroll
    for (int d = 0; d < 4; ++d)
#pragma unroll
        for (int r = 0; r < 16; ++r) o[d][r] = 0.f;
    const int kbase = h * 1024 + r32 * 16;
    const int g = lane >> 4, blk = g & 1, q_ = (lane & 15) >> 2, p_ = lane & 3;
    const int vb0 = KSLOT + 64 * (4 * h + q_) + 16 * ((2 * blk + (p_ >> 1)) ^ h) + 8 * (p_ & 1);
    const int vb1 = KSLOT + 2048 + 64 * (4 * h + q_) + 16 * ((2 * blk + (p_ >> 1)) ^ (2 + h)) + 8 * (p_ & 1);
#define ATT_QK0(D0, D1, SB) do { _Pragma("unroll") for (int r = 0; r < 16; ++r) { D0[r] = 0.f; D1[r] = 0.f; } \
        _Pragma("unroll") for (int ks = 0; ks < 4; ++ks) { \
            const bf16x8 k0 = *(const ATT_LAS bf16x8*)((SB) + kbase + ks * 2048), k1 = *(const ATT_LAS bf16x8*)((SB) + kbase + ks * 2048 + 512); \
            D0 = __builtin_amdgcn_mfma_f32_32x32x16_bf16(k0, qf[ks], D0, 0, 0, 0); D1 = __builtin_amdgcn_mfma_f32_32x32x16_bf16(k1, qf[ks], D1, 0, 0, 0); } } while (0)
#define ATT_TILE(C0, C1, N0, N1, SC, SN, TT) do { \
        ATT_LAS unsigned char* sc_ = lds + (SC) * SLOT; ATT_LAS unsigned char* sn_ = lds + (SN) * SLOT; \
        if ((TT) == u.ntot - 1 && u.nvalid_last < 64) { \
            _Pragma("unroll") for (int r = 0; r < 16; ++r) { const int kv = (r & 3) + 8 * (r >> 2) + 4 * h; if (kv >= u.nvalid_last) C0[r] = -1e30f; if (kv + 32 >= u.nvalid_last) C1[r] = -1e30f; } } \
        float mx; { float t_[8]; \
            _Pragma("unroll") for (int r = 0; r < 8; ++r) t_[r] = max3f(C0[2 * r], C0[2 * r + 1], C1[2 * r]); \
            _Pragma("unroll") for (int r = 0; r < 8; ++r) t_[r] = max3f(t_[r], C1[2 * r + 1], t_[r]); \
            const float u0_ = max3f(t_[0], t_[1], t_[2]), u1_ = max3f(t_[3], t_[4], t_[5]), u2_ = max3f(t_[6], t_[7], t_[7]); mx = max3f(u0_, u1_, u2_); } \
        mx = max3f(mx, __shfl_xor(mx, 32), mx); \
        if (first_ || __any(mx > 8.0f)) {       \
            const float dd = first_ ? mx : fmaxf(mx, 0.f), alpha = __builtin_amdgcn_exp2f(-dd); first_ = false; l *= alpha; negm_s -= dd; \
            _Pragma("unroll") for (int d = 0; d < 4; ++d) _Pragma("unroll") for (int r = 0; r < 16; ++r) o[d][r] *= alpha; \
            _Pragma("unroll") for (int r = 0; r < 16; ++r) { C0[r] -= dd; C1[r] -= dd; negm[r] = negm_s; } } \
        const unsigned va0 = (unsigned)(uintptr_t)(sc_ + vb0), va1 = (unsigned)(uintptr_t)(sc_ + vb1); \
        float rsa_[4] = {0.f, 0.f, 0.f, 0.f}; \
        _Pragma("unroll") for (int s = 0; s < 4; ++s) { \
            s16x4 lo[4], hi[4]; \
            if (!(ATT_VAR(u) & 2)) _Pragma("unroll") for (int d = 0; d < 4; ++d) { \
                asm volatile("ds_read_b64_tr_b16 %0, %1 offset:%c2" : "=&v"(lo[d]) : "v"(va0), "i"(d * 512 + s * 4096) : "memory"); \
                asm volatile("ds_read_b64_tr_b16 %0, %1 offset:%c2" : "=&v"(hi[d]) : "v"(va1), "i"(d * 512 + s * 4096) : "memory"); } \
            const bf16x8 k0 = *(const ATT_LAS bf16x8*)(sn_ + kbase + s * 2048), k1 = *(const ATT_LAS bf16x8*)(sn_ + kbase + s * 2048 + 512); \
            u32x4 w; \
            if (s < 2) { _Pragma("unroll") for (int e = 0; e < 8; ++e) { C0[8 * s + e] = (ATT_VAR(u) & 4) ? C0[8 * s + e] : __builtin_amdgcn_exp2f(C0[8 * s + e]); rsa_[e & 3] += C0[8 * s + e]; } \
                w.x = cvtpk(C0[8 * s], C0[8 * s + 1]); w.y = cvtpk(C0[8 * s + 2], C0[8 * s + 3]); w.z = cvtpk(C0[8 * s + 4], C0[8 * s + 5]); w.w = cvtpk(C0[8 * s + 6], C0[8 * s + 7]); } \
            else { const int b_ = 8 * (s - 2); _Pragma("unroll") for (int e = 0; e < 8; ++e) { C1[b_ + e] = (ATT_VAR(u) & 4) ? C1[b_ + e] : __builtin_amdgcn_exp2f(C1[b_ + e]); rsa_[e & 3] += C1[b_ + e]; } \
                w.x = cvtpk(C1[b_], C1[b_ + 1]); w.y = cvtpk(C1[b_ + 2], C1[b_ + 3]); w.z = cvtpk(C1[b_ + 4], C1[b_ + 5]); w.w = cvtpk(C1[b_ + 6], C1[b_ + 7]); } \
            const bf16x8 pf = __builtin_bit_cast(bf16x8, w); \
            if (s == 0) { N0 = __builtin_amdgcn_mfma_f32_32x32x16_bf16(k0, qf[0], negm, 0, 0, 0); N1 = __builtin_amdgcn_mfma_f32_32x32x16_bf16(k1, qf[0], negm, 0, 0, 0); } \
            else { N0 = __builtin_amdgcn_mfma_f32_32x32x16_bf16(k0, qf[s], N0, 0, 0, 0); N1 = __builtin_amdgcn_mfma_f32_32x32x16_bf16(k1, qf[s], N1, 0, 0, 0); } \
            asm volatile("s_waitcnt lgkmcnt(0)" ::: "memory"); \
            if (!(ATT_VAR(u) & 2)) _Pragma("unroll") for (int d = 0; d < 4; ++d) { \
                const bf16x8 vf = (bf16x8){lo[d][0], lo[d][1], lo[d][2], lo[d][3], hi[d][0], hi[d][1], hi[d][2], hi[d][3]}; \
                o[d] = __builtin_amdgcn_mfma_f32_32x32x16_bf16(vf, pf, o[d], 0, 0, 0); } \
        } \
        l += (rsa_[0] + rsa_[1]) + (rsa_[2] + rsa_[3]); } while (0)
    f32x16 sA0, sA1, sB0, sB1;
#define ATT_WAITBAR(N) do { if (ATT_VAR(u) & 8) asm volatile("s_waitcnt vmcnt(" #N ") lgkmcnt(0)" ::: "memory"); else asm volatile("s_waitcnt vmcnt(" #N ") lgkmcnt(0)\n\ts_barrier" ::: "memory"); } while (0)
    if (u.ntot > 1) ATT_WAITBAR(3); else ATT_WAITBAR(0);
    if (active) ATT_QK0(sA0, sA1, lds);
    int slot = 0;
#define ATT_HALF(TT, C0, C1, N0, N1) do { const int sn = slot == 2 ? 0 : slot + 1; \
        if ((TT) + 1 < u.ntot) ATT_WAITBAR(0); \
        if ((TT) + 2 < u.ntot) ATT_DMA((TT) + 2, slot == 0 ? 2 : slot - 1); \
        if (active && (TT) < nmine && !(ATT_VAR(u) & 16)) ATT_TILE(C0, C1, N0, N1, slot, sn, (TT)); \
        slot = sn; } while (0)
    for (int t = 0; t < u.ntot; t += 2) {
        ATT_HALF(t, sA0, sA1, sB0, sB1);
        if (t + 1 < u.ntot) ATT_HALF(t + 1, sB0, sB1, sA0, sA1);
    }
#undef ATT_HALF
#undef ATT_WAITBAR
#undef ATT_TILE
#undef ATT_QK0
    __builtin_amdgcn_s_setprio(0);
    lsum = l + __shfl_xor(l, 32);
#undef ATT_DMA
}

__device__ __forceinline__ void attn_unit(ATT_LAS unsigned char* lds, const Unit& u, float lam, const float* subw, int wave, int lane) {
    asm volatile("" : "+v"(lane));
    const int r32 = lane & 31, h = lane >> 5;
    const bool active = u.sample ? (wave == 0) : true;
    const int nmine = u.sample ? u.ntot : 4 * u.qb + (wave >> 1) + 1;
    f32x16 o[4]; float l1, l2;
    ATT_LAS u32x4* park = (ATT_LAS u32x4*)(lds + PARK_OFF + wave * 8192) + lane;
    pass(lds, u, 0, active, nmine, wave, lane, o, l1);
    { const float inv = 1.0f / l1;
#pragma unroll
      for (int d = 0; d < 4; ++d)
#pragma unroll
          for (int r4 = 0; r4 < 2; ++r4) { u32x4 w; w.x = cvtpk(o[d][8 * r4] * inv, o[d][8 * r4 + 1] * inv); w.y = cvtpk(o[d][8 * r4 + 2] * inv, o[d][8 * r4 + 3] * inv);
              w.z = cvtpk(o[d][8 * r4 + 4] * inv, o[d][8 * r4 + 5] * inv); w.w = cvtpk(o[d][8 * r4 + 6] * inv, o[d][8 * r4 + 7] * inv); if (active) park[(2 * d + r4) * 64] = w; } }
    pass(lds, u, 64, active, nmine, wave, lane, o, l2);
    if (!active) return;
    const float c2 = lam / l2;
    float ss = 0.f;
#pragma unroll
    for (int d = 0; d < 4; ++d)
#pragma unroll
        for (int r4 = 0; r4 < 2; ++r4) { const u32x4 w = park[(2 * d + r4) * 64];
#pragma unroll
            for (int e = 0; e < 4; ++e) { const unsigned pw = w[e]; const int r = 8 * r4 + 2 * e;
                const float v0 = __uint_as_float(pw << 16) - c2 * o[d][r], v1 = __uint_as_float(pw & 0xffff0000u) - c2 * o[d][r + 1];
                o[d][r] = v0; o[d][r + 1] = v1; ss += v0 * v0 + v1 * v1; } }
    ss += __shfl_xor(ss, 32);
    const float rn = (1.0f - LAM0) / sqrtf(ss * (1.0f / 128.0f) + EPS);
    unsigned short* orow = u.O + (size_t)(wave * 32 + r32) * 4096 + 8 * h;
    const bool st_ok = !(u.sample && r32 >= 16);
#pragma unroll
    for (int d = 0; d < 4; ++d)
#pragma unroll
        for (int kp = 0; kp < 4; kp += 2) {
            u32x2 pa, pb;
            { const int dc = 32 * d + 8 * kp + 4 * h; const f32x4 w = *(const f32x4*)(subw + dc);
              pa.x = cvtpk(o[d][4 * kp] * rn * w[0], o[d][4 * kp + 1] * rn * w[1]); pa.y = cvtpk(o[d][4 * kp + 2] * rn * w[2], o[d][4 * kp + 3] * rn * w[3]); }
            { const int dc = 32 * d + 8 * (kp + 1) + 4 * h; const f32x4 w = *(const f32x4*)(subw + dc);
              pb.x = cvtpk(o[d][4 * kp + 4] * rn * w[0], o[d][4 * kp + 5] * rn * w[1]); pb.y = cvtpk(o[d][4 * kp + 6] * rn * w[2], o[d][4 * kp + 7] * rn * w[3]); }
            const auto rx = __builtin_amdgcn_permlane32_swap(pa.x, pb.x, false, false); const auto ry = __builtin_amdgcn_permlane32_swap(pa.y, pb.y, false, false);
            const u32x4 v = (u32x4){rx[0], ry[0], rx[1], ry[1]};
            if (st_ok) *(u32x4*)(orow + 32 * d + 8 * kp) = v;
        }
}
}

namespace ssd {
typedef short bf16x8 __attribute__((ext_vector_type(8)));
typedef short s16x4 __attribute__((ext_vector_type(4)));
typedef float f32x4 __attribute__((ext_vector_type(4)));
typedef unsigned u32x4 __attribute__((ext_vector_type(4)));
typedef unsigned u32x2 __attribute__((ext_vector_type(2)));
#define SSD_LAS __attribute__((address_space(3)))
constexpr int XT_STRIDE = 144;
constexpr int L_CM = 0, L_BM = 16384, L_XT = 32768, L_ZT = L_XT + 256 * XT_STRIDE  , L_TAB = L_ZT + 32768  ,
              L_G = L_TAB + 2048  , L_SSQ = L_G + 16384  , L_CW = L_SSQ + 2048  , SSD_LDS_BYTES = L_CW + 10240;
static_assert(SSD_LDS_BYTES <= 139264, "ssd lds");
__device__ __forceinline__ unsigned off_a(unsigned row, unsigned ch) { return 2048u * (row >> 3) + 512u * (ch >> 2) + 64u * (row & 7) + 16u * ((ch & 3) ^ ((row >> 2) & 3)); }
__device__ __forceinline__ unsigned cvtpk(float lo, float hi) { unsigned r; asm volatile("v_cvt_pk_bf16_f32 %0, %1, %2" : "=v"(r) : "v"(lo), "v"(hi)); return r; }
__device__ __forceinline__ float bf2f(unsigned short b) { return __uint_as_float((unsigned)b << 16); }
__device__ __forceinline__ float silu(float v) { return v * __builtin_amdgcn_rcpf(1.0f + __builtin_amdgcn_exp2f(-1.4426950408889634f * v)); }
__device__ __forceinline__ bf16x8 pack8(const f32x4 a, const f32x4 b) { u32x4 w; w.x = cvtpk(a[0], a[1]); w.y = cvtpk(a[2], a[3]); w.z = cvtpk(b[0], b[1]); w.w = cvtpk(b[2], b[3]); return __builtin_bit_cast(bf16x8, w); }
__device__ __forceinline__ void glds16(const void* gsrc, unsigned lds_dst) { unsigned keep;
    asm volatile("s_mov_b32 %0, m0\n\ts_mov_b32 m0, %2\n\ts_nop 0\n\tglobal_load_lds_dwordx4 %1, off\n\ts_mov_b32 m0, %0" : "=&s"(keep) : "v"(gsrc), "s"(lds_dst) : "memory"); }
#define SSD_BAR() asm volatile("s_waitcnt lgkmcnt(0)\n\ts_barrier" ::: "memory")
__device__ __forceinline__ float row16_sum(float v) {
    v += __builtin_bit_cast(float, __builtin_amdgcn_update_dpp(0, __builtin_bit_cast(int, v), 0xB1, 0xf, 0xf, false));
    v += __builtin_bit_cast(float, __builtin_amdgcn_update_dpp(0, __builtin_bit_cast(int, v), 0x4E, 0xf, 0xf, false));
    v += __builtin_bit_cast(float, __builtin_amdgcn_update_dpp(0, __builtin_bit_cast(int, v), 0x141, 0xf, 0xf, false));
    v += __builtin_bit_cast(float, __builtin_amdgcn_update_dpp(0, __builtin_bit_cast(int, v), 0x140, 0xf, 0xf, false));
    return v;
}
#define MFMA16(a, b, c) __builtin_amdgcn_mfma_f32_16x16x32_bf16((a), (b), (c), 0, 0, 0)

struct Unit {
    const unsigned short* xbc;
    const unsigned short* z;
    const float* dtraw;
    const float* hist;
    const float* init;
    float* fin;
    unsigned short* y;
    int len;
    int g;
    int prev;
    int seg;
    float* fseg;
    unsigned* flag;
    int last;
};
constexpr int FSTRIDE = 4 * 64 * 128 + 64;
#define SSD_RLX __ATOMIC_RELAXED, __HIP_MEMORY_SCOPE_AGENT
struct Params { const float* conv_w; const float* conv_b; const float* dt_bias; const float* A_log; const float* D; const float* norm_w; };

template <bool PRE>
__device__ __forceinline__ void ssd_unit(SSD_LAS unsigned char* lds, const Unit& u, const Params& P, int tid, int wave, int lane) {
    asm volatile("" : "+v"(tid), "+v"(lane));
    const int g = u.g, hh = wave >> 1, ph = wave & 1, head = 4 * g + hh;
    const int c16 = lane & 15, g4 = lane >> 4, q_ = c16 >> 2, p_ = lane & 3;
    const float A = -__expf(P.A_log[head]), Dh = P.D[head], dtb = P.dt_bias[head];
    const int xq = (c16 >> 2) & 3, rbase = 2048 * (c16 >> 3) + 64 * (c16 & 7);
    const int rowrd = rbase + 16 * (g4 ^ xq);
    const int c_lo = rbase + 16 * ((g4 >> 1) ^ xq) + 8 * (g4 & 1);
    const int c_hi = rbase + 16 * ((2 + (g4 >> 1)) ^ xq) + 8 * (g4 & 1);
    const int trb = 2048 * g4 + 64 * q_ + 8 * (p_ & 1), tcc = g4 & 1, tbb = p_ >> 1;
    const int tr00 = trb + 32 * (0 ^ tcc) + 16 * (tbb ^ 0), tr01 = trb + 32 * (0 ^ tcc) + 16 * (tbb ^ 1), tr10 = trb + 32 * (1 ^ tcc) + 16 * (tbb ^ 0), tr11 = trb + 32 * (1 ^ tcc) + 16 * (tbb ^ 1);
    const int xt_lane = (64 * hh + 32 * ph + c16) * XT_STRIDE;
    f32x4 st[8][2];
#pragma unroll
    for (int nt = 0; nt < 8; ++nt)
#pragma unroll
        for (int pt = 0; pt < 2; ++pt) {
            if (u.init) st[nt][pt] = *(const f32x4*)(u.init + ((size_t)head * 64 + 32 * ph + 16 * pt + c16) * 128 + 16 * nt + 4 * g4);
            else st[nt][pt] = (f32x4){0.f, 0.f, 0.f, 0.f};
        }
    if constexpr (!PRE) {
        if (u.seg > 0) {
            if (tid == 0) { const unsigned want = (1u << u.seg) - 1u; unsigned sp = 0;
                while ((__hip_atomic_load(u.flag, SSD_RLX) & want) != want) { __builtin_amdgcn_s_sleep(8); if (++sp > (1u << 22)) break; } }
            __syncthreads();
            for (int i = 0; i < u.seg; ++i) {
                const float* F = u.fseg + (size_t)i * FSTRIDE;
                const float Di = __uint_as_float(__hip_atomic_load((const unsigned*)(F + 4 * 64 * 128 + hh), SSD_RLX));
#pragma unroll
                for (int nt = 0; nt < 8; ++nt)
#pragma unroll
                    for (int pt = 0; pt < 2; ++pt) {
                        const unsigned long long* fp = (const unsigned long long*)(F + ((size_t)hh * 64 + 32 * ph + 16 * pt + c16) * 128 + 16 * nt + 4 * g4);
                        const unsigned long long a = __hip_atomic_load(fp, SSD_RLX), b = __hip_atomic_load(fp + 1, SSD_RLX);
                        st[nt][pt] = st[nt][pt] * Di + (f32x4){__uint_as_float((unsigned)a), __uint_as_float((unsigned)(a >> 32)), __uint_as_float((unsigned)b), __uint_as_float((unsigned)(b >> 32))};
                    }
            }
        }
    }
    float asum = 0.f;
    const int cp = ((wave & 3) << 6) | lane, rh = wave >> 2;
    const int ccol = cp < 128 ? 256 * g + 2 * cp : cp < 192 ? 2048 + 128 * g + 2 * (cp - 128) : 3072 + 128 * g + 2 * (cp - 192);
    typedef float f32x2 __attribute__((ext_vector_type(2)));
    if (rh == 0) {
#pragma unroll
        for (int i = 0; i < 4; ++i) ((SSD_LAS f32x2*)(lds + L_CW))[i * 256 + cp] = (f32x2){P.conv_w[i * 4096 + ccol], P.conv_w[i * 4096 + ccol + 1]};
        ((SSD_LAS f32x2*)(lds + L_CW))[4 * 256 + cp] = (f32x2){P.conv_b[ccol], P.conv_b[ccol + 1]};
    }
    __syncthreads();
        const int nchunks = (u.len + 63) >> 6;
    unsigned raw[2][19]; float dtr = 0.f;
    const int tmin = u.prev ? -3 : 0;
    const unsigned zlds = (unsigned)(uintptr_t)(lds + L_ZT) + (unsigned)wave * 4096u;
    const int hd_l = 4 * g + (wave & 3);
    const float dtb_l = P.dt_bias[hd_l], A_l = -__expf(P.A_log[hd_l]);
#define SSD_ISSUE(cc) do { const int tb_ = 64 * (cc); \
        _Pragma("unroll") for (int hb = 0; hb < 2; ++hb) _Pragma("unroll") for (int i = 0; i < 19; ++i) { \
            int t = tb_ + 32 * rh + 16 * hb - 3 + i; t = t < tmin ? tmin : (t >= u.len ? u.len - 1 : t); raw[hb][i] = *(const unsigned*)(u.xbc + (long)t * 4096 + ccol); } \
        if (wave < 4) { int t = tb_ + lane; t = t >= u.len ? u.len - 1 : t; dtr = u.dtraw[(size_t)t * 32 + hd_l]; } } while (0)
#define SSD_ISSUE_Z(cc) do { const int tb_ = 64 * (cc); \
        _Pragma("unroll") for (int i = 0; i < 4; ++i) { int t = tb_ + 8 * wave + 2 * i + (lane >> 5); t = t >= u.len ? u.len - 1 : t; \
            glds16(u.z + (size_t)t * 2048 + 256 * g + 8 * (lane & 31), (unsigned)__builtin_amdgcn_readfirstlane(zlds + 1024u * i)); } } while (0)
    SSD_ISSUE(0); if constexpr (!PRE) SSD_ISSUE_Z(0);
    for (int c = 0; c < nchunks; ++c) {
        const int t0 = 64 * c;
        {
            float cw[4][2], cb[2];
#pragma unroll
            for (int i = 0; i < 4; ++i) { const f32x2 w = ((const SSD_LAS f32x2*)(lds + L_CW))[i * 256 + cp]; cw[i][0] = w.x; cw[i][1] = w.y; }
            { const f32x2 w = ((const SSD_LAS f32x2*)(lds + L_CW))[4 * 256 + cp]; cb[0] = w.x; cb[1] = w.y; }
#pragma unroll
            for (int hb = 0; hb < 2; ++hb) {
                float x0[19], x1[19];
#pragma unroll
                for (int i = 0; i < 19; ++i) {
                    const int t = t0 + 32 * rh + 16 * hb - 3 + i;
                    const unsigned v = raw[hb][i];
                    float a = 0.f, b = 0.f;
                    if (t >= tmin && t < u.len) { a = __uint_as_float(v << 16); b = __uint_as_float(v & 0xffff0000u); }
                    x0[i] = a; x1[i] = b;
                }
                if (hb == 0 && u.hist && c == 0 && rh == 0) {
#pragma unroll
                    for (int i = 0; i < 3; ++i) { x0[i] = u.hist[i * 4096 + ccol]; x1[i] = u.hist[i * 4096 + ccol + 1]; }
                }
                if (cp < 128) {
#pragma unroll
                    for (int k = 0; k < 2; ++k) {
                        float e0[8], e1[8];
#pragma unroll
                        for (int j = 0; j < 8; ++j) { const int i = 8 * k + j;
                            e0[j] = silu(cb[0] + cw[0][0] * x0[i] + cw[1][0] * x0[i + 1] + cw[2][0] * x0[i + 2] + cw[3][0] * x0[i + 3]);
                            e1[j] = silu(cb[1] + cw[0][1] * x1[i] + cw[1][1] * x1[i + 1] + cw[2][1] * x1[i + 2] + cw[3][1] * x1[i + 3]); }
                        u32x4 w0, w1;
                        w0.x = cvtpk(e0[0], e0[1]); w0.y = cvtpk(e0[2], e0[3]); w0.z = cvtpk(e0[4], e0[5]); w0.w = cvtpk(e0[6], e0[7]);
                        w1.x = cvtpk(e1[0], e1[1]); w1.y = cvtpk(e1[2], e1[3]); w1.z = cvtpk(e1[4], e1[5]); w1.w = cvtpk(e1[6], e1[7]);
                        *(SSD_LAS u32x4*)(lds + L_XT + (2 * cp) * XT_STRIDE + 64 * rh + 32 * hb + 16 * k) = w0;
                        *(SSD_LAS u32x4*)(lds + L_XT + (2 * cp + 1) * XT_STRIDE + 64 * rh + 32 * hb + 16 * k) = w1;
                    }
                } else if (!PRE || cp < 192) {
                    const int n = cp < 192 ? 2 * (cp - 128) : 2 * (cp - 192); const int base = (cp < 192 ? L_BM : L_CM) + 8192 * rh + 512 * (n >> 5) + 2 * (n & 7);
                    const int chl = (n >> 3) & 3;
#pragma unroll
                    for (int i = 0; i < 16; ++i) {
                        const float e0 = silu(cb[0] + cw[0][0] * x0[i] + cw[1][0] * x0[i + 1] + cw[2][0] * x0[i + 2] + cw[3][0] * x0[i + 3]);
                        const float e1 = silu(cb[1] + cw[0][1] * x1[i] + cw[1][1] * x1[i + 1] + cw[2][1] * x1[i + 2] + cw[3][1] * x1[i + 3]);
                        *(SSD_LAS unsigned*)(lds + base + 16 * (chl ^ ((i >> 2) & 3)) + 2048 * (2 * hb + (i >> 3)) + 64 * (i & 7)) = cvtpk(e0, e1);
                    }
                }
            }
            if (wave < 4) {
                const int t = t0 + lane;
                float dt = 0.f;
                if (t < u.len) { const float v = dtr + dtb_l; dt = fmaxf(v, 0.f) + log1pf(__expf(-fabsf(v))); }
                float a = dt * A_l;
#pragma unroll
                for (int o = 1; o < 64; o <<= 1) { const float n = __shfl_up(a, o); if (lane >= o) a += n; }
                ((SSD_LAS float*)(lds + L_TAB))[wave * 64 + lane] = dt; ((SSD_LAS float*)(lds + L_TAB + 1024))[wave * 64 + lane] = a;
            }
            if (c + 1 < nchunks) SSD_ISSUE(c + 1);
        }
        if constexpr (PRE) SSD_BAR();
        else if (c + 1 < nchunks) { if (wave < 4) asm volatile("s_waitcnt vmcnt(39) lgkmcnt(0)\n\ts_barrier" ::: "memory"); else asm volatile("s_waitcnt vmcnt(38) lgkmcnt(0)\n\ts_barrier" ::: "memory"); }
        else asm volatile("s_waitcnt vmcnt(0) lgkmcnt(0)\n\ts_barrier" ::: "memory");
        if constexpr (!PRE) {
        {
#pragma unroll
            for (int rep = 0; rep < 2; ++rep) {
                const int ti = wave + 8 * rep;
                if (ti < 10) {
                    const int stq = ti < 4 ? 0 : ti < 7 ? 1 : ti < 9 ? 2 : 3, qtq = ti < 4 ? ti : ti < 7 ? ti - 3 : ti < 9 ? ti - 5 : 3;
                    f32x4 acc = (f32x4){0.f, 0.f, 0.f, 0.f};
#pragma unroll
                    for (int ks = 0; ks < 4; ++ks) {
                        const bf16x8 a = *(const SSD_LAS bf16x8*)(lds + L_BM + rowrd + 4096 * stq + 512 * ks);
                        const bf16x8 b = *(const SSD_LAS bf16x8*)(lds + L_CM + rowrd + 4096 * qtq + 512 * ks);
                        acc = MFMA16(a, b, acc);
                    }
                    *(SSD_LAS f32x4*)(lds + L_G + (stq * 4 + qtq) * 1024 + lane * 16) = acc;
                }
            }
        }
        SSD_BAR();
        const SSD_LAS float* dtt = (const SSD_LAS float*)(lds + L_TAB) + hh * 64;
        const SSD_LAS float* act = (const SSD_LAS float*)(lds + L_TAB + 1024) + hh * 64;
        f32x4 y[4][2];
        {
#pragma unroll
            for (int qt = 0; qt < 4; ++qt) { y[qt][0] = (f32x4){0.f, 0.f, 0.f, 0.f}; y[qt][1] = (f32x4){0.f, 0.f, 0.f, 0.f}; }
#pragma unroll
            for (int ks = 0; ks < 4; ++ks) {
                const bf16x8 sf0 = pack8(st[2 * ks][0], st[2 * ks + 1][0]), sf1 = pack8(st[2 * ks][1], st[2 * ks + 1][1]);
#pragma unroll
                for (int qt = 0; qt < 4; ++qt) {
                    const u32x2 lo = *(const SSD_LAS u32x2*)(lds + L_CM + c_lo + 4096 * qt + 512 * ks);
                    const u32x2 hi = *(const SSD_LAS u32x2*)(lds + L_CM + c_hi + 4096 * qt + 512 * ks);
                    const bf16x8 cf = __builtin_bit_cast(bf16x8, (u32x4){lo.x, lo.y, hi.x, hi.y});
                    y[qt][0] = MFMA16(cf, sf0, y[qt][0]); y[qt][1] = MFMA16(cf, sf1, y[qt][1]);
                }
            }
#pragma unroll
            for (int qt = 0; qt < 4; ++qt) {
                const f32x4 aq = *(const SSD_LAS f32x4*)(act + 16 * qt + 4 * g4);
#pragma unroll
                for (int r = 0; r < 4; ++r) { const float e = __expf(aq[r]); y[qt][0][r] *= e; y[qt][1][r] *= e; }
            }
#pragma unroll
            for (int qt = 0; qt < 4; ++qt) {
                const float aqc = act[16 * qt + c16];
                const int qcol = 16 * qt + c16;
#pragma unroll
                for (int ks = 0; ks <= (qt >> 1); ++ks) {
                    f32x4 m[2];
#pragma unroll
                    for (int e2 = 0; e2 < 2; ++e2) {
                        const int stt = 2 * ks + e2;
                        if (stt <= qt) {
                            const f32x4 gv = *(const SSD_LAS f32x4*)(lds + L_G + (stt * 4 + qt) * 1024 + lane * 16);
                            const f32x4 as = *(const SSD_LAS f32x4*)(act + 16 * stt + 4 * g4);
                            const f32x4 ds = *(const SSD_LAS f32x4*)(dtt + 16 * stt + 4 * g4);
#pragma unroll
                            for (int r = 0; r < 4; ++r) { const int s = 16 * stt + 4 * g4 + r; m[e2][r] = s <= qcol ? gv[r] * __expf(aqc - as[r]) * ds[r] : 0.f; }
                        } else m[e2] = (f32x4){0.f, 0.f, 0.f, 0.f};
                    }
                    const bf16x8 mf = pack8(m[0], m[1]);
#pragma unroll
                    for (int pt = 0; pt < 2; ++pt) {
                        const u32x2 lo = *(const SSD_LAS u32x2*)(lds + L_XT + xt_lane + 8 * g4 + 16 * XT_STRIDE * pt + 64 * ks);
                        const u32x2 hi = *(const SSD_LAS u32x2*)(lds + L_XT + xt_lane + 8 * g4 + 16 * XT_STRIDE * pt + 64 * ks + 32);
                        const bf16x8 xf = __builtin_bit_cast(bf16x8, (u32x4){lo.x, lo.y, hi.x, hi.y});
                        y[qt][pt] = MFMA16(mf, xf, y[qt][pt]);
                    }
                }
            }
#pragma unroll
            for (int qt = 0; qt < 4; ++qt) {
                f32x4 sq = (f32x4){0.f, 0.f, 0.f, 0.f};
#pragma unroll
                for (int pt = 0; pt < 2; ++pt) {
                    const u32x2 xv = *(const SSD_LAS u32x2*)(lds + L_XT + xt_lane + 8 * g4 + 16 * XT_STRIDE * pt + 32 * qt);
                    const SSD_LAS unsigned short* zp0 = (const SSD_LAS unsigned short*)(lds + L_ZT) + (4 * g4) * 256 + 64 * hh + 32 * ph + c16 + 16 * pt + (16 * qt) * 256;
                    const float xs[4] = {__uint_as_float(xv.x << 16), __uint_as_float(xv.x & 0xffff0000u), __uint_as_float(xv.y << 16), __uint_as_float(xv.y & 0xffff0000u)};
                    const float zs[4] = {bf2f(zp0[0]), bf2f(zp0[256]), bf2f(zp0[512]), bf2f(zp0[768])};
#pragma unroll
                    for (int r = 0; r < 4; ++r) { const float v = (y[qt][pt][r] + Dh * xs[r]) * silu(zs[r]); y[qt][pt][r] = v; sq[r] += v * v; }
                }
#pragma unroll
                for (int r = 0; r < 4; ++r) { sq[r] = row16_sum(sq[r]); }
                if (c16 == 0) *(SSD_LAS f32x4*)(lds + L_SSQ + wave * 256 + (16 * qt + 4 * g4) * 4) = sq;
            }
        }
        SSD_BAR();
        {
            float nw[2];
#pragma unroll
            for (int pt = 0; pt < 2; ++pt) nw[pt] = P.norm_w[256 * g + 64 * hh + 32 * ph + 16 * pt + c16];
#pragma unroll
            for (int qt = 0; qt < 4; ++qt) {
                f32x4 tot = (f32x4){0.f, 0.f, 0.f, 0.f};
#pragma unroll
                for (int w = 0; w < 8; ++w) tot += *(const SSD_LAS f32x4*)(lds + L_SSQ + w * 256 + (16 * qt + 4 * g4) * 4);
#pragma unroll
                for (int r = 0; r < 4; ++r) {
                    const int t = t0 + 16 * qt + 4 * g4 + r;
                    if (t < u.len) {
                        const float rn = __builtin_amdgcn_rsqf(tot[r] * (1.0f / 256.0f) + EPS);
#pragma unroll
                        for (int pt = 0; pt < 2; ++pt) {
                            const unsigned b = cvtpk(y[qt][pt][r] * rn * nw[pt], 0.f);
                            u.y[(size_t)t * 4096 + 256 * g + 64 * hh + 32 * ph + 16 * pt + c16] = (unsigned short)b;
                        }
                    }
                }
            }
        }
        if (c + 1 < nchunks) SSD_ISSUE_Z(c + 1);
        }
        {
            const SSD_LAS float* dtt = (const SSD_LAS float*)(lds + L_TAB) + hh * 64;
            const SSD_LAS float* act = (const SSD_LAS float*)(lds + L_TAB + 1024) + hh * 64;
            const float aend = act[63], cd = __expf(aend); asum += aend;
            bf16x8 xw[2][2];
#pragma unroll
            for (int ks = 0; ks < 2; ++ks) {
                const f32x4 a0 = *(const SSD_LAS f32x4*)(act + 32 * ks + 8 * g4), a1 = *(const SSD_LAS f32x4*)(act + 32 * ks + 8 * g4 + 4);
                const f32x4 d0 = *(const SSD_LAS f32x4*)(dtt + 32 * ks + 8 * g4), d1 = *(const SSD_LAS f32x4*)(dtt + 32 * ks + 8 * g4 + 4);
                float wv[8];
#pragma unroll
                for (int j = 0; j < 4; ++j) { wv[j] = d0[j] * __expf(aend - a0[j]); wv[4 + j] = d1[j] * __expf(aend - a1[j]); }
#pragma unroll
                for (int pt = 0; pt < 2; ++pt) {
                    const u32x4 xv = *(const SSD_LAS u32x4*)(lds + L_XT + xt_lane + 16 * g4 + 16 * XT_STRIDE * pt + 64 * ks);
                    u32x4 o;
                    o.x = cvtpk(__uint_as_float(xv.x << 16) * wv[0], __uint_as_float(xv.x & 0xffff0000u) * wv[1]);
                    o.y = cvtpk(__uint_as_float(xv.y << 16) * wv[2], __uint_as_float(xv.y & 0xffff0000u) * wv[3]);
                    o.z = cvtpk(__uint_as_float(xv.z << 16) * wv[4], __uint_as_float(xv.z & 0xffff0000u) * wv[5]);
                    o.w = cvtpk(__uint_as_float(xv.w << 16) * wv[6], __uint_as_float(xv.w & 0xffff0000u) * wv[7]);
                    xw[ks][pt] = __builtin_bit_cast(bf16x8, o);
                }
            }
            const unsigned bm00 = (unsigned)(uintptr_t)(lds + L_BM + tr00), bm01 = (unsigned)(uintptr_t)(lds + L_BM + tr01), bm10 = (unsigned)(uintptr_t)(lds + L_BM + tr10), bm11 = (unsigned)(uintptr_t)(lds + L_BM + tr11);
#pragma unroll
            for (int nt = 0; nt < 8; ++nt) {
                st[nt][0] *= cd; st[nt][1] *= cd;
                s16x4 t0v[2], t1v[2];
#pragma unroll
                for (int ks = 0; ks < 2; ++ks) {
                    asm volatile("ds_read_b64_tr_b16 %0, %1 offset:%c2" : "=&v"(t0v[ks]) : "v"((nt & 1) ? bm10 : bm00), "i"(8192 * ks + 512 * (nt >> 1)) : "memory");
                    asm volatile("ds_read_b64_tr_b16 %0, %1 offset:%c2" : "=&v"(t1v[ks]) : "v"((nt & 1) ? bm11 : bm01), "i"(8192 * ks + 512 * (nt >> 1) + 256) : "memory");
                }
                asm volatile("s_waitcnt lgkmcnt(0)" ::: "memory");
                __builtin_amdgcn_sched_barrier(0);
#pragma unroll
                for (int ks = 0; ks < 2; ++ks) {
                    const bf16x8 bt = (bf16x8){t0v[ks][0], t0v[ks][1], t0v[ks][2], t0v[ks][3], t1v[ks][0], t1v[ks][1], t1v[ks][2], t1v[ks][3]};
                    st[nt][0] = MFMA16(bt, xw[ks][0], st[nt][0]); st[nt][1] = MFMA16(bt, xw[ks][1], st[nt][1]);
                }
            }
        }
        SSD_BAR();
    }
#undef SSD_ISSUE
#undef SSD_ISSUE_Z
    if constexpr (PRE) {
        float* F = u.fseg + (size_t)u.seg * FSTRIDE;
#pragma unroll
        for (int nt = 0; nt < 8; ++nt)
#pragma unroll
            for (int pt = 0; pt < 2; ++pt) {
                unsigned long long* fp = (unsigned long long*)(F + ((size_t)hh * 64 + 32 * ph + 16 * pt + c16) * 128 + 16 * nt + 4 * g4);
                const f32x4 v = st[nt][pt];
                __hip_atomic_store(fp, ((unsigned long long)__float_as_uint(v[1]) << 32) | __float_as_uint(v[0]), SSD_RLX);
                __hip_atomic_store(fp + 1, ((unsigned long long)__float_as_uint(v[3]) << 32) | __float_as_uint(v[2]), SSD_RLX);
            }
        if (ph == 0 && lane == 0) __hip_atomic_store((unsigned*)(F + 4 * 64 * 128 + hh), __float_as_uint(__expf(asum)), SSD_RLX);
        asm volatile("s_waitcnt vmcnt(0)" ::: "memory");
        __syncthreads();
        if (tid == 0) __hip_atomic_fetch_or(u.flag, 1u << u.seg, SSD_RLX);
    } else if (u.last) {
#pragma unroll
        for (int nt = 0; nt < 8; ++nt)
#pragma unroll
            for (int pt = 0; pt < 2; ++pt) *(f32x4*)(u.fin + ((size_t)head * 64 + 32 * ph + 16 * pt + c16) * 128 + 16 * nt + 4 * g4) = st[nt][pt] * TEST_ALPHA;
    }
}
}

namespace sk {
typedef short bf16x8 __attribute__((ext_vector_type(8)));
typedef float f32x4 __attribute__((ext_vector_type(4)));
#define SK_LAS __attribute__((address_space(3)))
__device__ __forceinline__ unsigned cvtpk(float lo, float hi) { unsigned r; asm volatile("v_cvt_pk_bf16_f32 %0, %1, %2" : "=v"(r) : "v"(lo), "v"(hi)); return r; }
__device__ __forceinline__ unsigned short bf(float v) { return (unsigned short)cvtpk(v, 0.f); }

template <int NRT, int NB, bool DEEP = false, bool NTB = false  , class Epi>
__device__ __forceinline__ void skinny(SK_LAS unsigned char* lds, const unsigned short* A, int lda, int K, int njobs, const Epi& E, int wave, int lane, int wg, int nwg) {
    asm volatile("" : "+v"(lane));
    constexpr int RS = 528, BUF = 16 * NRT * RS;
    const int c16 = lane & 15, g4 = lane >> 4, tid = wave * 64 + lane;
    const int nch = K >> 8;
    const unsigned short* asrc = A + (size_t)(tid >> 5) * lda + 8 * (tid & 31);
    SK_LAS unsigned char* adst = lds + (tid >> 5) * RS + 16 * (tid & 31);
    const SK_LAS unsigned char* ard = lds + c16 * RS + 16 * g4;
    for (int base = wg * 8; base < njobs; base += nwg * 8) {
        const int job = base + wave; const bool valid = job < njobs; const int jobc = valid ? job : njobs - 1;
        const unsigned short* brow[NB];
#pragma unroll
        for (int nb = 0; nb < NB; ++nb) brow[nb] = E.brow(jobc, c16, nb) + 8 * g4;
        f32x4 acc[NB][NRT];
#pragma unroll
        for (int nb = 0; nb < NB; ++nb)
#pragma unroll
            for (int rt = 0; rt < NRT; ++rt) acc[nb][rt] = (f32x4){0.f, 0.f, 0.f, 0.f};
        bf16x8 an[NRT];
#pragma unroll
        for (int i = 0; i < NRT; ++i) an[i] = *(const bf16x8*)(asrc + (size_t)(16 * i) * lda);
#pragma unroll
        for (int i = 0; i < NRT; ++i) *(SK_LAS bf16x8*)(adst + 16 * i * RS) = an[i];
        __syncthreads();
        if constexpr (NB == 1 && DEEP) {
            bf16x8 q0[4], q1[4], q2[4], q3[4];
            const int nh = 2 * nch;
#define SK_LOADH(Q, h) { const int hh_ = (h) < nh ? (h) : nh - 1; \
            _Pragma("unroll") for (int ks = 0; ks < 4; ++ks) Q[ks] = NTB ? __builtin_nontemporal_load((const bf16x8*)(brow[0] + 128 * hh_ + 32 * ks)) : *(const bf16x8*)(brow[0] + 128 * hh_ + 32 * ks); __builtin_amdgcn_sched_barrier(0); }
#define SK_COMP(Q, bufo, kh) { \
            _Pragma("unroll") for (int ks = 0; ks < 4; ++ks) \
                _Pragma("unroll") for (int rt = 0; rt < NRT; ++rt) { \
                    const bf16x8 a = *(const SK_LAS bf16x8*)(ard + (bufo) + 16 * rt * RS + 64 * (4 * (kh) + ks)); \
                    acc[0][rt] = __builtin_amdgcn_mfma_f32_16x16x32_bf16(a, Q[ks], acc[0][rt], 0, 0, 0); \
                    if ((rt & 3) == 3) __builtin_amdgcn_sched_barrier(0); } }
#define SK_LOADA(cn) { const int cn_ = (cn) < nch ? (cn) : nch - 1; \
            _Pragma("unroll") for (int i = 0; i < NRT; ++i) an[i] = *(const bf16x8*)(asrc + (size_t)(16 * i) * lda + 256 * cn_); __builtin_amdgcn_sched_barrier(0); }
#define SK_PUTA(bufo) { _Pragma("unroll") for (int i = 0; i < NRT; ++i) *(SK_LAS bf16x8*)(adst + (bufo) + 16 * i * RS) = an[i]; __syncthreads(); }
            SK_LOADH(q0, 0); SK_LOADH(q1, 1); SK_LOADH(q2, 2);
#pragma unroll 1
            for (int c = 0;; c += 2) {
                SK_LOADA(c + 1); SK_LOADH(q3, 2 * c + 3); SK_COMP(q0, 0, 0); SK_LOADH(q0, 2 * c + 4); SK_COMP(q1, 0, 1); SK_PUTA(BUF);
                if (c + 1 >= nch) break;
                SK_LOADA(c + 2); SK_LOADH(q1, 2 * c + 5); SK_COMP(q2, BUF, 0); SK_LOADH(q2, 2 * c + 6); SK_COMP(q3, BUF, 1); SK_PUTA(0);
                if (c + 2 >= nch) break;
            }
#undef SK_LOADH
#undef SK_COMP
#undef SK_LOADA
#undef SK_PUTA
        } else {
        bf16x8 b[8][NB];
#pragma unroll
        for (int ks = 0; ks < 8; ++ks)
#pragma unroll
            for (int nb = 0; nb < NB; ++nb) b[ks][nb] = NTB ? __builtin_nontemporal_load((const bf16x8*)(brow[nb] + 32 * ks)) : *(const bf16x8*)(brow[nb] + 32 * ks);
#pragma unroll 1
        for (int c = 0; c < nch; ++c) {
            const int buf = (c & 1) * BUF;
            constexpr int PF = NB == 1 ? 8 : 4;
            bf16x8 bn[PF][NB];
            const int cn = c + 1 < nch ? c + 1 : c;
#pragma unroll
            for (int ks = 0; ks < PF; ++ks)
#pragma unroll
                for (int nb = 0; nb < NB; ++nb) bn[ks][nb] = NTB ? __builtin_nontemporal_load((const bf16x8*)(brow[nb] + 256 * cn + 32 * ks)) : *(const bf16x8*)(brow[nb] + 256 * cn + 32 * ks);
#pragma unroll
            for (int i = 0; i < NRT; ++i) an[i] = *(const bf16x8*)(asrc + (size_t)(16 * i) * lda + 256 * cn);
#pragma unroll
            for (int ks = 0; ks < 8; ++ks)
#pragma unroll
                for (int rt = 0; rt < NRT; ++rt) {
                    const bf16x8 a = *(const SK_LAS bf16x8*)(ard + buf + 16 * rt * RS + 64 * ks);
#pragma unroll
                    for (int nb = 0; nb < NB; ++nb) acc[nb][rt] = __builtin_amdgcn_mfma_f32_16x16x32_bf16(a, b[ks][nb], acc[nb][rt], 0, 0, 0);
                    if ((rt & 3) == 3) __builtin_amdgcn_sched_barrier(0);
                }
#pragma unroll
            for (int i = 0; i < NRT; ++i) *(SK_LAS bf16x8*)(adst + (BUF - buf) + 16 * i * RS) = an[i];
#pragma unroll
            for (int ks = 0; ks < PF; ++ks)
#pragma unroll
                for (int nb = 0; nb < NB; ++nb) b[ks][nb] = bn[ks][nb];
#pragma unroll
            for (int ks = PF; ks < 8; ++ks)
#pragma unroll
                for (int nb = 0; nb < NB; ++nb) b[ks][nb] = NTB ? __builtin_nontemporal_load((const bf16x8*)(brow[nb] + 256 * cn + 32 * ks)) : *(const bf16x8*)(brow[nb] + 256 * cn + 32 * ks);
            __syncthreads();
        }
        }
        if (valid) {
            int c16e = c16, g4e = g4; asm volatile("" : "+v"(c16e), "+v"(g4e));
#pragma unroll
            for (int rt = 0; rt < NRT; ++rt) { f32x4 v[NB];
#pragma unroll
                for (int nb = 0; nb < NB; ++nb) v[nb] = acc[nb][rt];
                E.store(job, rt, c16e, g4e, v); }
        }
    }
}

struct EpiInS {
    const unsigned short* WinT; unsigned short *Q, *Z, *XBC, *Kext, *Vext; float* DT; float* out;
    __device__ __forceinline__ const unsigned short* brow(int job, int n, int) const { return WinT + (size_t)(16 * job + n) * DM; }
    __device__ __forceinline__ void store(int job, int rt, int n, int g4, const f32x4 (&v)[1]) const {
        const int c0 = 16 * job, col = c0 + n, rs0 = 16 * rt + 4 * g4;
        if (c0 < 2048) {
#pragma unroll
            for (int r = 0; r < 4; ++r) Q[((size_t)MP + rs0 + r) * AW + col] = bf(v[0][r] * QSCALE);
        } else if (c0 < 6144) {
            const bool isk = c0 < 4096; const int c = col - (isk ? 2048 : 4096); float* o = out + (isk ? O_KS : O_VS); unsigned short* e = isk ? Kext : Vext;
#pragma unroll
            for (int r = 0; r < 4; ++r) { const int rs = rs0 + r; o[(size_t)rs * AW + c] = v[0][r] * TEST_ALPHA; e[((size_t)(rs >> 4) * KVROWS + PAST + (rs & 15)) * AW + c] = bf(v[0][r]); }
        } else if (c0 < 8192) {
#pragma unroll
            for (int r = 0; r < 4; ++r) Z[((size_t)MP + rs0 + r) * SSDI + col - 6144] = bf(v[0][r]);
        } else if (c0 < 12288) {
            const int c = col - 8192;
#pragma unroll
            for (int r = 0; r < 4; ++r) { const int rs = rs0 + r; XBC[((size_t)MP + rs) * CONVD + c] = bf(v[0][r]); const int t = (rs & 15) - 13; if (t >= 0) out[O_CS + (size_t)((rs >> 4) * 3 + t) * CONVD + c] = v[0][r] * TEST_ALPHA; }
        } else {
#pragma unroll
            for (int r = 0; r < 4; ++r) DT[((size_t)MP + rs0 + r) * SH + col - 12288] = v[0][r];
        }
    }
};
struct EpiDtP {
    const unsigned short* XN; float* DT;
    __device__ __forceinline__ const unsigned short* brow(int job, int n, int) const { return XN + (size_t)(16 * job + n) * DM; }
    __device__ __forceinline__ void store(int job, int rt, int n, int g4, const f32x4 (&v)[1]) const {
        *(f32x4*)(DT + (size_t)(16 * job + n) * SH + 16 * rt + 4 * g4) = v[0];
    }
};
struct EpiOutS {
    const unsigned short* WoT; const float* xs; float* out; unsigned short* X1B; float* ss;
    __device__ __forceinline__ const unsigned short* brow(int job, int n, int) const { return WoT + (size_t)(16 * job + n) * DM; }
    __device__ __forceinline__ void store(int job, int rt, int n, int g4, const f32x4 (&v)[1]) const {
        const int col = 16 * job + n;
#pragma unroll
        for (int r = 0; r < 4; ++r) {
            const int rs = 16 * rt + 4 * g4 + r; const float x1 = xs[(size_t)rs * DM + col] + v[0][r];
            X1B[((size_t)MP + rs) * DM + col] = bf(x1);
            float sq = x1 * x1; sq += __shfl_xor(sq, 1); sq += __shfl_xor(sq, 2); sq += __shfl_xor(sq, 4); sq += __shfl_xor(sq, 8);
            if (n == 0) atomicAdd(ss + MP + rs, sq);
        }
    }
};
struct EpiGuS {
    const unsigned short* WguT; unsigned short* H; const float* ss;
    __device__ __forceinline__ const unsigned short* brow(int job, int n, int nb) const { const int f = 16 * job + n; return WguT + (size_t)(256 * (f >> 7) + (f & 127) + 128 * nb) * DM; }
    __device__ __forceinline__ void store(int job, int rt, int n, int g4, const f32x4 (&v)[2]) const {
        const int f = 16 * job + n;
#pragma unroll
        for (int r = 0; r < 4; ++r) {
            const int rs = 16 * rt + 4 * g4 + r; const float rn = 1.0f / sqrtf(ss[MP + rs] * (1.0f / DM) + EPS);
            const float g = v[0][r] * rn, up = v[1][r] * rn;
            H[(size_t)rs * DFF + f] = bf(g * up * __builtin_amdgcn_rcpf(1.0f + __builtin_amdgcn_exp2f(-1.4426950408889634f * g)));
        }
    }
};
struct EpiDownS {
    const unsigned short* WdT; const unsigned short* X1B; unsigned short* X2B; float* ss;
    __device__ __forceinline__ const unsigned short* brow(int job, int n, int) const { return WdT + (size_t)(16 * job + n) * DFF; }
    __device__ __forceinline__ void store(int job, int rt, int n, int g4, const f32x4 (&v)[1]) const {
        const int col = 16 * job + n;
#pragma unroll
        for (int r = 0; r < 4; ++r) {
            const int rs = 16 * rt + 4 * g4 + r; const size_t idx = ((size_t)MP + rs) * DM + col; const float x2 = __uint_as_float((unsigned)X1B[idx] << 16) + v[0][r]; X2B[idx] = bf(x2);
            float sq = x2 * x2; sq += __shfl_xor(sq, 1); sq += __shfl_xor(sq, 2); sq += __shfl_xor(sq, 4); sq += __shfl_xor(sq, 8);
            if (n == 0) atomicAdd(ss + MP + rs, sq);
        }
    }
};
struct EpiOutPart {
    const unsigned short* WoT; float* part; int koff;
    __device__ __forceinline__ const unsigned short* brow(int job, int n, int) const { return WoT + (size_t)(16 * job + n) * DM + koff; }
    __device__ __forceinline__ void store(int job, int rt, int n, int g4, const f32x4 (&v)[1]) const {
#pragma unroll
        for (int r = 0; r < 4; ++r) part[(size_t)(16 * rt + 4 * g4 + r) * DM + 16 * job + n] = v[0][r];
    }
};
struct EpiDownPart {
    const unsigned short* WdT; float* part; int koff;
    __device__ __forceinline__ const unsigned short* brow(int job, int n, int) const { return WdT + (size_t)(16 * job + n) * DFF + koff; }
    __device__ __forceinline__ void store(int job, int rt, int n, int g4, const f32x4 (&v)[1]) const {
#pragma unroll
        for (int r = 0; r < 4; ++r) part[(size_t)(16 * rt + 4 * g4 + r) * DM + 16 * job + n] = v[0][r];
    }
};
}

struct Args { const float* in[25]; float* out; unsigned char* ws; int ph_lo, ph_hi; };
enum { I_XP = 0, I_XS, I_CK, I_CV, I_SCONV, I_SSSM, I_N1W, I_WIN, I_LQ1, I_LK1, I_LQ2, I_LK2, I_SUBLN, I_CONVW, I_CONVB, I_DTB, I_ALOG, I_DSKIP, I_SSDNW, I_WOUT, I_N2W, I_WG, I_WU, I_WD, I_FNW };

#ifndef P4_INT8
#define P4_INT8 1
#endif
constexpr bool WGU_BF16 = !P4_INT8;
constexpr int WQ_SAMPLE_ROWS = 48;
__device__ __forceinline__ float wq_scale(const unsigned char* ws, int t) { const float s = ((const float*)(ws + WS_CTL))[CW_WSTAT + t]; return pg8::W8I_CLIP / sqrtf(s * (1.0f / ((float)WQ_SAMPLE_ROWS * DFF)) + 1e-30f); }
__device__ __forceinline__ void p0_prologue(const Frame& F, const Args& a) {
    unsigned char* ws = a.ws;
    LAS float* scr = (LAS float*)(F.lds + RING_OFF + F.wave * 17408);
    const int gw = F.vcu * NWAVES + F.wave, NGW = F.G * NWAVES, lane = F.lane;
    bf16* WinT = (bf16*)(ws + WS_WIN); bf16* WoT = (bf16*)(ws + WS_WO); bf16* WguT = (bf16*)(ws + WS_WGU); bf16* WdT = (bf16*)(ws + WS_WD);
    constexpr int I_IN = (DM / 64) * (NIN / 32), I_O = (DM / 64) * (DM / 32), I_G = (DM / 64) * (DFF / 32), I_D = (DFF / 64) * (DM / 32);
    for (int it = 2 * gw; it < I_IN; it += 2 * NGW) p0_transpose_pair<0>(a.in[I_WIN], DM, NIN, WinT, nullptr, scr, it, I_IN, lane);
    { GAS v4u* z = (GAS v4u*)(WinT + (size_t)NIN * DM); const int n16 = (NINP - NIN) * DM * 2 / 16;
      for (int i = gw * 64 + lane; i < n16; i += NGW * 64) z[i] = (v4u){0u, 0u, 0u, 0u}; }
    bf16* XN = (bf16*)(ws + WS_XN);
    for (int m = gw; m < MPAD; m += 2 * NGW) {
        const int m1 = m + NGW;
        if (m1 < MR) rms_row2_to_bf16(lane, m < MP ? a.in[I_XP] + (size_t)m * DM : a.in[I_XS] + (size_t)(m - MP) * DM, m1 < MP ? a.in[I_XP] + (size_t)m1 * DM : a.in[I_XS] + (size_t)(m1 - MP) * DM,
                                      a.in[I_N1W], XN + (size_t)m * DM, XN + (size_t)m1 * DM);
        else {
            for (int mm = m; mm < MPAD; mm += NGW) {
                if (mm > m1) break;
                if (mm < MR) rms_row_to_bf16(lane, mm < MP ? a.in[I_XP] + (size_t)mm * DM : a.in[I_XS] + (size_t)(mm - MP) * DM, a.in[I_N1W], XN + (size_t)mm * DM);
                else { GAS v4u* z = (GAS v4u*)(XN + (size_t)mm * DM);
#pragma unroll
                    for (int j = 0; j < 8; ++j) z[lane + 64 * j] = (v4u){0u, 0u, 0u, 0u}; }
            }
        }
    }
    { float* wst = (float*)(ws + WS_CTL) + CW_WSTAT; constexpr int NV = WQ_SAMPLE_ROWS * (DFF / 4);
      float sg = 0.f, su = 0.f;
      for (int i = gw * 64 + lane; i < NV; i += NGW * 64) { const int k = i / (DFF / 4); const f32x4 x = *(const GAS f32x4*)(a.in[I_WG] + 4 * (size_t)i), y = *(const GAS f32x4*)(a.in[I_WU] + 4 * (size_t)i);
          const float n2 = a.in[I_N2W][k];
          sg += n2 * n2 * ((x.x * x.x + x.y * x.y) + (x.z * x.z + x.w * x.w)); su += n2 * n2 * ((y.x * y.x + y.y * y.y) + (y.z * y.z + y.w * y.w)); }
      sg = wave_sum(sg); su = wave_sum(su); if (lane == 0) { atomicAdd(wst + 0, sg); atomicAdd(wst + 1, su); } }
    {
        bf16* Kext = (bf16*)(ws + WS_KEXT); bf16* Vext = (bf16*)(ws + WS_VEXT);
        const int zvec = DEC_B * (KVROWS - PAST - DEC_T) * AW / 8;
        for (int i = gw * 64 + lane; i < 2 * zvec; i += NGW * 64) {
            const bool isv = i >= zvec; const int j = isv ? i - zvec : i; const int e = j * 8, per = (KVROWS - PAST - DEC_T) * AW, b = e / per, rem = e % per;
            *(GAS v4u*)((isv ? Vext : Kext) + ((size_t)b * KVROWS + PAST + DEC_T) * AW + rem) = (v4u){0u, 0u, 0u, 0u};
        }
    }
}

__device__ __forceinline__ void p2_cache_slice(const Frame& F, const Args& a, int b, int h) {
    int tid = F.tid; asm volatile("" : "+v"(tid));
    const int r0 = tid >> 5, c4 = (tid & 31) * 4;
    const float* ks = a.in[I_CK] + ((size_t)b * PAST + r0) * AW + h * HD + c4; const float* vs = a.in[I_CV] + ((size_t)b * PAST + r0) * AW + h * HD + c4;
    bf16* kd = (bf16*)(a.ws + WS_KEXT) + ((size_t)b * KVROWS + r0) * AW + h * HD + c4; bf16* vd = (bf16*)(a.ws + WS_VEXT) + ((size_t)b * KVROWS + r0) * AW + h * HD + c4;
    for (int i0 = 0; i0 < PAST / 16; i0 += 8) {
        f32x4 kx[8], vx[8];
#pragma unroll
        for (int q = 0; q < 8; ++q) { kx[q] = __builtin_nontemporal_load((const GAS f32x4*)(ks + (size_t)(i0 + q) * 16 * AW)); vx[q] = __builtin_nontemporal_load((const GAS f32x4*)(vs + (size_t)(i0 + q) * 16 * AW)); }
#pragma unroll
        for (int q = 0; q < 8; ++q) { typedef unsigned u32x2g __attribute__((ext_vector_type(2)));
            *(GAS u32x2g*)(kd + (size_t)(i0 + q) * 16 * AW) = (u32x2g){pk2(kx[q].x, kx[q].y), pk2(kx[q].z, kx[q].w)};
            *(GAS u32x2g*)(vd + (size_t)(i0 + q) * 16 * AW) = (u32x2g){pk2(vx[q].x, vx[q].y), pk2(vx[q].z, vx[q].w)}; }
    }
    asm volatile("s_waitcnt vmcnt(0)" ::: "memory");
    __syncthreads();
}

constexpr int CONV_PAIRS_O = (DM / 64) * (DM / 32) / 2, CONV_PAIRS_G = (DM / 64) * (DFF / 32) / 2, CONV_PAIRS_D = (DFF / 64) * (DM / 32) / 2;
constexpr int CONV_ITEMS = (CONV_PAIRS_O + 2 * CONV_PAIRS_G + CONV_PAIRS_D) / 64;
constexpr int CONV_ITEMS_A = (CONV_PAIRS_O + 2 * CONV_PAIRS_G) / 64;
static_assert(CONV_PAIRS_O % 64 == 0 && CONV_PAIRS_G % 64 == 0 && CONV_PAIRS_D % 64 == 0, "a queue item stays inside one matrix");
__device__ __forceinline__ void p0_deferred_item(const Frame& F, const Args& a, int k) {
    unsigned char* ws = a.ws;
    LAS float* scr = (LAS float*)(F.lds + RING_OFF + F.wave * 17408);
    bf16* WoT = (bf16*)(ws + WS_WO); bf16* WguT = (bf16*)(ws + WS_WGU); bf16* WdT = (bf16*)(ws + WS_WD);
    int lane = F.lane; asm volatile("" : "+v"(lane));
    int p = k * 64 + F.wave * 8;
    if (p < CONV_PAIRS_O) { for (int i = 0; i < 8; ++i) p0_transpose_pair<0>(a.in[I_WOUT], DM, DM, WoT, nullptr, scr, 2 * (p + i), 2 * CONV_PAIRS_O, lane); return; }
    p -= CONV_PAIRS_O;
    if (p < CONV_PAIRS_G) { const float sq = wq_scale(ws, 0); for (int i = 0; i < 8; ++i) p0_transpose_pair<1>(a.in[I_WG], DM, DFF, WGU_BF16 ? WguT : (bf16*)nullptr, a.in[I_N2W], scr, 2 * (p + i), 2 * CONV_PAIRS_G, lane, ws + WS_WGUQ, sq, true); return; }
    p -= CONV_PAIRS_G;
    if (p < CONV_PAIRS_G) { const float sq = wq_scale(ws, 1); for (int i = 0; i < 8; ++i) p0_transpose_pair<2>(a.in[I_WU], DM, DFF, WGU_BF16 ? WguT : (bf16*)nullptr, a.in[I_N2W], scr, 2 * (p + i), 2 * CONV_PAIRS_G, lane, ws + WS_WGUQ, sq, true); return; }
    p -= CONV_PAIRS_G;
    for (int i = 0; i < 8; ++i) p0_transpose_pair<0>(a.in[I_WD], DFF, DM, WdT, nullptr, scr, 2 * (p + i), 2 * CONV_PAIRS_D, lane, ws + WS_WD8, pg8::WD8_SCALE);
}

__device__ __forceinline__ void p3b_quant_rows(const Frame& F, const Args& a) {
    const int gw = F.vcu * NWAVES + F.wave, NGW = F.G * NWAVES; int lane = F.lane; asm volatile("" : "+v"(lane));
    const float* ss = (const float*)(a.ws + WS_CTL) + CW_SS2; float* RQ = (float*)(a.ws + WS_CTL) + CW_RQ;
    const bf16* X1B = (const bf16*)(a.ws + WS_KEXT); unsigned char* X1Q = a.ws + WS_X1Q;
    typedef unsigned u32x2g __attribute__((ext_vector_type(2)));
    for (int m0 = gw; m0 < MR; m0 += 2 * NGW) {
      v4u vv[2][8];
#pragma unroll
      for (int t = 0; t < 2; ++t) { const int mt = m0 + t * NGW < MR ? m0 + t * NGW : m0; const GAS v4u* xr = (const GAS v4u*)(X1B + (size_t)mt * DM) + lane;
#pragma unroll
          for (int j = 0; j < 8; ++j) vv[t][j] = xr[64 * j]; }
#pragma unroll
      for (int t = 0; t < 2; ++t) {
        const int m = m0 + t * NGW; if (m >= MR) break;
        v4u v[8]; float mx = 0.f;
#pragma unroll
        for (int j = 0; j < 8; ++j) v[j] = vv[t][j];
#pragma unroll
        for (int j = 0; j < 8; ++j) {
            mx = fmaxf(mx, fmaxf(fmaxf(fabsf(pg8::bflo(v[j].x)), fabsf(pg8::bfhi(v[j].x))), fmaxf(fabsf(pg8::bflo(v[j].y)), fabsf(pg8::bfhi(v[j].y)))));
            mx = fmaxf(mx, fmaxf(fmaxf(fabsf(pg8::bflo(v[j].z)), fabsf(pg8::bfhi(v[j].z))), fmaxf(fabsf(pg8::bflo(v[j].w)), fabsf(pg8::bfhi(v[j].w))))); }
#pragma unroll
        for (int o = 1; o < 64; o <<= 1) mx = fmaxf(mx, __shfl_xor(mx, o));
        mx = fmaxf(mx, 1e-30f);
        const float sc = 127.0f / mx;
        GAS u32x2g* o8 = (GAS u32x2g*)(X1Q + (size_t)m * DM) + lane;
#pragma unroll
        for (int j = 0; j < 8; ++j) { u32x2g o;
            o.x = pg8::pk4_i8(pg8::bflo(v[j].x) * sc, pg8::bfhi(v[j].x) * sc, pg8::bflo(v[j].y) * sc, pg8::bfhi(v[j].y) * sc);
            o.y = pg8::pk4_i8(pg8::bflo(v[j].z) * sc, pg8::bfhi(v[j].z) * sc, pg8::bflo(v[j].w) * sc, pg8::bfhi(v[j].w) * sc);
            o8[64 * j] = o; }
        if (lane == 0) RQ[m] = mx * (1.0f / 127.0f) / sqrtf(ss[m] * (1.0f / DM) + EPS);
      }
    }
}

__device__ __forceinline__ void p3_sample_final(const Frame& F, const Args& a, int row, const unsigned* cnt, unsigned want) {
    int lane = F.lane; asm volatile("" : "+v"(lane));
    { unsigned sp = 0; while (__hip_atomic_load(cnt, RLX_AGENT) < want) { __builtin_amdgcn_s_sleep(4); if (++sp > (1u << 22)) break; } }
    __builtin_amdgcn_fence(__ATOMIC_ACQUIRE, "agent");
    const float* xs = a.in[I_XS] + (size_t)row * DM; const float* part = (const float*)(a.ws + WS_PARK) + (size_t)row * DM;
    bf16* X1B = (bf16*)(a.ws + WS_KEXT) + ((size_t)MP + row) * DM;
    float s = 0.f;
#pragma unroll 4
    for (int j = 0; j < 16; ++j) { const int c = 4 * (lane + 64 * j);
        f32x4 t = *(const GAS f32x4*)(xs + c);
#pragma unroll
        for (int q = 0; q < 8; ++q) t += *(const GAS f32x4*)(part + (size_t)q * MS * DM + c);
        s += (t.x * t.x + t.y * t.y) + (t.z * t.z + t.w * t.w);
        typedef unsigned u32x2g __attribute__((ext_vector_type(2)));
        *(GAS u32x2g*)(X1B + c) = (u32x2g){pk2(t.x, t.y), pk2(t.z, t.w)}; }
    s = wave_sum(s);
    if (lane == 0) ((float*)(a.ws + WS_CTL))[CW_SS2 + MP + row] = s;
}

constexpr int SMP_SLICES = 8;
__device__ __forceinline__ void p5_sample_final(const Frame& F, const Args& a, int row, const unsigned* cnt, unsigned want) {
    int lane = F.lane; asm volatile("" : "+v"(lane));
    { unsigned sp = 0; while (__hip_atomic_load(cnt, RLX_AGENT) < want) { __builtin_amdgcn_s_sleep(4); if (++sp > (1u << 22)) break; } }
    __builtin_amdgcn_fence(__ATOMIC_ACQUIRE, "agent");
    const bf16* X1B = (const bf16*)(a.ws + WS_KEXT) + ((size_t)MP + row) * DM; const float* part = (const float*)(a.ws + WS_PARK) + (size_t)row * DM;
    f32x4 v[16]; float s = 0.f;
#pragma unroll
    for (int j = 0; j < 16; ++j) { const int c = 4 * (lane + 64 * j);
        typedef unsigned u32x2g __attribute__((ext_vector_type(2)));
        const u32x2g xw = *(const GAS u32x2g*)(X1B + c);
        f32x4 t = (f32x4){__uint_as_float(xw.x << 16), __uint_as_float(xw.x & 0xffff0000u), __uint_as_float(xw.y << 16), __uint_as_float(xw.y & 0xffff0000u)};
#pragma unroll
        for (int q = 0; q < SMP_SLICES; ++q) t += *(const GAS f32x4*)(part + (size_t)q * MS * DM + c);
        v[j] = t; s += (t.x * t.x + t.y * t.y) + (t.z * t.z + t.w * t.w); }
    const float r = 1.0f / sqrtf(wave_sum(s) * (1.0f / DM) + EPS);
    float* y = a.out + O_YS + (size_t)row * DM;
#pragma unroll
    for (int j = 0; j < 16; ++j) { const int c = 4 * (lane + 64 * j); const f32x4 g = *(const GAS f32x4*)(a.in[I_FNW] + c);
        *(GAS f32x4*)(y + c) = (f32x4){v[j].x * r * g.x, v[j].y * r * g.y, v[j].z * r * g.z, v[j].w * r * g.w}; }
}

__device__ __forceinline__ void p6_final_norm(const Frame& F, const Args& a) {
    const int gw = F.vcu * NWAVES + F.wave, NGW = F.G * NWAVES, lane = F.lane;
    const float* ss = (const float*)(a.ws + WS_CTL) + CW_SS3;
    const bf16* X2B = (const bf16*)(a.ws + WS_XN);
    for (int m = gw; m < MR; m += NGW) {
        const float r = 1.0f / sqrtf(__hip_atomic_load(ss + m, __ATOMIC_RELAXED, __HIP_MEMORY_SCOPE_AGENT) * (1.0f / DM) + EPS);
        const GAS v4u* xr = (const GAS v4u*)(X2B + (size_t)m * DM) + lane;
        GAS f32x4* y = (GAS f32x4*)(a.out + (m < MP ? O_YP + (size_t)m * DM : O_YS + (size_t)(m - MP) * DM)) + 2 * lane;
        const GAS f32x4* wv = (const GAS f32x4*)a.in[I_FNW] + 2 * lane;
#pragma unroll
        for (int j = 0; j < 8; ++j) { const v4u x = xr[64 * j]; const f32x4 g0 = wv[128 * j], g1 = wv[128 * j + 1];
            f32x4 o0, o1;
            o0.x = __uint_as_float(x.x << 16) * r * g0.x; o0.y = __uint_as_float(x.x & 0xffff0000u) * r * g0.y; o0.z = __uint_as_float(x.y << 16) * r * g0.z; o0.w = __uint_as_float(x.y & 0xffff0000u) * r * g0.w;
            o1.x = __uint_as_float(x.z << 16) * r * g1.x; o1.y = __uint_as_float(x.z & 0xffff0000u) * r * g1.y; o1.z = __uint_as_float(x.w << 16) * r * g1.z; o1.w = __uint_as_float(x.w & 0xffff0000u) * r * g1.w;
            y[128 * j] = o0; y[128 * j + 1] = o1; }
    }
}

__device__ __forceinline__ void p5_norm_own(const Frame& F, const Args& a, int pm, int col0, int ncols, int row0g, int nrows, unsigned* cnt, unsigned want) {
    int tid = F.tid; asm volatile("" : "+v"(tid));
    if (F.tid == 0) { unsigned sp = 0; while (__hip_atomic_load(cnt, RLX_AGENT) < want) { __builtin_amdgcn_s_sleep(4); if (++sp > (1u << 22)) break; } }
    asm volatile("s_waitcnt vmcnt(0)" ::: "memory");
    __syncthreads();
    LAS float* rs = (LAS float*)(F.lds + RING_OFF);
    const float* ss = (const float*)(a.ws + WS_CTL) + CW_SS3;
    if (tid < nrows) rs[tid] = 1.0f / sqrtf(__uint_as_float(__hip_atomic_load((const unsigned*)(ss + row0g + tid), RLX_AGENT)) * (1.0f / DM) + EPS);
    __syncthreads();
    const bf16* X2B = (const bf16*)(a.ws + WS_XN);
    const int pcs = ncols >> 3;
    if (ncols == 1024 && (nrows & 31) == 0) {
        const int cp = tid & 127, rb = tid >> 7, c = col0 + 8 * cp;
        const f32x4 g0 = *(const GAS f32x4*)(a.in[I_FNW] + c), g1 = *(const GAS f32x4*)(a.in[I_FNW] + c + 4);
        for (int j0 = 0; j0 < nrows / 4; j0 += 8) {
            v4u x[8];
#pragma unroll
            for (int q = 0; q < 8; ++q) x[q] = *(const GAS v4u*)(X2B + (size_t)(row0g + rb + 4 * (j0 + q)) * DM + c);
#pragma unroll
            for (int q = 0; q < 8; ++q) { const int r = rb + 4 * (j0 + q), row = row0g + r; const float rr = rs[r];
                f32x4 o0, o1;
                o0.x = __uint_as_float(x[q].x << 16) * rr * g0.x; o0.y = __uint_as_float(x[q].x & 0xffff0000u) * rr * g0.y; o0.z = __uint_as_float(x[q].y << 16) * rr * g0.z; o0.w = __uint_as_float(x[q].y & 0xffff0000u) * rr * g0.w;
                o1.x = __uint_as_float(x[q].z << 16) * rr * g1.x; o1.y = __uint_as_float(x[q].z & 0xffff0000u) * rr * g1.y; o1.z = __uint_as_float(x[q].w << 16) * rr * g1.z; o1.w = __uint_as_float(x[q].w & 0xffff0000u) * rr * g1.w;
                float* y = a.out + (row < MP ? O_YP + (size_t)row * DM : O_YS + (size_t)(row - MP) * DM) + c;
                *(GAS f32x4*)y = o0; *(GAS f32x4*)(y + 4) = o1; }
        }
    } else
    for (int i = tid; i < nrows * pcs; i += NWAVES * 64) {
        const int r = i / pcs, c = col0 + 8 * (i - r * pcs); const int row = row0g + r;
        const v4u x = *(const GAS v4u*)(X2B + (size_t)row * DM + c);
        const f32x4 g0 = *(const GAS f32x4*)(a.in[I_FNW] + c), g1 = *(const GAS f32x4*)(a.in[I_FNW] + c + 4); const float rr = rs[r];
        f32x4 o0, o1;
        o0.x = __uint_as_float(x.x << 16) * rr * g0.x; o0.y = __uint_as_float(x.x & 0xffff0000u) * rr * g0.y; o0.z = __uint_as_float(x.y << 16) * rr * g0.z; o0.w = __uint_as_float(x.y & 0xffff0000u) * rr * g0.w;
        o1.x = __uint_as_float(x.z << 16) * rr * g1.x; o1.y = __uint_as_float(x.z & 0xffff0000u) * rr * g1.y; o1.z = __uint_as_float(x.w << 16) * rr * g1.z; o1.w = __uint_as_float(x.w & 0xffff0000u) * rr * g1.w;
        float* y = a.out + (row < MP ? O_YP + (size_t)row * DM : O_YS + (size_t)(row - MP) * DM) + c;
        *(GAS f32x4*)y = o0; *(GAS f32x4*)(y + 4) = o1;
    }
    __syncthreads();
}

#ifndef P4_INT8
#define P4_INT8 1
#endif
#ifndef GEMM_ALIGN
#define GEMM_ALIGN true
#endif
#ifndef GEMM_SP2
#define GEMM_SP2 true
#endif
#ifndef GEMM_DIM16
#define GEMM_DIM16 false
#endif
#ifndef P4_WGM
#define P4_WGM 8
#endif
#ifndef P5_NT
#define P5_NT 0
#endif
#ifndef GEMM_DIM
#define GEMM_DIM false
#endif
#ifndef TEST_STAGE
#define TEST_STAGE 99
#endif
__global__ void __launch_bounds__(NWAVES * 64, 2) fwd(Args args) {
    extern __shared__ __attribute__((aligned(16))) unsigned char lds[];
    Frame F;
    F.lds = (LAS unsigned char*)lds;
    F.MISC = (volatile LAS unsigned*)(F.lds + MISC_OFF);
    F.tid = threadIdx.x; F.lane = F.tid & 63; F.wave = __builtin_amdgcn_readfirstlane(F.tid >> 6);
    F.G = gridDim.x; { const int bx = blockIdx.x; F.vcu = (F.G % 8 == 0) ? (bx % 8) * (F.G / 8) + bx / 8 : bx; }
    unsigned char* ws = args.ws;
    F.ctl = (gu32*)(ws + WS_CTL);
    for (int u = F.tid; u < (LDS_BYTES - LDSCTL_OFF) / 4; u += NWAVES * 64) ((LAS unsigned*)(F.lds + LDSCTL_OFF))[u] = 0u;
    __syncthreads();
    XcdBarrier bar = xcd_barrier_post((unsigned*)(F.ctl + CW_BAR), F.MISC + 8);
#define GRID_BAR() xcd_barrier(bar)
    bf16* WinT = (bf16*)(ws + WS_WIN); bf16* WoT = (bf16*)(ws + WS_WO); bf16* WguT = (bf16*)(ws + WS_WGU); bf16* WdT = (bf16*)(ws + WS_WD);
    bf16* XN = (bf16*)(ws + WS_XN); bf16* Qb = (bf16*)(ws + WS_Q); bf16* Kb = (bf16*)(ws + WS_KB); bf16* Vb = (bf16*)(ws + WS_VB); bf16* Zb = (bf16*)(ws + WS_Z);
    bf16* XBC = (bf16*)(ws + WS_XBC); float* DT = (float*)(ws + WS_DT); bf16* Kext = (bf16*)(ws + WS_KEXT); bf16* Vext = (bf16*)(ws + WS_VEXT);
    bf16* MIX = (bf16*)(ws + WS_MIX); bf16* X1B = (bf16*)(ws + WS_X1B); bf16* HB = (bf16*)(ws + WS_H); bf16* X2B = (bf16*)(ws + WS_XN);
    float* SS2 = (float*)(ws + WS_CTL) + CW_SS2; float* SS3 = (float*)(ws + WS_CTL) + CW_SS3;

#if defined(PROBE_SPIN_A) && !defined(PROBE_TIMING)
#define PROBE_TIMING 1
#endif
#ifdef PROBE_TIMING
#define STAMP(k) do { if (blockIdx.x == 0 && F.tid == 0) { const unsigned long long t_ = __builtin_amdgcn_s_memrealtime(); F.MISC[16 + 2 * (k)] = (unsigned)t_; F.MISC[17 + 2 * (k)] = (unsigned)(t_ >> 32); } } while (0)
#else
#define STAMP(k) do { } while (0)
#endif
    unsigned long long sp_t0 = 0; (void)sp_t0;
#ifdef PROBE_SPREAD
#define SPREAD_T0(k) do { if ((k) == PROBE_SPREAD) sp_t0 = __builtin_amdgcn_s_memrealtime(); } while (0)
#define SPREAD_T1(k) do { if ((k) == PROBE_SPREAD && F.tid == 0) { const unsigned d_ = (unsigned)(__builtin_amdgcn_s_memrealtime() - sp_t0); __hip_atomic_fetch_add(F.ctl + CW_TMO + 4, d_, RLX_AGENT); __hip_atomic_fetch_add(F.ctl + CW_TMO + 32 + (blockIdx.x & 7), d_, RLX_AGENT); } } while (0)
#define SPREAD_T2(k) do { if ((k) == PROBE_SPREAD && blockIdx.x == 0 && F.tid == 0) { F.MISC[16 + 2 * 21] = __hip_atomic_load(F.ctl + CW_TMO + 4, RLX_AGENT) / (unsigned)F.G; F.MISC[17 + 2 * 21] = 0u; \
        F.MISC[16 + 2 * 22] = (unsigned)(__builtin_amdgcn_s_memrealtime() - sp_t0); F.MISC[17 + 2 * 22] = 0u; \
        unsigned mx_ = 0u, mn_ = 0xffffffffu; for (int x_ = 0; x_ < 8; ++x_) { const unsigned v_ = __hip_atomic_load(F.ctl + CW_TMO + 32 + x_, RLX_AGENT) / (unsigned)(F.G / 8); mx_ = v_ > mx_ ? v_ : mx_; mn_ = v_ < mn_ ? v_ : mn_; } \
        F.MISC[16 + 2 * 23] = mn_; F.MISC[17 + 2 * 23] = 0u; F.MISC[16 + 2 * 24] = mx_; F.MISC[17 + 2 * 24] = 0u; } } while (0)
#else
#define SPREAD_T0(k) do { } while (0)
#define SPREAD_T1(k) do { } while (0)
#define SPREAD_T2(k) do { } while (0)
#endif
    STAMP(0);
    p0_prologue(F, args);
#ifdef PROBE_P0_REPS
    for (int rep = 1; rep < PROBE_P0_REPS; ++rep) { GRID_BAR(); p0_prologue(F, args); }
#endif
#if TEST_STAGE < 99
    {
        const size_t gt = (size_t)F.vcu * NWAVES * 64 + F.tid, NT = (size_t)F.G * NWAVES * 64;
        GAS f32x4* o = (GAS f32x4*)args.out;
        for (size_t i = gt; i < O_END / 4; i += NT) {
            const size_t e = i * 4;
            bool keep = false;
#if TEST_STAGE >= 1
            keep = (e >= O_KP && e < O_SP) || (e >= O_KS && e < O_SS);
#endif
#if TEST_STAGE >= 2
            keep = keep || (e >= O_SP && e < O_KS) || (e >= O_SS);
#endif
            if (!keep) o[i] = (f32x4){0.f, 0.f, 0.f, 0.f};
        }
    }
#endif
    GRID_BAR();
    STAMP(1); SPREAD_T0(1);

#ifndef PROBE_P1_REPS
#define PROBE_P1_REPS 1
#endif
#ifndef PROBE_P4_REPS
#define PROBE_P4_REPS 1
#endif
    for (int rep = 0; rep < PROBE_P1_REPS; ++rep) {
        if (rep > 0) GRID_BAR();
        pg8::Gemm g{XN, WinT, MP, 12288, DM}; pg8::StaticOrder S; S.init(MP, 12288, F.G, (int)blockIdx.x);
        pg8::EpiInProj E{Qb, Kb, Vb, Zb, XBC, Kext, Vext, DT, args.out};
#ifdef PROBE_P1_LIGHT
        if (rep > 0) { pg8::EpiProbe EP{(bf16*)(ws + WS_DUMMY), 12288}; pg8::gemm_phase<pg8::EpiProbe, pg8::StaticOrder, GEMM_ALIGN, GEMM_SP2, 0, GEMM_DIM16>(F.lds + RING_OFF, g, S, EP); } else
#endif
        pg8::gemm_phase<pg8::EpiInProj, pg8::StaticOrder, GEMM_ALIGN, GEMM_SP2, 0, GEMM_DIM16>(F.lds + RING_OFF, g, S, E);
    }
    STAMP(11); SPREAD_T1(1);
#ifndef PROBE_SK1_REPS
#define PROBE_SK1_REPS 1
#endif
#ifndef PROBE_SK4_REPS
#define PROBE_SK4_REPS 1
#endif
    for (int rep = 0; rep < PROBE_SK1_REPS; ++rep) {
        const sk::EpiInS E1{WinT, Qb, Zb, XBC, Kext, Vext, DT, args.out};
        sk::skinny<8, 1, true>(F.lds + RING_OFF, XN + (size_t)MP * DM, DM, DM, NIN / 16, E1, F.wave, F.lane, (int)blockIdx.x, F.G);
        STAMP(13);
        const sk::EpiDtP E2{XN, DT};
        sk::skinny<2, 1, true>(F.lds + RING_OFF, WinT + (size_t)12288 * DM, DM, DM, MP / 16, E2, F.wave, F.lane, (int)((blockIdx.x + F.G / 2) % F.G), F.G);
    }
#if TEST_STAGE >= 2
    GRID_BAR();
    STAMP(2); SPREAD_T2(1);

    {
        float lam;
        { const float a = F.lane < 64 ? args.in[I_LQ1][F.lane] * args.in[I_LK1][F.lane] : 0.f, b = args.in[I_LQ2][F.lane] * args.in[I_LK2][F.lane];
          lam = __expf(wave_sum(a)) - __expf(wave_sum(b)) + LAM0; }
        const ssd::Params SP{args.in[I_CONVW], args.in[I_CONVB], args.in[I_DTB], args.in[I_ALOG], args.in[I_DSKIP], args.in[I_SSDNW]};
        constexpr int NSEG = 4, SEGLEN = SEQ / NSEG, NBG = NB * SG;
        constexpr int JS = 736  ;
        constexpr int E0 = (NSEG - 1) * NBG, E1 = E0 + NBG, E2 = E1 + 192, E3 = E2 + (NSEG - 1) * NBG, E4 = E3 + (JS - 192), E5 = E4 + DEC_B * NH, E6 = E5 + (1024 - JS), E7 = E6 + DEC_B * SG, NITEMS = E7;
        float* FSEG = (float*)(ws + WS_F);
#ifndef PROBE_MIX_REPS
#define PROBE_MIX_REPS 1
#define PROBE_MIX_SKIP 0
#endif
        for (int rep = 0; rep < PROBE_MIX_REPS; ++rep) {
        if (rep > 0) GRID_BAR();
        for (;;) {
            if (F.tid == 0) F.MISC[0] = __hip_atomic_fetch_add(F.ctl + CW_QUEUE + 64 * rep, 1u, RLX_AGENT);
            __syncthreads();
            const int pos = (int)F.MISC[0];
            __syncthreads();
            constexpr int NPOS = 256 + 3 * CONV_ITEMS;
            if (pos >= NPOS) break;
            int item = pos;
            if (pos >= 256) { const int q = pos - 256, grp = q / 3, r = q - 3 * grp;
                if (r == 2) { if (rep == 0) p0_deferred_item(F, args, grp); __syncthreads(); continue; }
                item = 256 + 2 * grp + r; }
            if (item >= NITEMS) continue;
            const bool is_ssd = item < E1 || (item >= E2 && item < E3) || item >= E6;
            if (rep > 0 && ((PROBE_MIX_SKIP == 1 && is_ssd) || (PROBE_MIX_SKIP == 2 && !is_ssd))) continue;
            if (is_ssd) {
                ssd::Unit u; bool pre = false;
                if (item < E6) {
                    int seg, bg;
                    if (item < E0) { pre = true; seg = item / NBG; bg = item % NBG; }
                    else if (item < E1) { seg = 0; bg = item - E0; }
                    else { const int k = item - E2; seg = 1 + k / NBG; bg = k % NBG; }
                    const int b = bg >> 3; u.g = bg & 7; const size_t r0 = (size_t)b * SEQ + (size_t)seg * SEGLEN;
                    u.xbc = XBC + r0 * CONVD; u.z = Zb + r0 * SSDI; u.dtraw = DT + r0 * SH; u.hist = nullptr; u.init = nullptr;
                    u.fin = args.out + O_SP + (size_t)b * SH * SHD * DS; u.y = MIX + r0 * DM + AW; u.len = SEGLEN;
                    u.prev = seg > 0; u.seg = seg; u.fseg = FSEG + (size_t)bg * (NSEG - 1) * ssd::FSTRIDE; u.flag = (unsigned*)(F.ctl + CW_SSDF + 64 * bg) + 16 * rep; u.last = seg == NSEG - 1;
                } else { const int j = item - E6; const int b = j >> 3; u.g = j & 7; const size_t r0 = (size_t)MP + (size_t)b * DEC_T;
                    u.xbc = XBC + r0 * CONVD; u.z = Zb + r0 * SSDI; u.dtraw = DT + r0 * SH; u.hist = args.in[I_SCONV] + (size_t)b * 3 * CONVD; u.init = args.in[I_SSSM] + (size_t)b * SH * SHD * DS;
                    u.fin = args.out + O_SS + (size_t)b * SH * SHD * DS; u.y = MIX + r0 * DM + AW; u.len = DEC_T;
                    u.prev = 0; u.seg = 0; u.fseg = nullptr; u.flag = nullptr; u.last = 1; }
                if (pre) ssd::ssd_unit<true>(F.lds + RING_OFF, u, SP, F.tid, F.wave, F.lane);
                else ssd::ssd_unit<false>(F.lds + RING_OFF, u, SP, F.tid, F.wave, F.lane);
            } else {
                att::Unit u;
                if (item < E4 || item >= E5) { const int j = item < E2 ? item - E1 : item < E4 ? item - E3 + 192 : item - E5 + JS; const int qb = 31 - (j >> 5), bh = j & 31, b = bh >> 4, h = bh & 15; const size_t r0 = (size_t)b * SEQ;
                    u.Q = Qb + (r0 + 256 * qb) * AW + h * HD; u.K = Kb + r0 * AW + h * HD; u.V = Vb + r0 * AW + h * HD; u.O = MIX + (r0 + 256 * qb) * DM + h * HD;
                    u.ntot = 4 * qb + 4; u.nvalid_last = 64; u.sample = 0; u.qb = qb; u.park = nullptr; u.variant = 0;
#ifdef PROBE_ATT_VARIANT
                    if (rep > 0) { u.variant = PROBE_ATT_VARIANT; u.O = (bf16*)(ws + WS_DUMMY) + (r0 + 256 * qb) * DM + h * HD; }
#endif
                    }
                else { const int j = item - E4; const int b = j >> 4, h = j & 15; const size_t r0 = (size_t)MP + (size_t)b * DEC_T;
                    u.Q = Qb + r0 * AW + h * HD; u.K = Kext + (size_t)b * KVROWS * AW + h * HD; u.V = Vext + (size_t)b * KVROWS * AW + h * HD; u.O = MIX + r0 * DM + h * HD;
                    u.ntot = KVROWS / 64; u.nvalid_last = PAST + DEC_T - (KVROWS / 64 - 1) * 64; u.sample = 1; u.qb = 0; u.park = nullptr; u.variant = 0;
                    p2_cache_slice(F, args, b, h);
#ifdef PROBE_ATT_VARIANT
                    if (rep > 0) { u.variant = PROBE_ATT_VARIANT; u.O = (bf16*)(ws + WS_DUMMY) + r0 * DM + h * HD; }
#endif
                    }
                att::attn_unit(F.lds + RING_OFF, u, lam, args.in[I_SUBLN], F.wave, F.lane);
            }
            __syncthreads();
        }
        }
    }
#endif
#if TEST_STAGE >= 3
#ifdef PROBE_TIMING
    if (F.tid == 0) __hip_atomic_fetch_max(F.ctl + CW_TMO + 2, ~(unsigned)__builtin_amdgcn_s_memrealtime(), RLX_AGENT);
#endif
    GRID_BAR();
    STAMP(3); SPREAD_T0(3);
#ifdef PROBE_TIMING
    if (blockIdx.x == 0 && F.tid == 0) { F.MISC[16 + 2 * 20] = ~__hip_atomic_load(F.ctl + CW_TMO + 2, RLX_AGENT); F.MISC[17 + 2 * 20] = F.MISC[17 + 2 * 3]; }
#endif
    {
        if (F.G == 256) {
            const int sl = (int)blockIdx.x & 7;
            const sk::EpiOutPart E1{WoT, (float*)(ws + WS_PARK) + (size_t)sl * MS * DM, 512 * sl};
            sk::skinny<8, 1>(F.lds + RING_OFF, MIX + (size_t)MP * DM + 512 * sl, DM, 512, DM / 16, E1, F.wave, F.lane, (int)blockIdx.x >> 3, 32);
            asm volatile("s_waitcnt vmcnt(0)" ::: "memory"); __syncthreads();
            if (F.tid == 0) { __builtin_amdgcn_fence(__ATOMIC_RELEASE, "agent"); __hip_atomic_fetch_add(F.ctl + CW_SMPC + 64, 1u, RLX_AGENT); }
        }
        pg8::Gemm g{MIX, WoT, MP, DM, DM}; pg8::StaticOrder S; S.init(MP, DM, F.G, (int)blockIdx.x);
        pg8::EpiOutProj E{args.in[I_XP], args.in[I_XS], args.out, X1B, SS2};
        pg8::gemm_phase<pg8::EpiOutProj, pg8::StaticOrder, GEMM_ALIGN, GEMM_SP2, 0, GEMM_DIM16>(F.lds + RING_OFF, g, S, E);
        STAMP(12); SPREAD_T1(3);
#ifdef PROBE_P3_REPS
        for (int rep = 1; rep < PROBE_P3_REPS; ++rep) { GRID_BAR(); pg8::EpiProbe EP{HB, DM}; pg8::gemm_phase<pg8::EpiProbe, pg8::StaticOrder, GEMM_ALIGN, GEMM_SP2, 0, GEMM_DIM16>(F.lds + RING_OFF, g, S, EP); }
#endif
        if (F.G == 256) { if (blockIdx.x < 16) p3_sample_final(F, args, 8 * (int)blockIdx.x + F.wave, (const unsigned*)(F.ctl + CW_SMPC + 64), 256u); }
        else {
            const sk::EpiOutS E1{WoT, args.in[I_XS], args.out, X1B, SS2};
            sk::skinny<8, 1>(F.lds + RING_OFF, MIX + (size_t)MP * DM, DM, DM, DM / 16, E1, F.wave, F.lane, (int)blockIdx.x, F.G);
        }
    }
    GRID_BAR();
#ifdef PROBE_EXTRA_BARS
    for (int i = 0; i < PROBE_EXTRA_BARS; ++i) GRID_BAR();
#endif
    STAMP(4); SPREAD_T2(3);
#if P4_INT8
    p3b_quant_rows(F, args);
    GRID_BAR();
    STAMP(7); SPREAD_T0(4);
#endif
    for (int rep = 0; rep < PROBE_P4_REPS; ++rep) {
        if (rep > 0) GRID_BAR();
#if P4_INT8
        pg8::Gemm g{(const bf16*)(ws + WS_X1Q), (const bf16*)(ws + WS_WGUQ), MPAD, 2 * DFF, DM / 2};
        pg8::EpiGateUpT<true> E{HB, (const float*)(F.ctl + CW_RQ), 1.0f / wq_scale(ws, 0), 1.0f / wq_scale(ws, 1), (bf16*)(ws + WS_HS)};
        if (F.G == 256 && rep == 0) {
            pg8::TailOrder S; S.init(MPAD, 2 * DFF, F.G, (int)blockIdx.x, (unsigned*)(F.ctl + CW_P4T), (volatile LAS unsigned*)(F.MISC + 2));
            pg8::gemm_phase<pg8::EpiGateUpT<true>, pg8::TailOrder, GEMM_ALIGN, GEMM_SP2, 2, GEMM_DIM>(F.lds + RING_OFF, g, S, E);
        } else {
            pg8::StaticOrder S; S.init(MPAD, 2 * DFF, F.G, (int)blockIdx.x);
            pg8::gemm_phase<pg8::EpiGateUpT<true>, pg8::StaticOrder, GEMM_ALIGN, GEMM_SP2, 2, GEMM_DIM>(F.lds + RING_OFF, g, S, E);
        }
#else
        pg8::Gemm g{X1B, WguT, MP, 2 * DFF, DM}; pg8::StaticOrder S; S.init(MP, 2 * DFF, F.G, (int)blockIdx.x);
        pg8::EpiGateUp E{HB, SS2};
        pg8::gemm_phase<pg8::EpiGateUp, pg8::StaticOrder, GEMM_ALIGN, GEMM_SP2, 0, GEMM_DIM16>(F.lds + RING_OFF, g, S, E);
#endif
    }
    SPREAD_T1(4);
#if !P4_INT8
    for (int rep = 0; rep < PROBE_SK4_REPS; ++rep) {
        const sk::EpiGuS E1{WguT, (bf16*)(ws + WS_HS), SS2};
        if (F.G == 256) { if (blockIdx.x >= 128) sk::skinny<8, 2>(F.lds + RING_OFF, X1B + (size_t)MP * DM, DM, DM, DFF / 16, E1, F.wave, F.lane, (int)blockIdx.x - 128, 128); }
        else sk::skinny<8, 2>(F.lds + RING_OFF, X1B + (size_t)MP * DM, DM, DM, DFF / 16, E1, F.wave, F.lane, (int)blockIdx.x, F.G);
    }
#endif
    GRID_BAR();
    STAMP(5); SPREAD_T2(4); SPREAD_T0(5);
    if (F.G == 256) {
        {
            const int sl = (int)blockIdx.x & 7, c0 = sl * 5 + (sl < 3 ? sl : 3), ncs = sl < 3 ? 6 : 5;
            const sk::EpiDownPart E1{WdT, (float*)(ws + WS_PARK) + (size_t)sl * MS * DM, 256 * c0};
            sk::skinny<8, 1>(F.lds + RING_OFF, (const bf16*)(ws + WS_HS) + 256 * c0, DFF, 256 * ncs, DM / 16, E1, F.wave, F.lane, (int)blockIdx.x >> 3, 32);
            asm volatile("s_waitcnt vmcnt(0)" ::: "memory"); __syncthreads();
            if (F.tid == 0) { __builtin_amdgcn_fence(__ATOMIC_RELEASE, "agent"); __hip_atomic_fetch_add(F.ctl + CW_SMPC, 1u, RLX_AGENT); }
        }
        STAMP(10);
        pg8::Gemm g{HB, (const bf16*)(ws + WS_WD8), MP, DM, DFF / 2}; pg8::PanelOrder S; S.init((int)blockIdx.x, (unsigned*)(F.ctl + CW_P5C));
        pg8::EpiDown E{X1B, X2B, SS3};
        pg8::gemm_phase<pg8::EpiDown, pg8::PanelOrder, GEMM_ALIGN, GEMM_SP2, 1, GEMM_DIM>(F.lds + RING_OFF, g, S, E);
        STAMP(8); SPREAD_T1(5);
        p5_norm_own(F, args, S.pm, 1024 * S.q4, 1024, 256 * S.pm, 256, (unsigned*)(F.ctl + CW_P5C) + 64 * S.pm, 128u);
        STAMP(9);
        if (blockIdx.x < 16) p5_sample_final(F, args, 8 * (int)blockIdx.x + F.wave, (const unsigned*)(F.ctl + CW_SMPC), 256u);
    } else {
        {
            pg8::Gemm g{HB, (const bf16*)(ws + WS_WD8), MP, DM, DFF / 2}; pg8::StaticOrder S; S.init(MP, DM, F.G, (int)blockIdx.x);
            pg8::EpiDown E{X1B, X2B, SS3};
            pg8::gemm_phase<pg8::EpiDown, pg8::StaticOrder, GEMM_ALIGN, GEMM_SP2, 1, GEMM_DIM>(F.lds + RING_OFF, g, S, E);
            const sk::EpiDownS E1{WdT, X1B, X2B, SS3};
            sk::skinny<8, 1>(F.lds + RING_OFF, (const bf16*)(ws + WS_HS), DFF, DFF, DM / 16, E1, F.wave, F.lane, (int)blockIdx.x, F.G);
        }
        GRID_BAR();
        p6_final_norm(F, args);
    }
#endif
#ifdef PROBE_SPIN_A
    STAMP(6);
    if (blockIdx.x == 0 && F.tid == 0) {
        const unsigned long long ta = (unsigned long long)F.MISC[16 + 2 * (PROBE_SPIN_A)] | ((unsigned long long)F.MISC[17 + 2 * (PROBE_SPIN_A)] << 32);
        const unsigned long long tb = (unsigned long long)F.MISC[16 + 2 * (PROBE_SPIN_B)] | ((unsigned long long)F.MISC[17 + 2 * (PROBE_SPIN_B)] << 32);
        const unsigned long long d = 4ull * (tb - ta), t0 = __builtin_amdgcn_s_memrealtime();
        while (__builtin_amdgcn_s_memrealtime() - t0 < d) __builtin_amdgcn_s_sleep(32);
    }
#endif
}

extern "C" void kernel_launch(void* const* d_in, const int* in_sizes, int n_in, void* d_out, int out_size, void* d_ws, size_t ws_size, hipStream_t stream) {
    static int grid = 0;
    if (grid == 0) {
        if (n_in != 25 || (size_t)out_size != O_END || ws_size < WS_END) { fprintf(stderr, "kernel_launch: unexpected shapes: n_in %d out %d ws %zu; nothing launched\n", n_in, out_size, ws_size); grid = -1; return; }
        int dev = 0, cus = 0, per_cu = 0;
        if (hipGetDevice(&dev) != hipSuccess || hipDeviceGetAttribute(&cus, hipDeviceAttributeMultiprocessorCount, dev) != hipSuccess) { grid = -1; return; }
        if (hipFuncSetAttribute((const void*)fwd, hipFuncAttributeMaxDynamicSharedMemorySize, LDS_BYTES) != hipSuccess) { fprintf(stderr, "kernel_launch: hipFuncSetAttribute failed\n"); grid = -1; return; }
        if (hipOccupancyMaxActiveBlocksPerMultiprocessor(&per_cu, (const void*)fwd, NWAVES * 64, LDS_BYTES) != hipSuccess || per_cu < 1)
            fprintf(stderr, "kernel_launch: note: occupancy query reports %d workgroups per CU\n", per_cu);
        (void)hipGetLastError();
        grid = cus;
    }
    if (grid < 0) return;
    if (hipMemsetAsync((char*)d_ws + WS_CTL, 0, CTL_ZERO_BYTES, stream) != hipSuccess) return;
    Args a{};
    for (int i = 0; i < 25; ++i) a.in[i] = (const float*)d_in[i];
    a.out = (float*)d_out; a.ws = (unsigned char*)d_ws; a.ph_lo = 0; a.ph_hi = 99;
    hipLaunchKernelGGL(fwd, dim3(grid), dim3(NWAVES * 64), LDS_BYTES, stream, a);
}
```

```cpp
#include <hip/hip_runtime.h>
#include <cstdio>
#include <cstdint>
namespace pg8 {
#define PG8_LAS __attribute__((address_space(3)))
typedef unsigned short bf16_t;
typedef short bf16x8 __attribute__((ext_vector_type(8)));
typedef float f32x4 __attribute__((ext_vector_type(4)));
typedef unsigned u32x4 __attribute__((ext_vector_type(4)));
constexpr int BM = 256, BK = 64, HALF = 128, HTB = HALF * BK * 2  , STAGE_BYTES = 8 * HTB, NXCD = 8, WGM = 8;

__host__ __device__ __forceinline__ int lds_byte(int r, int c) { const int st = (r >> 4) * 2 + (c >> 5), rr = r & 15, cc = c & 31, ob = rr * 64 + cc * 2; return st * 1024 + (ob ^ (((ob >> 9) & 1) << 5)); }
__host__ __device__ __forceinline__ void stage_rc(int b, int& R, int& C) { const int st = b / 1024, sb = b % 1024, swz = sb ^ (((sb >> 9) & 1) << 5); R = (st >> 1) * 16 + swz / 64; C = (st & 1) * 32 + (swz % 64) / 2; }
__host__ __device__ __forceinline__ int perm32(int rho) { const int n = rho >> 4, i = rho & 15; return 8 * (i >> 2) + 4 * n + (i & 3); }

struct Unit { int pm, pn; };
struct Gemm { const bf16_t* A; const bf16_t* Bt; int M, N, K; };

struct StaticOrder {
    int nM, nN, nwg, G, c, wgm;
    __host__ __device__ void init(int M, int N, int G_, int c_) { nM = M / BM; nN = N / BM; nwg = nM * nN; G = G_; c = c_; wgm = WGM; }
    __host__ __device__ bool next(int i, Unit& u) const {
        const long L = (long)i * G + c; if (L >= nwg) return false;
        int wgid = (int)L; { const int q = nwg / NXCD, r = nwg % NXCD, xcd = wgid % NXCD, off = wgid / NXCD; wgid = (xcd < r ? xcd * (q + 1) : r * (q + 1) + (xcd - r) * q) + off; }
        const int nig = wgm * nN, gid = wgid / nig, fm = gid * wgm, gsz = (nM - fm) < wgm ? (nM - fm) : wgm;
        u.pm = fm + ((wgid % nig) % gsz); u.pn = (wgid % nig) / gsz; return true;
    }
    __device__ __forceinline__ void a_ready(const Unit&) const {}
    __device__ __forceinline__ void done(const Unit&) const {}
};

__device__ __forceinline__ unsigned cvt_pk_bf16(float lo, float hi) { unsigned r; asm volatile("v_cvt_pk_bf16_f32 %0, %1, %2" : "=v"(r) : "v"(lo), "v"(hi)); return r; }
typedef float f32x2 __attribute__((ext_vector_type(2)));
template <class Epi, class Sched, bool ALIGN_EPI = false, bool SP2 = false, int QM = 0  , bool DIM = false>
__device__ __forceinline__ void gemm_phase(PG8_LAS unsigned char* lds, const Gemm g, const Sched& S, const Epi& E) {
    constexpr bool FP8 = (QM == 1), INT8 = (QM == 2);
    int tid_ = threadIdx.x; asm volatile("" : "+v"(tid_));
    const int tid = tid_, wid = __builtin_amdgcn_readfirstlane(tid >> 6), lane = tid & 63, wr = wid >> 2, wc = wid & 3, fr = lane & 15, fq = lane >> 4;
    const int K = g.K, nt = K / BK;
    unsigned voffA[2], voffB[2];
#pragma unroll
    for (int i = 0; i < 2; ++i) { int R, C; stage_rc(tid * 16 + i * 8192, R, C); const int Rb = Epi::PERM ? ((R & ~31) + perm32(R & 31)) : R;
        voffA[i] = (unsigned)(R * K + C) * 2u; voffB[i] = (unsigned)(Rb * K + C) * 2u; }
    const size_t kstep = (size_t)(BK * 2);
    const size_t hstep = (size_t)HALF * K * 2;
    const size_t tstep = 2 * hstep;
    const unsigned ldsw = (unsigned)wid * 1024u;
    const int aoff = lds_byte(wr * 64 + fr, FP8 ? fq * 16 : fq * 8), boff = lds_byte(wc * 32 + fr, FP8 ? fq * 16 : fq * 8);
    const int aoff1 = FP8 ? aoff + 16 : aoff + 1024, boff1 = FP8 ? boff + 16 : boff + 1024;
    typedef int v8i_t __attribute__((ext_vector_type(8))); typedef int v4i_t __attribute__((ext_vector_type(4)));
#define PG8_SA(b, h) (((b) * 2 + (h)) * HTB)
#define PG8_SB(b, h) ((4 + (b) * 2 + (h)) * HTB)
#define PG8_STAGE(bufoff, gbase, voff) do { _Pragma("unroll") for (int _i = 0; _i < 2; ++_i) \
        __builtin_amdgcn_global_load_lds((const unsigned*)((const char*)(gbase) + (voff)[_i]), (PG8_LAS unsigned*)(lds + (bufoff) + ldsw + _i * 8192), 16, 0, 0); } while (0)
#define PG8_CAT8(x, y) __builtin_shufflevector(__builtin_bit_cast(v4i_t, x), __builtin_bit_cast(v4i_t, y), 0, 1, 2, 3, 4, 5, 6, 7)
#define PG8_LDA(dst, b, h) do { if constexpr (FP8) { _Pragma("unroll") for (int m = 0; m < 4; ++m) dst##8[m] = PG8_CAT8(*(const PG8_LAS bf16x8*)(lds + PG8_SA(b, h) + aoff + m * 2048), *(const PG8_LAS bf16x8*)(lds + PG8_SA(b, h) + aoff1 + m * 2048)); } \
        else { _Pragma("unroll") for (int m = 0; m < 4; ++m) _Pragma("unroll") for (int k = 0; k < 2; ++k) dst[m][k] = *(const PG8_LAS bf16x8*)(lds + PG8_SA(b, h) + (k ? aoff1 : aoff) + m * 2048); } } while (0)
#define PG8_LDB(dst, b, h) do { if constexpr (FP8) { _Pragma("unroll") for (int n = 0; n < 2; ++n) dst##8[n] = PG8_CAT8(*(const PG8_LAS bf16x8*)(lds + PG8_SB(b, h) + boff + n * 2048), *(const PG8_LAS bf16x8*)(lds + PG8_SB(b, h) + boff1 + n * 2048)); } \
        else { _Pragma("unroll") for (int n = 0; n < 2; ++n) _Pragma("unroll") for (int k = 0; k < 2; ++k) dst[n][k] = *(const PG8_LAS bf16x8*)(lds + PG8_SB(b, h) + (k ? boff1 : boff) + n * 2048); } } while (0)
#define PG8_MMA(ai, bj, At, Bt) do { __builtin_amdgcn_s_setprio(1); \
        if constexpr (FP8) { _Pragma("unroll") for (int m = 0; m < 4; ++m) _Pragma("unroll") for (int n = 0; n < 2; ++n) \
            asm volatile("v_mfma_scale_f32_16x16x128_f8f6f4 %0, %1, %2, %0, %3, %3 op_sel_hi:[0,0,0]" : "+v"(acc[ai][bj][m][n]) : "v"(Bt##8[n]), "v"(At##8[m]), "v"(sc8_)); } \
        else if constexpr (INT8) { _Pragma("unroll") for (int m = 0; m < 4; ++m) _Pragma("unroll") for (int n = 0; n < 2; ++n) _Pragma("unroll") for (int k = 0; k < 2; ++k) \
            acc[ai][bj][m][n] = __builtin_bit_cast(f32x4, __builtin_amdgcn_mfma_i32_16x16x64_i8(__builtin_bit_cast(v4i_t, Bt[n][k]), __builtin_bit_cast(v4i_t, At[m][k]), __builtin_bit_cast(v4i_t, acc[ai][bj][m][n]), 0, 0, 0)); } \
        else { _Pragma("unroll") for (int m = 0; m < 4; ++m) _Pragma("unroll") for (int n = 0; n < 2; ++n) _Pragma("unroll") for (int k = 0; k < 2; ++k) \
            acc[ai][bj][m][n] = __builtin_amdgcn_mfma_f32_16x16x32_bf16(Bt[n][k], At[m][k], acc[ai][bj][m][n], 0, 0, 0); } \
        __builtin_amdgcn_s_setprio(0); } while (0)
#define PG8_MMAH(ai, bj, At, Bt, m0) do { \
        if constexpr (FP8) { _Pragma("unroll") for (int m = m0; m < m0 + 2; ++m) _Pragma("unroll") for (int n = 0; n < 2; ++n) \
            asm volatile("v_mfma_scale_f32_16x16x128_f8f6f4 %0, %1, %2, %0, %3, %3 op_sel_hi:[0,0,0]" : "+v"(acc[ai][bj][m][n]) : "v"(Bt##8[n]), "v"(At##8[m]), "v"(sc8_)); } \
        else if constexpr (INT8) { _Pragma("unroll") for (int m = m0; m < m0 + 2; ++m) _Pragma("unroll") for (int n = 0; n < 2; ++n) _Pragma("unroll") for (int k = 0; k < 2; ++k) \
            acc[ai][bj][m][n] = __builtin_bit_cast(f32x4, __builtin_amdgcn_mfma_i32_16x16x64_i8(__builtin_bit_cast(v4i_t, Bt[n][k]), __builtin_bit_cast(v4i_t, At[m][k]), __builtin_bit_cast(v4i_t, acc[ai][bj][m][n]), 0, 0, 0)); } \
        else { _Pragma("unroll") for (int m = m0; m < m0 + 2; ++m) _Pragma("unroll") for (int n = 0; n < 2; ++n) _Pragma("unroll") for (int k = 0; k < 2; ++k) \
            acc[ai][bj][m][n] = __builtin_amdgcn_mfma_f32_16x16x32_bf16(Bt[n][k], At[m][k], acc[ai][bj][m][n], 0, 0, 0); } } while (0)
#define PG8_WAIT_V(n) asm volatile("s_waitcnt vmcnt(" #n ")" ::: "memory")
#define PG8_WAIT_L(n) asm volatile("s_waitcnt lgkmcnt(" #n ")" ::: "memory")
#define PG8_BAR __builtin_amdgcn_s_barrier()
#define PG8_SCHED __builtin_amdgcn_sched_barrier(0)
    Unit cur, nxt; int ui = 0;
    if (!S.next(0, cur)) return;
    f32x4 acc[2][2][4][2];
#pragma unroll
    for (int a = 0; a < 2; ++a)
#pragma unroll
        for (int b = 0; b < 2; ++b)
#pragma unroll
            for (int m = 0; m < 4; ++m)
#pragma unroll
                for (int n = 0; n < 2; ++n) acc[a][b][m][n] = (f32x4){0.f, 0.f, 0.f, 0.f};
    bf16x8 At[4][2], B0[2][2], B1[2][2]; v8i_t At8[4], B08[2], B18[2]; const int sc8_ = 0x7f7f7f7f;
    const char* cA = (const char*)g.A + (size_t)cur.pm * tstep; const char* cB = (const char*)g.Bt + (size_t)cur.pn * tstep;
    S.a_ready(cur);
    if constexpr (SP2) {
        PG8_STAGE(PG8_SB(0, 0), cB, voffB); PG8_STAGE(PG8_SB(0, 1), cB + hstep, voffB); PG8_STAGE(PG8_SA(0, 0), cA, voffA); PG8_STAGE(PG8_SA(0, 1), cA + hstep, voffA);
        if (wr == 1) PG8_BAR;
        PG8_WAIT_V(2); PG8_BAR;
        PG8_STAGE(PG8_SB(1, 0), cB + kstep, voffB); PG8_STAGE(PG8_SA(1, 0), cA + kstep, voffA); PG8_STAGE(PG8_SB(1, 1), cB + hstep + kstep, voffB);
        PG8_WAIT_V(6); PG8_BAR;
    } else {
        PG8_STAGE(PG8_SB(0, 0), cB, voffB); PG8_STAGE(PG8_SA(0, 0), cA, voffA); PG8_STAGE(PG8_SB(0, 1), cB + hstep, voffB); PG8_STAGE(PG8_SA(0, 1), cA + hstep, voffA);
        if (wr == 1) PG8_BAR;
        PG8_WAIT_V(4); PG8_BAR;
        PG8_STAGE(PG8_SB(1, 0), cB + kstep, voffB); PG8_STAGE(PG8_SA(1, 0), cA + kstep, voffA); PG8_STAGE(PG8_SB(1, 1), cB + hstep + kstep, voffB);
        PG8_WAIT_V(6); PG8_BAR;
    }
    for (;;) {
        const bool has_next = S.next(ui + 1, nxt);
        const char* nA = has_next ? (const char*)g.A + (size_t)nxt.pm * tstep : cA; const char* nB = has_next ? (const char*)g.Bt + (size_t)nxt.pn * tstep : cB;
        for (int t = 0; t < nt; t += 2) {
            const bool last = (t == nt - 2);
            const char* a1 = cA + (size_t)(t + 1) * kstep;
            const char* a2 = last ? nA : cA + (size_t)(t + 2) * kstep; const char* b2 = last ? nB : cB + (size_t)(t + 2) * kstep;
            const char* a3 = a2 + kstep; const char* b3 = b2 + kstep;
            if (last && has_next) S.a_ready(nxt);
            if constexpr (SP2 && DIM) {
            PG8_LDB(B0, 0, 0); PG8_LDB(B1, 0, 1); PG8_SCHED; PG8_LDA(At, 0, 0);
            PG8_WAIT_V(6); PG8_WAIT_L(0); PG8_BAR; __builtin_amdgcn_s_setprio(1); PG8_MMAH(0, 0, At, B0, 0); PG8_MMAH(0, 0, At, B0, 2); PG8_SCHED; PG8_STAGE(PG8_SA(1, 1), a1 + hstep, voffA); PG8_SCHED; PG8_MMAH(0, 1, At, B1, 0); PG8_MMAH(0, 1, At, B1, 2); __builtin_amdgcn_s_setprio(0); PG8_BAR; PG8_SCHED;
            PG8_LDA(At, 0, 1);
            PG8_WAIT_V(2); PG8_WAIT_L(0); PG8_BAR; __builtin_amdgcn_s_setprio(1); PG8_MMAH(1, 0, At, B0, 0); PG8_SCHED; PG8_STAGE(PG8_SB(0, 0), b2, voffB); PG8_SCHED; PG8_MMAH(1, 0, At, B0, 2); PG8_SCHED; PG8_STAGE(PG8_SB(0, 1), b2 + hstep, voffB); PG8_SCHED;
            PG8_MMAH(1, 1, At, B1, 0); PG8_SCHED; PG8_STAGE(PG8_SA(0, 0), a2, voffA); PG8_SCHED; PG8_MMAH(1, 1, At, B1, 2); __builtin_amdgcn_s_setprio(0); PG8_BAR; PG8_SCHED;
            PG8_LDB(B0, 1, 0); PG8_LDB(B1, 1, 1); PG8_SCHED; PG8_LDA(At, 1, 0);
            PG8_WAIT_V(6); PG8_WAIT_L(0); PG8_BAR; __builtin_amdgcn_s_setprio(1); PG8_MMAH(0, 0, At, B0, 0); PG8_MMAH(0, 0, At, B0, 2); PG8_SCHED; PG8_STAGE(PG8_SA(0, 1), a2 + hstep, voffA); PG8_SCHED; PG8_MMAH(0, 1, At, B1, 0); PG8_MMAH(0, 1, At, B1, 2); __builtin_amdgcn_s_setprio(0); PG8_BAR; PG8_SCHED;
            PG8_LDA(At, 1, 1);
            PG8_WAIT_V(2); PG8_WAIT_L(0); PG8_BAR; __builtin_amdgcn_s_setprio(1); PG8_MMAH(1, 0, At, B0, 0); PG8_SCHED; PG8_STAGE(PG8_SB(1, 0), b3, voffB); PG8_SCHED; PG8_MMAH(1, 0, At, B0, 2); PG8_SCHED; PG8_STAGE(PG8_SB(1, 1), b3 + hstep, voffB); PG8_SCHED;
            PG8_MMAH(1, 1, At, B1, 0); PG8_SCHED; PG8_STAGE(PG8_SA(1, 0), a3, voffA); PG8_SCHED; PG8_MMAH(1, 1, At, B1, 2); __builtin_amdgcn_s_setprio(0); PG8_BAR; PG8_SCHED;
            } else if constexpr (SP2) {
            PG8_LDB(B0, 0, 0); PG8_LDB(B1, 0, 1); PG8_SCHED; PG8_LDA(At, 0, 0); PG8_STAGE(PG8_SA(1, 1), a1 + hstep, voffA);
            PG8_WAIT_V(8); PG8_WAIT_L(0); PG8_BAR; PG8_MMA(0, 0, At, B0); PG8_MMA(0, 1, At, B1); PG8_BAR; PG8_SCHED;
            PG8_LDA(At, 0, 1); PG8_STAGE(PG8_SB(0, 0), b2, voffB); PG8_STAGE(PG8_SB(0, 1), b2 + hstep, voffB); PG8_STAGE(PG8_SA(0, 0), a2, voffA);
            PG8_WAIT_V(8); PG8_WAIT_L(0); PG8_BAR; PG8_MMA(1, 0, At, B0); PG8_MMA(1, 1, At, B1); PG8_BAR; PG8_SCHED;
            PG8_LDB(B0, 1, 0); PG8_LDB(B1, 1, 1); PG8_SCHED; PG8_LDA(At, 1, 0); PG8_STAGE(PG8_SA(0, 1), a2 + hstep, voffA);
            PG8_WAIT_V(8); PG8_WAIT_L(0); PG8_BAR; PG8_MMA(0, 0, At, B0); PG8_MMA(0, 1, At, B1); PG8_BAR; PG8_SCHED;
            PG8_LDA(At, 1, 1); PG8_STAGE(PG8_SB(1, 0), b3, voffB); PG8_STAGE(PG8_SB(1, 1), b3 + hstep, voffB); PG8_STAGE(PG8_SA(1, 0), a3, voffA);
            PG8_WAIT_V(8); PG8_WAIT_L(0); PG8_BAR; PG8_MMA(1, 0, At, B0); PG8_MMA(1, 1, At, B1); PG8_BAR; PG8_SCHED;
            } else {
            PG8_LDB(B0, 0, 0); PG8_SCHED; PG8_LDA(At, 0, 0); PG8_STAGE(PG8_SA(1, 1), a1 + hstep, voffA);
            PG8_WAIT_L(8); PG8_BAR; PG8_WAIT_L(0); PG8_MMA(0, 0, At, B0); PG8_BAR; PG8_SCHED;
            PG8_LDB(B1, 0, 1); PG8_STAGE(PG8_SB(0, 0), b2, voffB);
            PG8_BAR; PG8_WAIT_L(0); PG8_MMA(0, 1, At, B1); PG8_BAR;
            PG8_LDA(At, 0, 1); PG8_STAGE(PG8_SA(0, 0), a2, voffA);
            PG8_BAR; PG8_WAIT_L(0); PG8_MMA(1, 0, At, B0); PG8_BAR; PG8_SCHED;
            PG8_STAGE(PG8_SB(0, 1), b2 + hstep, voffB);
            PG8_WAIT_V(6); PG8_BAR; PG8_MMA(1, 1, At, B1); PG8_BAR;
            PG8_LDB(B0, 1, 0); PG8_SCHED; PG8_LDA(At, 1, 0); PG8_STAGE(PG8_SA(0, 1), a2 + hstep, voffA);
            PG8_WAIT_L(8); PG8_BAR; PG8_WAIT_L(0); PG8_MMA(0, 0, At, B0); PG8_BAR; PG8_SCHED;
            PG8_LDB(B1, 1, 1); PG8_STAGE(PG8_SB(1, 0), b3, voffB);
            PG8_BAR; PG8_WAIT_L(0); PG8_MMA(0, 1, At, B1); PG8_BAR;
            PG8_LDA(At, 1, 1); PG8_STAGE(PG8_SA(1, 0), a3, voffA);
            PG8_BAR; PG8_WAIT_L(0); PG8_MMA(1, 0, At, B0); PG8_BAR; PG8_SCHED;
            PG8_STAGE(PG8_SB(1, 1), b3 + hstep, voffB);
            PG8_WAIT_V(6); PG8_BAR; PG8_MMA(1, 1, At, B1); PG8_BAR;
            }
        }
        if constexpr (ALIGN_EPI) { if (wr == 0) PG8_BAR; }
        if constexpr (FP8) asm volatile("s_nop 15\n\ts_nop 7" ::: "memory");
        if constexpr (!Epi::AFTER_DRAIN) { E(acc, cur, wr, wc, fr, fq); S.done(cur); }
        if (!has_next) break;
#pragma unroll
        for (int a = 0; a < 2; ++a)
#pragma unroll
            for (int b = 0; b < 2; ++b)
#pragma unroll
                for (int m = 0; m < 4; ++m)
#pragma unroll
                    for (int n = 0; n < 2; ++n) acc[a][b][m][n] = (f32x4){0.f, 0.f, 0.f, 0.f};
        cur = nxt; cA = nA; cB = nB; ++ui;
        if constexpr (ALIGN_EPI) { if (wr == 1) PG8_BAR; }
    }
    PG8_WAIT_V(0);
    if constexpr (!ALIGN_EPI) { if (wr == 0) PG8_BAR; }
    PG8_BAR;
    if constexpr (Epi::AFTER_DRAIN) { E.fused(acc, cur, wr, wc, fr, fq, lds, wid, lane); S.done(cur); }
#undef PG8_SA
#undef PG8_SB
#undef PG8_STAGE
#undef PG8_LDA
#undef PG8_LDB
#undef PG8_MMA
#undef PG8_MMAH
#undef PG8_CAT8
#undef PG8_WAIT_V
#undef PG8_WAIT_L
#undef PG8_BAR
#undef PG8_SCHED
}
}

#ifndef TEST_ALPHA
#define TEST_ALPHA 1.0f
#endif
constexpr int DM = 4096, SEQ = 8192, NB = 2, MP = NB * SEQ  , MS = 128  , MR = MP + MS  , MPAD = 16640  ;
constexpr int DEC_B = 8, DEC_T = 16, PAST = 2048, KVROWS = 2112  ;
constexpr int AW = 2048, NH = 16, HD = 128, QKD = 64, SSDI = 2048, SH = 32, SHD = 64, SG = 8, DS = 128, CONVD = 4096, DFF = 11008;
constexpr int NIN = 12320, NINP = 12544  ;
constexpr float EPS = 1e-6f;
constexpr float LAM0 = 0.2f;
constexpr float QSCALE = 0.125f * 1.4426950408889634f;
constexpr size_t O_YP = 0, O_YS = O_YP + (size_t)MP * DM, O_KP = O_YS + (size_t)MS * DM, O_VP = O_KP + (size_t)MP * AW, O_CP = O_VP + (size_t)MP * AW,
                 O_SP = O_CP + (size_t)NB * 3 * CONVD, O_KS = O_SP + (size_t)NB * SH * SHD * DS, O_VS = O_KS + (size_t)MS * AW, O_CS = O_VS + (size_t)MS * AW,
                 O_SS = O_CS + (size_t)DEC_B * 3 * CONVD, O_END = O_SS + (size_t)DEC_B * SH * SHD * DS;
static_assert(O_END == 138010624ull, "output size");

namespace pg8 {
typedef unsigned u32x2 __attribute__((ext_vector_type(2)));
__device__ __forceinline__ u32x4 pack8(const f32x4 a, const f32x4 b) { u32x4 w; w.x = cvt_pk_bf16(a[0], a[1]); w.y = cvt_pk_bf16(a[2], a[3]); w.z = cvt_pk_bf16(b[0], b[1]); w.w = cvt_pk_bf16(b[2], b[3]); return w; }

__device__ __forceinline__ unsigned pk4_fp8(float a, float b, float c, float d) { int p = 0; p = __builtin_amdgcn_cvt_pk_fp8_f32(a, b, p, false); p = __builtin_amdgcn_cvt_pk_fp8_f32(c, d, p, true); return (unsigned)p; }
__device__ __forceinline__ unsigned pk4_i8(float a, float b, float c, float d) {
    const int ia = (int)__builtin_rintf(__builtin_fminf(__builtin_fmaxf(a, -127.f), 127.f)), ib = (int)__builtin_rintf(__builtin_fminf(__builtin_fmaxf(b, -127.f), 127.f));
    const int ic = (int)__builtin_rintf(__builtin_fminf(__builtin_fmaxf(c, -127.f), 127.f)), id = (int)__builtin_rintf(__builtin_fminf(__builtin_fmaxf(d, -127.f), 127.f));
    return (unsigned)(ia & 255) | ((unsigned)(ib & 255) << 8) | ((unsigned)(ic & 255) << 16) | ((unsigned)id << 24);
}
constexpr float W8I_CLIP = 32.0f;
constexpr float H8_SCALE = 4.0f, WD8_SCALE = 128.0f;

struct EpiInProj {
    static constexpr bool PERM = true, AFTER_DRAIN = false;
    bf16_t *Q, *Kb, *Vb, *Z, *XBC, *Kext, *Vext; float* DT; float* out;
    template <int MODE  >
    __device__ __forceinline__ void tile(const f32x4 (&acc)[2][2][4][2], bf16_t* B, int ldb, float* O32, int ld32, int row0, int c0) const {
#pragma unroll
        for (int ai = 0; ai < 2; ++ai)
#pragma unroll
            for (int m = 0; m < 4; ++m) {
                const int row = row0 + ai * HALF + m * 16;
#pragma unroll
                for (int bj = 0; bj < 2; ++bj) {
                    const int c = c0 + bj * HALF;
                    const f32x4 v0 = acc[ai][bj][m][0], v1 = acc[ai][bj][m][1];
                    if (MODE == 1) *(u32x4*)(B + (size_t)row * ldb + c) = pack8(v0 * QSCALE, v1 * QSCALE);
                    else *(u32x4*)(B + (size_t)row * ldb + c) = pack8(v0, v1);
                    if (MODE == 2) { float* o = O32 + (size_t)row * ld32 + c; *(f32x4*)o = v0 * TEST_ALPHA; *(f32x4*)(o + 4) = v1 * TEST_ALPHA; }
                }
            }
    }
    __device__ __forceinline__ void operator()(const f32x4 (&acc)[2][2][4][2], const Unit& u, int wr, int wc, int fr, int fq) const {
        const int pn = u.pn, row0 = u.pm * BM + wr * 64 + fr, cl = wc * 32 + 8 * fq;
        if (pn < 8) tile<1>(acc, Q, AW, nullptr, 0, row0, pn * BM + cl);
        else if (pn < 16) tile<2>(acc, Kb, AW, out + O_KP, AW, row0, (pn - 8) * BM + cl);
        else if (pn < 24) tile<2>(acc, Vb, AW, out + O_VP, AW, row0, (pn - 16) * BM + cl);
        else if (pn < 32) tile<0>(acc, Z, SSDI, nullptr, 0, row0, (pn - 24) * BM + cl);
        else {
            tile<0>(acc, XBC, CONVD, nullptr, 0, row0, (pn - 32) * BM + cl);
            if ((u.pm & 31) == 31 && wr == 1) {
#pragma unroll
                for (int bj = 0; bj < 2; ++bj) { const int c = (pn - 32) * BM + cl + bj * HALF; const int row = row0 + HALF + 48, t = (row & (SEQ - 1)) - (SEQ - 3);
                    if (t >= 0) { float* o = out + O_CP + (size_t)((row >> 13) * 3 + t) * CONVD + c; *(f32x4*)o = acc[1][bj][3][0] * TEST_ALPHA; *(f32x4*)(o + 4) = acc[1][bj][3][1] * TEST_ALPHA; } }
            }
        }
    }
};

struct EpiOutProj {
    static constexpr bool PERM = true, AFTER_DRAIN = false;
    const float* xp; const float* xs; float* out; bf16_t* X1B; float* ss;
    __device__ __forceinline__ void operator()(const f32x4 (&acc)[2][2][4][2], const Unit& u, int wr, int wc, int fr, int fq) const {
        const int row0 = u.pm * BM + wr * 64 + fr, col0 = u.pn * BM + wc * 32 + 8 * fq;
#pragma unroll
        for (int ai = 0; ai < 2; ++ai) {
#pragma unroll
            for (int m = 0; m < 4; ++m) {
                const int row = row0 + ai * HALF + m * 16;
                const float* xr = xp + (size_t)row * DM;
                float sq = 0.f;
#pragma unroll
                for (int bj = 0; bj < 2; ++bj) {
                    const int c = col0 + bj * HALF;
                    const f32x4 v0 = acc[ai][bj][m][0] + __builtin_nontemporal_load((const f32x4*)(xr + c)), v1 = acc[ai][bj][m][1] + __builtin_nontemporal_load((const f32x4*)(xr + c + 4));
                    *(u32x4*)(X1B + (size_t)row * DM + c) = pack8(v0, v1);
                    sq += (v0[0] * v0[0] + v0[1] * v0[1]) + (v0[2] * v0[2] + v0[3] * v0[3]) + (v1[0] * v1[0] + v1[1] * v1[1]) + (v1[2] * v1[2] + v1[3] * v1[3]);
                }
                sq += __shfl_xor(sq, 16); sq += __shfl_xor(sq, 32);
                if (fq == 0) atomicAdd(ss + row, sq);
            }
        }
    }
};

struct EpiProbe {
    static constexpr bool PERM = true, AFTER_DRAIN = false;
    bf16_t* O; int ldc;
    __device__ __forceinline__ void operator()(const f32x4 (&acc)[2][2][4][2], const Unit& u, int wr, int wc, int fr, int fq) const {
        const int row0 = u.pm * BM + wr * 64 + fr, col0 = u.pn * BM + wc * 32 + 8 * fq;
#pragma unroll
        for (int ai = 0; ai < 2; ++ai)
#pragma unroll
            for (int m = 0; m < 4; ++m)
#pragma unroll
                for (int bj = 0; bj < 2; ++bj) *(u32x4*)(O + (size_t)(row0 + ai * HALF + m * 16) * ldc + col0 + bj * HALF) = pack8(acc[ai][bj][m][0], acc[ai][bj][m][1]);
    }
};

template <bool Q8>
struct EpiGateUpT {
    static constexpr bool PERM = true, AFTER_DRAIN = false;
    bf16_t* H; const float* ss; float wqg, wqu; bf16_t* HS;
    __device__ __forceinline__ void operator()(const f32x4 (&acc)[2][2][4][2], const Unit& u, int wr, int wc, int fr, int fq) const {
        if constexpr (Q8) asm volatile("" : "+v"(fr), "+v"(fq));
        const int row0 = u.pm * BM + wr * 64 + fr, col0 = u.pn * HALF + wc * 32 + 8 * fq;
#pragma unroll
        for (int ai = 0; ai < 2; ++ai) {
            if (u.pm == 64 && ai == 1) continue;
#pragma unroll
            for (int m = 0; m < 4; ++m) {
                const int row = row0 + ai * HALF + m * 16;
                const float r = Q8 ? ss[row] * wqg : 1.0f / sqrtf(ss[row] * (1.0f / DM) + EPS);
                const float r2 = Q8 ? ss[row] * wqu : r;
                f32x4 h[2];
#pragma unroll
                for (int n = 0; n < 2; ++n)
#pragma unroll
                    for (int e = 0; e < 4; ++e) { const float g = (Q8 ? (float)__float_as_int(acc[ai][0][m][n][e]) : acc[ai][0][m][n][e]) * r, up = (Q8 ? (float)__float_as_int(acc[ai][1][m][n][e]) : acc[ai][1][m][n][e]) * r2;
                        h[n][e] = g * up * __builtin_amdgcn_rcpf(1.0f + __builtin_amdgcn_exp2f(-1.4426950408889634f * g)); }
                if (Q8 && u.pm == 64) { *(u32x4*)(HS + (size_t)(row - MP) * DFF + col0) = pack8(h[0], h[1]); continue; }
                u32x2 w8; w8.x = pk4_fp8(h[0][0] * H8_SCALE, h[0][1] * H8_SCALE, h[0][2] * H8_SCALE, h[0][3] * H8_SCALE); w8.y = pk4_fp8(h[1][0] * H8_SCALE, h[1][1] * H8_SCALE, h[1][2] * H8_SCALE, h[1][3] * H8_SCALE);
                *(u32x2*)((unsigned char*)H + (size_t)row * DFF + col0) = w8;
            }
        }
    }
};
using EpiGateUp = EpiGateUpT<false>;

__device__ __forceinline__ float bflo(unsigned w) { return __uint_as_float(w << 16); }
__device__ __forceinline__ float bfhi(unsigned w) { return __uint_as_float(w & 0xffff0000u); }
struct EpiDown {
    static constexpr bool PERM = true, AFTER_DRAIN = false;
    const bf16_t* X1B; bf16_t* X2B; float* ss;
    static constexpr float ASC = 1.0f / (H8_SCALE * WD8_SCALE);
    __device__ __forceinline__ void operator()(const f32x4 (&acc)[2][2][4][2], const Unit& u, int wr, int wc, int fr, int fq) const {
        asm volatile("" : "+v"(fr), "+v"(fq));
        const int row0 = u.pm * BM + wr * 64 + fr, col0 = u.pn * BM + wc * 32 + 8 * fq;
#pragma unroll
        for (int ai = 0; ai < 2; ++ai) {
#pragma unroll
            for (int m = 0; m < 4; ++m) {
                const int row = row0 + ai * HALF + m * 16;
                float sq = 0.f;
#pragma unroll
                for (int bj = 0; bj < 2; ++bj) {
                    const int c = col0 + bj * HALF;
                    const u32x4 xw = __builtin_nontemporal_load((const u32x4*)(X1B + (size_t)row * DM + c));
                    const f32x4 v0 = acc[ai][bj][m][0] * ASC + (f32x4){bflo(xw.x), bfhi(xw.x), bflo(xw.y), bfhi(xw.y)}, v1 = acc[ai][bj][m][1] * ASC + (f32x4){bflo(xw.z), bfhi(xw.z), bflo(xw.w), bfhi(xw.w)};
                    *(u32x4*)(X2B + (size_t)row * DM + c) = pack8(v0, v1);
                    sq += (v0[0] * v0[0] + v0[1] * v0[1]) + (v0[2] * v0[2] + v0[3] * v0[3]) + (v1[0] * v1[0] + v1[1] * v1[1]) + (v1[2] * v1[2] + v1[3] * v1[3]);
                }
                sq += __shfl_xor(sq, 16); sq += __shfl_xor(sq, 32);
                if (fq == 0) atomicAdd(ss + row, sq);
            }
        }
    }
};
struct PanelOrder {
    int pm, q4, nu; unsigned* cnt;
    __device__ void init(int c, unsigned* cnt_) { const int x = c & 7, j = c >> 3; pm = x * 8 + (j >> 2); q4 = j & 3; cnt = cnt_; nu = 4; asm volatile("" : "+s"(nu)); }
    __device__ __forceinline__ bool next(int i, Unit& u) const { if (i >= nu) return false; int p = pm; asm volatile("" : "+s"(p)); u.pm = p; u.pn = 4 * q4 + i; return true; }
    __device__ __forceinline__ void a_ready(const Unit&) const {}
    __device__ __forceinline__ void done(const Unit& u) const {
        asm volatile("s_waitcnt vmcnt(0)" ::: "memory");
        if ((threadIdx.x & 63) == 0) __hip_atomic_fetch_add(cnt + 64 * u.pm, 1u, __ATOMIC_RELAXED, __HIP_MEMORY_SCOPE_AGENT);
    }
};
struct TailOrder {
    StaticOrder so; int nstat; unsigned* cnt; volatile PG8_LAS unsigned* mail;
    __device__ void init(int M, int N, int G_, int c_, unsigned* cnt_, volatile PG8_LAS unsigned* mail_) { so.init(M, N, G_, c_); nstat = so.nwg / G_; cnt = cnt_; mail = mail_; }
    __device__ __forceinline__ bool next(int i, Unit& u) const {
        if (i < nstat) return so.next(i, u);
        if (i > nstat) return false;
        if (threadIdx.x == 0) *mail = __hip_atomic_fetch_add(cnt, 1u, __ATOMIC_RELAXED, __HIP_MEMORY_SCOPE_AGENT);
        asm volatile("s_waitcnt lgkmcnt(0)" ::: "memory"); __builtin_amdgcn_s_barrier();
        const unsigned t = *mail;
        const int ntail = so.nwg - nstat * so.G;
        if (t >= (unsigned)ntail) return false;
        StaticOrder s2 = so; s2.c = (int)t;
        return s2.next(nstat, u);
    }
    __device__ __forceinline__ void a_ready(const Unit&) const {}
    __device__ __forceinline__ void done(const Unit&) const {}
};
}
#define GAS __attribute__((address_space(1)))
#define LAS __attribute__((address_space(3)))
typedef unsigned short bf16;
typedef unsigned v4u __attribute__((ext_vector_type(4)));
typedef float f32x4 __attribute__((ext_vector_type(4)));
typedef short bf16x8 __attribute__((ext_vector_type(8)));
typedef GAS unsigned gu32;
typedef GAS unsigned long long gu64;
#define RLX_AGENT __ATOMIC_RELAXED, __HIP_MEMORY_SCOPE_AGENT
#define LDS_WAIT() asm volatile("s_waitcnt lgkmcnt(0)" ::: "memory")
#define VM_WAIT() asm volatile("s_waitcnt vmcnt(0)" ::: "memory")
__device__ __forceinline__ unsigned long long rt() { return __builtin_amdgcn_s_memrealtime(); }
__device__ __forceinline__ unsigned f2bf(float f) { unsigned u = __builtin_bit_cast(unsigned, f); return (u + 0x7fffu + ((u >> 16) & 1u)) >> 16; }
__device__ __forceinline__ unsigned pk2(float lo, float hi) { return f2bf(lo) | (f2bf(hi) << 16); }

#define XB_TMO      128
#define XB_XCNT(j)  (256  + 64 * (j))
#define XB_XSUB(j)  (1280 + 64 * (j))
#define XB_XGEN(j)  (2304 + 64 * (j))
#define XB_TOP      3328
#define XB_TOPGEN   3392
#define XCD_BAR_WORDS 3456
#define XB_SPIN_CAP (1u << 18)

__device__ __forceinline__ unsigned xb_ld(unsigned* p)              { return __hip_atomic_load(p, __ATOMIC_RELAXED, __HIP_MEMORY_SCOPE_AGENT); }
__device__ __forceinline__ unsigned xb_add(unsigned* p, unsigned v) { return __hip_atomic_fetch_add(p, v, __ATOMIC_RELAXED, __HIP_MEMORY_SCOPE_AGENT); }
__device__ __forceinline__ unsigned xb_xcc_id() { return (unsigned)__builtin_amdgcn_s_getreg((3 << 11) | 20) & 0xFu; }
#define XB_SPIN(cond, bar) do { unsigned _sp = 0; while (cond) { __builtin_amdgcn_s_sleep(1); \
    if ((++_sp & 255u) == 0u) { if (xb_ld(&(bar)[XB_TMO])) break; if (_sp > XB_SPIN_CAP) { atomicAdd(&(bar)[XB_TMO], 1u); break; } } } } while (0)

struct XcdBarrier {
    unsigned* bar; unsigned x;
    volatile LAS unsigned* st;
};

__device__ __forceinline__ XcdBarrier xcd_barrier_post(unsigned* bar, volatile LAS unsigned* st) {
    XcdBarrier b; b.bar = bar; b.x = xb_xcc_id(); b.st = st;
    if (threadIdx.x == 0) (void)xb_add(&bar[XB_XCNT(b.x)], 1u);
    return b;
}
__device__ __forceinline__ void xcd_barrier_complete(unsigned* bar, unsigned x, unsigned& nloc, unsigned& nx) {
    const unsigned G = gridDim.x * gridDim.y * gridDim.z;
    unsigned sum, cnt, mine, sp = 0u;
    for (;;) {
        sum = 0u; cnt = 0u; mine = 0u;
#pragma unroll
        for (unsigned j = 0; j < 16; ++j) { const unsigned c = xb_ld(&bar[XB_XCNT(j)]); sum += c; cnt += (c > 0u) ? 1u : 0u; mine = (j == x) ? c : mine; }
        if (sum == G) break;
        __builtin_amdgcn_s_sleep(1);
        if ((++sp & 255u) == 0u) { if (xb_ld(&bar[XB_TMO])) break; if (sp > XB_SPIN_CAP) { atomicAdd(&bar[XB_TMO], 1u); break; } }
    }
    nloc = mine > 0u ? mine : 1u; nx = cnt > 0u ? cnt : 1u;
}

__device__ __forceinline__ void xcd_barrier(const XcdBarrier& b) {
    asm volatile("s_waitcnt vmcnt(0)" ::: "memory");
    __syncthreads();
    if (threadIdx.x == 0) {
        unsigned* bar = b.bar;
        __builtin_amdgcn_s_waitcnt(0);
        unsigned nloc = b.st[0], nx = b.st[1];
        if (nloc == 0u) { xcd_barrier_complete(bar, b.x, nloc, nx); b.st[0] = nloc; b.st[1] = nx; }
        const unsigned old = xb_add(&bar[XB_XSUB(b.x)], 1u);
        const unsigned gen = old / nloc;
        if (old + 1u == (gen + 1u) * nloc) {
            __builtin_amdgcn_fence(__ATOMIC_RELEASE, "agent");
            asm volatile("s_waitcnt vmcnt(0)" ::: "memory");
            const unsigned og = xb_add(&bar[XB_TOP], 1u);
            const unsigned tg = og / nx;
            if (og + 1u == (tg + 1u) * nx) xb_add(&bar[XB_TOPGEN], 1u);
            else XB_SPIN(xb_ld(&bar[XB_TOPGEN]) == tg, bar);
            __builtin_amdgcn_fence(__ATOMIC_ACQUIRE, "agent");
            xb_add(&bar[XB_XGEN(b.x)], 1u);
            asm volatile("s_waitcnt vmcnt(0)" ::: "memory");
        } else {
            XB_SPIN(xb_ld(&bar[XB_XGEN(b.x)]) == gen, bar);
            __builtin_amdgcn_fence(__ATOMIC_ACQUIRE, "agent");
            asm volatile("s_waitcnt vmcnt(0)" ::: "memory");
        }
    }
    __syncthreads();
}

constexpr int NWAVES = 8;
constexpr size_t MiB = 1u << 20;
constexpr size_t WS_CTL = 0, CTL_ZERO_BYTES = 1 * MiB;
constexpr size_t WS_WD = 1 * MiB, WS_WGU = 87 * MiB, WS_WO = 259 * MiB, WS_WIN = 291 * MiB, WS_XN = 389 * MiB, WS_Q = 519 * MiB, WS_KB = 584 * MiB, WS_VB = 649 * MiB,
                 WS_Z = 714 * MiB, WS_XBC = 779 * MiB, WS_DT = 909 * MiB, WS_KEXT = 912 * MiB, WS_VEXT = 978 * MiB, WS_WD8 = WS_WIN  , WS_HS = WS_Q + 256 * MiB  , WS_F = 1044 * MiB  , WS_PARK = 1052 * MiB  , WS_DUMMY = 1068 * MiB  , WS_WGUQ = 1068 * MiB  , WS_X1Q = 1154 * MiB  , WS_END = 1219 * MiB;
constexpr size_t WS_MIX = WS_XN;
constexpr size_t WS_X1B = WS_KEXT;
constexpr size_t WS_H = WS_Q;
static_assert(WS_WD + (size_t)DM * DFF * 2 <= WS_WGU && WS_WGU + (size_t)2 * DFF * DM * 2 <= WS_WO && WS_WO + (size_t)DM * DM * 2 <= WS_WIN && WS_WIN + (size_t)NINP * DM * 2 <= WS_XN &&
              WS_XN + (size_t)MPAD * DM * 2 <= WS_Q && WS_Q + (size_t)MPAD * AW * 2 <= WS_KB && WS_XBC + (size_t)MPAD * CONVD * 2 <= WS_DT && WS_DT + (size_t)MPAD * SH * 4 <= WS_KEXT &&
              WS_KEXT + (size_t)DEC_B * KVROWS * AW * 2 <= WS_VEXT && WS_VEXT + (size_t)DEC_B * KVROWS * AW * 2 <= WS_F && WS_H + (size_t)MPAD * DFF * 2 <= WS_DT &&
              WS_X1B + (size_t)MPAD * DM * 2 <= WS_END, "d_ws map");
constexpr int CW_TMO = 0, CW_CODE = 1, CW_WSTAT = 8  , CW_QUEUE = 64, CW_P1T = 3648  , CW_P4T = 3584  , CW_SMPC = 512  , CW_P5C = 12288  , CW_SSDF = 2048  , CW_BAR = 4096, CW_SS2 = 65536, CW_SS3 = 131072, CW_RQ = 196608  ;
constexpr int RING_OFF = 0, RING_BYTES = 139264, LDSCTL_OFF = RING_BYTES, MISC_OFF = LDSCTL_OFF + 320, LDS_BYTES = 147456;

struct Frame {
    LAS unsigned char* lds;
    volatile LAS unsigned* MISC;
    gu32* ctl;
    int tid, lane, wave, vcu, G;
};

__device__ __forceinline__ float wave_sum(float v) {
#pragma unroll
    for (int o = 1; o < 64; o <<= 1) v += __shfl_xor(v, o);
    return v;
}
template <int MODE>
__device__ __forceinline__ void p0_transpose_pair(const float* W, int K, int N, bf16* WT, const float* kscale, LAS float* scr, int item0, int nitems, int lane, unsigned char* W8 = nullptr, float s8 = 1.0f, bool as_int8 = false) {
    const int nblk = N / 32;
    f32x4 v[2][8]; float ks[2][8];
#pragma unroll
    for (int t = 0; t < 2; ++t) { const int item = item0 + t < nitems ? item0 + t : item0; const int kb = item / nblk, nb = item % nblk, k0 = 64 * kb, n0 = 32 * nb;
#pragma unroll
        for (int i = 0; i < 8; ++i) { const int kk = 8 * i + (lane >> 3); v[t][i] = __builtin_nontemporal_load((const GAS f32x4*)(W + (size_t)(k0 + kk) * N + n0 + 4 * (lane & 7)));        ks[t][i] = kscale ? kscale[k0 + kk] : 1.0f; } }
#pragma unroll
    for (int t = 0; t < 2; ++t) {
        if (item0 + t >= nitems) break;
        const int item = item0 + t; const int kb = item / nblk, nb = item % nblk, k0 = 64 * kb, n0 = 32 * nb;
        LAS float* s0 = scr + t * (64 * 33);
#pragma unroll
        for (int i = 0; i < 8; ++i) { const int kk = 8 * i + (lane >> 3); LAS float* d = s0 + kk * 33 + 4 * (lane & 7); const f32x4 x = v[t][i] * ks[t][i]; d[0] = x.x; d[1] = x.y; d[2] = x.z; d[3] = x.w; }
        LDS_WAIT(); asm volatile("" ::: "memory");
        const int c = lane & 7;
        const int rbase = MODE == 0 ? n0 : 256 * (n0 >> 7) + (n0 & 127) + (MODE == 2 ? 128 : 0);
#pragma unroll
        for (int j = 0; j < 4; ++j) { const int n = (lane >> 3) + 8 * j; const LAS float* s = s0 + (8 * c) * 33 + n;
            v4u o; o.x = pk2(s[0 * 33], s[1 * 33]); o.y = pk2(s[2 * 33], s[3 * 33]); o.z = pk2(s[4 * 33], s[5 * 33]); o.w = pk2(s[6 * 33], s[7 * 33]);
            if (WT) *(GAS v4u*)(WT + (size_t)(rbase + n) * K + k0 + 8 * c) = o;
            if (W8) {
                typedef unsigned u32x2g __attribute__((ext_vector_type(2))); u32x2g o8;
                int p0 = 0, p1 = 0;
                if (as_int8) { p0 = (int)pg8::pk4_i8(s[0 * 33] * s8, s[1 * 33] * s8, s[2 * 33] * s8, s[3 * 33] * s8); p1 = (int)pg8::pk4_i8(s[4 * 33] * s8, s[5 * 33] * s8, s[6 * 33] * s8, s[7 * 33] * s8); }
                else {
                p0 = __builtin_amdgcn_cvt_pk_fp8_f32(s[0 * 33] * s8, s[1 * 33] * s8, p0, false); p0 = __builtin_amdgcn_cvt_pk_fp8_f32(s[2 * 33] * s8, s[3 * 33] * s8, p0, true);
                p1 = __builtin_amdgcn_cvt_pk_fp8_f32(s[4 * 33] * s8, s[5 * 33] * s8, p1, false); p1 = __builtin_amdgcn_cvt_pk_fp8_f32(s[6 * 33] * s8, s[7 * 33] * s8, p1, true); }
                o8.x = (unsigned)p0; o8.y = (unsigned)p1;
                *(GAS u32x2g*)(W8 + (size_t)(rbase + n) * K + k0 + 8 * c) = o8; } }
    }
    LDS_WAIT(); asm volatile("" ::: "memory");
}
__device__ __forceinline__ void rms_row2_to_bf16(int lane, const float* xrow0, const float* xrow1, const float* w, bf16* orow0, bf16* orow1) {
    const GAS f32x4* xr0 = (const GAS f32x4*)xrow0 + lane; const GAS f32x4* xr1 = (const GAS f32x4*)xrow1 + lane; const GAS f32x4* wr = (const GAS f32x4*)w + lane;
    f32x4 v0[16], v1[16]; float s0 = 0.f, s1 = 0.f;
#pragma unroll
    for (int j = 0; j < 16; ++j) v0[j] = __builtin_nontemporal_load(xr0 + 64 * j);
#pragma unroll
    for (int j = 0; j < 16; ++j) v1[j] = __builtin_nontemporal_load(xr1 + 64 * j);
#pragma unroll
    for (int j = 0; j < 16; ++j) s0 += (v0[j].x * v0[j].x + v0[j].y * v0[j].y) + (v0[j].z * v0[j].z + v0[j].w * v0[j].w);
#pragma unroll
    for (int j = 0; j < 16; ++j) s1 += (v1[j].x * v1[j].x + v1[j].y * v1[j].y) + (v1[j].z * v1[j].z + v1[j].w * v1[j].w);
    const float r0 = 1.0f / sqrtf(wave_sum(s0) * (1.0f / DM) + EPS), r1 = 1.0f / sqrtf(wave_sum(s1) * (1.0f / DM) + EPS);
    GAS unsigned long long* o0 = (GAS unsigned long long*)orow0 + lane; GAS unsigned long long* o1 = (GAS unsigned long long*)orow1 + lane;
#pragma unroll
    for (int j = 0; j < 16; ++j) { const f32x4 g = wr[64 * j];
        o0[64 * j] = (unsigned long long)pk2(v0[j].x * r0 * g.x, v0[j].y * r0 * g.y) | ((unsigned long long)pk2(v0[j].z * r0 * g.z, v0[j].w * r0 * g.w) << 32);
        o1[64 * j] = (unsigned long long)pk2(v1[j].x * r1 * g.x, v1[j].y * r1 * g.y) | ((unsigned long long)pk2(v1[j].z * r1 * g.z, v1[j].w * r1 * g.w) << 32); }
}
__device__ __forceinline__ void rms_row_to_bf16(int lane, const float* xrow, const float* w, bf16* orow) {
    const GAS f32x4* xr = (const GAS f32x4*)xrow + lane; const GAS f32x4* wr = (const GAS f32x4*)w + lane;
    f32x4 v[16]; float s = 0.f;
#pragma unroll
    for (int j = 0; j < 16; ++j) { v[j] = xr[64 * j]; s += (v[j].x * v[j].x + v[j].y * v[j].y) + (v[j].z * v[j].z + v[j].w * v[j].w); }
    const float r = 1.0f / sqrtf(wave_sum(s) * (1.0f / DM) + EPS);
    GAS unsigned long long* o8 = (GAS unsigned long long*)orow + lane;
#pragma unroll
    for (int j = 0; j < 16; ++j) { const f32x4 g = wr[64 * j]; o8[64 * j] = (unsigned long long)pk2(v[j].x * r * g.x, v[j].y * r * g.y) | ((unsigned long long)pk2(v[j].z * r * g.z, v[j].w * r * g.w) << 32); }
}

namespace att {
typedef short bf16x8 __attribute__((ext_vector_type(8)));
typedef short s16x4 __attribute__((ext_vector_type(4)));
typedef float f32x16 __attribute__((ext_vector_type(16)));
typedef unsigned u32x4 __attribute__((ext_vector_type(4)));
typedef unsigned u32x2 __attribute__((ext_vector_type(2)));
constexpr int KSLOT = 8192, VSLOT = 16384, SLOT = KSLOT + VSLOT, NSLOT = 3, PITCH = 2048;
constexpr int PARK_OFF = NSLOT * SLOT, ATTN_LDS_BYTES = PARK_OFF + 8 * 8192;
#define ATT_LAS __attribute__((address_space(3)))
#ifdef PROBE_ATT_VARIANT
#define ATT_VAR(u) ((u).variant)
#else
#define ATT_VAR(u) 0
#endif
__device__ __forceinline__ unsigned cvtpk(float lo, float hi) { unsigned r; asm volatile("v_cvt_pk_bf16_f32 %0, %1, %2" : "=v"(r) : "v"(lo), "v"(hi)); return r; }

__device__ __forceinline__ void glds16(const void* gsrc, unsigned lds_dst) { unsigned keep;
    asm volatile("s_mov_b32 %0, m0\n\ts_mov_b32 m0, %2\n\ts_nop 0\n\tglobal_load_lds_dwordx4 %1, off\n\ts_mov_b32 m0, %0" : "=&s"(keep) : "v"(gsrc), "s"(lds_dst) : "memory"); }
__device__ __forceinline__ float max3f(float a, float b, float c) { float r; asm("v_max3_f32 %0, %1, %2, %3" : "=v"(r) : "v"(a), "v"(b), "v"(c)); return r; }
struct Unit {
    const unsigned short* Q;
    const unsigned short* K;
    const unsigned short* V;
    unsigned short* O;
    int ntot;
    int nvalid_last;
    int sample;
    int qb;
    unsigned char* park;
    int variant;
};

__device__ __forceinline__ void pass(ATT_LAS unsigned char* lds, const Unit& u, int mapoff, bool active, int nmine, int wave, int lane, f32x16 (&o)[4], float& lsum) {
    asm volatile("" : "+v"(lane));
    const int r32 = lane & 31, h = lane >> 5;
    const unsigned short* ksrc = u.K + mapoff + (size_t)lane * PITCH + wave * 8;
    const int rowgrp = wave >> 1, half = wave & 1, sub = lane >> 5, rr = (lane & 31) >> 2, vrow = 8 * rowgrp + rr;
    const int chl = (lane & 3) ^ ((vrow >> 2) & 3);
    const unsigned short* vsrc = u.V + (size_t)vrow * PITCH + (4 * (2 * half + sub) + chl) * 8;
    const unsigned ldsw = (unsigned)(uintptr_t)lds + (unsigned)wave * 1024u;
#define ATT_DMA(t, slot) do { if (ATT_VAR(u) & 1) break; \
        glds16(ksrc + (size_t)(t) * 64 * PITCH, (unsigned)__builtin_amdgcn_readfirstlane(ldsw + (slot) * SLOT)); \
        glds16(vsrc + (size_t)(t) * 64 * PITCH, (unsigned)__builtin_amdgcn_readfirstlane(ldsw + (slot) * SLOT + KSLOT)); \
        glds16(vsrc + (size_t)(t) * 64 * PITCH + 32 * PITCH, (unsigned)__builtin_amdgcn_readfirstlane(ldsw + (slot) * SLOT + KSLOT + 8192)); } while (0)
    asm volatile("s_waitcnt lgkmcnt(0)\n\ts_barrier" ::: "memory");
    ATT_DMA(0, 0);
    if (u.ntot > 1) ATT_DMA(1, 1);
    bf16x8 qf[4];
    { const unsigned short* qrow = u.Q + mapoff + (size_t)(wave * 32 + r32) * PITCH + 8 * h;
#pragma unroll
      for (int ks = 0; ks < 4; ++ks) qf[ks] = active ? *(const bf16x8*)(qrow + 16 * ks) : (bf16x8){0,0,0,0,0,0,0,0}; }
    asm volatile("" : "+v"(qf[0]), "+v"(qf[1]), "+v"(qf[2]), "+v"(qf[3]));
    if (wave >= 4) __builtin_amdgcn_s_setprio(1);
    float l = 0.f, negm_s = 0.f; bool first_ = true;
    f32x16 negm;
#pragma unroll
    for (int r = 0; r < 16; ++r) negm[r] = 0.f;
#pragma unroll
    for (int d = 0; d < 4; ++d)
#pragma unroll
        for (int r = 0; r < 16; ++r) o[d][r] = 0.f;
    const int kbase = h * 1024 + r32 * 16;
    const int g = lane >> 4, blk = g & 1, q_ = (lane & 15) >> 2, p_ = lane & 3;
    const int vb0 = KSLOT + 64 * (4 * h + q_) + 16 * ((2 * blk + (p_ >> 1)) ^ h) + 8 * (p_ & 1);
    const int vb1 = KSLOT + 2048 + 64 * (4 * h + q_) + 16 * ((2 * blk + (p_ >> 1)) ^ (2 + h)) + 8 * (p_ & 1);
#define ATT_QK0(D0, D1, SB) do { _Pragma("unroll") for (int r = 0; r < 16; ++r) { D0[r] = 0.f; D1[r] = 0.f; } \
        _Pragma("unroll") for (int ks = 0; ks < 4; ++ks) { \
            const bf16x8 k0 = *(const ATT_LAS bf16x8*)((SB) + kbase + ks * 2048), k1 = *(const ATT_LAS bf16x8*)((SB) + kbase + ks * 2048 + 512); \
            D0 = __builtin_amdgcn_mfma_f32_32x32x16_bf16(k0, qf[ks], D0, 0, 0, 0); D1 = __builtin_amdgcn_mfma_f32_32x32x16_bf16(k1, qf[ks], D1, 0, 0, 0); } } while (0)
#define ATT_TILE(C0, C1, N0, N1, SC, SN, TT) do { \
        ATT_LAS unsigned char* sc_ = lds + (SC) * SLOT; ATT_LAS unsigned char* sn_ = lds + (SN) * SLOT; \
        if ((TT) == u.ntot - 1 && u.nvalid_last < 64) { \
            _Pragma("unroll") for (int r = 0; r < 16; ++r) { const int kv = (r & 3) + 8 * (r >> 2) + 4 * h; if (kv >= u.nvalid_last) C0[r] = -1e30f; if (kv + 32 >= u.nvalid_last) C1[r] = -1e30f; } } \
        float mx; { float t_[8]; \
            _Pragma("unroll") for (int r = 0; r < 8; ++r) t_[r] = max3f(C0[2 * r], C0[2 * r + 1], C1[2 * r]); \
            _Pragma("unroll") for (int r = 0; r < 8; ++r) t_[r] = max3f(t_[r], C1[2 * r + 1], t_[r]); \
            const float u0_ = max3f(t_[0], t_[1], t_[2]), u1_ = max3f(t_[3], t_[4], t_[5]), u2_ = max3f(t_[6], t_[7], t_[7]); mx = max3f(u0_, u1_, u2_); } \
        mx = max3f(mx, __shfl_xor(mx, 32), mx); \
        if (first_ || __any(mx > 8.0f)) {       \
            const float dd = first_ ? mx : fmaxf(mx, 0.f), alpha = __builtin_amdgcn_exp2f(-dd); first_ = false; l *= alpha; negm_s -= dd; \
            _Pragma("unroll") for (int d = 0; d < 4; ++d) _Pragma("unroll") for (int r = 0; r < 16; ++r) o[d][r] *= alpha; \
            _Pragma("unroll") for (int r = 0; r < 16; ++r) { C0[r] -= dd; C1[r] -= dd; negm[r] = negm_s; } } \
        const unsigned va0 = (unsigned)(uintptr_t)(sc_ + vb0), va1 = (unsigned)(uintptr_t)(sc_ + vb1); \
        float rsa_[4] = {0.f, 0.f, 0.f, 0.f}; \
        _Pragma("unroll") for (int s = 0; s < 4; ++s) { \
            s16x4 lo[4], hi[4]; \
            if (!(ATT_VAR(u) & 2)) _Pragma("unroll") for (int d = 0; d < 4; ++d) { \
                asm volatile("ds_read_b64_tr_b16 %0, %1 offset:%c2" : "=&v"(lo[d]) : "v"(va0), "i"(d * 512 + s * 4096) : "memory"); \
                asm volatile("ds_read_b64_tr_b16 %0, %1 offset:%c2" : "=&v"(hi[d]) : "v"(va1), "i"(d * 512 + s * 4096) : "memory"); } \
            const bf16x8 k0 = *(const ATT_LAS bf16x8*)(sn_ + kbase + s * 2048), k1 = *(const ATT_LAS bf16x8*)(sn_ + kbase + s * 2048 + 512); \
            u32x4 w; \
            if (s < 2) { _Pragma("unroll") for (int e = 0; e < 8; ++e) { C0[8 * s + e] = (ATT_VAR(u) & 4) ? C0[8 * s + e] : __builtin_amdgcn_exp2f(C0[8 * s + e]); rsa_[e & 3] += C0[8 * s + e]; } \
                w.x = cvtpk(C0[8 * s], C0[8 * s + 1]); w.y = cvtpk(C0[8 * s + 2], C0[8 * s + 3]); w.z = cvtpk(C0[8 * s + 4], C0[8 * s + 5]); w.w = cvtpk(C0[8 * s + 6], C0[8 * s + 7]); } \
            else { const int b_ = 8 * (s - 2); _Pragma("unroll") for (int e = 0; e < 8; ++e) { C1[b_ + e] = (ATT_VAR(u) & 4) ? C1[b_ + e] : __builtin_amdgcn_exp2f(C1[b_ + e]); rsa_[e & 3] += C1[b_ + e]; } \
                w.x = cvtpk(C1[b_], C1[b_ + 1]); w.y = cvtpk(C1[b_ + 2], C1[b_ + 3]); w.z = cvtpk(C1[b_ + 4], C1[b_ + 5]); w.w = cvtpk(C1[b_ + 6], C1[b_ + 7]); } \
            const bf16x8 pf = __builtin_bit_cast(bf16x8, w); \
            if (s == 0) { N0 = __builtin_amdgcn_mfma_f32_32x32x16_bf16(k0, qf[0], negm, 0, 0, 0); N1 = __builtin_amdgcn_mfma_f32_32x32x16_bf16(k1, qf[0], negm, 0, 0, 0); } \
            else { N0 = __builtin_amdgcn_mfma_f32_32x32x16_bf16(k0, qf[s], N0, 0, 0, 0); N1 = __builtin_amdgcn_mfma_f32_32x32x16_bf16(k1, qf[s], N1, 0, 0, 0); } \
            asm volatile("s_waitcnt lgkmcnt(0)" ::: "memory"); \
            if (!(ATT_VAR(u) & 2)) _Pragma("unroll") for (int d = 0; d < 4; ++d) { \
                const bf16x8 vf = (bf16x8){lo[d][0], lo[d][1], lo[d][2], lo[d][3], hi[d][0], hi[d][1], hi[d][2], hi[d][3]}; \
                o[d] = __builtin_amdgcn_mfma_f32_32x32x16_bf16(vf, pf, o[d], 0, 0, 0); } \
        } \
        l += (rsa_[0] + rsa_[1]) + (rsa_[2] + rsa_[3]); } while (0)
    f32x16 sA0, sA1, sB0, sB1;
#define ATT_WAITBAR(N) do { if (ATT_VAR(u) & 8) asm volatile("s_waitcnt vmcnt(" #N ") lgkmcnt(0)" ::: "memory"); else asm volatile("s_waitcnt vmcnt(" #N ") lgkmcnt(0)\n\ts_barrier" ::: "memory"); } while (0)
    if (u.ntot > 1) ATT_WAITBAR(3); else ATT_WAITBAR(0);
    if (active) ATT_QK0(sA0, sA1, lds);
    int slot = 0;
#define ATT_HALF(TT, C0, C1, N0, N1) do { const int sn = slot == 2 ? 0 : slot + 1; \
        if ((TT) + 1 < u.ntot) ATT_WAITBAR(0); \
        if ((TT) + 2 < u.ntot) ATT_DMA((TT) + 2, slot == 0 ? 2 : slot - 1); \
        if (active && (TT) < nmine && !(ATT_VAR(u) & 16)) ATT_TILE(C0, C1, N0, N1, slot, sn, (TT)); \
        slot = sn; } while (0)
    for (int t = 0; t < u.ntot; t += 2) {
        ATT_HALF(t, sA0, sA1, sB0, sB1);
        if (t + 1 < u.ntot) ATT_HALF(t + 1, sB0, sB1, sA0, sA1);
    }
#undef ATT_HALF
#undef ATT_WAITBAR
#undef ATT_TILE
#undef ATT_QK0
    __builtin_amdgcn_s_setprio(0);
    lsum = l + __shfl_xor(l, 32);
#undef ATT_DMA
}

__device__ __forceinline__ void attn_unit(ATT_LAS unsigned char* lds, const Unit& u, float lam, const float* subw, int wave, int lane) {
    asm volatile("" : "+v"(lane));
    const int r32 = lane & 31, h = lane >> 5;
    const bool active = u.sample ? (wave == 0) : true;
    const int nmine = u.sample ? u.ntot : 4 * u.qb + (wave >> 1) + 1;
    f32x16 o[4]; float l1, l2;
    ATT_LAS u32x4* park = (ATT_LAS u32x4*)(lds + PARK_OFF + wave * 8192) + lane;
    pass(lds, u, 0, active, nmine, wave, lane, o, l1);
    { const float inv = 1.0f / l1;
#pragma unroll
      for (int d = 0; d < 4; ++d)
#pragma unroll
          for (int r4 = 0; r4 < 2; ++r4) { u32x4 w; w.x = cvtpk(o[d][8 * r4] * inv, o[d][8 * r4 + 1] * inv); w.y = cvtpk(o[d][8 * r4 + 2] * inv, o[d][8 * r4 + 3] * inv);
              w.z = cvtpk(o[d][8 * r4 + 4] * inv, o[d][8 * r4 + 5] * inv); w.w = cvtpk(o[d][8 * r4 + 6] * inv, o[d][8 * r4 + 7] * inv); if (active) park[(2 * d + r4) * 64] = w; } }
    pass(lds, u, 64, active, nmine, wave, lane, o, l2);
    if (!active) return;
    const float c2 = lam / l2;
    float ss = 0.f;
#pragma unroll
    for (int d = 0; d < 4; ++d)
#pragma unroll
        for (int r4 = 0; r4 < 2; ++r4) { const u32x4 w = park[(2 * d + r4) * 64];
#pragma unroll
            for (int e = 0; e < 4; ++e) { const unsigned pw = w[e]; const int r = 8 * r4 + 2 * e;
                const float v0 = __uint_as_float(pw << 16) - c2 * o[d][r], v1 = __uint_as_float(pw & 0xffff0000u) - c2 * o[d][r + 1];
                o[d][r] = v0; o[d][r + 1] = v1; ss += v0 * v0 + v1 * v1; } }
    ss += __shfl_xor(ss, 32);
    const float rn = (1.0f - LAM0) / sqrtf(ss * (1.0f / 128.0f) + EPS);
    unsigned short* orow = u.O + (size_t)(wave * 32 + r32) * 4096 + 8 * h;
    const bool st_ok = !(u.sample && r32 >= 16);
#pragma unroll
    for (int d = 0; d < 4; ++d)
#pragma unroll
        for (int kp = 0; kp < 4; kp += 2) {
            u32x2 pa, pb;
            { const int dc = 32 * d + 8 * kp + 4 * h; const f32x4 w = *(const f32x4*)(subw + dc);
              pa.x = cvtpk(o[d][4 * kp] * rn * w[0], o[d][4 * kp + 1] * rn * w[1]); pa.y = cvtpk(o[d][4 * kp + 2] * rn * w[2], o[d][4 * kp + 3] * rn * w[3]); }
            { const int dc = 32 * d + 8 * (kp + 1) + 4 * h; const f32x4 w = *(const f32x4*)(subw + dc);
              pb.x = cvtpk(o[d][4 * kp + 4] * rn * w[0], o[d][4 * kp + 5] * rn * w[1]); pb.y = cvtpk(o[d][4 * kp + 6] * rn * w[2], o[d][4 * kp + 7] * rn * w[3]); }
            const auto rx = __builtin_amdgcn_permlane32_swap(pa.x, pb.x, false, false); const auto ry = __builtin_amdgcn_permlane32_swap(pa.y, pb.y, false, false);
            const u32x4 v = (u32x4){rx[0], ry[0], rx[1], ry[1]};
            if (st_ok) *(u32x4*)(orow + 32 * d + 8 * kp) = v;
        }
}
}

namespace ssd {
typedef short bf16x8 __attribute__((ext_vector_type(8)));
typedef short s16x4 __attribute__((ext_vector_type(4)));
typedef float f32x4 __attribute__((ext_vector_type(4)));
typedef unsigned u32x4 __attribute__((ext_vector_type(4)));
typedef unsigned u32x2 __attribute__((ext_vector_type(2)));
#define SSD_LAS __attribute__((address_space(3)))
constexpr int XT_STRIDE = 144;
constexpr int L_CM = 0, L_BM = 16384, L_XT = 32768, L_ZT = L_XT + 256 * XT_STRIDE  , L_TAB = L_ZT + 32768  ,
              L_G = L_TAB + 2048  , L_SSQ = L_G + 16384  , L_CW = L_SSQ + 2048  , SSD_LDS_BYTES = L_CW + 10240;
static_assert(SSD_LDS_BYTES <= 139264, "ssd lds");
__device__ __forceinline__ unsigned off_a(unsigned row, unsigned ch) { return 2048u * (row >> 3) + 512u * (ch >> 2) + 64u * (row & 7) + 16u * ((ch & 3) ^ ((row >> 2) & 3)); }
__device__ __forceinline__ unsigned cvtpk(float lo, float hi) { unsigned r; asm volatile("v_cvt_pk_bf16_f32 %0, %1, %2" : "=v"(r) : "v"(lo), "v"(hi)); return r; }
__device__ __forceinline__ float bf2f(unsigned short b) { return __uint_as_float((unsigned)b << 16); }
__device__ __forceinline__ float silu(float v) { return v * __builtin_amdgcn_rcpf(1.0f + __builtin_amdgcn_exp2f(-1.4426950408889634f * v)); }
__device__ __forceinline__ bf16x8 pack8(const f32x4 a, const f32x4 b) { u32x4 w; w.x = cvtpk(a[0], a[1]); w.y = cvtpk(a[2], a[3]); w.z = cvtpk(b[0], b[1]); w.w = cvtpk(b[2], b[3]); return __builtin_bit_cast(bf16x8, w); }
__device__ __forceinline__ void glds16(const void* gsrc, unsigned lds_dst) { unsigned keep;
    asm volatile("s_mov_b32 %0, m0\n\ts_mov_b32 m0, %2\n\ts_nop 0\n\tglobal_load_lds_dwordx4 %1, off\n\ts_mov_b32 m0, %0" : "=&s"(keep) : "v"(gsrc), "s"(lds_dst) : "memory"); }
#define SSD_BAR() asm volatile("s_waitcnt lgkmcnt(0)\n\ts_barrier" ::: "memory")
__device__ __forceinline__ float row16_sum(float v) {
    v += __builtin_bit_cast(float, __builtin_amdgcn_update_dpp(0, __builtin_bit_cast(int, v), 0xB1, 0xf, 0xf, false));
    v += __builtin_bit_cast(float, __builtin_amdgcn_update_dpp(0, __builtin_bit_cast(int, v), 0x4E, 0xf, 0xf, false));
    v += __builtin_bit_cast(float, __builtin_amdgcn_update_dpp(0, __builtin_bit_cast(int, v), 0x141, 0xf, 0xf, false));
    v += __builtin_bit_cast(float, __builtin_amdgcn_update_dpp(0, __builtin_bit_cast(int, v), 0x140, 0xf, 0xf, false));
    return v;
}
#define MFMA16(a, b, c) __builtin_amdgcn_mfma_f32_16x16x32_bf16((a), (b), (c), 0, 0, 0)

struct Unit {
    const unsigned short* xbc;
    const unsigned short* z;
    const float* dtraw;
    const float* hist;
    const float* init;
    float* fin;
    unsigned short* y;
    int len;
    int g;
    int prev;
    int seg;
    float* fseg;
    unsigned* flag;
    int last;
};
constexpr int FSTRIDE = 4 * 64 * 128 + 64;
#define SSD_RLX __ATOMIC_RELAXED, __HIP_MEMORY_SCOPE_AGENT
struct Params { const float* conv_w; const float* conv_b; const float* dt_bias; const float* A_log; const float* D; const float* norm_w; };

template <bool PRE>
__device__ __forceinline__ void ssd_unit(SSD_LAS unsigned char* lds, const Unit& u, const Params& P, int tid, int wave, int lane) {
    asm volatile("" : "+v"(tid), "+v"(lane));
    const int g = u.g, hh = wave >> 1, ph = wave & 1, head = 4 * g + hh;
    const int c16 = lane & 15, g4 = lane >> 4, q_ = c16 >> 2, p_ = lane & 3;
    const float A = -__expf(P.A_log[head]), Dh = P.D[head], dtb = P.dt_bias[head];
    const int xq = (c16 >> 2) & 3, rbase = 2048 * (c16 >> 3) + 64 * (c16 & 7);
    const int rowrd = rbase + 16 * (g4 ^ xq);
    const int c_lo = rbase + 16 * ((g4 >> 1) ^ xq) + 8 * (g4 & 1);
    const int c_hi = rbase + 16 * ((2 + (g4 >> 1)) ^ xq) + 8 * (g4 & 1);
    const int trb = 2048 * g4 + 64 * q_ + 8 * (p_ & 1), tcc = g4 & 1, tbb = p_ >> 1;
    const int tr00 = trb + 32 * (0 ^ tcc) + 16 * (tbb ^ 0), tr01 = trb + 32 * (0 ^ tcc) + 16 * (tbb ^ 1), tr10 = trb + 32 * (1 ^ tcc) + 16 * (tbb ^ 0), tr11 = trb + 32 * (1 ^ tcc) + 16 * (tbb ^ 1);
    const int xt_lane = (64 * hh + 32 * ph + c16) * XT_STRIDE;
    f32x4 st[8][2];
#pragma unroll
    for (int nt = 0; nt < 8; ++nt)
#pragma unroll
        for (int pt = 0; pt < 2; ++pt) {
            if (u.init) st[nt][pt] = *(const f32x4*)(u.init + ((size_t)head * 64 + 32 * ph + 16 * pt + c16) * 128 + 16 * nt + 4 * g4);
            else st[nt][pt] = (f32x4){0.f, 0.f, 0.f, 0.f};
        }
    if constexpr (!PRE) {
        if (u.seg > 0) {
            if (tid == 0) { const unsigned want = (1u << u.seg) - 1u; unsigned sp = 0;
                while ((__hip_atomic_load(u.flag, SSD_RLX) & want) != want) { __builtin_amdgcn_s_sleep(8); if (++sp > (1u << 22)) break; } }
            __syncthreads();
            for (int i = 0; i < u.seg; ++i) {
                const float* F = u.fseg + (size_t)i * FSTRIDE;
                const float Di = __uint_as_float(__hip_atomic_load((const unsigned*)(F + 4 * 64 * 128 + hh), SSD_RLX));
#pragma unroll
                for (int nt = 0; nt < 8; ++nt)
#pragma unroll
                    for (int pt = 0; pt < 2; ++pt) {
                        const unsigned long long* fp = (const unsigned long long*)(F + ((size_t)hh * 64 + 32 * ph + 16 * pt + c16) * 128 + 16 * nt + 4 * g4);
                        const unsigned long long a = __hip_atomic_load(fp, SSD_RLX), b = __hip_atomic_load(fp + 1, SSD_RLX);
                        st[nt][pt] = st[nt][pt] * Di + (f32x4){__uint_as_float((unsigned)a), __uint_as_float((unsigned)(a >> 32)), __uint_as_float((unsigned)b), __uint_as_float((unsigned)(b >> 32))};
                    }
            }
        }
    }
    float asum = 0.f;
    const int cp = ((wave & 3) << 6) | lane, rh = wave >> 2;
    const int ccol = cp < 128 ? 256 * g + 2 * cp : cp < 192 ? 2048 + 128 * g + 2 * (cp - 128) : 3072 + 128 * g + 2 * (cp - 192);
    typedef float f32x2 __attribute__((ext_vector_type(2)));
    if (rh == 0) {
#pragma unroll
        for (int i = 0; i < 4; ++i) ((SSD_LAS f32x2*)(lds + L_CW))[i * 256 + cp] = (f32x2){P.conv_w[i * 4096 + ccol], P.conv_w[i * 4096 + ccol + 1]};
        ((SSD_LAS f32x2*)(lds + L_CW))[4 * 256 + cp] = (f32x2){P.conv_b[ccol], P.conv_b[ccol + 1]};
    }
    __syncthreads();
        const int nchunks = (u.len + 63) >> 6;
    unsigned raw[2][19]; float dtr = 0.f;
    const int tmin = u.prev ? -3 : 0;
    const unsigned zlds = (unsigned)(uintptr_t)(lds + L_ZT) + (unsigned)wave * 4096u;
    const int hd_l = 4 * g + (wave & 3);
    const float dtb_l = P.dt_bias[hd_l], A_l = -__expf(P.A_log[hd_l]);
#define SSD_ISSUE(cc) do { const int tb_ = 64 * (cc); \
        _Pragma("unroll") for (int hb = 0; hb < 2; ++hb) _Pragma("unroll") for (int i = 0; i < 19; ++i) { \
            int t = tb_ + 32 * rh + 16 * hb - 3 + i; t = t < tmin ? tmin : (t >= u.len ? u.len - 1 : t); raw[hb][i] = *(const unsigned*)(u.xbc + (long)t * 4096 + ccol); } \
        if (wave < 4) { int t = tb_ + lane; t = t >= u.len ? u.len - 1 : t; dtr = u.dtraw[(size_t)t * 32 + hd_l]; } } while (0)
#define SSD_ISSUE_Z(cc) do { const int tb_ = 64 * (cc); \
        _Pragma("unroll") for (int i = 0; i < 4; ++i) { int t = tb_ + 8 * wave + 2 * i + (lane >> 5); t = t >= u.len ? u.len - 1 : t; \
            glds16(u.z + (size_t)t * 2048 + 256 * g + 8 * (lane & 31), (unsigned)__builtin_amdgcn_readfirstlane(zlds + 1024u * i)); } } while (0)
    SSD_ISSUE(0); if constexpr (!PRE) SSD_ISSUE_Z(0);
    for (int c = 0; c < nchunks; ++c) {
        const int t0 = 64 * c;
        {
            float cw[4][2], cb[2];
#pragma unroll
            for (int i = 0; i < 4; ++i) { const f32x2 w = ((const SSD_LAS f32x2*)(lds + L_CW))[i * 256 + cp]; cw[i][0] = w.x; cw[i][1] = w.y; }
            { const f32x2 w = ((const SSD_LAS f32x2*)(lds + L_CW))[4 * 256 + cp]; cb[0] = w.x; cb[1] = w.y; }
#pragma unroll
            for (int hb = 0; hb < 2; ++hb) {
                float x0[19], x1[19];
#pragma unroll
                for (int i = 0; i < 19; ++i) {
                    const int t = t0 + 32 * rh + 16 * hb - 3 + i;
                    const unsigned v = raw[hb][i];
                    float a = 0.f, b = 0.f;
                    if (t >= tmin && t < u.len) { a = __uint_as_float(v << 16); b = __uint_as_float(v & 0xffff0000u); }
                    x0[i] = a; x1[i] = b;
                }
                if (hb == 0 && u.hist && c == 0 && rh == 0) {
#pragma unroll
                    for (int i = 0; i < 3; ++i) { x0[i] = u.hist[i * 4096 + ccol]; x1[i] = u.hist[i * 4096 + ccol + 1]; }
                }
                if (cp < 128) {
#pragma unroll
                    for (int k = 0; k < 2; ++k) {
                        float e0[8], e1[8];
#pragma unroll
                        for (int j = 0; j < 8; ++j) { const int i = 8 * k + j;
                            e0[j] = silu(cb[0] + cw[0][0] * x0[i] + cw[1][0] * x0[i + 1] + cw[2][0] * x0[i + 2] + cw[3][0] * x0[i + 3]);
                            e1[j] = silu(cb[1] + cw[0][1] * x1[i] + cw[1][1] * x1[i + 1] + cw[2][1] * x1[i + 2] + cw[3][1] * x1[i + 3]); }
                        u32x4 w0, w1;
                        w0.x = cvtpk(e0[0], e0[1]); w0.y = cvtpk(e0[2], e0[3]); w0.z = cvtpk(e0[4], e0[5]); w0.w = cvtpk(e0[6], e0[7]);
                        w1.x = cvtpk(e1[0], e1[1]); w1.y = cvtpk(e1[2], e1[3]); w1.z = cvtpk(e1[4], e1[5]); w1.w = cvtpk(e1[6], e1[7]);
                        *(SSD_LAS u32x4*)(lds + L_XT + (2 * cp) * XT_STRIDE + 64 * rh + 32 * hb + 16 * k) = w0;
                        *(SSD_LAS u32x4*)(lds + L_XT + (2 * cp + 1) * XT_STRIDE + 64 * rh + 32 * hb + 16 * k) = w1;
                    }
                } else if (!PRE || cp < 192) {
                    const int n = cp < 192 ? 2 * (cp - 128) : 2 * (cp - 192); const int base = (cp < 192 ? L_BM : L_CM) + 8192 * rh + 512 * (n >> 5) + 2 * (n & 7);
                    const int chl = (n >> 3) & 3;
#pragma unroll
                    for (int i = 0; i < 16; ++i) {
                        const float e0 = silu(cb[0] + cw[0][0] * x0[i] + cw[1][0] * x0[i + 1] + cw[2][0] * x0[i + 2] + cw[3][0] * x0[i + 3]);
                        const float e1 = silu(cb[1] + cw[0][1] * x1[i] + cw[1][1] * x1[i + 1] + cw[2][1] * x1[i + 2] + cw[3][1] * x1[i + 3]);
                        *(SSD_LAS unsigned*)(lds + base + 16 * (chl ^ ((i >> 2) & 3)) + 2048 * (2 * hb + (i >> 3)) + 64 * (i & 7)) = cvtpk(e0, e1);
                    }
                }
            }
            if (wave < 4) {
                const int t = t0 + lane;
                float dt = 0.f;
                if (t < u.len) { const float v = dtr + dtb_l; dt = fmaxf(v, 0.f) + log1pf(__expf(-fabsf(v))); }
                float a = dt * A_l;
#pragma unroll
                for (int o = 1; o < 64; o <<= 1) { const float n = __shfl_up(a, o); if (lane >= o) a += n; }
                ((SSD_LAS float*)(lds + L_TAB))[wave * 64 + lane] = dt; ((SSD_LAS float*)(lds + L_TAB + 1024))[wave * 64 + lane] = a;
            }
            if (c + 1 < nchunks) SSD_ISSUE(c + 1);
        }
        if constexpr (PRE) SSD_BAR();
        else if (c + 1 < nchunks) { if (wave < 4) asm volatile("s_waitcnt vmcnt(39) lgkmcnt(0)\n\ts_barrier" ::: "memory"); else asm volatile("s_waitcnt vmcnt(38) lgkmcnt(0)\n\ts_barrier" ::: "memory"); }
        else asm volatile("s_waitcnt vmcnt(0) lgkmcnt(0)\n\ts_barrier" ::: "memory");
        if constexpr (!PRE) {
        {
#pragma unroll
            for (int rep = 0; rep < 2; ++rep) {
                const int ti = wave + 8 * rep;
                if (ti < 10) {
                    const int stq = ti < 4 ? 0 : ti < 7 ? 1 : ti < 9 ? 2 : 3, qtq = ti < 4 ? ti : ti < 7 ? ti - 3 : ti < 9 ? ti - 5 : 3;
                    f32x4 acc = (f32x4){0.f, 0.f, 0.f, 0.f};
#pragma unroll
                    for (int ks = 0; ks < 4; ++ks) {
                        const bf16x8 a = *(const SSD_LAS bf16x8*)(lds + L_BM + rowrd + 4096 * stq + 512 * ks);
                        const bf16x8 b = *(const SSD_LAS bf16x8*)(lds + L_CM + rowrd + 4096 * qtq + 512 * ks);
                        acc = MFMA16(a, b, acc);
                    }
                    *(SSD_LAS f32x4*)(lds + L_G + (stq * 4 + qtq) * 1024 + lane * 16) = acc;
                }
            }
        }
        SSD_BAR();
        const SSD_LAS float* dtt = (const SSD_LAS float*)(lds + L_TAB) + hh * 64;
        const SSD_LAS float* act = (const SSD_LAS float*)(lds + L_TAB + 1024) + hh * 64;
        f32x4 y[4][2];
        {
#pragma unroll
            for (int qt = 0; qt < 4; ++qt) { y[qt][0] = (f32x4){0.f, 0.f, 0.f, 0.f}; y[qt][1] = (f32x4){0.f, 0.f, 0.f, 0.f}; }
#pragma unroll
            for (int ks = 0; ks < 4; ++ks) {
                const bf16x8 sf0 = pack8(st[2 * ks][0], st[2 * ks + 1][0]), sf1 = pack8(st[2 * ks][1], st[2 * ks + 1][1]);
#pragma unroll
                for (int qt = 0; qt < 4; ++qt) {
                    const u32x2 lo = *(const SSD_LAS u32x2*)(lds + L_CM + c_lo + 4096 * qt + 512 * ks);
                    const u32x2 hi = *(const SSD_LAS u32x2*)(lds + L_CM + c_hi + 4096 * qt + 512 * ks);
                    const bf16x8 cf = __builtin_bit_cast(bf16x8, (u32x4){lo.x, lo.y, hi.x, hi.y});
                    y[qt][0] = MFMA16(cf, sf0, y[qt][0]); y[qt][1] = MFMA16(cf, sf1, y[qt][1]);
                }
            }
#pragma unroll
            for (int qt = 0; qt < 4; ++qt) {
                const f32x4 aq = *(const SSD_LAS f32x4*)(act + 16 * qt + 4 * g4);
#pragma unroll
                for (int r = 0; r < 4; ++r) { const float e = __expf(aq[r]); y[qt][0][r] *= e; y[qt][1][r] *= e; }
            }
#pragma unroll
            for (int qt = 0; qt < 4; ++qt) {
                const float aqc = act[16 * qt + c16];
                const int qcol = 16 * qt + c16;
#pragma unroll
                for (int ks = 0; ks <= (qt >> 1); ++ks) {
                    f32x4 m[2];
#pragma unroll
                    for (int e2 = 0; e2 < 2; ++e2) {
                        const int stt = 2 * ks + e2;
                        if (stt <= qt) {
                            const f32x4 gv = *(const SSD_LAS f32x4*)(lds + L_G + (stt * 4 + qt) * 1024 + lane * 16);
                            const f32x4 as = *(const SSD_LAS f32x4*)(act + 16 * stt + 4 * g4);
                            const f32x4 ds = *(const SSD_LAS f32x4*)(dtt + 16 * stt + 4 * g4);
#pragma unroll
                            for (int r = 0; r < 4; ++r) { const int s = 16 * stt + 4 * g4 + r; m[e2][r] = s <= qcol ? gv[r] * __expf(aqc - as[r]) * ds[r] : 0.f; }
                        } else m[e2] = (f32x4){0.f, 0.f, 0.f, 0.f};
                    }
                    const bf16x8 mf = pack8(m[0], m[1]);
#pragma unroll
                    for (int pt = 0; pt < 2; ++pt) {
                        const u32x2 lo = *(const SSD_LAS u32x2*)(lds + L_XT + xt_lane + 8 * g4 + 16 * XT_STRIDE * pt + 64 * ks);
                        const u32x2 hi = *(const SSD_LAS u32x2*)(lds + L_XT + xt_lane + 8 * g4 + 16 * XT_STRIDE * pt + 64 * ks + 32);
                        const bf16x8 xf = __builtin_bit_cast(bf16x8, (u32x4){lo.x, lo.y, hi.x, hi.y});
                        y[qt][pt] = MFMA16(mf, xf, y[qt][pt]);
                    }
                }
            }
#pragma unroll
            for (int qt = 0; qt < 4; ++qt) {
                f32x4 sq = (f32x4){0.f, 0.f, 0.f, 0.f};
#pragma unroll
                for (int pt = 0; pt < 2; ++pt) {
                    const u32x2 xv = *(const SSD_LAS u32x2*)(lds + L_XT + xt_lane + 8 * g4 + 16 * XT_STRIDE * pt + 32 * qt);
                    const SSD_LAS unsigned short* zp0 = (const SSD_LAS unsigned short*)(lds + L_ZT) + (4 * g4) * 256 + 64 * hh + 32 * ph + c16 + 16 * pt + (16 * qt) * 256;
                    const float xs[4] = {__uint_as_float(xv.x << 16), __uint_as_float(xv.x & 0xffff0000u), __uint_as_float(xv.y << 16), __uint_as_float(xv.y & 0xffff0000u)};
                    const float zs[4] = {bf2f(zp0[0]), bf2f(zp0[256]), bf2f(zp0[512]), bf2f(zp0[768])};
#pragma unroll
                    for (int r = 0; r < 4; ++r) { const float v = (y[qt][pt][r] + Dh * xs[r]) * silu(zs[r]); y[qt][pt][r] = v; sq[r] += v * v; }
                }
#pragma unroll
                for (int r = 0; r < 4; ++r) { sq[r] = row16_sum(sq[r]); }
                if (c16 == 0) *(SSD_LAS f32x4*)(lds + L_SSQ + wave * 256 + (16 * qt + 4 * g4) * 4) = sq;
            }
        }
        SSD_BAR();
        {
            float nw[2];
#pragma unroll
            for (int pt = 0; pt < 2; ++pt) nw[pt] = P.norm_w[256 * g + 64 * hh + 32 * ph + 16 * pt + c16];
#pragma unroll
            for (int qt = 0; qt < 4; ++qt) {
                f32x4 tot = (f32x4){0.f, 0.f, 0.f, 0.f};
#pragma unroll
                for (int w = 0; w < 8; ++w) tot += *(const SSD_LAS f32x4*)(lds + L_SSQ + w * 256 + (16 * qt + 4 * g4) * 4);
#pragma unroll
                for (int r = 0; r < 4; ++r) {
                    const int t = t0 + 16 * qt + 4 * g4 + r;
                    if (t < u.len) {
                        const float rn = __builtin_amdgcn_rsqf(tot[r] * (1.0f / 256.0f) + EPS);
#pragma unroll
                        for (int pt = 0; pt < 2; ++pt) {
                            const unsigned b = cvtpk(y[qt][pt][r] * rn * nw[pt], 0.f);
                            u.y[(size_t)t * 4096 + 256 * g + 64 * hh + 32 * ph + 16 * pt + c16] = (unsigned short)b;
                        }
                    }
                }
            }
        }
        if (c + 1 < nchunks) SSD_ISSUE_Z(c + 1);
        }
        {
            const SSD_LAS float* dtt = (const SSD_LAS float*)(lds + L_TAB) + hh * 64;
            const SSD_LAS float* act = (const SSD_LAS float*)(lds + L_TAB + 1024) + hh * 64;
            const float aend = act[63], cd = __expf(aend); asum += aend;
            bf16x8 xw[2][2];
#pragma unroll
            for (int ks = 0; ks < 2; ++ks) {
                const f32x4 a0 = *(const SSD_LAS f32x4*)(act + 32 * ks + 8 * g4), a1 = *(const SSD_LAS f32x4*)(act + 32 * ks + 8 * g4 + 4);
                const f32x4 d0 = *(const SSD_LAS f32x4*)(dtt + 32 * ks + 8 * g4), d1 = *(const SSD_LAS f32x4*)(dtt + 32 * ks + 8 * g4 + 4);
                float wv[8];
#pragma unroll
                for (int j = 0; j < 4; ++j) { wv[j] = d0[j] * __expf(aend - a0[j]); wv[4 + j] = d1[j] * __expf(aend - a1[j]); }
#pragma unroll
                for (int pt = 0; pt < 2; ++pt) {
                    const u32x4 xv = *(const SSD_LAS u32x4*)(lds + L_XT + xt_lane + 16 * g4 + 16 * XT_STRIDE * pt + 64 * ks);
                    u32x4 o;
                    o.x = cvtpk(__uint_as_float(xv.x << 16) * wv[0], __uint_as_float(xv.x & 0xffff0000u) * wv[1]);
                    o.y = cvtpk(__uint_as_float(xv.y << 16) * wv[2], __uint_as_float(xv.y & 0xffff0000u) * wv[3]);
                    o.z = cvtpk(__uint_as_float(xv.z << 16) * wv[4], __uint_as_float(xv.z & 0xffff0000u) * wv[5]);
                    o.w = cvtpk(__uint_as_float(xv.w << 16) * wv[6], __uint_as_float(xv.w & 0xffff0000u) * wv[7]);
                    xw[ks][pt] = __builtin_bit_cast(bf16x8, o);
                }
            }
            const unsigned bm00 = (unsigned)(uintptr_t)(lds + L_BM + tr00), bm01 = (unsigned)(uintptr_t)(lds + L_BM + tr01), bm10 = (unsigned)(uintptr_t)(lds + L_BM + tr10), bm11 = (unsigned)(uintptr_t)(lds + L_BM + tr11);
#pragma unroll
            for (int nt = 0; nt < 8; ++nt) {
                st[nt][0] *= cd; st[nt][1] *= cd;
                s16x4 t0v[2], t1v[2];
#pragma unroll
                for (int ks = 0; ks < 2; ++ks) {
                    asm volatile("ds_read_b64_tr_b16 %0, %1 offset:%c2" : "=&v"(t0v[ks]) : "v"((nt & 1) ? bm10 : bm00), "i"(8192 * ks + 512 * (nt >> 1)) : "memory");
                    asm volatile("ds_read_b64_tr_b16 %0, %1 offset:%c2" : "=&v"(t1v[ks]) : "v"((nt & 1) ? bm11 : bm01), "i"(8192 * ks + 512 * (nt >> 1) + 256) : "memory");
                }
                asm volatile("s_waitcnt lgkmcnt(0)" ::: "memory");
                __builtin_amdgcn_sched_barrier(0);
#pragma unroll
                for (int ks = 0; ks < 2; ++ks) {
                    const bf16x8 bt = (bf16x8){t0v[ks][0], t0v[ks][1], t0v[ks][2], t0v[ks][3], t1v[ks][0], t1v[ks][1], t1v[ks][2], t1v[ks][3]};
                    st[nt][0] = MFMA16(bt, xw[ks][0], st[nt][0]); st[nt][1] = MFMA16(bt, xw[ks][1], st[nt][1]);
                }
            }
        }
        SSD_BAR();
    }
#undef SSD_ISSUE
#undef SSD_ISSUE_Z
    if constexpr (PRE) {
        float* F = u.fseg + (size_t)u.seg * FSTRIDE;
#pragma unroll
        for (int nt = 0; nt < 8; ++nt)
#pragma unroll
            for (int pt = 0; pt < 2; ++pt) {
                unsigned long long* fp = (unsigned long long*)(F + ((size_t)hh * 64 + 32 * ph + 16 * pt + c16) * 128 + 16 * nt + 4 * g4);
                const f32x4 v = st[nt][pt];
                __hip_atomic_store(fp, ((unsigned long long)__float_as_uint(v[1]) << 32) | __float_as_uint(v[0]), SSD_RLX);
                __hip_atomic_store(fp + 1, ((unsigned long long)__float_as_uint(v[3]) << 32) | __float_as_uint(v[2]), SSD_RLX);
            }
        if (ph == 0 && lane == 0) __hip_atomic_store((unsigned*)(F + 4 * 64 * 128 + hh), __float_as_uint(__expf(asum)), SSD_RLX);
        asm volatile("s_waitcnt vmcnt(0)" ::: "memory");
        __syncthreads();
        if (tid == 0) __hip_atomic_fetch_or(u.flag, 1u << u.seg, SSD_RLX);
    } else if (u.last) {
#pragma unroll
        for (int nt = 0; nt < 8; ++nt)
#pragma unroll
            for (int pt = 0; pt < 2; ++pt) *(f32x4*)(u.fin + ((size_t)head * 64 + 32 * ph + 16 * pt + c16) * 128 + 16 * nt + 4 * g4) = st[nt][pt] * TEST_ALPHA;
    }
}
}

namespace sk {
typedef short bf16x8 __attribute__((ext_vector_type(8)));
typedef float f32x4 __attribute__((ext_vector_type(4)));
#define SK_LAS __attribute__((address_space(3)))
__device__ __forceinline__ unsigned cvtpk(float lo, float hi) { unsigned r; asm volatile("v_cvt_pk_bf16_f32 %0, %1, %2" : "=v"(r) : "v"(lo), "v"(hi)); return r; }
__device__ __forceinline__ unsigned short bf(float v) { return (unsigned short)cvtpk(v, 0.f); }

template <int NRT, int NB, bool DEEP = false, bool NTB = false  , class Epi>
__device__ __forceinline__ void skinny(SK_LAS unsigned char* lds, const unsigned short* A, int lda, int K, int njobs, const Epi& E, int wave, int lane, int wg, int nwg) {
    asm volatile("" : "+v"(lane));
    constexpr int RS = 528, BUF = 16 * NRT * RS;
    const int c16 = lane & 15, g4 = lane >> 4, tid = wave * 64 + lane;
    const int nch = K >> 8;
    const unsigned short* asrc = A + (size_t)(tid >> 5) * lda + 8 * (tid & 31);
    SK_LAS unsigned char* adst = lds + (tid >> 5) * RS + 16 * (tid & 31);
    const SK_LAS unsigned char* ard = lds + c16 * RS + 16 * g4;
    for (int base = wg * 8; base < njobs; base += nwg * 8) {
        const int job = base + wave; const bool valid = job < njobs; const int jobc = valid ? job : njobs - 1;
        const unsigned short* brow[NB];
#pragma unroll
        for (int nb = 0; nb < NB; ++nb) brow[nb] = E.brow(jobc, c16, nb) + 8 * g4;
        f32x4 acc[NB][NRT];
#pragma unroll
        for (int nb = 0; nb < NB; ++nb)
#pragma unroll
            for (int rt = 0; rt < NRT; ++rt) acc[nb][rt] = (f32x4){0.f, 0.f, 0.f, 0.f};
        bf16x8 an[NRT];
#pragma unroll
        for (int i = 0; i < NRT; ++i) an[i] = *(const bf16x8*)(asrc + (size_t)(16 * i) * lda);
#pragma unroll
        for (int i = 0; i < NRT; ++i) *(SK_LAS bf16x8*)(adst + 16 * i * RS) = an[i];
        __syncthreads();
        if constexpr (NB == 1 && DEEP) {
            bf16x8 q0[4], q1[4], q2[4], q3[4];
            const int nh = 2 * nch;
#define SK_LOADH(Q, h) { const int hh_ = (h) < nh ? (h) : nh - 1; \
            _Pragma("unroll") for (int ks = 0; ks < 4; ++ks) Q[ks] = NTB ? __builtin_nontemporal_load((const bf16x8*)(brow[0] + 128 * hh_ + 32 * ks)) : *(const bf16x8*)(brow[0] + 128 * hh_ + 32 * ks); __builtin_amdgcn_sched_barrier(0); }
#define SK_COMP(Q, bufo, kh) { \
            _Pragma("unroll") for (int ks = 0; ks < 4; ++ks) \
                _Pragma("unroll") for (int rt = 0; rt < NRT; ++rt) { \
                    const bf16x8 a = *(const SK_LAS bf16x8*)(ard + (bufo) + 16 * rt * RS + 64 * (4 * (kh) + ks)); \
                    acc[0][rt] = __builtin_amdgcn_mfma_f32_16x16x32_bf16(a, Q[ks], acc[0][rt], 0, 0, 0); \
                    if ((rt & 3) == 3) __builtin_amdgcn_sched_barrier(0); } }
#define SK_LOADA(cn) { const int cn_ = (cn) < nch ? (cn) : nch - 1; \
            _Pragma("unroll") for (int i = 0; i < NRT; ++i) an[i] = *(const bf16x8*)(asrc + (size_t)(16 * i) * lda + 256 * cn_); __builtin_amdgcn_sched_barrier(0); }
#define SK_PUTA(bufo) { _Pragma("unroll") for (int i = 0; i < NRT; ++i) *(SK_LAS bf16x8*)(adst + (bufo) + 16 * i * RS) = an[i]; __syncthreads(); }
            SK_LOADH(q0, 0); SK_LOADH(q1, 1); SK_LOADH(q2, 2);
#pragma unroll 1
            for (int c = 0;; c += 2) {
                SK_LOADA(c + 1); SK_LOADH(q3, 2 * c + 3); SK_COMP(q0, 0, 0); SK_LOADH(q0, 2 * c + 4); SK_COMP(q1, 0, 1); SK_PUTA(BUF);
                if (c + 1 >= nch) break;
                SK_LOADA(c + 2); SK_LOADH(q1, 2 * c + 5); SK_COMP(q2, BUF, 0); SK_LOADH(q2, 2 * c + 6); SK_COMP(q3, BUF, 1); SK_PUTA(0);
                if (c + 2 >= nch) break;
            }
#undef SK_LOADH
#undef SK_COMP
#undef SK_LOADA
#undef SK_PUTA
        } else {
        bf16x8 b[8][NB];
#pragma unroll
        for (int ks = 0; ks < 8; ++ks)
#pragma unroll
            for (int nb = 0; nb < NB; ++nb) b[ks][nb] = NTB ? __builtin_nontemporal_load((const bf16x8*)(brow[nb] + 32 * ks)) : *(const bf16x8*)(brow[nb] + 32 * ks);
#pragma unroll 1
        for (int c = 0; c < nch; ++c) {
            const int buf = (c & 1) * BUF;
            constexpr int PF = NB == 1 ? 8 : 4;
            bf16x8 bn[PF][NB];
            const int cn = c + 1 < nch ? c + 1 : c;
#pragma unroll
            for (int ks = 0; ks < PF; ++ks)
#pragma unroll
                for (int nb = 0; nb < NB; ++nb) bn[ks][nb] = NTB ? __builtin_nontemporal_load((const bf16x8*)(brow[nb] + 256 * cn + 32 * ks)) : *(const bf16x8*)(brow[nb] + 256 * cn + 32 * ks);
#pragma unroll
            for (int i = 0; i < NRT; ++i) an[i] = *(const bf16x8*)(asrc + (size_t)(16 * i) * lda + 256 * cn);
#pragma unroll
            for (int ks = 0; ks < 8; ++ks)
#pragma unroll
                for (int rt = 0; rt < NRT; ++rt) {
                    const bf16x8 a = *(const SK_LAS bf16x8*)(ard + buf + 16 * rt * RS + 64 * ks);
#pragma unroll
                    for (int nb = 0; nb < NB; ++nb) acc[nb][rt] = __builtin_amdgcn_mfma_f32_16x16x32_bf16(a, b[ks][nb], acc[nb][rt], 0, 0, 0);
                    if ((rt & 3) == 3) __builtin_amdgcn_sched_barrier(0);
                }
#pragma unroll
            for (int i = 0; i < NRT; ++i) *(SK_LAS bf16x8*)(adst + (BUF - buf) + 16 * i * RS) = an[i];
#pragma unroll
            for (int ks = 0; ks < PF; ++ks)
#pragma unroll
                for (int nb = 0; nb < NB; ++nb) b[ks][nb] = bn[ks][nb];
#pragma unroll
            for (int ks = PF; ks < 8; ++ks)
#pragma unroll
                for (int nb = 0; nb < NB; ++nb) b[ks][nb] = NTB ? __builtin_nontemporal_load((const bf16x8*)(brow[nb] + 256 * cn + 32 * ks)) : *(const bf16x8*)(brow[nb] + 256 * cn + 32 * ks);
            __syncthreads();
        }
        }
        if (valid) {
            int c16e = c16, g4e = g4; asm volatile("" : "+v"(c16e), "+v"(g4e));
#pragma unroll
            for (int rt = 0; rt < NRT; ++rt) { f32x4 v[NB];
#pragma unroll
                for (int nb = 0; nb < NB; ++nb) v[nb] = acc[nb][rt];
                E.store(job, rt, c16e, g4e, v); }
        }
    }
}

struct EpiInS {
    const unsigned short* WinT; unsigned short *Q, *Z, *XBC, *Kext, *Vext; float* DT; float* out;
    __device__ __forceinline__ const unsigned short* brow(int job, int n, int) const { return WinT + (size_t)(16 * job + n) * DM; }
    __device__ __forceinline__ void store(int job, int rt, int n, int g4, const f32x4 (&v)[1]) const {
        const int c0 = 16 * job, col = c0 + n, rs0 = 16 * rt + 4 * g4;
        if (c0 < 2048) {
#pragma unroll
            for (int r = 0; r < 4; ++r) Q[((size_t)MP + rs0 + r) * AW + col] = bf(v[0][r] * QSCALE);
        } else if (c0 < 6144) {
            const bool isk = c0 < 4096; const int c = col - (isk ? 2048 : 4096); float* o = out + (isk ? O_KS : O_VS); unsigned short* e = isk ? Kext : Vext;
#pragma unroll
            for (int r = 0; r < 4; ++r) { const int rs = rs0 + r; o[(size_t)rs * AW + c] = v[0][r] * TEST_ALPHA; e[((size_t)(rs >> 4) * KVROWS + PAST + (rs & 15)) * AW + c] = bf(v[0][r]); }
        } else if (c0 < 8192) {
#pragma unroll
            for (int r = 0; r < 4; ++r) Z[((size_t)MP + rs0 + r) * SSDI + col - 6144] = bf(v[0][r]);
        } else if (c0 < 12288) {
            const int c = col - 8192;
#pragma unroll
            for (int r = 0; r < 4; ++r) { const int rs = rs0 + r; XBC[((size_t)MP + rs) * CONVD + c] = bf(v[0][r]); const int t = (rs & 15) - 13; if (t >= 0) out[O_CS + (size_t)((rs >> 4) * 3 + t) * CONVD + c] = v[0][r] * TEST_ALPHA; }
        } else {
#pragma unroll
            for (int r = 0; r < 4; ++r) DT[((size_t)MP + rs0 + r) * SH + col - 12288] = v[0][r];
        }
    }
};
struct EpiDtP {
    const unsigned short* XN; float* DT;
    __device__ __forceinline__ const unsigned short* brow(int job, int n, int) const { return XN + (size_t)(16 * job + n) * DM; }
    __device__ __forceinline__ void store(int job, int rt, int n, int g4, const f32x4 (&v)[1]) const {
        *(f32x4*)(DT + (size_t)(16 * job + n) * SH + 16 * rt + 4 * g4) = v[0];
    }
};
struct EpiOutS {
    const unsigned short* WoT; const float* xs; float* out; unsigned short* X1B; float* ss;
    __device__ __forceinline__ const unsigned short* brow(int job, int n, int) const { return WoT + (size_t)(16 * job + n) * DM; }
    __device__ __forceinline__ void store(int job, int rt, int n, int g4, const f32x4 (&v)[1]) const {
        const int col = 16 * job + n;
#pragma unroll
        for (int r = 0; r < 4; ++r) {
            const int rs = 16 * rt + 4 * g4 + r; const float x1 = xs[(size_t)rs * DM + col] + v[0][r];
            X1B[((size_t)MP + rs) * DM + col] = bf(x1);
            float sq = x1 * x1; sq += __shfl_xor(sq, 1); sq += __shfl_xor(sq, 2); sq += __shfl_xor(sq, 4); sq += __shfl_xor(sq, 8);
            if (n == 0) atomicAdd(ss + MP + rs, sq);
        }
    }
};
struct EpiGuS {
    const unsigned short* WguT; unsigned short* H; const float* ss;
    __device__ __forceinline__ const unsigned short* brow(int job, int n, int nb) const { const int f = 16 * job + n; return WguT + (size_t)(256 * (f >> 7) + (f & 127) + 128 * nb) * DM; }
    __device__ __forceinline__ void store(int job, int rt, int n, int g4, const f32x4 (&v)[2]) const {
        const int f = 16 * job + n;
#pragma unroll
        for (int r = 0; r < 4; ++r) {
            const int rs = 16 * rt + 4 * g4 + r; const float rn = 1.0f / sqrtf(ss[MP + rs] * (1.0f / DM) + EPS);
            const float g = v[0][r] * rn, up = v[1][r] * rn;
            H[(size_t)rs * DFF + f] = bf(g * up * __builtin_amdgcn_rcpf(1.0f + __builtin_amdgcn_exp2f(-1.4426950408889634f * g)));
        }
    }
};
struct EpiDownS {
    const unsigned short* WdT; const unsigned short* X1B; unsigned short* X2B; float* ss;
    __device__ __forceinline__ const unsigned short* brow(int job, int n, int) const { return WdT + (size_t)(16 * job + n) * DFF; }
    __device__ __forceinline__ void store(int job, int rt, int n, int g4, const f32x4 (&v)[1]) const {
        const int col = 16 * job + n;
#pragma unroll
        for (int r = 0; r < 4; ++r) {
            const int rs = 16 * rt + 4 * g4 + r; const size_t idx = ((size_t)MP + rs) * DM + col; const float x2 = __uint_as_float((unsigned)X1B[idx] << 16) + v[0][r]; X2B[idx] = bf(x2);
            float sq = x2 * x2; sq += __shfl_xor(sq, 1); sq += __shfl_xor(sq, 2); sq += __shfl_xor(sq, 4); sq += __shfl_xor(sq, 8);
            if (n == 0) atomicAdd(ss + MP + rs, sq);
        }
    }
};
struct EpiOutPart {
    const unsigned short* WoT; float* part; int koff;
    __device__ __forceinline__ const unsigned short* brow(int job, int n, int) const { return WoT + (size_t)(16 * job + n) * DM + koff; }
    __device__ __forceinline__ void store(int job, int rt, int n, int g4, const f32x4 (&v)[1]) const {
#pragma unroll
        for (int r = 0; r < 4; ++r) part[(size_t)(16 * rt + 4 * g4 + r) * DM + 16 * job + n] = v[0][r];
    }
};
struct EpiDownPart {
    const unsigned short* WdT; float* part; int koff;
    __device__ __forceinline__ const unsigned short* brow(int job, int n, int) const { return WdT + (size_t)(16 * job + n) * DFF + koff; }
    __device__ __forceinline__ void store(int job, int rt, int n, int g4, const f32x4 (&v)[1]) const {
#pragma unroll
        for (int r = 0; r < 4; ++r) part[(size_t)(16 * rt + 4 * g4 + r) * DM + 16 * job + n] = v[0][r];
    }
};
}

struct Args { const float* in[25]; float* out; unsigned char* ws; int ph_lo, ph_hi; };
enum { I_XP = 0, I_XS, I_CK, I_CV, I_SCONV, I_SSSM, I_N1W, I_WIN, I_LQ1, I_LK1, I_LQ2, I_LK2, I_SUBLN, I_CONVW, I_CONVB, I_DTB, I_ALOG, I_DSKIP, I_SSDNW, I_WOUT, I_N2W, I_WG, I_WU, I_WD, I_FNW };

#ifndef P4_INT8
#define P4_INT8 1
#endif
constexpr bool WGU_BF16 = !P4_INT8;
constexpr int WQ_SAMPLE_ROWS = 48;
__device__ __forceinline__ float wq_scale(const unsigned char* ws, int t) { const float s = ((const float*)(ws + WS_CTL))[CW_WSTAT + t]; return pg8::W8I_CLIP / sqrtf(s * (1.0f / ((float)WQ_SAMPLE_ROWS * DFF)) + 1e-30f); }
__device__ __forceinline__ void p0_prologue(const Frame& F, const Args& a) {
    unsigned char* ws = a.ws;
    LAS float* scr = (LAS float*)(F.lds + RING_OFF + F.wave * 17408);
    const int gw = F.vcu * NWAVES + F.wave, NGW = F.G * NWAVES, lane = F.lane;
    bf16* WinT = (bf16*)(ws + WS_WIN); bf16* WoT = (bf16*)(ws + WS_WO); bf16* WguT = (bf16*)(ws + WS_WGU); bf16* WdT = (bf16*)(ws + WS_WD);
    constexpr int I_IN = (DM / 64) * (NIN / 32), I_O = (DM / 64) * (DM / 32), I_G = (DM / 64) * (DFF / 32), I_D = (DFF / 64) * (DM / 32);
    for (int it = 2 * gw; it < I_IN; it += 2 * NGW) p0_transpose_pair<0>(a.in[I_WIN], DM, NIN, WinT, nullptr, scr, it, I_IN, lane);
    { GAS v4u* z = (GAS v4u*)(WinT + (size_t)NIN * DM); const int n16 = (NINP - NIN) * DM * 2 / 16;
      for (int i = gw * 64 + lane; i < n16; i += NGW * 64) z[i] = (v4u){0u, 0u, 0u, 0u}; }
    bf16* XN = (bf16*)(ws + WS_XN);
    for (int m = gw; m < MPAD; m += 2 * NGW) {
        const int m1 = m + NGW;
        if (m1 < MR) rms_row2_to_bf16(lane, m < MP ? a.in[I_XP] + (size_t)m * DM : a.in[I_XS] + (size_t)(m - MP) * DM, m1 < MP ? a.in[I_XP] + (size_t)m1 * DM : a.in[I_XS] + (size_t)(m1 - MP) * DM,
                                      a.in[I_N1W], XN + (size_t)m * DM, XN + (size_t)m1 * DM);
        else {
            for (int mm = m; mm < MPAD; mm += NGW) {
                if (mm > m1) break;
                if (mm < MR) rms_row_to_bf16(lane, mm < MP ? a.in[I_XP] + (size_t)mm * DM : a.in[I_XS] + (size_t)(mm - MP) * DM, a.in[I_N1W], XN + (size_t)mm * DM);
                else { GAS v4u* z = (GAS v4u*)(XN + (size_t)mm * DM);
#pragma unroll
                    for (int j = 0; j < 8; ++j) z[lane + 64 * j] = (v4u){0u, 0u, 0u, 0u}; }
            }
        }
    }
    { float* wst = (float*)(ws + WS_CTL) + CW_WSTAT; constexpr int NV = WQ_SAMPLE_ROWS * (DFF / 4);
      float sg = 0.f, su = 0.f;
      for (int i = gw * 64 + lane; i < NV; i += NGW * 64) { const int k = i / (DFF / 4); const f32x4 x = *(const GAS f32x4*)(a.in[I_WG] + 4 * (size_t)i), y = *(const GAS f32x4*)(a.in[I_WU] + 4 * (size_t)i);
          const float n2 = a.in[I_N2W][k];
          sg += n2 * n2 * ((x.x * x.x + x.y * x.y) + (x.z * x.z + x.w * x.w)); su += n2 * n2 * ((y.x * y.x + y.y * y.y) + (y.z * y.z + y.w * y.w)); }
      sg = wave_sum(sg); su = wave_sum(su); if (lane == 0) { atomicAdd(wst + 0, sg); atomicAdd(wst + 1, su); } }
    {
        bf16* Kext = (bf16*)(ws + WS_KEXT); bf16* Vext = (bf16*)(ws + WS_VEXT);
        const int zvec = DEC_B * (KVROWS - PAST - DEC_T) * AW / 8;
        for (int i = gw * 64 + lane; i < 2 * zvec; i += NGW * 64) {
            const bool isv = i >= zvec; const int j = isv ? i - zvec : i; const int e = j * 8, per = (KVROWS - PAST - DEC_T) * AW, b = e / per, rem = e % per;
            *(GAS v4u*)((isv ? Vext : Kext) + ((size_t)b * KVROWS + PAST + DEC_T) * AW + rem) = (v4u){0u, 0u, 0u, 0u};
        }
    }
}

__device__ __forceinline__ void p2_cache_slice(const Frame& F, const Args& a, int b, int h) {
    int tid = F.tid; asm volatile("" : "+v"(tid));
    const int r0 = tid >> 5, c4 = (tid & 31) * 4;
    const float* ks = a.in[I_CK] + ((size_t)b * PAST + r0) * AW + h * HD + c4; const float* vs = a.in[I_CV] + ((size_t)b * PAST + r0) * AW + h * HD + c4;
    bf16* kd = (bf16*)(a.ws + WS_KEXT) + ((size_t)b * KVROWS + r0) * AW + h * HD + c4; bf16* vd = (bf16*)(a.ws + WS_VEXT) + ((size_t)b * KVROWS + r0) * AW + h * HD + c4;
    for (int i0 = 0; i0 < PAST / 16; i0 += 8) {
        f32x4 kx[8], vx[8];
#pragma unroll
        for (int q = 0; q < 8; ++q) { kx[q] = __builtin_nontemporal_load((const GAS f32x4*)(ks + (size_t)(i0 + q) * 16 * AW)); vx[q] = __builtin_nontemporal_load((const GAS f32x4*)(vs + (size_t)(i0 + q) * 16 * AW)); }
#pragma unroll
        for (int q = 0; q < 8; ++q) { typedef unsigned u32x2g __attribute__((ext_vector_type(2)));
            *(GAS u32x2g*)(kd + (size_t)(i0 + q) * 16 * AW) = (u32x2g){pk2(kx[q].x, kx[q].y), pk2(kx[q].z, kx[q].w)};
            *(GAS u32x2g*)(vd + (size_t)(i0 + q) * 16 * AW) = (u32x2g){pk2(vx[q].x, vx[q].y), pk2(vx[q].z, vx[q].w)}; }
    }
    asm volatile("s_waitcnt vmcnt(0)" ::: "memory");
    __syncthreads();
}

constexpr int CONV_PAIRS_O = (DM / 64) * (DM / 32) / 2, CONV_PAIRS_G = (DM / 64) * (DFF / 32) / 2, CONV_PAIRS_D = (DFF / 64) * (DM / 32) / 2;
constexpr int CONV_ITEMS = (CONV_PAIRS_O + 2 * CONV_PAIRS_G + CONV_PAIRS_D) / 64;
constexpr int CONV_ITEMS_A = (CONV_PAIRS_O + 2 * CONV_PAIRS_G) / 64;
static_assert(CONV_PAIRS_O % 64 == 0 && CONV_PAIRS_G % 64 == 0 && CONV_PAIRS_D % 64 == 0, "a queue item stays inside one matrix");
__device__ __forceinline__ void p0_deferred_item(const Frame& F, const Args& a, int k) {
    unsigned char* ws = a.ws;
    LAS float* scr = (LAS float*)(F.lds + RING_OFF + F.wave * 17408);
    bf16* WoT = (bf16*)(ws + WS_WO); bf16* WguT = (bf16*)(ws + WS_WGU); bf16* WdT = (bf16*)(ws + WS_WD);
    int lane = F.lane; asm volatile("" : "+v"(lane));
    int p = k * 64 + F.wave * 8;
    if (p < CONV_PAIRS_O) { for (int i = 0; i < 8; ++i) p0_transpose_pair<0>(a.in[I_WOUT], DM, DM, WoT, nullptr, scr, 2 * (p + i), 2 * CONV_PAIRS_O, lane); return; }
    p -= CONV_PAIRS_O;
    if (p < CONV_PAIRS_G) { const float sq = wq_scale(ws, 0); for (int i = 0; i < 8; ++i) p0_transpose_pair<1>(a.in[I_WG], DM, DFF, WGU_BF16 ? WguT : (bf16*)nullptr, a.in[I_N2W], scr, 2 * (p + i), 2 * CONV_PAIRS_G, lane, ws + WS_WGUQ, sq, true); return; }
    p -= CONV_PAIRS_G;
    if (p < CONV_PAIRS_G) { const float sq = wq_scale(ws, 1); for (int i = 0; i < 8; ++i) p0_transpose_pair<2>(a.in[I_WU], DM, DFF, WGU_BF16 ? WguT : (bf16*)nullptr, a.in[I_N2W], scr, 2 * (p + i), 2 * CONV_PAIRS_G, lane, ws + WS_WGUQ, sq, true); return; }
    p -= CONV_PAIRS_G;
    for (int i = 0; i < 8; ++i) p0_transpose_pair<0>(a.in[I_WD], DFF, DM, WdT, nullptr, scr, 2 * (p + i), 2 * CONV_PAIRS_D, lane, ws + WS_WD8, pg8::WD8_SCALE);
}

__device__ __forceinline__ void p3b_quant_rows(const Frame& F, const Args& a) {
    const int gw = F.vcu * NWAVES + F.wave, NGW = F.G * NWAVES; int lane = F.lane; asm volatile("" : "+v"(lane));
    const float* ss = (const float*)(a.ws + WS_CTL) + CW_SS2; float* RQ = (float*)(a.ws + WS_CTL) + CW_RQ;
    const bf16* X1B = (const bf16*)(a.ws + WS_KEXT); unsigned char* X1Q = a.ws + WS_X1Q;
    typedef unsigned u32x2g __attribute__((ext_vector_type(2)));
    for (int m0 = gw; m0 < MR; m0 += 2 * NGW) {
      v4u vv[2][8];
#pragma unroll
      for (int t = 0; t < 2; ++t) { const int mt = m0 + t * NGW < MR ? m0 + t * NGW : m0; const GAS v4u* xr = (const GAS v4u*)(X1B + (size_t)mt * DM) + lane;
#pragma unroll
          for (int j = 0; j < 8; ++j) vv[t][j] = xr[64 * j]; }
#pragma unroll
      for (int t = 0; t < 2; ++t) {
        const int m = m0 + t * NGW; if (m >= MR) break;
        v4u v[8]; float mx = 0.f;
#pragma unroll
        for (int j = 0; j < 8; ++j) v[j] = vv[t][j];
#pragma unroll
        for (int j = 0; j < 8; ++j) {
            mx = fmaxf(mx, fmaxf(fmaxf(fabsf(pg8::bflo(v[j].x)), fabsf(pg8::bfhi(v[j].x))), fmaxf(fabsf(pg8::bflo(v[j].y)), fabsf(pg8::bfhi(v[j].y)))));
            mx = fmaxf(mx, fmaxf(fmaxf(fabsf(pg8::bflo(v[j].z)), fabsf(pg8::bfhi(v[j].z))), fmaxf(fabsf(pg8::bflo(v[j].w)), fabsf(pg8::bfhi(v[j].w))))); }
#pragma unroll
        for (int o = 1; o < 64; o <<= 1) mx = fmaxf(mx, __shfl_xor(mx, o));
        mx = fmaxf(mx, 1e-30f);
        const float sc = 127.0f / mx;
        GAS u32x2g* o8 = (GAS u32x2g*)(X1Q + (size_t)m * DM) + lane;
#pragma unroll
        for (int j = 0; j < 8; ++j) { u32x2g o;
            o.x = pg8::pk4_i8(pg8::bflo(v[j].x) * sc, pg8::bfhi(v[j].x) * sc, pg8::bflo(v[j].y) * sc, pg8::bfhi(v[j].y) * sc);
            o.y = pg8::pk4_i8(pg8::bflo(v[j].z) * sc, pg8::bfhi(v[j].z) * sc, pg8::bflo(v[j].w) * sc, pg8::bfhi(v[j].w) * sc);
            o8[64 * j] = o; }
        if (lane == 0) RQ[m] = mx * (1.0f / 127.0f) / sqrtf(ss[m] * (1.0f / DM) + EPS);
      }
    }
}

__device__ __forceinline__ void p3_sample_final(const Frame& F, const Args& a, int row, const unsigned* cnt, unsigned want) {
    int lane = F.lane; asm volatile("" : "+v"(lane));
    { unsigned sp = 0; while (__hip_atomic_load(cnt, RLX_AGENT) < want) { __builtin_amdgcn_s_sleep(4); if (++sp > (1u << 22)) break; } }
    __builtin_amdgcn_fence(__ATOMIC_ACQUIRE, "agent");
    const float* xs = a.in[I_XS] + (size_t)row * DM; const float* part = (const float*)(a.ws + WS_PARK) + (size_t)row * DM;
    bf16* X1B = (bf16*)(a.ws + WS_KEXT) + ((size_t)MP + row) * DM;
    float s = 0.f;
#pragma unroll 4
    for (int j = 0; j < 16; ++j) { const int c = 4 * (lane + 64 * j);
        f32x4 t = *(const GAS f32x4*)(xs + c);
#pragma unroll
        for (int q = 0; q < 8; ++q) t += *(const GAS f32x4*)(part + (size_t)q * MS * DM + c);
        s += (t.x * t.x + t.y * t.y) + (t.z * t.z + t.w * t.w);
        typedef unsigned u32x2g __attribute__((ext_vector_type(2)));
        *(GAS u32x2g*)(X1B + c) = (u32x2g){pk2(t.x, t.y), pk2(t.z, t.w)}; }
    s = wave_sum(s);
    if (lane == 0) ((float*)(a.ws + WS_CTL))[CW_SS2 + MP + row] = s;
}

constexpr int SMP_SLICES = 8;
__device__ __forceinline__ void p5_sample_final(const Frame& F, const Args& a, int row, const unsigned* cnt, unsigned want) {
    int lane = F.lane; asm volatile("" : "+v"(lane));
    { unsigned sp = 0; while (__hip_atomic_load(cnt, RLX_AGENT) < want) { __builtin_amdgcn_s_sleep(4); if (++sp > (1u << 22)) break; } }
    __builtin_amdgcn_fence(__ATOMIC_ACQUIRE, "agent");
    const bf16* X1B = (const bf16*)(a.ws + WS_KEXT) + ((size_t)MP + row) * DM; const float* part = (const float*)(a.ws + WS_PARK) + (size_t)row * DM;
    f32x4 v[16]; float s = 0.f;
#pragma unroll
    for (int j = 0; j < 16; ++j) { const int c = 4 * (lane + 64 * j);
        typedef unsigned u32x2g __attribute__((ext_vector_type(2)));
        const u32x2g xw = *(const GAS u32x2g*)(X1B + c);
        f32x4 t = (f32x4){__uint_as_float(xw.x << 16), __uint_as_float(xw.x & 0xffff0000u), __uint_as_float(xw.y << 16), __uint_as_float(xw.y & 0xffff0000u)};
#pragma unroll
        for (int q = 0; q < SMP_SLICES; ++q) t += *(const GAS f32x4*)(part + (size_t)q * MS * DM + c);
        v[j] = t; s += (t.x * t.x + t.y * t.y) + (t.z * t.z + t.w * t.w); }
    const float r = 1.0f / sqrtf(wave_sum(s) * (1.0f / DM) + EPS);
    float* y = a.out + O_YS + (size_t)row * DM;
#pragma unroll
    for (int j = 0; j < 16; ++j) { const int c = 4 * (lane + 64 * j); const f32x4 g = *(const GAS f32x4*)(a.in[I_FNW] + c);
        *(GAS f32x4*)(y + c) = (f32x4){v[j].x * r * g.x, v[j].y * r * g.y, v[j].z * r * g.z, v[j].w * r * g.w}; }
}

__device__ __forceinline__ void p6_final_norm(const Frame& F, const Args& a) {
    const int gw = F.vcu * NWAVES + F.wave, NGW = F.G * NWAVES, lane = F.lane;
    const float* ss = (const float*)(a.ws + WS_CTL) + CW_SS3;
    const bf16* X2B = (const bf16*)(a.ws + WS_XN);
    for (int m = gw; m < MR; m += NGW) {
        const float r = 1.0f / sqrtf(__hip_atomic_load(ss + m, __ATOMIC_RELAXED, __HIP_MEMORY_SCOPE_AGENT) * (1.0f / DM) + EPS);
        const GAS v4u* xr = (const GAS v4u*)(X2B + (size_t)m * DM) + lane;
        GAS f32x4* y = (GAS f32x4*)(a.out + (m < MP ? O_YP + (size_t)m * DM : O_YS + (size_t)(m - MP) * DM)) + 2 * lane;
        const GAS f32x4* wv = (const GAS f32x4*)a.in[I_FNW] + 2 * lane;
#pragma unroll
        for (int j = 0; j < 8; ++j) { const v4u x = xr[64 * j]; const f32x4 g0 = wv[128 * j], g1 = wv[128 * j + 1];
            f32x4 o0, o1;
            o0.x = __uint_as_float(x.x << 16) * r * g0.x; o0.y = __uint_as_float(x.x & 0xffff0000u) * r * g0.y; o0.z = __uint_as_float(x.y << 16) * r * g0.z; o0.w = __uint_as_float(x.y & 0xffff0000u) * r * g0.w;
            o1.x = __uint_as_float(x.z << 16) * r * g1.x; o1.y = __uint_as_float(x.z & 0xffff0000u) * r * g1.y; o1.z = __uint_as_float(x.w << 16) * r * g1.z; o1.w = __uint_as_float(x.w & 0xffff0000u) * r * g1.w;
            y[128 * j] = o0; y[128 * j + 1] = o1; }
    }
}

__device__ __forceinline__ void p5_norm_own(const Frame& F, const Args& a, int pm, int col0, int ncols, int row0g, int nrows, unsigned* cnt, unsigned want) {
    int tid = F.tid; asm volatile("" : "+v"(tid));
    if (F.tid == 0) { unsigned sp = 0; while (__hip_atomic_load(cnt, RLX_AGENT) < want) { __builtin_amdgcn_s_sleep(4); if (++sp > (1u << 22)) break; } }
    asm volatile("s_waitcnt vmcnt(0)" ::: "memory");
    __syncthreads();
    LAS float* rs = (LAS float*)(F.lds + RING_OFF);
    const float* ss = (const float*)(a.ws + WS_CTL) + CW_SS3;
    if (tid < nrows) rs[tid] = 1.0f / sqrtf(__uint_as_float(__hip_atomic_load((const unsigned*)(ss + row0g + tid), RLX_AGENT)) * (1.0f / DM) + EPS);
    __syncthreads();
    const bf16* X2B = (const bf16*)(a.ws + WS_XN);
    const int pcs = ncols >> 3;
    if (ncols == 1024 && (nrows & 31) == 0) {
        const int cp = tid & 127, rb = tid >> 7, c = col0 + 8 * cp;
        const f32x4 g0 = *(const GAS f32x4*)(a.in[I_FNW] + c), g1 = *(const GAS f32x4*)(a.in[I_FNW] + c + 4);
        for (int j0 = 0; j0 < nrows / 4; j0 += 8) {
            v4u x[8];
#pragma unroll
            for (int q = 0; q < 8; ++q) x[q] = *(const GAS v4u*)(X2B + (size_t)(row0g + rb + 4 * (j0 + q)) * DM + c);
#pragma unroll
            for (int q = 0; q < 8; ++q) { const int r = rb + 4 * (j0 + q), row = row0g + r; const float rr = rs[r];
                f32x4 o0, o1;
                o0.x = __uint_as_float(x[q].x << 16) * rr * g0.x; o0.y = __uint_as_float(x[q].x & 0xffff0000u) * rr * g0.y; o0.z = __uint_as_float(x[q].y << 16) * rr * g0.z; o0.w = __uint_as_float(x[q].y & 0xffff0000u) * rr * g0.w;
                o1.x = __uint_as_float(x[q].z << 16) * rr * g1.x; o1.y = __uint_as_float(x[q].z & 0xffff0000u) * rr * g1.y; o1.z = __uint_as_float(x[q].w << 16) * rr * g1.z; o1.w = __uint_as_float(x[q].w & 0xffff0000u) * rr * g1.w;
                float* y = a.out + (row < MP ? O_YP + (size_t)row * DM : O_YS + (size_t)(row - MP) * DM) + c;
                *(GAS f32x4*)y = o0; *(GAS f32x4*)(y + 4) = o1; }
        }
    } else
    for (int i = tid; i < nrows * pcs; i += NWAVES * 64) {
        const int r = i / pcs, c = col0 + 8 * (i - r * pcs); const int row = row0g + r;
        const v4u x = *(const GAS v4u*)(X2B + (size_t)row * DM + c);
        const f32x4 g0 = *(const GAS f32x4*)(a.in[I_FNW] + c), g1 = *(const GAS f32x4*)(a.in[I_FNW] + c + 4); const float rr = rs[r];
        f32x4 o0, o1;
        o0.x = __uint_as_float(x.x << 16) * rr * g0.x; o0.y = __uint_as_float(x.x & 0xffff0000u) * rr * g0.y; o0.z = __uint_as_float(x.y << 16) * rr * g0.z; o0.w = __uint_as_float(x.y & 0xffff0000u) * rr * g0.w;
        o1.x = __uint_as_float(x.z << 16) * rr * g1.x; o1.y = __uint_as_float(x.z & 0xffff0000u) * rr * g1.y; o1.z = __uint_as_float(x.w << 16) * rr * g1.z; o1.w = __uint_as_float(x.w & 0xffff0000u) * rr * g1.w;
        float* y = a.out + (row < MP ? O_YP + (size_t)row * DM : O_YS + (size_t)(row - MP) * DM) + c;
        *(GAS f32x4*)y = o0; *(GAS f32x4*)(y + 4) = o1;
    }
    __syncthreads();
}

#ifndef P4_INT8
#define P4_INT8 1
#endif
#ifndef GEMM_ALIGN
#define GEMM_ALIGN true
#endif
#ifndef GEMM_SP2
#define GEMM_SP2 true
#endif
#ifndef GEMM_DIM16
#define GEMM_DIM16 false
#endif
#ifndef P4_WGM
#define P4_WGM 8
#endif
#ifndef P5_NT
#define P5_NT 0
#endif
#ifndef GEMM_DIM
#define GEMM_DIM false
#endif
#ifndef TEST_STAGE
#define TEST_STAGE 99
#endif
__global__ void __launch_bounds__(NWAVES * 64, 2) fwd(Args args) {
    extern __shared__ __attribute__((aligned(16))) unsigned char lds[];
    Frame F;
    F.lds = (LAS unsigned char*)lds;
    F.MISC = (volatile LAS unsigned*)(F.lds + MISC_OFF);
    F.tid = threadIdx.x; F.lane = F.tid & 63; F.wave = __builtin_amdgcn_readfirstlane(F.tid >> 6);
    F.G = gridDim.x; { const int bx = blockIdx.x; F.vcu = (F.G % 8 == 0) ? (bx % 8) * (F.G / 8) + bx / 8 : bx; }
    unsigned char* ws = args.ws;
    F.ctl = (gu32*)(ws + WS_CTL);
    for (int u = F.tid; u < (LDS_BYTES - LDSCTL_OFF) / 4; u += NWAVES * 64) ((LAS unsigned*)(F.lds + LDSCTL_OFF))[u] = 0u;
    __syncthreads();
    XcdBarrier bar = xcd_barrier_post((unsigned*)(F.ctl + CW_BAR), F.MISC + 8);
#define GRID_BAR() xcd_barrier(bar)
    bf16* WinT = (bf16*)(ws + WS_WIN); bf16* WoT = (bf16*)(ws + WS_WO); bf16* WguT = (bf16*)(ws + WS_WGU); bf16* WdT = (bf16*)(ws + WS_WD);
    bf16* XN = (bf16*)(ws + WS_XN); bf16* Qb = (bf16*)(ws + WS_Q); bf16* Kb = (bf16*)(ws + WS_KB); bf16* Vb = (bf16*)(ws + WS_VB); bf16* Zb = (bf16*)(ws + WS_Z);
    bf16* XBC = (bf16*)(ws + WS_XBC); float* DT = (float*)(ws + WS_DT); bf16* Kext = (bf16*)(ws + WS_KEXT); bf16* Vext = (bf16*)(ws + WS_VEXT);
    bf16* MIX = (bf16*)(ws + WS_MIX); bf16* X1B = (bf16*)(ws + WS_X1B); bf16* HB = (bf16*)(ws + WS_H); bf16* X2B = (bf16*)(ws + WS_XN);
    float* SS2 = (float*)(ws + WS_CTL) + CW_SS2; float* SS3 = (float*)(ws + WS_CTL) + CW_SS3;

#if defined(PROBE_SPIN_A) && !defined(PROBE_TIMING)
#define PROBE_TIMING 1
#endif
#ifdef PROBE_TIMING
#define STAMP(k) do { if (blockIdx.x == 0 && F.tid == 0) { const unsigned long long t_ = __builtin_amdgcn_s_memrealtime(); F.MISC[16 + 2 * (k)] = (unsigned)t_; F.MISC[17 + 2 * (k)] = (unsigned)(t_ >> 32); } } while (0)
#else
#define STAMP(k) do { } while (0)
#endif
    unsigned long long sp_t0 = 0; (void)sp_t0;
#ifdef PROBE_SPREAD
#define SPREAD_T0(k) do { if ((k) == PROBE_SPREAD) sp_t0 = __builtin_amdgcn_s_memrealtime(); } while (0)
#define SPREAD_T1(k) do { if ((k) == PROBE_SPREAD && F.tid == 0) { const unsigned d_ = (unsigned)(__builtin_amdgcn_s_memrealtime() - sp_t0); __hip_atomic_fetch_add(F.ctl + CW_TMO + 4, d_, RLX_AGENT); __hip_atomic_fetch_add(F.ctl + CW_TMO + 32 + (blockIdx.x & 7), d_, RLX_AGENT); } } while (0)
#define SPREAD_T2(k) do { if ((k) == PROBE_SPREAD && blockIdx.x == 0 && F.tid == 0) { F.MISC[16 + 2 * 21] = __hip_atomic_load(F.ctl + CW_TMO + 4, RLX_AGENT) / (unsigned)F.G; F.MISC[17 + 2 * 21] = 0u; \
        F.MISC[16 + 2 * 22] = (unsigned)(__builtin_amdgcn_s_memrealtime() - sp_t0); F.MISC[17 + 2 * 22] = 0u; \
        unsigned mx_ = 0u, mn_ = 0xffffffffu; for (int x_ = 0; x_ < 8; ++x_) { const unsigned v_ = __hip_atomic_load(F.ctl + CW_TMO + 32 + x_, RLX_AGENT) / (unsigned)(F.G / 8); mx_ = v_ > mx_ ? v_ : mx_; mn_ = v_ < mn_ ? v_ : mn_; } \
        F.MISC[16 + 2 * 23] = mn_; F.MISC[17 + 2 * 23] = 0u; F.MISC[16 + 2 * 24] = mx_; F.MISC[17 + 2 * 24] = 0u; } } while (0)
#else
#define SPREAD_T0(k) do { } while (0)
#define SPREAD_T1(k) do { } while (0)
#define SPREAD_T2(k) do { } while (0)
#endif
    STAMP(0);
    p0_prologue(F, args);
#ifdef PROBE_P0_REPS
    for (int rep = 1; rep < PROBE_P0_REPS; ++rep) { GRID_BAR(); p0_prologue(F, args); }
#endif
#if TEST_STAGE < 99
    {
        const size_t gt = (size_t)F.vcu * NWAVES * 64 + F.tid, NT = (size_t)F.G * NWAVES * 64;
        GAS f32x4* o = (GAS f32x4*)args.out;
        for (size_t i = gt; i < O_END / 4; i += NT) {
            const size_t e = i * 4;
            bool keep = false;
#if TEST_STAGE >= 1
            keep = (e >= O_KP && e < O_SP) || (e >= O_KS && e < O_SS);
#endif
#if TEST_STAGE >= 2
            keep = keep || (e >= O_SP && e < O_KS) || (e >= O_SS);
#endif
            if (!keep) o[i] = (f32x4){0.f, 0.f, 0.f, 0.f};
        }
    }
#endif
    GRID_BAR();
    STAMP(1); SPREAD_T0(1);

#ifndef PROBE_P1_REPS
#define PROBE_P1_REPS 1
#endif
#ifndef PROBE_P4_REPS
#define PROBE_P4_REPS 1
#endif
    for (int rep = 0; rep < PROBE_P1_REPS; ++rep) {
        if (rep > 0) GRID_BAR();
        pg8::Gemm g{XN, WinT, MP, 12288, DM}; pg8::StaticOrder S; S.init(MP, 12288, F.G, (int)blockIdx.x);
        pg8::EpiInProj E{Qb, Kb, Vb, Zb, XBC, Kext, Vext, DT, args.out};
#ifdef PROBE_P1_LIGHT
        if (rep > 0) { pg8::EpiProbe EP{(bf16*)(ws + WS_DUMMY), 12288}; pg8::gemm_phase<pg8::EpiProbe, pg8::StaticOrder, GEMM_ALIGN, GEMM_SP2, 0, GEMM_DIM16>(F.lds + RING_OFF, g, S, EP); } else
#endif
        pg8::gemm_phase<pg8::EpiInProj, pg8::StaticOrder, GEMM_ALIGN, GEMM_SP2, 0, GEMM_DIM16>(F.lds + RING_OFF, g, S, E);
    }
    STAMP(11); SPREAD_T1(1);
#ifndef PROBE_SK1_REPS
#define PROBE_SK1_REPS 1
#endif
#ifndef PROBE_SK4_REPS
#define PROBE_SK4_REPS 1
#endif
    if (F.G == 256) {
        if (F.tid == 0) F.MISC[2] = __hip_atomic_fetch_add(F.ctl + CW_P1T, 1u, RLX_AGENT);
        __syncthreads();
        const unsigned tk = F.MISC[2];
        __syncthreads();
        constexpr unsigned NSKS1 = (NIN / 16 + 7) / 8, NSKD1 = MP / 16 / 8;
        if (tk < NSKS1) { const sk::EpiInS E1{WinT, Qb, Zb, XBC, Kext, Vext, DT, args.out};
            sk::skinny<8, 1, true>(F.lds + RING_OFF, XN + (size_t)MP * DM, DM, DM, NIN / 16, E1, F.wave, F.lane, (int)tk, (int)NSKS1); }
        else if (tk < NSKS1 + NSKD1) { const sk::EpiDtP E2{XN, DT};
            sk::skinny<2, 1, true>(F.lds + RING_OFF, WinT + (size_t)12288 * DM, DM, DM, MP / 16, E2, F.wave, F.lane, (int)(tk - NSKS1), (int)NSKD1); }
    } else
    for (int rep = 0; rep < PROBE_SK1_REPS; ++rep) {
        const sk::EpiInS E1{WinT, Qb, Zb, XBC, Kext, Vext, DT, args.out};
        sk::skinny<8, 1, true>(F.lds + RING_OFF, XN + (size_t)MP * DM, DM, DM, NIN / 16, E1, F.wave, F.lane, (int)blockIdx.x, F.G);
        STAMP(13);
        const sk::EpiDtP E2{XN, DT};
        sk::skinny<2, 1, true>(F.lds + RING_OFF, WinT + (size_t)12288 * DM, DM, DM, MP / 16, E2, F.wave, F.lane, (int)((blockIdx.x + F.G / 2) % F.G), F.G);
    }
#if TEST_STAGE >= 2
    GRID_BAR();
    STAMP(2); SPREAD_T2(1);

    {
        float lam;
        { const float a = F.lane < 64 ? args.in[I_LQ1][F.lane] * args.in[I_LK1][F.lane] : 0.f, b = args.in[I_LQ2][F.lane] * args.in[I_LK2][F.lane];
          lam = __expf(wave_sum(a)) - __expf(wave_sum(b)) + LAM0; }
        const ssd::Params SP{args.in[I_CONVW], args.in[I_CONVB], args.in[I_DTB], args.in[I_ALOG], args.in[I_DSKIP], args.in[I_SSDNW]};
        constexpr int NSEG = 4, SEGLEN = SEQ / NSEG, NBG = NB * SG;
        constexpr int JS = 736  ;
        constexpr int E0 = (NSEG - 1) * NBG, E1 = E0 + NBG, E2 = E1 + 192, E3 = E2 + (NSEG - 1) * NBG, E4 = E3 + (JS - 192), E5 = E4 + DEC_B * NH, E6 = E5 + (1024 - JS), E7 = E6 + DEC_B * SG, NITEMS = E7;
        float* FSEG = (float*)(ws + WS_F);
#ifndef PROBE_MIX_REPS
#define PROBE_MIX_REPS 1
#define PROBE_MIX_SKIP 0
#endif
        for (int rep = 0; rep < PROBE_MIX_REPS; ++rep) {
        if (rep > 0) GRID_BAR();
        for (;;) {
            if (F.tid == 0) F.MISC[0] = __hip_atomic_fetch_add(F.ctl + CW_QUEUE + 64 * rep, 1u, RLX_AGENT);
            __syncthreads();
            const int pos = (int)F.MISC[0];
            __syncthreads();
            constexpr int NPOS = 256 + 3 * CONV_ITEMS;
            if (pos >= NPOS) break;
            int item = pos;
            if (pos >= 256) { const int q = pos - 256, grp = q / 3, r = q - 3 * grp;
                if (r == 2) { if (rep == 0) p0_deferred_item(F, args, grp); __syncthreads(); continue; }
                item = 256 + 2 * grp + r; }
            if (item >= NITEMS) continue;
            const bool is_ssd = item < E1 || (item >= E2 && item < E3) || item >= E6;
            if (rep > 0 && ((PROBE_MIX_SKIP == 1 && is_ssd) || (PROBE_MIX_SKIP == 2 && !is_ssd))) continue;
            if (is_ssd) {
                ssd::Unit u; bool pre = false;
                if (item < E6) {
                    int seg, bg;
                    if (item < E0) { pre = true; seg = item / NBG; bg = item % NBG; }
                    else if (item < E1) { seg = 0; bg = item - E0; }
                    else { const int k = item - E2; seg = 1 + k / NBG; bg = k % NBG; }
                    const int b = bg >> 3; u.g = bg & 7; const size_t r0 = (size_t)b * SEQ + (size_t)seg * SEGLEN;
                    u.xbc = XBC + r0 * CONVD; u.z = Zb + r0 * SSDI; u.dtraw = DT + r0 * SH; u.hist = nullptr; u.init = nullptr;
                    u.fin = args.out + O_SP + (size_t)b * SH * SHD * DS; u.y = MIX + r0 * DM + AW; u.len = SEGLEN;
                    u.prev = seg > 0; u.seg = seg; u.fseg = FSEG + (size_t)bg * (NSEG - 1) * ssd::FSTRIDE; u.flag = (unsigned*)(F.ctl + CW_SSDF + 64 * bg) + 16 * rep; u.last = seg == NSEG - 1;
                } else { const int j = item - E6; const int b = j >> 3; u.g = j & 7; const size_t r0 = (size_t)MP + (size_t)b * DEC_T;
                    u.xbc = XBC + r0 * CONVD; u.z = Zb + r0 * SSDI; u.dtraw = DT + r0 * SH; u.hist = args.in[I_SCONV] + (size_t)b * 3 * CONVD; u.init = args.in[I_SSSM] + (size_t)b * SH * SHD * DS;
                    u.fin = args.out + O_SS + (size_t)b * SH * SHD * DS; u.y = MIX + r0 * DM + AW; u.len = DEC_T;
                    u.prev = 0; u.seg = 0; u.fseg = nullptr; u.flag = nullptr; u.last = 1; }
                if (pre) ssd::ssd_unit<true>(F.lds + RING_OFF, u, SP, F.tid, F.wave, F.lane);
                else ssd::ssd_unit<false>(F.lds + RING_OFF, u, SP, F.tid, F.wave, F.lane);
            } else {
                att::Unit u;
                if (item < E4 || item >= E5) { const int j = item < E2 ? item - E1 : item < E4 ? item - E3 + 192 : item - E5 + JS; const int qb = 31 - (j >> 5), bh = j & 31, b = bh >> 4, h = bh & 15; const size_t r0 = (size_t)b * SEQ;
                    u.Q = Qb + (r0 + 256 * qb) * AW + h * HD; u.K = Kb + r0 * AW + h * HD; u.V = Vb + r0 * AW + h * HD; u.O = MIX + (r0 + 256 * qb) * DM + h * HD;
                    u.ntot = 4 * qb + 4; u.nvalid_last = 64; u.sample = 0; u.qb = qb; u.park = nullptr; u.variant = 0;
#ifdef PROBE_ATT_VARIANT
                    if (rep > 0) { u.variant = PROBE_ATT_VARIANT; u.O = (bf16*)(ws + WS_DUMMY) + (r0 + 256 * qb) * DM + h * HD; }
#endif
                    }
                else { const int j = item - E4; const int b = j >> 4, h = j & 15; const size_t r0 = (size_t)MP + (size_t)b * DEC_T;
                    u.Q = Qb + r0 * AW + h * HD; u.K = Kext + (size_t)b * KVROWS * AW + h * HD; u.V = Vext + (size_t)b * KVROWS * AW + h * HD; u.O = MIX + r0 * DM + h * HD;
                    u.ntot = KVROWS / 64; u.nvalid_last = PAST + DEC_T - (KVROWS / 64 - 1) * 64; u.sample = 1; u.qb = 0; u.park = nullptr; u.variant = 0;
                    p2_cache_slice(F, args, b, h);
#ifdef PROBE_ATT_VARIANT
                    if (rep > 0) { u.variant = PROBE_ATT_VARIANT; u.O = (bf16*)(ws + WS_DUMMY) + r0 * DM + h * HD; }
#endif
                    }
                att::attn_unit(F.lds + RING_OFF, u, lam, args.in[I_SUBLN], F.wave, F.lane);
            }
            __syncthreads();
        }
        }
    }
#endif
#if TEST_STAGE >= 3
#ifdef PROBE_TIMING
    if (F.tid == 0) __hip_atomic_fetch_max(F.ctl + CW_TMO + 2, ~(unsigned)__builtin_amdgcn_s_memrealtime(), RLX_AGENT);
#endif
    GRID_BAR();
    STAMP(3); SPREAD_T0(3);
#ifdef PROBE_TIMING
    if (blockIdx.x == 0 && F.tid == 0) { F.MISC[16 + 2 * 20] = ~__hip_atomic_load(F.ctl + CW_TMO + 2, RLX_AGENT); F.MISC[17 + 2 * 20] = F.MISC[17 + 2 * 3]; }
#endif
    {
        if (F.G == 256) {
            const int sl = (int)blockIdx.x & 7;
            const sk::EpiOutPart E1{WoT, (float*)(ws + WS_PARK) + (size_t)sl * MS * DM, 512 * sl};
            sk::skinny<8, 1>(F.lds + RING_OFF, MIX + (size_t)MP * DM + 512 * sl, DM, 512, DM / 16, E1, F.wave, F.lane, (int)blockIdx.x >> 3, 32);
            asm volatile("s_waitcnt vmcnt(0)" ::: "memory"); __syncthreads();
            if (F.tid == 0) { __builtin_amdgcn_fence(__ATOMIC_RELEASE, "agent"); __hip_atomic_fetch_add(F.ctl + CW_SMPC + 64, 1u, RLX_AGENT); }
        }
        pg8::Gemm g{MIX, WoT, MP, DM, DM}; pg8::StaticOrder S; S.init(MP, DM, F.G, (int)blockIdx.x);
        pg8::EpiOutProj E{args.in[I_XP], args.in[I_XS], args.out, X1B, SS2};
        pg8::gemm_phase<pg8::EpiOutProj, pg8::StaticOrder, GEMM_ALIGN, GEMM_SP2, 0, GEMM_DIM16>(F.lds + RING_OFF, g, S, E);
        STAMP(12); SPREAD_T1(3);
#ifdef PROBE_P3_REPS
        for (int rep = 1; rep < PROBE_P3_REPS; ++rep) { GRID_BAR(); pg8::EpiProbe EP{HB, DM}; pg8::gemm_phase<pg8::EpiProbe, pg8::StaticOrder, GEMM_ALIGN, GEMM_SP2, 0, GEMM_DIM16>(F.lds + RING_OFF, g, S, EP); }
#endif
        if (F.G == 256) { if (blockIdx.x < 16) p3_sample_final(F, args, 8 * (int)blockIdx.x + F.wave, (const unsigned*)(F.ctl + CW_SMPC + 64), 256u); }
        else {
            const sk::EpiOutS E1{WoT, args.in[I_XS], args.out, X1B, SS2};
            sk::skinny<8, 1>(F.lds + RING_OFF, MIX + (size_t)MP * DM, DM, DM, DM / 16, E1, F.wave, F.lane, (int)blockIdx.x, F.G);
        }
    }
    GRID_BAR();
#ifdef PROBE_EXTRA_BARS
    for (int i = 0; i < PROBE_EXTRA_BARS; ++i) GRID_BAR();
#endif
    STAMP(4); SPREAD_T2(3);
#if P4_INT8
    p3b_quant_rows(F, args);
    GRID_BAR();
    STAMP(7); SPREAD_T0(4);
#endif
    for (int rep = 0; rep < PROBE_P4_REPS; ++rep) {
        if (rep > 0) GRID_BAR();
#if P4_INT8
        pg8::Gemm g{(const bf16*)(ws + WS_X1Q), (const bf16*)(ws + WS_WGUQ), MPAD, 2 * DFF, DM / 2};
        pg8::EpiGateUpT<true> E{HB, (const float*)(F.ctl + CW_RQ), 1.0f / wq_scale(ws, 0), 1.0f / wq_scale(ws, 1), (bf16*)(ws + WS_HS)};
        if (F.G == 256 && rep == 0) {
            pg8::TailOrder S; S.init(MPAD, 2 * DFF, F.G, (int)blockIdx.x, (unsigned*)(F.ctl + CW_P4T), (volatile LAS unsigned*)(F.MISC + 2));
            pg8::gemm_phase<pg8::EpiGateUpT<true>, pg8::TailOrder, GEMM_ALIGN, GEMM_SP2, 2, GEMM_DIM>(F.lds + RING_OFF, g, S, E);
        } else {
            pg8::StaticOrder S; S.init(MPAD, 2 * DFF, F.G, (int)blockIdx.x);
            pg8::gemm_phase<pg8::EpiGateUpT<true>, pg8::StaticOrder, GEMM_ALIGN, GEMM_SP2, 2, GEMM_DIM>(F.lds + RING_OFF, g, S, E);
        }
#else
        pg8::Gemm g{X1B, WguT, MP, 2 * DFF, DM}; pg8::StaticOrder S; S.init(MP, 2 * DFF, F.G, (int)blockIdx.x);
        pg8::EpiGateUp E{HB, SS2};
        pg8::gemm_phase<pg8::EpiGateUp, pg8::StaticOrder, GEMM_ALIGN, GEMM_SP2, 0, GEMM_DIM16>(F.lds + RING_OFF, g, S, E);
#endif
    }
    SPREAD_T1(4);
#if !P4_INT8
    for (int rep = 0; rep < PROBE_SK4_REPS; ++rep) {
        const sk::EpiGuS E1{WguT, (bf16*)(ws + WS_HS), SS2};
        if (F.G == 256) { if (blockIdx.x >= 128) sk::skinny<8, 2>(F.lds + RING_OFF, X1B + (size_t)MP * DM, DM, DM, DFF / 16, E1, F.wave, F.lane, (int)blockIdx.x - 128, 128); }
        else sk::skinny<8, 2>(F.lds + RING_OFF, X1B + (size_t)MP * DM, DM, DM, DFF / 16, E1, F.wave, F.lane, (int)blockIdx.x, F.G);
    }
#endif
    GRID_BAR();
    STAMP(5); SPREAD_T2(4); SPREAD_T0(5);
    if (F.G == 256) {
        {
            const int sl = (int)blockIdx.x & 7, c0 = sl * 5 + (sl < 3 ? sl : 3), ncs = sl < 3 ? 6 : 5;
            const sk::EpiDownPart E1{WdT, (float*)(ws + WS_PARK) + (size_t)sl * MS * DM, 256 * c0};
            sk::skinny<8, 1>(F.lds + RING_OFF, (const bf16*)(ws + WS_HS) + 256 * c0, DFF, 256 * ncs, DM / 16, E1, F.wave, F.lane, (int)blockIdx.x >> 3, 32);
            asm volatile("s_waitcnt vmcnt(0)" ::: "memory"); __syncthreads();
            if (F.tid == 0) { __builtin_amdgcn_fence(__ATOMIC_RELEASE, "agent"); __hip_atomic_fetch_add(F.ctl + CW_SMPC, 1u, RLX_AGENT); }
        }
        STAMP(10);
        pg8::Gemm g{HB, (const bf16*)(ws + WS_WD8), MP, DM, DFF / 2}; pg8::PanelOrder S; S.init((int)blockIdx.x, (unsigned*)(F.ctl + CW_P5C));
        pg8::EpiDown E{X1B, X2B, SS3};
        pg8::gemm_phase<pg8::EpiDown, pg8::PanelOrder, GEMM_ALIGN, GEMM_SP2, 1, GEMM_DIM>(F.lds + RING_OFF, g, S, E);
        STAMP(8); SPREAD_T1(5);
        p5_norm_own(F, args, S.pm, 1024 * S.q4, 1024, 256 * S.pm, 256, (unsigned*)(F.ctl + CW_P5C) + 64 * S.pm, 128u);
        STAMP(9);
        if (blockIdx.x < 16) p5_sample_final(F, args, 8 * (int)blockIdx.x + F.wave, (const unsigned*)(F.ctl + CW_SMPC), 256u);
    } else {
        {
            pg8::Gemm g{HB, (const bf16*)(ws + WS_WD8), MP, DM, DFF / 2}; pg8::StaticOrder S; S.init(MP, DM, F.G, (int)blockIdx.x);
            pg8::EpiDown E{X1B, X2B, SS3};
            pg8::gemm_phase<pg8::EpiDown, pg8::StaticOrder, GEMM_ALIGN, GEMM_SP2, 1, GEMM_DIM>(F.lds + RING_OFF, g, S, E);
            const sk::EpiDownS E1{WdT, X1B, X2B, SS3};
            sk::skinny<8, 1>(F.lds + RING_OFF, (const bf16*)(ws + WS_HS), DFF, DFF, DM / 16, E1, F.wave, F.lane, (int)blockIdx.x, F.G);
        }
        GRID_BAR();
        p6_final_norm(F, args);
    }
#endif
#ifdef PROBE_SPIN_A
    STAMP(6);
    if (blockIdx.x == 0 && F.tid == 0) {
        const unsigned long long ta = (unsigned long long)F.MISC[16 + 2 * (PROBE_SPIN_A)] | ((unsigned long long)F.MISC[17 + 2 * (PROBE_SPIN_A)] << 32);
        const unsigned long long tb = (unsigned long long)F.MISC[16 + 2 * (PROBE_SPIN_B)] | ((unsigned long long)F.MISC[17 + 2 * (PROBE_SPIN_B)] << 32);
        const unsigned long long d = 4ull * (tb - ta), t0 = __builtin_amdgcn_s_memrealtime();
        while (__builtin_amdgcn_s_memrealtime() - t0 < d) __builtin_amdgcn_s_sleep(32);
    }
#endif
}

extern "C" void kernel_launch(void* const* d_in, const int* in_sizes, int n_in, void* d_out, int out_size, void* d_ws, size_t ws_size, hipStream_t stream) {
    static int grid = 0;
    if (grid == 0) {
        if (n_in != 25 || (size_t)out_size != O_END || ws_size < WS_END) { fprintf(stderr, "kernel_launch: unexpected shapes: n_in %d out %d ws %zu; nothing launched\n", n_in, out_size, ws_size); grid = -1; return; }
        int dev = 0, cus = 0, per_cu = 0;
        if (hipGetDevice(&dev) != hipSuccess || hipDeviceGetAttribute(&cus, hipDeviceAttributeMultiprocessorCount, dev) != hipSuccess) { grid = -1; return; }
        if (hipFuncSetAttribute((const void*)fwd, hipFuncAttributeMaxDynamicSharedMemorySize, LDS_BYTES) != hipSuccess) { fprintf(stderr, "kernel_launch: hipFuncSetAttribute failed\n"); grid = -1; return; }
        if (hipOccupancyMaxActiveBlocksPerMultiprocessor(&per_cu, (const void*)fwd, NWAVES * 64, LDS_BYTES) != hipSuccess || per_cu < 1)
            fprintf(stderr, "kernel_launch: note: occupancy query reports %d workgroups per CU\n", per_cu);
        (void)hipGetLastError();
        grid = cus;
    }
    if (grid < 0) return;
    if (hipMemsetAsync((char*)d_ws + WS_CTL, 0, CTL_ZERO_BYTES, stream) != hipSuccess) return;
    Args a{};
    for (int i = 0; i < 25; ++i) a.in[i] = (const float*)d_in[i];
    a.out = (float*)d_out; a.ws = (unsigned char*)d_ws; a.ph_lo = 0; a.ph_hi = 99;
    hipLaunchKernelGGL(fwd, dim3(grid), dim3(NWAVES * 64), LDS_BYTES, stream, a);
}
```

```cpp
#include <hip/hip_runtime.h>
#include <cstdio>
#include <cstdint>
namespace pg8 {
#define PG8_LAS __attribute__((address_space(3)))
typedef unsigned short bf16_t;
typedef short bf16x8 __attribute__((ext_vector_type(8)));
typedef float f32x4 __attribute__((ext_vector_type(4)));
typedef unsigned u32x4 __attribute__((ext_vector_type(4)));
constexpr int BM = 256, BK = 64, HALF = 128, HTB = HALF * BK * 2  , STAGE_BYTES = 8 * HTB, NXCD = 8, WGM = 8;

__host__ __device__ __forceinline__ int lds_byte(int r, int c) { const int st = (r >> 4) * 2 + (c >> 5), rr = r & 15, cc = c & 31, ob = rr * 64 + cc * 2; return st * 1024 + (ob ^ (((ob >> 9) & 1) << 5)); }
__host__ __device__ __forceinline__ void stage_rc(int b, int& R, int& C) { const int st = b / 1024, sb = b % 1024, swz = sb ^ (((sb >> 9) & 1) << 5); R = (st >> 1) * 16 + swz / 64; C = (st & 1) * 32 + (swz % 64) / 2; }
__host__ __device__ __forceinline__ int perm32(int rho) { const int n = rho >> 4, i = rho & 15; return 8 * (i >> 2) + 4 * n + (i & 3); }

struct Unit { int pm, pn; };
struct Gemm { const bf16_t* A; const bf16_t* Bt; int M, N, K; };

struct StaticOrder {
    int nM, nN, nwg, G, c, wgm;
    __host__ __device__ void init(int M, int N, int G_, int c_) { nM = M / BM; nN = N / BM; nwg = nM * nN; G = G_; c = c_; wgm = WGM; }
    __host__ __device__ bool next(int i, Unit& u) const {
        const long L = (long)i * G + c; if (L >= nwg) return false;
        int wgid = (int)L; { const int q = nwg / NXCD, r = nwg % NXCD, xcd = wgid % NXCD, off = wgid / NXCD; wgid = (xcd < r ? xcd * (q + 1) : r * (q + 1) + (xcd - r) * q) + off; }
        const int nig = wgm * nN, gid = wgid / nig, fm = gid * wgm, gsz = (nM - fm) < wgm ? (nM - fm) : wgm;
        u.pm = fm + ((wgid % nig) % gsz); u.pn = (wgid % nig) / gsz; return true;
    }
    __device__ __forceinline__ void a_ready(const Unit&) const {}
    __device__ __forceinline__ void done(const Unit&) const {}
};

__device__ __forceinline__ unsigned cvt_pk_bf16(float lo, float hi) { unsigned r; asm volatile("v_cvt_pk_bf16_f32 %0, %1, %2" : "=v"(r) : "v"(lo), "v"(hi)); return r; }
typedef float f32x2 __attribute__((ext_vector_type(2)));
template <class Epi, class Sched, bool ALIGN_EPI = false, bool SP2 = false, int QM = 0  , bool DIM = false>
__device__ __forceinline__ void gemm_phase(PG8_LAS unsigned char* lds, const Gemm g, const Sched& S, const Epi& E) {
    constexpr bool FP8 = (QM == 1), INT8 = (QM == 2);
    int tid_ = threadIdx.x; asm volatile("" : "+v"(tid_));
    const int tid = tid_, wid = __builtin_amdgcn_readfirstlane(tid >> 6), lane = tid & 63, wr = wid >> 2, wc = wid & 3, fr = lane & 15, fq = lane >> 4;
    const int K = g.K, nt = K / BK;
    unsigned voffA[2], voffB[2];
#pragma unroll
    for (int i = 0; i < 2; ++i) { int R, C; stage_rc(tid * 16 + i * 8192, R, C); const int Rb = Epi::PERM ? ((R & ~31) + perm32(R & 31)) : R;
        voffA[i] = (unsigned)(R * K + C) * 2u; voffB[i] = (unsigned)(Rb * K + C) * 2u; }
    const size_t kstep = (size_t)(BK * 2);
    const size_t hstep = (size_t)HALF * K * 2;
    const size_t tstep = 2 * hstep;
    const unsigned ldsw = (unsigned)wid * 1024u;
    const int aoff = lds_byte(wr * 64 + fr, FP8 ? fq * 16 : fq * 8), boff = lds_byte(wc * 32 + fr, FP8 ? fq * 16 : fq * 8);
    const int aoff1 = FP8 ? aoff + 16 : aoff + 1024, boff1 = FP8 ? boff + 16 : boff + 1024;
    typedef int v8i_t __attribute__((ext_vector_type(8))); typedef int v4i_t __attribute__((ext_vector_type(4)));
#define PG8_SA(b, h) (((b) * 2 + (h)) * HTB)
#define PG8_SB(b, h) ((4 + (b) * 2 + (h)) * HTB)
#define PG8_STAGE(bufoff, gbase, voff) do { _Pragma("unroll") for (int _i = 0; _i < 2; ++_i) \
        __builtin_amdgcn_global_load_lds((const unsigned*)((const char*)(gbase) + (voff)[_i]), (PG8_LAS unsigned*)(lds + (bufoff) + ldsw + _i * 8192), 16, 0, 0); } while (0)
#define PG8_CAT8(x, y) __builtin_shufflevector(__builtin_bit_cast(v4i_t, x), __builtin_bit_cast(v4i_t, y), 0, 1, 2, 3, 4, 5, 6, 7)
#define PG8_LDA(dst, b, h) do { if constexpr (FP8) { _Pragma("unroll") for (int m = 0; m < 4; ++m) dst##8[m] = PG8_CAT8(*(const PG8_LAS bf16x8*)(lds + PG8_SA(b, h) + aoff + m * 2048), *(const PG8_LAS bf16x8*)(lds + PG8_SA(b, h) + aoff1 + m * 2048)); } \
        else { _Pragma("unroll") for (int m = 0; m < 4; ++m) _Pragma("unroll") for (int k = 0; k < 2; ++k) dst[m][k] = *(const PG8_LAS bf16x8*)(lds + PG8_SA(b, h) + (k ? aoff1 : aoff) + m * 2048); } } while (0)
#define PG8_LDB(dst, b, h) do { if constexpr (FP8) { _Pragma("unroll") for (int n = 0; n < 2; ++n) dst##8[n] = PG8_CAT8(*(const PG8_LAS bf16x8*)(lds + PG8_SB(b, h) + boff + n * 2048), *(const PG8_LAS bf16x8*)(lds + PG8_SB(b, h) + boff1 + n * 2048)); } \
        else { _Pragma("unroll") for (int n = 0; n < 2; ++n) _Pragma("unroll") for (int k = 0; k < 2; ++k) dst[n][k] = *(const PG8_LAS bf16x8*)(lds + PG8_SB(b, h) + (k ? boff1 : boff) + n * 2048); } } while (0)
#define PG8_MMA(ai, bj, At, Bt) do { __builtin_amdgcn_s_setprio(1); \
        if constexpr (FP8) { _Pragma("unroll") for (int m = 0; m < 4; ++m) _Pragma("unroll") for (int n = 0; n < 2; ++n) \
            asm volatile("v_mfma_scale_f32_16x16x128_f8f6f4 %0, %1, %2, %0, %3, %3 op_sel_hi:[0,0,0]" : "+v"(acc[ai][bj][m][n]) : "v"(Bt##8[n]), "v"(At##8[m]), "v"(sc8_)); } \
        else if constexpr (INT8) { _Pragma("unroll") for (int m = 0; m < 4; ++m) _Pragma("unroll") for (int n = 0; n < 2; ++n) _Pragma("unroll") for (int k = 0; k < 2; ++k) \
            acc[ai][bj][m][n] = __builtin_bit_cast(f32x4, __builtin_amdgcn_mfma_i32_16x16x64_i8(__builtin_bit_cast(v4i_t, Bt[n][k]), __builtin_bit_cast(v4i_t, At[m][k]), __builtin_bit_cast(v4i_t, acc[ai][bj][m][n]), 0, 0, 0)); } \
        else { _Pragma("unroll") for (int m = 0; m < 4; ++m) _Pragma("unroll") for (int n = 0; n < 2; ++n) _Pragma("unroll") for (int k = 0; k < 2; ++k) \
            acc[ai][bj][m][n] = __builtin_amdgcn_mfma_f32_16x16x32_bf16(Bt[n][k], At[m][k], acc[ai][bj][m][n], 0, 0, 0); } \
        __builtin_amdgcn_s_setprio(0); } while (0)
#define PG8_MMAH(ai, bj, At, Bt, m0) do { \
        if constexpr (FP8) { _Pragma("unroll") for (int m = m0; m < m0 + 2; ++m) _Pragma("unroll") for (int n = 0; n < 2; ++n) \
            asm volatile("v_mfma_scale_f32_16x16x128_f8f6f4 %0, %1, %2, %0, %3, %3 op_sel_hi:[0,0,0]" : "+v"(acc[ai][bj][m][n]) : "v"(Bt##8[n]), "v"(At##8[m]), "v"(sc8_)); } \
        else if constexpr (INT8) { _Pragma("unroll") for (int m = m0; m < m0 + 2; ++m) _Pragma("unroll") for (int n = 0; n < 2; ++n) _Pragma("unroll") for (int k = 0; k < 2; ++k) \
            acc[ai][bj][m][n] = __builtin_bit_cast(f32x4, __builtin_amdgcn_mfma_i32_16x16x64_i8(__builtin_bit_cast(v4i_t, Bt[n][k]), __builtin_bit_cast(v4i_t, At[m][k]), __builtin_bit_cast(v4i_t, acc[ai][bj][m][n]), 0, 0, 0)); } \
        else { _Pragma("unroll") for (int m = m0; m < m0 + 2; ++m) _Pragma("unroll") for (int n = 0; n < 2; ++n) _Pragma("unroll") for (int k = 0; k < 2; ++k) \
            acc[ai][bj][m][n] = __builtin_amdgcn_mfma_f32_16x16x32_bf16(Bt[n][k], At[m][k], acc[ai][bj][m][n], 0, 0, 0); } } while (0)
#define PG8_WAIT_V(n) asm volatile("s_waitcnt vmcnt(" #n ")" ::: "memory")
#define PG8_WAIT_L(n) asm volatile("s_waitcnt lgkmcnt(" #n ")" ::: "memory")
#define PG8_BAR __builtin_amdgcn_s_barrier()
#define PG8_SCHED __builtin_amdgcn_sched_barrier(0)
    Unit cur, nxt; int ui = 0;
    if (!S.next(0, cur)) return;
    f32x4 acc[2][2][4][2];
#pragma unroll
    for (int a = 0; a < 2; ++a)
#pragma unroll
        for (int b = 0; b < 2; ++b)
#pragma unroll
            for (int m = 0; m < 4; ++m)
#pragma unroll
                for (int n = 0; n < 2; ++n) acc[a][b][m][n] = (f32x4){0.f, 0.f, 0.f, 0.f};
    bf16x8 At[4][2], B0[2][2], B1[2][2]; v8i_t At8[4], B08[2], B18[2]; const int sc8_ = 0x7f7f7f7f;
    const char* cA = (const char*)g.A + (size_t)cur.pm * tstep; const char* cB = (const char*)g.Bt + (size_t)cur.pn * tstep;
    S.a_ready(cur);
    if constexpr (SP2) {
        PG8_STAGE(PG8_SB(0, 0), cB, voffB); PG8_STAGE(PG8_SB(0, 1), cB + hstep, voffB); PG8_STAGE(PG8_SA(0, 0), cA, voffA); PG8_STAGE(PG8_SA(0, 1), cA + hstep, voffA);
        if (wr == 1) PG8_BAR;
        PG8_WAIT_V(2); PG8_BAR;
        PG8_STAGE(PG8_SB(1, 0), cB + kstep, voffB); PG8_STAGE(PG8_SA(1, 0), cA + kstep, voffA); PG8_STAGE(PG8_SB(1, 1), cB + hstep + kstep, voffB);
        PG8_WAIT_V(6); PG8_BAR;
    } else {
        PG8_STAGE(PG8_SB(0, 0), cB, voffB); PG8_STAGE(PG8_SA(0, 0), cA, voffA); PG8_STAGE(PG8_SB(0, 1), cB + hstep, voffB); PG8_STAGE(PG8_SA(0, 1), cA + hstep, voffA);
        if (wr == 1) PG8_BAR;
        PG8_WAIT_V(4); PG8_BAR;
        PG8_STAGE(PG8_SB(1, 0), cB + kstep, voffB); PG8_STAGE(PG8_SA(1, 0), cA + kstep, voffA); PG8_STAGE(PG8_SB(1, 1), cB + hstep + kstep, voffB);
        PG8_WAIT_V(6); PG8_BAR;
    }
    for (;;) {
        const bool has_next = S.next(ui + 1, nxt);
        const char* nA = has_next ? (const char*)g.A + (size_t)nxt.pm * tstep : cA; const char* nB = has_next ? (const char*)g.Bt + (size_t)nxt.pn * tstep : cB;
        for (int t = 0; t < nt; t += 2) {
            const bool last = (t == nt - 2);
            const char* a1 = cA + (size_t)(t + 1) * kstep;
            const char* a2 = last ? nA : cA + (size_t)(t + 2) * kstep; const char* b2 = last ? nB : cB + (size_t)(t + 2) * kstep;
            const char* a3 = a2 + kstep; const char* b3 = b2 + kstep;
            if (last && has_next) S.a_ready(nxt);
            if constexpr (SP2 && DIM) {
            PG8_LDB(B0, 0, 0); PG8_LDB(B1, 0, 1); PG8_SCHED; PG8_LDA(At, 0, 0);
            PG8_WAIT_V(6); PG8_WAIT_L(0); PG8_BAR; __builtin_amdgcn_s_setprio(1); PG8_MMAH(0, 0, At, B0, 0); PG8_MMAH(0, 0, At, B0, 2); PG8_SCHED; PG8_STAGE(PG8_SA(1, 1), a1 + hstep, voffA); PG8_SCHED; PG8_MMAH(0, 1, At, B1, 0); PG8_MMAH(0, 1, At, B1, 2); __builtin_amdgcn_s_setprio(0); PG8_BAR; PG8_SCHED;
            PG8_LDA(At, 0, 1);
            PG8_WAIT_V(2); PG8_WAIT_L(0); PG8_BAR; __builtin_amdgcn_s_setprio(1); PG8_MMAH(1, 0, At, B0, 0); PG8_SCHED; PG8_STAGE(PG8_SB(0, 0), b2, voffB); PG8_SCHED; PG8_MMAH(1, 0, At, B0, 2); PG8_SCHED; PG8_STAGE(PG8_SB(0, 1), b2 + hstep, voffB); PG8_SCHED;
            PG8_MMAH(1, 1, At, B1, 0); PG8_SCHED; PG8_STAGE(PG8_SA(0, 0), a2, voffA); PG8_SCHED; PG8_MMAH(1, 1, At, B1, 2); __builtin_amdgcn_s_setprio(0); PG8_BAR; PG8_SCHED;
            PG8_LDB(B0, 1, 0); PG8_LDB(B1, 1, 1); PG8_SCHED; PG8_LDA(At, 1, 0);
            PG8_WAIT_V(6); PG8_WAIT_L(0); PG8_BAR; __builtin_amdgcn_s_setprio(1); PG8_MMAH(0, 0, At, B0, 0); PG8_MMAH(0, 0, At, B0, 2); PG8_SCHED; PG8_STAGE(PG8_SA(0, 1), a2 + hstep, voffA); PG8_SCHED; PG8_MMAH(0, 1, At, B1, 0); PG8_MMAH(0, 1, At, B1, 2); __builtin_amdgcn_s_setprio(0); PG8_BAR; PG8_SCHED;
            PG8_LDA(At, 1, 1);
            PG8_WAIT_V(2); PG8_WAIT_L(0); PG8_BAR; __builtin_amdgcn_s_setprio(1); PG8_MMAH(1, 0, At, B0, 0); PG8_SCHED; PG8_STAGE(PG8_SB(1, 0), b3, voffB); PG8_SCHED; PG8_MMAH(1, 0, At, B0, 2); PG8_SCHED; PG8_STAGE(PG8_SB(1, 1), b3 + hstep, voffB); PG8_SCHED;
            PG8_MMAH(1, 1, At, B1, 0); PG8_SCHED; PG8_STAGE(PG8_SA(1, 0), a3, voffA); PG8_SCHED; PG8_MMAH(1, 1, At, B1, 2); __builtin_amdgcn_s_setprio(0); PG8_BAR; PG8_SCHED;
            } else if constexpr (SP2) {
            PG8_LDB(B0, 0, 0); PG8_LDB(B1, 0, 1); PG8_SCHED; PG8_LDA(At, 0, 0); PG8_STAGE(PG8_SA(1, 1), a1 + hstep, voffA);
            PG8_WAIT_V(8); PG8_WAIT_L(0); PG8_BAR; PG8_MMA(0, 0, At, B0); PG8_MMA(0, 1, At, B1); PG8_BAR; PG8_SCHED;
            PG8_LDA(At, 0, 1); PG8_STAGE(PG8_SB(0, 0), b2, voffB); PG8_STAGE(PG8_SB(0, 1), b2 + hstep, voffB); PG8_STAGE(PG8_SA(0, 0), a2, voffA);
            PG8_WAIT_V(8); PG8_WAIT_L(0); PG8_BAR; PG8_MMA(1, 0, At, B0); PG8_MMA(1, 1, At, B1); PG8_BAR; PG8_SCHED;
            PG8_LDB(B0, 1, 0); PG8_LDB(B1, 1, 1); PG8_SCHED; PG8_LDA(At, 1, 0); PG8_STAGE(PG8_SA(0, 1), a2 + hstep, voffA);
            PG8_WAIT_V(8); PG8_WAIT_L(0); PG8_BAR; PG8_MMA(0, 0, At, B0); PG8_MMA(0, 1, At, B1); PG8_BAR; PG8_SCHED;
            PG8_LDA(At, 1, 1); PG8_STAGE(PG8_SB(1, 0), b3, voffB); PG8_STAGE(PG8_SB(1, 1), b3 + hstep, voffB); PG8_STAGE(PG8_SA(1, 0), a3, voffA);
            PG8_WAIT_V(8); PG8_WAIT_L(0); PG8_BAR; PG8_MMA(1, 0, At, B0); PG8_MMA(1, 1, At, B1); PG8_BAR; PG8_SCHED;
            } else {
            PG8_LDB(B0, 0, 0); PG8_SCHED; PG8_LDA(At, 0, 0); PG8_STAGE(PG8_SA(1, 1), a1 + hstep, voffA);
            PG8_WAIT_L(8); PG8_BAR; PG8_WAIT_L(0); PG8_MMA(0, 0, At, B0); PG8_BAR; PG8_SCHED;
            PG8_LDB(B1, 0, 1); PG8_STAGE(PG8_SB(0, 0), b2, voffB);
            PG8_BAR; PG8_WAIT_L(0); PG8_MMA(0, 1, At, B1); PG8_BAR;
            PG8_LDA(At, 0, 1); PG8_STAGE(PG8_SA(0, 0), a2, voffA);
            PG8_BAR; PG8_WAIT_L(0); PG8_MMA(1, 0, At, B0); PG8_BAR; PG8_SCHED;
            PG8_STAGE(PG8_SB(0, 1), b2 + hstep, voffB);
            PG8_WAIT_V(6); PG8_BAR; PG8_MMA(1, 1, At, B1); PG8_BAR;
            PG8_LDB(B0, 1, 0); PG8_SCHED; PG8_LDA(At, 1, 0); PG8_STAGE(PG8_SA(0, 1), a2 + hstep, voffA);
            PG8_WAIT_L(8); PG8_BAR; PG8_WAIT_L(0); PG8_MMA(0, 0, At, B0); PG8_BAR; PG8_SCHED;
            PG8_LDB(B1, 1, 1); PG8_STAGE(PG8_SB(1, 0), b3, voffB);
            PG8_BAR; PG8_WAIT_L(0); PG8_MMA(0, 1, At, B1); PG8_BAR;
            PG8_LDA(At, 1, 1); PG8_STAGE(PG8_SA(1, 0), a3, voffA);
            PG8_BAR; PG8_WAIT_L(0); PG8_MMA(1, 0, At, B0); PG8_BAR; PG8_SCHED;
            PG8_STAGE(PG8_SB(1, 1), b3 + hstep, voffB);
            PG8_WAIT_V(6); PG8_BAR; PG8_MMA(1, 1, At, B1); PG8_BAR;
            }
        }
        if constexpr (ALIGN_EPI) { if (wr == 0) PG8_BAR; }
        if constexpr (FP8) asm volatile("s_nop 15\n\ts_nop 7" ::: "memory");
        if constexpr (!Epi::AFTER_DRAIN) { E(acc, cur, wr, wc, fr, fq); S.done(cur); }
        if (!has_next) break;
#pragma unroll
        for (int a = 0; a < 2; ++a)
#pragma unroll
            for (int b = 0; b < 2; ++b)
#pragma unroll
                for (int m = 0; m < 4; ++m)
#pragma unroll
                    for (int n = 0; n < 2; ++n) acc[a][b][m][n] = (f32x4){0.f, 0.f, 0.f, 0.f};
        cur = nxt; cA = nA; cB = nB; ++ui;
        if constexpr (ALIGN_EPI) { if (wr == 1) PG8_BAR; }
    }
    PG8_WAIT_V(0);
    if constexpr (!ALIGN_EPI) { if (wr == 0) PG8_BAR; }
    PG8_BAR;
    if constexpr (Epi::AFTER_DRAIN) { E.fused(acc, cur, wr, wc, fr, fq, lds, wid, lane); S.done(cur); }
#undef PG8_SA
#undef PG8_SB
#undef PG8_STAGE
#undef PG8_LDA
#undef PG8_LDB
#undef PG8_MMA
#undef PG8_MMAH
#undef PG8_CAT8
#undef PG8_WAIT_V
#undef PG8_WAIT_L
#undef PG8_BAR
#undef PG8_SCHED
}
}

#ifndef TEST_ALPHA
#define TEST_ALPHA 1.0f
#endif
constexpr int DM = 4096, SEQ = 8192, NB = 2, MP = NB * SEQ  , MS = 128  , MR = MP + MS  , MPAD = 16640  ;
constexpr int DEC_B = 8, DEC_T = 16, PAST = 2048, KVROWS = 2112  ;
constexpr int AW = 2048, NH = 16, HD = 128, QKD = 64, SSDI = 2048, SH = 32, SHD = 64, SG = 8, DS = 128, CONVD = 4096, DFF = 11008;
constexpr int NIN = 12320, NINP = 12544  ;
constexpr float EPS = 1e-6f;
constexpr float LAM0 = 0.2f;
constexpr float QSCALE = 0.125f * 1.4426950408889634f;
constexpr size_t O_YP = 0, O_YS = O_YP + (size_t)MP * DM, O_KP = O_YS + (size_t)MS * DM, O_VP = O_KP + (size_t)MP * AW, O_CP = O_VP + (size_t)MP * AW,
                 O_SP = O_CP + (size_t)NB * 3 * CONVD, O_KS = O_SP + (size_t)NB * SH * SHD * DS, O_VS = O_KS + (size_t)MS * AW, O_CS = O_VS + (size_t)MS * AW,
                 O_SS = O_CS + (size_t)DEC_B * 3 * CONVD, O_END = O_SS + (size_t)DEC_B * SH * SHD * DS;
static_assert(O_END == 138010624ull, "output size");

namespace pg8 {
typedef unsigned u32x2 __attribute__((ext_vector_type(2)));
__device__ __forceinline__ u32x4 pack8(const f32x4 a, const f32x4 b) { u32x4 w; w.x = cvt_pk_bf16(a[0], a[1]); w.y = cvt_pk_bf16(a[2], a[3]); w.z = cvt_pk_bf16(b[0], b[1]); w.w = cvt_pk_bf16(b[2], b[3]); return w; }

__device__ __forceinline__ unsigned pk4_fp8(float a, float b, float c, float d) { int p = 0; p = __builtin_amdgcn_cvt_pk_fp8_f32(a, b, p, false); p = __builtin_amdgcn_cvt_pk_fp8_f32(c, d, p, true); return (unsigned)p; }
__device__ __forceinline__ unsigned pk4_i8(float a, float b, float c, float d) {
    const int ia = (int)__builtin_rintf(__builtin_fminf(__builtin_fmaxf(a, -127.f), 127.f)), ib = (int)__builtin_rintf(__builtin_fminf(__builtin_fmaxf(b, -127.f), 127.f));
    const int ic = (int)__builtin_rintf(__builtin_fminf(__builtin_fmaxf(c, -127.f), 127.f)), id = (int)__builtin_rintf(__builtin_fminf(__builtin_fmaxf(d, -127.f), 127.f));
    return (unsigned)(ia & 255) | ((unsigned)(ib & 255) << 8) | ((unsigned)(ic & 255) << 16) | ((unsigned)id << 24);
}
constexpr float W8I_CLIP = 32.0f;
constexpr float H8_SCALE = 4.0f, WD8_SCALE = 128.0f;

struct EpiInProj {
    static constexpr bool PERM = true, AFTER_DRAIN = false;
    bf16_t *Q, *Kb, *Vb, *Z, *XBC, *Kext, *Vext; float* DT; float* out;
    template <int MODE  >
    __device__ __forceinline__ void tile(const f32x4 (&acc)[2][2][4][2], bf16_t* B, int ldb, float* O32, int ld32, int row0, int c0) const {
#pragma unroll
        for (int ai = 0; ai < 2; ++ai)
#pragma unroll
            for (int m = 0; m < 4; ++m) {
                const int row = row0 + ai * HALF + m * 16;
#pragma unroll
                for (int bj = 0; bj < 2; ++bj) {
                    const int c = c0 + bj * HALF;
                    const f32x4 v0 = acc[ai][bj][m][0], v1 = acc[ai][bj][m][1];
                    if (MODE == 1) *(u32x4*)(B + (size_t)row * ldb + c) = pack8(v0 * QSCALE, v1 * QSCALE);
                    else *(u32x4*)(B + (size_t)row * ldb + c) = pack8(v0, v1);
                    if (MODE == 2) { float* o = O32 + (size_t)row * ld32 + c; *(f32x4*)o = v0 * TEST_ALPHA; *(f32x4*)(o + 4) = v1 * TEST_ALPHA; }
                }
            }
    }
    __device__ __forceinline__ void operator()(const f32x4 (&acc)[2][2][4][2], const Unit& u, int wr, int wc, int fr, int fq) const {
        const int pn = u.pn, row0 = u.pm * BM + wr * 64 + fr, cl = wc * 32 + 8 * fq;
        if (pn < 8) tile<1>(acc, Q, AW, nullptr, 0, row0, pn * BM + cl);
        else if (pn < 16) tile<2>(acc, Kb, AW, out + O_KP, AW, row0, (pn - 8) * BM + cl);
        else if (pn < 24) tile<2>(acc, Vb, AW, out + O_VP, AW, row0, (pn - 16) * BM + cl);
        else if (pn < 32) tile<0>(acc, Z, SSDI, nullptr, 0, row0, (pn - 24) * BM + cl);
        else {
            tile<0>(acc, XBC, CONVD, nullptr, 0, row0, (pn - 32) * BM + cl);
            if ((u.pm & 31) == 31 && wr == 1) {
#pragma unroll
                for (int bj = 0; bj < 2; ++bj) { const int c = (pn - 32) * BM + cl + bj * HALF; const int row = row0 + HALF + 48, t = (row & (SEQ - 1)) - (SEQ - 3);
                    if (t >= 0) { float* o = out + O_CP + (size_t)((row >> 13) * 3 + t) * CONVD + c; *(f32x4*)o = acc[1][bj][3][0] * TEST_ALPHA; *(f32x4*)(o + 4) = acc[1][bj][3][1] * TEST_ALPHA; } }
            }
        }
    }
};

struct EpiOutProj {
    static constexpr bool PERM = true, AFTER_DRAIN = false;
    const float* xp; const float* xs; float* out; bf16_t* X1B; float* ss;
    __device__ __forceinline__ void operator()(const f32x4 (&acc)[2][2][4][2], const Unit& u, int wr, int wc, int fr, int fq) const {
        const int row0 = u.pm * BM + wr * 64 + fr, col0 = u.pn * BM + wc * 32 + 8 * fq;
#pragma unroll
        for (int ai = 0; ai < 2; ++ai) {
#pragma unroll
            for (int m = 0; m < 4; ++m) {
                const int row = row0 + ai * HALF + m * 16;
                const float* xr = xp + (size_t)row * DM;
                float sq = 0.f;
#pragma unroll
                for (int bj = 0; bj < 2; ++bj) {
                    const int c = col0 + bj * HALF;
                    const f32x4 v0 = acc[ai][bj][m][0] + __builtin_nontemporal_load((const f32x4*)(xr + c)), v1 = acc[ai][bj][m][1] + __builtin_nontemporal_load((const f32x4*)(xr + c + 4));
                    *(u32x4*)(X1B + (size_t)row * DM + c) = pack8(v0, v1);
                    sq += (v0[0] * v0[0] + v0[1] * v0[1]) + (v0[2] * v0[2] + v0[3] * v0[3]) + (v1[0] * v1[0] + v1[1] * v1[1]) + (v1[2] * v1[2] + v1[3] * v1[3]);
                }
                sq += __shfl_xor(sq, 16); sq += __shfl_xor(sq, 32);
                if (fq == 0) atomicAdd(ss + row, sq);
            }
        }
    }
};

struct EpiProbe {
    static constexpr bool PERM = true, AFTER_DRAIN = false;
    bf16_t* O; int ldc;
    __device__ __forceinline__ void operator()(const f32x4 (&acc)[2][2][4][2], const Unit& u, int wr, int wc, int fr, int fq) const {
        const int row0 = u.pm * BM + wr * 64 + fr, col0 = u.pn * BM + wc * 32 + 8 * fq;
#pragma unroll
        for (int ai = 0; ai < 2; ++ai)
#pragma unroll
            for (int m = 0; m < 4; ++m)
#pragma unroll
                for (int bj = 0; bj < 2; ++bj) *(u32x4*)(O + (size_t)(row0 + ai * HALF + m * 16) * ldc + col0 + bj * HALF) = pack8(acc[ai][bj][m][0], acc[ai][bj][m][1]);
    }
};

template <bool Q8>
struct EpiGateUpT {
    static constexpr bool PERM = true, AFTER_DRAIN = false;
    bf16_t* H; const float* ss; float wqg, wqu; bf16_t* HS;
    __device__ __forceinline__ void operator()(const f32x4 (&acc)[2][2][4][2], const Unit& u, int wr, int wc, int fr, int fq) const {
        if constexpr (Q8) asm volatile("" : "+v"(fr), "+v"(fq));
        const int row0 = u.pm * BM + wr * 64 + fr, col0 = u.pn * HALF + wc * 32 + 8 * fq;
#pragma unroll
        for (int ai = 0; ai < 2; ++ai) {
            if (u.pm == 64 && ai == 1) continue;
#pragma unroll
            for (int m = 0; m < 4; ++m) {
                const int row = row0 + ai * HALF + m * 16;
                const float r = Q8 ? ss[row] * wqg : 1.0f / sqrtf(ss[row] * (1.0f / DM) + EPS);
                const float r2 = Q8 ? ss[row] * wqu : r;
                f32x4 h[2];
#pragma unroll
                for (int n = 0; n < 2; ++n)
#pragma unroll
                    for (int e = 0; e < 4; ++e) { const float g = (Q8 ? (float)__float_as_int(acc[ai][0][m][n][e]) : acc[ai][0][m][n][e]) * r, up = (Q8 ? (float)__float_as_int(acc[ai][1][m][n][e]) : acc[ai][1][m][n][e]) * r2;
                        h[n][e] = g * up * __builtin_amdgcn_rcpf(1.0f + __builtin_amdgcn_exp2f(-1.4426950408889634f * g)); }
                if (Q8 && u.pm == 64) { *(u32x4*)(HS + (size_t)(row - MP) * DFF + col0) = pack8(h[0], h[1]); continue; }
                u32x2 w8; w8.x = pk4_fp8(h[0][0] * H8_SCALE, h[0][1] * H8_SCALE, h[0][2] * H8_SCALE, h[0][3] * H8_SCALE); w8.y = pk4_fp8(h[1][0] * H8_SCALE, h[1][1] * H8_SCALE, h[1][2] * H8_SCALE, h[1][3] * H8_SCALE);
                *(u32x2*)((unsigned char*)H + (size_t)row * DFF + col0) = w8;
            }
        }
    }
};
using EpiGateUp = EpiGateUpT<false>;

__device__ __forceinline__ float bflo(unsigned w) { return __uint_as_float(w << 16); }
__device__ __forceinline__ float bfhi(unsigned w) { return __uint_as_float(w & 0xffff0000u); }
struct EpiDown {
    static constexpr bool PERM = true, AFTER_DRAIN = false;
    const bf16_t* X1B; bf16_t* X2B; float* ss;
    static constexpr float ASC = 1.0f / (H8_SCALE * WD8_SCALE);
    __device__ __forceinline__ void operator()(const f32x4 (&acc)[2][2][4][2], const Unit& u, int wr, int wc, int fr, int fq) const {
        asm volatile("" : "+v"(fr), "+v"(fq));
        const int row0 = u.pm * BM + wr * 64 + fr, col0 = u.pn * BM + wc * 32 + 8 * fq;
#pragma unroll
        for (int ai = 0; ai < 2; ++ai) {
#pragma unroll
            for (int m = 0; m < 4; ++m) {
                const int row = row0 + ai * HALF + m * 16;
                float sq = 0.f;
#pragma unroll
                for (int bj = 0; bj < 2; ++bj) {
                    const int c = col0 + bj * HALF;
                    const u32x4 xw = __builtin_nontemporal_load((const u32x4*)(X1B + (size_t)row * DM + c));
                    const f32x4 v0 = acc[ai][bj][m][0] * ASC + (f32x4){bflo(xw.x), bfhi(xw.x), bflo(xw.y), bfhi(xw.y)}, v1 = acc[ai][bj][m][1] * ASC + (f32x4){bflo(xw.z), bfhi(xw.z), bflo(xw.w), bfhi(xw.w)};
                    *(u32x4*)(X2B + (size_t)row * DM + c) = pack8(v0, v1);
                    sq += (v0[0] * v0[0] + v0[1] * v0[1]) + (v0[2] * v0[2] + v0[3] * v0[3]) + (v1[0] * v1[0] + v1[1] * v1[1]) + (v1[2] * v1[2] + v1[3] * v1[3]);
                }
                sq += __shfl_xor(sq, 16); sq += __shfl_xor(sq, 32);
                if (fq == 0) atomicAdd(ss + row, sq);
            }
        }
    }
};
struct PanelOrder {
    int pm, q4, nu; unsigned* cnt;
    __device__ void init(int c, unsigned* cnt_) { const int x = c & 7, j = c >> 3; pm = x * 8 + (j >> 2); q4 = j & 3; cnt = cnt_; nu = 4; asm volatile("" : "+s"(nu)); }
    __device__ __forceinline__ bool next(int i, Unit& u) const { if (i >= nu) return false; int p = pm; asm volatile("" : "+s"(p)); u.pm = p; u.pn = 4 * q4 + i; return true; }
    __device__ __forceinline__ void a_ready(const Unit&) const {}
    __device__ __forceinline__ void done(const Unit& u) const {
        asm volatile("s_waitcnt vmcnt(0)" ::: "memory");
        if ((threadIdx.x & 63) == 0) __hip_atomic_fetch_add(cnt + 64 * u.pm, 1u, __ATOMIC_RELAXED, __HIP_MEMORY_SCOPE_AGENT);
    }
};
struct TailOrder {
    StaticOrder so; int nstat; unsigned* cnt; volatile PG8_LAS unsigned* mail;
    __device__ void init(int M, int N, int G_, int c_, unsigned* cnt_, volatile PG8_LAS unsigned* mail_) { so.init(M, N, G_, c_); nstat = so.nwg / G_; cnt = cnt_; mail = mail_; }
    __device__ __forceinline__ bool next(int i, Unit& u) const {
        if (i < nstat) return so.next(i, u);
        if (i > nstat) return false;
        if (threadIdx.x == 0) *mail = __hip_atomic_fetch_add(cnt, 1u, __ATOMIC_RELAXED, __HIP_MEMORY_SCOPE_AGENT);
        asm volatile("s_waitcnt lgkmcnt(0)" ::: "memory"); __builtin_amdgcn_s_barrier();
        const unsigned t = *mail;
        const int ntail = so.nwg - nstat * so.G;
        if (t >= (unsigned)ntail) return false;
        StaticOrder s2 = so; s2.c = (int)t;
        return s2.next(nstat, u);
    }
    __device__ __forceinline__ void a_ready(const Unit&) const {}
    __device__ __forceinline__ void done(const Unit&) const {}
};
}
#define GAS __attribute__((address_space(1)))
#define LAS __attribute__((address_space(3)))
typedef unsigned short bf16;
typedef unsigned v4u __attribute__((ext_vector_type(4)));
typedef float f32x4 __attribute__((ext_vector_type(4)));
typedef short bf16x8 __attribute__((ext_vector_type(8)));
typedef GAS unsigned gu32;
typedef GAS unsigned long long gu64;
#define RLX_AGENT __ATOMIC_RELAXED, __HIP_MEMORY_SCOPE_AGENT
#define LDS_WAIT() asm volatile("s_waitcnt lgkmcnt(0)" ::: "memory")
#define VM_WAIT() asm volatile("s_waitcnt vmcnt(0)" ::: "memory")
__device__ __forceinline__ unsigned long long rt() { return __builtin_amdgcn_s_memrealtime(); }
__device__ __forceinline__ unsigned f2bf(float f) { unsigned u = __builtin_bit_cast(unsigned, f); return (u + 0x7fffu + ((u >> 16) & 1u)) >> 16; }
__device__ __forceinline__ unsigned pk2(float lo, float hi) { return f2bf(lo) | (f2bf(hi) << 16); }

#define XB_TMO      128
#define XB_XCNT(j)  (256  + 64 * (j))
#define XB_XSUB(j)  (1280 + 64 * (j))
#define XB_XGEN(j)  (2304 + 64 * (j))
#define XB_TOP      3328
#define XB_TOPGEN   3392
#define XCD_BAR_WORDS 3456
#define XB_SPIN_CAP (1u << 18)

__device__ __forceinline__ unsigned xb_ld(unsigned* p)              { return __hip_atomic_load(p, __ATOMIC_RELAXED, __HIP_MEMORY_SCOPE_AGENT); }
__device__ __forceinline__ unsigned xb_add(unsigned* p, unsigned v) { return __hip_atomic_fetch_add(p, v, __ATOMIC_RELAXED, __HIP_MEMORY_SCOPE_AGENT); }
__device__ __forceinline__ unsigned xb_xcc_id() { return (unsigned)__builtin_amdgcn_s_getreg((3 << 11) | 20) & 0xFu; }
#define XB_SPIN(cond, bar) do { unsigned _sp = 0; while (cond) { __builtin_amdgcn_s_sleep(1); \
    if ((++_sp & 255u) == 0u) { if (xb_ld(&(bar)[XB_TMO])) break; if (_sp > XB_SPIN_CAP) { atomicAdd(&(bar)[XB_TMO], 1u); break; } } } } while (0)

struct XcdBarrier {
    unsigned* bar; unsigned x;
    volatile LAS unsigned* st;
};

__device__ __forceinline__ XcdBarrier xcd_barrier_post(unsigned* bar, volatile LAS unsigned* st) {
    XcdBarrier b; b.bar = bar; b.x = xb_xcc_id(); b.st = st;
    if (threadIdx.x == 0) (void)xb_add(&bar[XB_XCNT(b.x)], 1u);
    return b;
}
__device__ __forceinline__ void xcd_barrier_complete(unsigned* bar, unsigned x, unsigned& nloc, unsigned& nx) {
    const unsigned G = gridDim.x * gridDim.y * gridDim.z;
    unsigned sum, cnt, mine, sp = 0u;
    for (;;) {
        sum = 0u; cnt = 0u; mine = 0u;
#pragma unroll
        for (unsigned j = 0; j < 16; ++j) { const unsigned c = xb_ld(&bar[XB_XCNT(j)]); sum += c; cnt += (c > 0u) ? 1u : 0u; mine = (j == x) ? c : mine; }
        if (sum == G) break;
        __builtin_amdgcn_s_sleep(1);
        if ((++sp & 255u) == 0u) { if (xb_ld(&bar[XB_TMO])) break; if (sp > XB_SPIN_CAP) { atomicAdd(&bar[XB_TMO], 1u); break; } }
    }
    nloc = mine > 0u ? mine : 1u; nx = cnt > 0u ? cnt : 1u;
}

__device__ __forceinline__ void xcd_barrier(const XcdBarrier& b) {
    asm volatile("s_waitcnt vmcnt(0)" ::: "memory");
    __syncthreads();
    if (threadIdx.x == 0) {
        unsigned* bar = b.bar;
        __builtin_amdgcn_s_waitcnt(0);
        unsigned nloc = b.st[0], nx = b.st[1];
        if (nloc == 0u) { xcd_barrier_complete(bar, b.x, nloc, nx); b.st[0] = nloc; b.st[1] = nx; }
        const unsigned old = xb_add(&bar[XB_XSUB(b.x)], 1u);
        const unsigned gen = old / nloc;
        if (old + 1u == (gen + 1u) * nloc) {
            __builtin_amdgcn_fence(__ATOMIC_RELEASE, "agent");
            asm volatile("s_waitcnt vmcnt(0)" ::: "memory");
            const unsigned og = xb_add(&bar[XB_TOP], 1u);
            const unsigned tg = og / nx;
            if (og + 1u == (tg + 1u) * nx) xb_add(&bar[XB_TOPGEN], 1u);
            else XB_SPIN(xb_ld(&bar[XB_TOPGEN]) == tg, bar);
            __builtin_amdgcn_fence(__ATOMIC_ACQUIRE, "agent");
            xb_add(&bar[XB_XGEN(b.x)], 1u);
            asm volatile("s_waitcnt vmcnt(0)" ::: "memory");
        } else {
            XB_SPIN(xb_ld(&bar[XB_XGEN(b.x)]) == gen, bar);
            __builtin_amdgcn_fence(__ATOMIC_ACQUIRE, "agent");
            asm volatile("s_waitcnt vmcnt(0)" ::: "memory");
        }
    }
    __syncthreads();
}

constexpr int NWAVES = 8;
constexpr size_t MiB = 1u << 20;
constexpr size_t WS_CTL = 0, CTL_ZERO_BYTES = 1 * MiB;
constexpr size_t WS_WD = 1 * MiB, WS_WGU = 87 * MiB, WS_WO = 259 * MiB, WS_WIN = 291 * MiB, WS_XN = 389 * MiB, WS_Q = 519 * MiB, WS_KB = 584 * MiB, WS_VB = 649 * MiB,
                 WS_Z = 714 * MiB, WS_XBC = 779 * MiB, WS_DT = 909 * MiB, WS_KEXT = 912 * MiB, WS_VEXT = 978 * MiB, WS_WD8 = WS_WIN  , WS_HS = WS_Q + 256 * MiB  , WS_F = 1044 * MiB  , WS_PARK = 1052 * MiB  , WS_DUMMY = 1068 * MiB  , WS_WGUQ = 1068 * MiB  , WS_X1Q = 1154 * MiB  , WS_END = 1219 * MiB;
constexpr size_t WS_MIX = WS_XN;
constexpr size_t WS_X1B = WS_KEXT;
constexpr size_t WS_H = WS_Q;
static_assert(WS_WD + (size_t)DM * DFF * 2 <= WS_WGU && WS_WGU + (size_t)2 * DFF * DM * 2 <= WS_WO && WS_WO + (size_t)DM * DM * 2 <= WS_WIN && WS_WIN + (size_t)NINP * DM * 2 <= WS_XN &&
              WS_XN + (size_t)MPAD * DM * 2 <= WS_Q && WS_Q + (size_t)MPAD * AW * 2 <= WS_KB && WS_XBC + (size_t)MPAD * CONVD * 2 <= WS_DT && WS_DT + (size_t)MPAD * SH * 4 <= WS_KEXT &&
              WS_KEXT + (size_t)DEC_B * KVROWS * AW * 2 <= WS_VEXT && WS_VEXT + (size_t)DEC_B * KVROWS * AW * 2 <= WS_F && WS_H + (size_t)MPAD * DFF * 2 <= WS_DT &&
              WS_X1B + (size_t)MPAD * DM * 2 <= WS_END, "d_ws map");
constexpr int CW_TMO = 0, CW_CODE = 1, CW_WSTAT = 8  , CW_QUEUE = 64, CW_P1T = 3648  , CW_P4T = 3584  , CW_SMPC = 512  , CW_P5C = 12288  , CW_SSDF = 2048  , CW_BAR = 4096, CW_SS2 = 65536, CW_SS3 = 131072, CW_RQ = 196608  ;
constexpr int RING_OFF = 0, RING_BYTES = 139264, LDSCTL_OFF = RING_BYTES, MISC_OFF = LDSCTL_OFF + 320, LDS_BYTES = 147456;

struct Frame {
    LAS unsigned char* lds;
    volatile LAS unsigned* MISC;
    gu32* ctl;
    int tid, lane, wave, vcu, G;
};

__device__ __forceinline__ float wave_sum(float v) {
#pragma unroll
    for (int o = 1; o < 64; o <<= 1) v += __shfl_xor(v, o);
    return v;
}
template <int MODE>
__device__ __forceinline__ void p0_transpose_pair(const float* W, int K, int N, bf16* WT, const float* kscale, LAS float* scr, int item0, int nitems, int lane, unsigned char* W8 = nullptr, float s8 = 1.0f, bool as_int8 = false) {
    const int nblk = N / 32;
    f32x4 v[2][8]; float ks[2][8];
#pragma unroll
    for (int t = 0; t < 2; ++t) { const int item = item0 + t < nitems ? item0 + t : item0; const int kb = item / nblk, nb = item % nblk, k0 = 64 * kb, n0 = 32 * nb;
#pragma unroll
        for (int i = 0; i < 8; ++i) { const int kk = 8 * i + (lane >> 3); v[t][i] = __builtin_nontemporal_load((const GAS f32x4*)(W + (size_t)(k0 + kk) * N + n0 + 4 * (lane & 7)));        ks[t][i] = kscale ? kscale[k0 + kk] : 1.0f; } }
#pragma unroll
    for (int t = 0; t < 2; ++t) {
        if (item0 + t >= nitems) break;
        const int item = item0 + t; const int kb = item / nblk, nb = item % nblk, k0 = 64 * kb, n0 = 32 * nb;
        LAS float* s0 = scr + t * (64 * 33);
#pragma unroll
        for (int i = 0; i < 8; ++i) { const int kk = 8 * i + (lane >> 3); LAS float* d = s0 + kk * 33 + 4 * (lane & 7); const f32x4 x = v[t][i] * ks[t][i]; d[0] = x.x; d[1] = x.y; d[2] = x.z; d[3] = x.w; }
        LDS_WAIT(); asm volatile("" ::: "memory");
        const int c = lane & 7;
        const int rbase = MODE == 0 ? n0 : 256 * (n0 >> 7) + (n0 & 127) + (MODE == 2 ? 128 : 0);
#pragma unroll
        for (int j = 0; j < 4; ++j) { const int n = (lane >> 3) + 8 * j; const LAS float* s = s0 + (8 * c) * 33 + n;
            v4u o; o.x = pk2(s[0 * 33], s[1 * 33]); o.y = pk2(s[2 * 33], s[3 * 33]); o.z = pk2(s[4 * 33], s[5 * 33]); o.w = pk2(s[6 * 33], s[7 * 33]);
            if (WT) *(GAS v4u*)(WT + (size_t)(rbase + n) * K + k0 + 8 * c) = o;
            if (W8) {
                typedef unsigned u32x2g __attribute__((ext_vector_type(2))); u32x2g o8;
                int p0 = 0, p1 = 0;
                if (as_int8) { p0 = (int)pg8::pk4_i8(s[0 * 33] * s8, s[1 * 33] * s8, s[2 * 33] * s8, s[3 * 33] * s8); p1 = (int)pg8::pk4_i8(s[4 * 33] * s8, s[5 * 33] * s8, s[6 * 33] * s8, s[7 * 33] * s8); }
                else {
                p0 = __builtin_amdgcn_cvt_pk_fp8_f32(s[0 * 33] * s8, s[1 * 33] * s8, p0, false); p0 = __builtin_amdgcn_cvt_pk_fp8_f32(s[2 * 33] * s8, s[3 * 33] * s8, p0, true);
                p1 = __builtin_amdgcn_cvt_pk_fp8_f32(s[4 * 33] * s8, s[5 * 33] * s8, p1, false); p1 = __builtin_amdgcn_cvt_pk_fp8_f32(s[6 * 33] * s8, s[7 * 33] * s8, p1, true); }
                o8.x = (unsigned)p0; o8.y = (unsigned)p1;
                *(GAS u32x2g*)(W8 + (size_t)(rbase + n) * K + k0 + 8 * c) = o8; } }
    }
    LDS_WAIT(); asm volatile("" ::: "memory");
}
__device__ __forceinline__ void rms_row2_to_bf16(int lane, const float* xrow0, const float* xrow1, const float* w, bf16* orow0, bf16* orow1) {
    const GAS f32x4* xr0 = (const GAS f32x4*)xrow0 + lane; const GAS f32x4* xr1 = (const GAS f32x4*)xrow1 + lane; const GAS f32x4* wr = (const GAS f32x4*)w + lane;
    f32x4 v0[16], v1[16]; float s0 = 0.f, s1 = 0.f;
#pragma unroll
    for (int j = 0; j < 16; ++j) v0[j] = __builtin_nontemporal_load(xr0 + 64 * j);
#pragma unroll
    for (int j = 0; j < 16; ++j) v1[j] = __builtin_nontemporal_load(xr1 + 64 * j);
#pragma unroll
    for (int j = 0; j < 16; ++j) s0 += (v0[j].x * v0[j].x + v0[j].y * v0[j].y) + (v0[j].z * v0[j].z + v0[j].w * v0[j].w);
#pragma unroll
    for (int j = 0; j < 16; ++j) s1 += (v1[j].x * v1[j].x + v1[j].y * v1[j].y) + (v1[j].z * v1[j].z + v1[j].w * v1[j].w);
    const float r0 = 1.0f / sqrtf(wave_sum(s0) * (1.0f / DM) + EPS), r1 = 1.0f / sqrtf(wave_sum(s1) * (1.0f / DM) + EPS);
    GAS unsigned long long* o0 = (GAS unsigned long long*)orow0 + lane; GAS unsigned long long* o1 = (GAS unsigned long long*)orow1 + lane;
#pragma unroll
    for (int j = 0; j < 16; ++j) { const f32x4 g = wr[64 * j];
        o0[64 * j] = (unsigned long long)pk2(v0[j].x * r0 * g.x, v0[j].y * r0 * g.y) | ((unsigned long long)pk2(v0[j].z * r0 * g.z, v0[j].w * r0 * g.w) << 32);
        o1[64 * j] = (unsigned long long)pk2(v1[j].x * r1 * g.x, v1[j].y * r1 * g.y) | ((unsigned long long)pk2(v1[j].z * r1 * g.z, v1[j].w * r1 * g.w) << 32); }
}
__device__ __forceinline__ void rms_row_to_bf16(int lane, const float* xrow, const float* w, bf16* orow) {
    const GAS f32x4* xr = (const GAS f32x4*)xrow + lane; const GAS f32x4* wr = (const GAS f32x4*)w + lane;
    f32x4 v[16]; float s = 0.f;
#pragma unroll
    for (int j = 0; j < 16; ++j) { v[j] = xr[64 * j]; s += (v[j].x * v[j].x + v[j].y * v[j].y) + (v[j].z * v[j].z + v[j].w * v[j].w); }
    const float r = 1.0f / sqrtf(wave_sum(s) * (1.0f / DM) + EPS);
    GAS unsigned long long* o8 = (GAS unsigned long long*)orow + lane;
#pragma unroll
    for (int j = 0; j < 16; ++j) { const f32x4 g = wr[64 * j]; o8[64 * j] = (unsigned long long)pk2(v[j].x * r * g.x, v[j].y * r * g.y) | ((unsigned long long)pk2(v[j].z * r * g.z, v[j].w * r * g.w) << 32); }
}

namespace att {
typedef short bf16x8 __attribute__((ext_vector_type(8)));
typedef short s16x4 __attribute__((ext_vector_type(4)));
typedef float f32x16 __attribute__((ext_vector_type(16)));
typedef unsigned u32x4 __attribute__((ext_vector_type(4)));
typedef unsigned u32x2 __attribute__((ext_vector_type(2)));
constexpr int KSLOT = 8192, VSLOT = 16384, SLOT = KSLOT + VSLOT, NSLOT = 3, PITCH = 2048;
constexpr int PARK_OFF = NSLOT * SLOT, ATTN_LDS_BYTES = PARK_OFF + 8 * 8192;
#define ATT_LAS __attribute__((address_space(3)))
#ifdef PROBE_ATT_VARIANT
#define ATT_VAR(u) ((u).variant)
#else
#define ATT_VAR(u) 0
#endif
__device__ __forceinline__ unsigned cvtpk(float lo, float hi) { unsigned r; asm volatile("v_cvt_pk_bf16_f32 %0, %1, %2" : "=v"(r) : "v"(lo), "v"(hi)); return r; }

__device__ __forceinline__ void glds16(const void* gsrc, unsigned lds_dst) { unsigned keep;
    asm volatile("s_mov_b32 %0, m0\n\ts_mov_b32 m0, %2\n\ts_nop 0\n\tglobal_load_lds_dwordx4 %1, off\n\ts_mov_b32 m0, %0" : "=&s"(keep) : "v"(gsrc), "s"(lds_dst) : "memory"); }
__device__ __forceinline__ float max3f(float a, float b, float c) { float r; asm("v_max3_f32 %0, %1, %2, %3" : "=v"(r) : "v"(a), "v"(b), "v"(c)); return r; }
struct Unit {
    const unsigned short* Q;
    const unsigned short* K;
    const unsigned short* V;
    unsigned short* O;
    int ntot;
    int nvalid_last;
    int sample;
    int qb;
    unsigned char* park;
    int variant;
};

__device__ __forceinline__ void pass(ATT_LAS unsigned char* lds, const Unit& u, int mapoff, bool active, int nmine, int wave, int lane, f32x16 (&o)[4], float& lsum) {
    asm volatile("" : "+v"(lane));
    const int r32 = lane & 31, h = lane >> 5;
    const unsigned short* ksrc = u.K + mapoff + (size_t)lane * PITCH + wave * 8;
    const int rowgrp = wave >> 1, half = wave & 1, sub = lane >> 5, rr = (lane & 31) >> 2, vrow = 8 * rowgrp + rr;
    const int chl = (lane & 3) ^ ((vrow >> 2) & 3);
    const unsigned short* vsrc = u.V + (size_t)vrow * PITCH + (4 * (2 * half + sub) + chl) * 8;
    const unsigned ldsw = (unsigned)(uintptr_t)lds + (unsigned)wave * 1024u;
#define ATT_DMA(t, slot) do { if (ATT_VAR(u) & 1) break; \
        glds16(ksrc + (size_t)(t) * 64 * PITCH, (unsigned)__builtin_amdgcn_readfirstlane(ldsw + (slot) * SLOT)); \
        glds16(vsrc + (size_t)(t) * 64 * PITCH, (unsigned)__builtin_amdgcn_readfirstlane(ldsw + (slot) * SLOT + KSLOT)); \
        glds16(vsrc + (size_t)(t) * 64 * PITCH + 32 * PITCH, (unsigned)__builtin_amdgcn_readfirstlane(ldsw + (slot) * SLOT + KSLOT + 8192)); } while (0)
    asm volatile("s_waitcnt lgkmcnt(0)\n\ts_barrier" ::: "memory");
    ATT_DMA(0, 0);
    if (u.ntot > 1) ATT_DMA(1, 1);
    bf16x8 qf[4];
    { const unsigned short* qrow = u.Q + mapoff + (size_t)(wave * 32 + r32) * PITCH + 8 * h;
#pragma unroll
      for (int ks = 0; ks < 4; ++ks) qf[ks] = active ? *(const bf16x8*)(qrow + 16 * ks) : (bf16x8){0,0,0,0,0,0,0,0}; }
    asm volatile("" : "+v"(qf[0]), "+v"(qf[1]), "+v"(qf[2]), "+v"(qf[3]));
    if (wave >= 4) __builtin_amdgcn_s_setprio(1);
    float l = 0.f, negm_s = 0.f; bool first_ = true;
    f32x16 negm;
#pragma unroll
    for (int r = 0; r < 16; ++r) negm[r] = 0.f;
#pragma unroll
    for (int d = 0; d < 4; ++d)
#pragma unroll
        for (int r = 0; r < 16; ++r) o[d][r] = 0.f;
    const int kbase = h * 1024 + r32 * 16;
    const int g = lane >> 4, blk = g & 1, q_ = (lane & 15) >> 2, p_ = lane & 3;
    const int vb0 = KSLOT + 64 * (4 * h + q_) + 16 * ((2 * blk + (p_ >> 1)) ^ h) + 8 * (p_ & 1);
    const int vb1 = KSLOT + 2048 + 64 * (4 * h + q_) + 16 * ((2 * blk + (p_ >> 1)) ^ (2 + h)) + 8 * (p_ & 1);
#define ATT_QK0(D0, D1, SB) do { _Pragma("unroll") for (int r = 0; r < 16; ++r) { D0[r] = 0.f; D1[r] = 0.f; } \
        _Pragma("unroll") for (int ks = 0; ks < 4; ++ks) { \
            const bf16x8 k0 = *(const ATT_LAS bf16x8*)((SB) + kbase + ks * 2048), k1 = *(const ATT_LAS bf16x8*)((SB) + kbase + ks * 2048 + 512); \
            D0 = __builtin_amdgcn_mfma_f32_32x32x16_bf16(k0, qf[ks], D0, 0, 0, 0); D1 = __builtin_amdgcn_mfma_f32_32x32x16_bf16(k1, qf[ks], D1, 0, 0, 0); } } while (0)
#define ATT_TILE(C0, C1, N0, N1, SC, SN, TT) do { \
        ATT_LAS unsigned char* sc_ = lds + (SC) * SLOT; ATT_LAS unsigned char* sn_ = lds + (SN) * SLOT; \
        if ((TT) == u.ntot - 1 && u.nvalid_last < 64) { \
            _Pragma("unroll") for (int r = 0; r < 16; ++r) { const int kv = (r & 3) + 8 * (r >> 2) + 4 * h; if (kv >= u.nvalid_last) C0[r] = -1e30f; if (kv + 32 >= u.nvalid_last) C1[r] = -1e30f; } } \
        float mx; { float t_[8]; \
            _Pragma("unroll") for (int r = 0; r < 8; ++r) t_[r] = max3f(C0[2 * r], C0[2 * r + 1], C1[2 * r]); \
            _Pragma("unroll") for (int r = 0; r < 8; ++r) t_[r] = max3f(t_[r], C1[2 * r + 1], t_[r]); \
            const float u0_ = max3f(t_[0], t_[1], t_[2]), u1_ = max3f(t_[3], t_[4], t_[5]), u2_ = max3f(t_[6], t_[7], t_[7]); mx = max3f(u0_, u1_, u2_); } \
        mx = max3f(mx, __shfl_xor(mx, 32), mx); \
        if (first_ || __any(mx > 8.0f)) {       \
            const float dd = first_ ? mx : fmaxf(mx, 0.f), alpha = __builtin_amdgcn_exp2f(-dd); first_ = false; l *= alpha; negm_s -= dd; \
            _Pragma("unroll") for (int d = 0; d < 4; ++d) _Pragma("unroll") for (int r = 0; r < 16; ++r) o[d][r] *= alpha; \
            _Pragma("unroll") for (int r = 0; r < 16; ++r) { C0[r] -= dd; C1[r] -= dd; negm[r] = negm_s; } } \
        const unsigned va0 = (unsigned)(uintptr_t)(sc_ + vb0), va1 = (unsigned)(uintptr_t)(sc_ + vb1); \
        float rsa_[4] = {0.f, 0.f, 0.f, 0.f}; \
        _Pragma("unroll") for (int s = 0; s < 4; ++s) { \
            s16x4 lo[4], hi[4]; \
            if (!(ATT_VAR(u) & 2)) _Pragma("unroll") for (int d = 0; d < 4; ++d) { \
                asm volatile("ds_read_b64_tr_b16 %0, %1 offset:%c2" : "=&v"(lo[d]) : "v"(va0), "i"(d * 512 + s * 4096) : "memory"); \
                asm volatile("ds_read_b64_tr_b16 %0, %1 offset:%c2" : "=&v"(hi[d]) : "v"(va1), "i"(d * 512 + s * 4096) : "memory"); } \
            const bf16x8 k0 = *(const ATT_LAS bf16x8*)(sn_ + kbase + s * 2048), k1 = *(const ATT_LAS bf16x8*)(sn_ + kbase + s * 2048 + 512); \
            u32x4 w; \
            if (s < 2) { _Pragma("unroll") for (int e = 0; e < 8; ++e) { C0[8 * s + e] = (ATT_VAR(u) & 4) ? C0[8 * s + e] : __builtin_amdgcn_exp2f(C0[8 * s + e]); rsa_[e & 3] += C0[8 * s + e]; } \
                w.x = cvtpk(C0[8 * s], C0[8 * s + 1]); w.y = cvtpk(C0[8 * s + 2], C0[8 * s + 3]); w.z = cvtpk(C0[8 * s + 4], C0[8 * s + 5]); w.w = cvtpk(C0[8 * s + 6], C0[8 * s + 7]); } \
            else { const int b_ = 8 * (s - 2); _Pragma("unroll") for (int e = 0; e < 8; ++e) { C1[b_ + e] = (ATT_VAR(u) & 4) ? C1[b_ + e] : __builtin_amdgcn_exp2f(C1[b_ + e]); rsa_[e & 3] += C1[b_ + e]; } \
                w.x = cvtpk(C1[b_], C1[b_ + 1]); w.y = cvtpk(C1[b_ + 2], C1[b_ + 3]); w.z = cvtpk(C1[b_ + 4], C1[b_ + 5]); w.w = cvtpk(C1[b_ + 6], C1[b_ + 7]); } \
            const bf16x8 pf = __builtin_bit_cast(bf16x8, w); \
            if (s == 0) { N0 = __builtin_amdgcn_mfma_f32_32x32x16_bf16(k0, qf[0], negm, 0, 0, 0); N1 = __builtin_amdgcn_mfma_f32_32x32x16_bf16(k1, qf[0], negm, 0, 0, 0); } \
            else { N0 = __builtin_amdgcn_mfma_f32_32x32x16_bf16(k0, qf[s], N0, 0, 0, 0); N1 = __builtin_amdgcn_mfma_f32_32x32x16_bf16(k1, qf[s], N1, 0, 0, 0); } \
            asm volatile("s_waitcnt lgkmcnt(0)" ::: "memory"); \
            if (!(ATT_VAR(u) & 2)) _Pragma("unroll") for (int d = 0; d < 4; ++d) { \
                const bf16x8 vf = (bf16x8){lo[d][0], lo[d][1], lo[d][2], lo[d][3], hi[d][0], hi[d][1], hi[d][2], hi[d][3]}; \
                o[d] = __builtin_amdgcn_mfma_f32_32x32x16_bf16(vf, pf, o[d], 0, 0, 0); } \
        } \
        l += (rsa_[0] + rsa_[1]) + (rsa_[2] + rsa_[3]); } while (0)
    f32x16 sA0, sA1, sB0, sB1;
#define ATT_WAITBAR(N) do { if (ATT_VAR(u) & 8) asm volatile("s_waitcnt vmcnt(" #N ") lgkmcnt(0)" ::: "memory"); else asm volatile("s_waitcnt vmcnt(" #N ") lgkmcnt(0)\n\ts_barrier" ::: "memory"); } while (0)
    if (u.ntot > 1) ATT_WAITBAR(3); else ATT_WAITBAR(0);
    if (active) ATT_QK0(sA0, sA1, lds);
    int slot = 0;
#define ATT_HALF(TT, C0, C1, N0, N1) do { const int sn = slot == 2 ? 0 : slot + 1; \
        if ((TT) + 1 < u.ntot) ATT_WAITBAR(0); \
        if ((TT) + 2 < u.ntot) ATT_DMA((TT) + 2, slot == 0 ? 2 : slot - 1); \
        if (active && (TT) < nmine && !(ATT_VAR(u) & 16)) ATT_TILE(C0, C1, N0, N1, slot, sn, (TT)); \
        slot = sn; } while (0)
    for (int t = 0; t < u.ntot; t += 2) {
        ATT_HALF(t, sA0, sA1, sB0, sB1);
        if (t + 1 < u.ntot) ATT_HALF(t + 1, sB0, sB1, sA0, sA1);
    }
#undef ATT_HALF
#undef ATT_WAITBAR
#undef ATT_TILE
#undef ATT_QK0
    __builtin_amdgcn_s_setprio(0);
    lsum = l + __shfl_xor(l, 32);
#undef ATT_DMA
}

__device__ __forceinline__ void attn_unit(ATT_LAS unsigned char* lds, const Unit& u, float lam, const float* subw, int wave, int lane) {
    asm volatile("" : "+v"(lane));
    const int r32 = lane & 31, h = lane >> 5;
    const bool active = u.sample ? (wave == 0) : true;
    const int nmine = u.sample ? u.ntot : 4 * u.qb + (wave >> 1) + 1;
    f32x16 o[4]; float l1, l2;
    ATT_LAS u32x4* park = (ATT_LAS u32x4*)(lds + PARK_OFF + wave * 8192) + lane;
    pass(lds, u, 0, active, nmine, wave, lane, o, l1);
    { const float inv = 1.0f / l1;
#pragma unroll
      for (int d = 0; d < 4; ++d)
#pragma unroll
          for (int r4 = 0; r4 < 2; ++r4) { u32x4 w; w.x = cvtpk(o[d][8 * r4] * inv, o[d][8 * r4 + 1] * inv); w.y = cvtpk(o[d][8 * r4 + 2] * inv, o[d][8 * r4 + 3] * inv);
              w.z = cvtpk(o[d][8 * r4 + 4] * inv, o[d][8 * r4 + 5] * inv); w.w = cvtpk(o[d][8 * r4 + 6] * inv, o[d][8 * r4 + 7] * inv); if (active) park[(2 * d + r4) * 64] = w; } }
    pass(lds, u, 64, active, nmine, wave, lane, o, l2);
    if (!active) return;
    const float c2 = lam / l2;
    float ss = 0.f;
#pragma unroll
    for (int d = 0; d < 4; ++d)
#pragma unroll
        for (int r4 = 0; r4 < 2; ++r4) { const u32x4 w = park[(2 * d + r4) * 64];
#pragma unroll
            for (int e = 0; e < 4; ++e) { const unsigned pw = w[e]; const int r = 8 * r4 + 2 * e;
                const float v0 = __uint_as_float(pw << 16) - c2 * o[d][r], v1 = __uint_as_float(pw & 0xffff0000u) - c2 * o[d][r + 1];
                o[d][r] = v0; o[d][r + 1] = v1; ss += v0 * v0 + v1 * v1; } }
    ss += __shfl_xor(ss, 32);
    const float rn = (1.0f - LAM0) / sqrtf(ss * (1.0f / 128.0f) + EPS);
    unsigned short* orow = u.O + (size_t)(wave * 32 + r32) * 4096 + 8 * h;
    const bool st_ok = !(u.sample && r32 >= 16);
#pragma unroll
    for (int d = 0; d < 4; ++d)
#pragma unroll
        for (int kp = 0; kp < 4; kp += 2) {
            u32x2 pa, pb;
            { const int dc = 32 * d + 8 * kp + 4 * h; const f32x4 w = *(const f32x4*)(subw + dc);
              pa.x = cvtpk(o[d][4 * kp] * rn * w[0], o[d][4 * kp + 1] * rn * w[1]); pa.y = cvtpk(o[d][4 * kp + 2] * rn * w[2], o[d][4 * kp + 3] * rn * w[3]); }
            { const int dc = 32 * d + 8 * (kp + 1) + 4 * h; const f32x4 w = *(const f32x4*)(subw + dc);
              pb.x = cvtpk(o[d][4 * kp + 4] * rn * w[0], o[d][4 * kp + 5] * rn * w[1]); pb.y = cvtpk(o[d][4 * kp + 6] * rn * w[2], o[d][4 * kp + 7] * rn * w[3]); }
            const auto rx = __builtin_amdgcn_permlane32_swap(pa.x, pb.x, false, false); const auto ry = __builtin_amdgcn_permlane32_swap(pa.y, pb.y, false, false);
            const u32x4 v = (u32x4){rx[0], ry[0], rx[1], ry[1]};
            if (st_ok) *(u32x4*)(orow + 32 * d + 8 * kp) = v;
        }
}
}

namespace ssd {
typedef short bf16x8 __attribute__((ext_vector_type(8)));
typedef short s16x4 __attribute__((ext_vector_type(4)));
typedef float f32x4 __attribute__((ext_vector_type(4)));
typedef unsigned u32x4 __attribute__((ext_vector_type(4)));
typedef unsigned u32x2 __attribute__((ext_vector_type(2)));
#define SSD_LAS __attribute__((address_space(3)))
constexpr int XT_STRIDE = 144;
constexpr int L_CM = 0, L_BM = 16384, L_XT = 32768, L_ZT = L_XT + 256 * XT_STRIDE  , L_TAB = L_ZT + 32768  ,
              L_G = L_TAB + 2048  , L_SSQ = L_G + 16384  , L_CW = L_SSQ + 2048  , SSD_LDS_BYTES = L_CW + 10240;
static_assert(SSD_LDS_BYTES <= 139264, "ssd lds");
__device__ __forceinline__ unsigned off_a(unsigned row, unsigned ch) { return 2048u * (row >> 3) + 512u * (ch >> 2) + 64u * (row & 7) + 16u * ((ch & 3) ^ ((row >> 2) & 3)); }
__device__ __forceinline__ unsigned cvtpk(float lo, float hi) { unsigned r; asm volatile("v_cvt_pk_bf16_f32 %0, %1, %2" : "=v"(r) : "v"(lo), "v"(hi)); return r; }
__device__ __forceinline__ float bf2f(unsigned short b) { return __uint_as_float((unsigned)b << 16); }
__device__ __forceinline__ float silu(float v) { return v * __builtin_amdgcn_rcpf(1.0f + __builtin_amdgcn_exp2f(-1.4426950408889634f * v)); }
__device__ __forceinline__ bf16x8 pack8(const f32x4 a, const f32x4 b) { u32x4 w; w.x = cvtpk(a[0], a[1]); w.y = cvtpk(a[2], a[3]); w.z = cvtpk(b[0], b[1]); w.w = cvtpk(b[2], b[3]); return __builtin_bit_cast(bf16x8, w); }
__device__ __forceinline__ void glds16(const void* gsrc, unsigned lds_dst) { unsigned keep;
    asm volatile("s_mov_b32 %0, m0\n\ts_mov_b32 m0, %2\n\ts_nop 0\n\tglobal_load_lds_dwordx4 %1, off\n\ts_mov_b32 m0, %0" : "=&s"(keep) : "v"(gsrc), "s"(lds_dst) : "memory"); }
#define SSD_BAR() asm volatile("s_waitcnt lgkmcnt(0)\n\ts_barrier" ::: "memory")
__device__ __forceinline__ float row16_sum(float v) {
    v += __builtin_bit_cast(float, __builtin_amdgcn_update_dpp(0, __builtin_bit_cast(int, v), 0xB1, 0xf, 0xf, false));
    v += __builtin_bit_cast(float, __builtin_amdgcn_update_dpp(0, __builtin_bit_cast(int, v), 0x4E, 0xf, 0xf, false));
    v += __builtin_bit_cast(float, __builtin_amdgcn_update_dpp(0, __builtin_bit_cast(int, v), 0x141, 0xf, 0xf, false));
    v += __builtin_bit_cast(float, __builtin_amdgcn_update_dpp(0, __builtin_bit_cast(int, v), 0x140, 0xf, 0xf, false));
    return v;
}
#define MFMA16(a, b, c) __builtin_amdgcn_mfma_f32_16x16x32_bf16((a), (b), (c), 0, 0, 0)

struct Unit {
    const unsigned short* xbc;
    const unsigned short* z;
    const float* dtraw;
    const float* hist;
    const float* init;
    float* fin;
    unsigned short* y;
    int len;
    int g;
    int prev;
    int seg;
    float* fseg;
    unsigned* flag;
    int last;
};
constexpr int FSTRIDE = 4 * 64 * 128 + 64;
#define SSD_RLX __ATOMIC_RELAXED, __HIP_MEMORY_SCOPE_AGENT
struct Params { const float* conv_w; const float* conv_b; const float* dt_bias; const float* A_log; const float* D; const float* norm_w; };

template <bool PRE>
__device__ __forceinline__ void ssd_unit(SSD_LAS unsigned char* lds, const Unit& u, const Params& P, int tid, int wave, int lane) {
    asm volatile("" : "+v"(tid), "+v"(lane));
    const int g = u.g, hh = wave >> 1, ph = wave & 1, head = 4 * g + hh;
    const int c16 = lane & 15, g4 = lane >> 4, q_ = c16 >> 2, p_ = lane & 3;
    const float A = -__expf(P.A_log[head]), Dh = P.D[head], dtb = P.dt_bias[head];
    const int xq = (c16 >> 2) & 3, rbase = 2048 * (c16 >> 3) + 64 * (c16 & 7);
    const int rowrd = rbase + 16 * (g4 ^ xq);
    const int c_lo = rbase + 16 * ((g4 >> 1) ^ xq) + 8 * (g4 & 1);
    const int c_hi = rbase + 16 * ((2 + (g4 >> 1)) ^ xq) + 8 * (g4 & 1);
    const int trb = 2048 * g4 + 64 * q_ + 8 * (p_ & 1), tcc = g4 & 1, tbb = p_ >> 1;
    const int tr00 = trb + 32 * (0 ^ tcc) + 16 * (tbb ^ 0), tr01 = trb + 32 * (0 ^ tcc) + 16 * (tbb ^ 1), tr10 = trb + 32 * (1 ^ tcc) + 16 * (tbb ^ 0), tr11 = trb + 32 * (1 ^ tcc) + 16 * (tbb ^ 1);
    const int xt_lane = (64 * hh + 32 * ph + c16) * XT_STRIDE;
    f32x4 st[8][2];
#pragma unroll
    for (int nt = 0; nt < 8; ++nt)
#pragma unroll
        for (int pt = 0; pt < 2; ++pt) {
            if (u.init) st[nt][pt] = *(const f32x4*)(u.init + ((size_t)head * 64 + 32 * ph + 16 * pt + c16) * 128 + 16 * nt + 4 * g4);
            else st[nt][pt] = (f32x4){0.f, 0.f, 0.f, 0.f};
        }
    if constexpr (!PRE) {
        if (u.seg > 0) {
            if (tid == 0) { const unsigned want = (1u << u.seg) - 1u; unsigned sp = 0;
                while ((__hip_atomic_load(u.flag, SSD_RLX) & want) != want) { __builtin_amdgcn_s_sleep(8); if (++sp > (1u << 22)) break; } }
            __syncthreads();
            for (int i = 0; i < u.seg; ++i) {
                const float* F = u.fseg + (size_t)i * FSTRIDE;
                const float Di = __uint_as_float(__hip_atomic_load((const unsigned*)(F + 4 * 64 * 128 + hh), SSD_RLX));
#pragma unroll
                for (int nt = 0; nt < 8; ++nt)
#pragma unroll
                    for (int pt = 0; pt < 2; ++pt) {
                        const unsigned long long* fp = (const unsigned long long*)(F + ((size_t)hh * 64 + 32 * ph + 16 * pt + c16) * 128 + 16 * nt + 4 * g4);
                        const unsigned long long a = __hip_atomic_load(fp, SSD_RLX), b = __hip_atomic_load(fp + 1, SSD_RLX);
                        st[nt][pt] = st[nt][pt] * Di + (f32x4){__uint_as_float((unsigned)a), __uint_as_float((unsigned)(a >> 32)), __uint_as_float((unsigned)b), __uint_as_float((unsigned)(b >> 32))};
                    }
            }
        }
    }
    float asum = 0.f;
    const int cp = ((wave & 3) << 6) | lane, rh = wave >> 2;
    const int ccol = cp < 128 ? 256 * g + 2 * cp : cp < 192 ? 2048 + 128 * g + 2 * (cp - 128) : 3072 + 128 * g + 2 * (cp - 192);
    typedef float f32x2 __attribute__((ext_vector_type(2)));
    if (rh == 0) {
#pragma unroll
        for (int i = 0; i < 4; ++i) ((SSD_LAS f32x2*)(lds + L_CW))[i * 256 + cp] = (f32x2){P.conv_w[i * 4096 + ccol], P.conv_w[i * 4096 + ccol + 1]};
        ((SSD_LAS f32x2*)(lds + L_CW))[4 * 256 + cp] = (f32x2){P.conv_b[ccol], P.conv_b[ccol + 1]};
    }
    __syncthreads();
        const int nchunks = (u.len + 63) >> 6;
    unsigned raw[2][19]; float dtr = 0.f;
    const int tmin = u.prev ? -3 : 0;
    const unsigned zlds = (unsigned)(uintptr_t)(lds + L_ZT) + (unsigned)wave * 4096u;
    const int hd_l = 4 * g + (wave & 3);
    const float dtb_l = P.dt_bias[hd_l], A_l = -__expf(P.A_log[hd_l]);
#define SSD_ISSUE(cc) do { const int tb_ = 64 * (cc); \
        _Pragma("unroll") for (int hb = 0; hb < 2; ++hb) _Pragma("unroll") for (int i = 0; i < 19; ++i) { \
            int t = tb_ + 32 * rh + 16 * hb - 3 + i; t = t < tmin ? tmin : (t >= u.len ? u.len - 1 : t); raw[hb][i] = *(const unsigned*)(u.xbc + (long)t * 4096 + ccol); } \
        if (wave < 4) { int t = tb_ + lane; t = t >= u.len ? u.len - 1 : t; dtr = u.dtraw[(size_t)t * 32 + hd_l]; } } while (0)
#define SSD_ISSUE_Z(cc) do { const int tb_ = 64 * (cc); \
        _Pragma("unroll") for (int i = 0; i < 4; ++i) { int t = tb_ + 8 * wave + 2 * i + (lane >> 5); t = t >= u.len ? u.len - 1 : t; \
            glds16(u.z + (size_t)t * 2048 + 256 * g + 8 * (lane & 31), (unsigned)__builtin_amdgcn_readfirstlane(zlds + 1024u * i)); } } while (0)
    SSD_ISSUE(0); if constexpr (!PRE) SSD_ISSUE_Z(0);
    for (int c = 0; c < nchunks; ++c) {
        const int t0 = 64 * c;
        {
            float cw[4][2], cb[2];
#pragma unroll
            for (int i = 0; i < 4; ++i) { const f32x2 w = ((const SSD_LAS f32x2*)(lds + L_CW))[i * 256 + cp]; cw[i][0] = w.x; cw[i][1] = w.y; }
            { const f32x2 w = ((const SSD_LAS f32x2*)(lds + L_CW))[4 * 256 + cp]; cb[0] = w.x; cb[1] = w.y; }
#pragma unroll
            for (int hb = 0; hb < 2; ++hb) {
                float x0[19], x1[19];
#pragma unroll
                for (int i = 0; i < 19; ++i) {
                    const int t = t0 + 32 * rh + 16 * hb - 3 + i;
                    const unsigned v = raw[hb][i];
                    float a = 0.f, b = 0.f;
                    if (t >= tmin && t < u.len) { a = __uint_as_float(v << 16); b = __uint_as_float(v & 0xffff0000u); }
                    x0[i] = a; x1[i] = b;
                }
                if (hb == 0 && u.hist && c == 0 && rh == 0) {
#pragma unroll
                    for (int i = 0; i < 3; ++i) { x0[i] = u.hist[i * 4096 + ccol]; x1[i] = u.hist[i * 4096 + ccol + 1]; }
                }
                if (cp < 128) {
#pragma unroll
                    for (int k = 0; k < 2; ++k) {
                        float e0[8], e1[8];
#pragma unroll
                        for (int j = 0; j < 8; ++j) { const int i = 8 * k + j;
                            e0[j] = silu(cb[0] + cw[0][0] * x0[i] + cw[1][0] * x0[i + 1] + cw[2][0] * x0[i + 2] + cw[3][0] * x0[i + 3]);
                            e1[j] = silu(cb[1] + cw[0][1] * x1[i] + cw[1][1] * x1[i + 1] + cw[2][1] * x1[i + 2] + cw[3][1] * x1[i + 3]); }
                        u32x4 w0, w1;
                        w0.x = cvtpk(e0[0], e0[1]); w0.y = cvtpk(e0[2], e0[3]); w0.z = cvtpk(e0[4], e0[5]); w0.w = cvtpk(e0[6], e0[7]);
                        w1.x = cvtpk(e1[0], e1[1]); w1.y = cvtpk(e1[2], e1[3]); w1.z = cvtpk(e1[4], e1[5]); w1.w = cvtpk(e1[6], e1[7]);
                        *(SSD_LAS u32x4*)(lds + L_XT + (2 * cp) * XT_STRIDE + 64 * rh + 32 * hb + 16 * k) = w0;
                        *(SSD_LAS u32x4*)(lds + L_XT + (2 * cp + 1) * XT_STRIDE + 64 * rh + 32 * hb + 16 * k) = w1;
                    }
                } else if (!PRE || cp < 192) {
                    const int n = cp < 192 ? 2 * (cp - 128) : 2 * (cp - 192); const int base = (cp < 192 ? L_BM : L_CM) + 8192 * rh + 512 * (n >> 5) + 2 * (n & 7);
                    const int chl = (n >> 3) & 3;
#pragma unroll
                    for (int i = 0; i < 16; ++i) {
                        const float e0 = silu(cb[0] + cw[0][0] * x0[i] + cw[1][0] * x0[i + 1] + cw[2][0] * x0[i + 2] + cw[3][0] * x0[i + 3]);
                        const float e1 = silu(cb[1] + cw[0][1] * x1[i] + cw[1][1] * x1[i + 1] + cw[2][1] * x1[i + 2] + cw[3][1] * x1[i + 3]);
                        *(SSD_LAS unsigned*)(lds + base + 16 * (chl ^ ((i >> 2) & 3)) + 2048 * (2 * hb + (i >> 3)) + 64 * (i & 7)) = cvtpk(e0, e1);
                    }
                }
            }
            if (wave < 4) {
                const int t = t0 + lane;
                float dt = 0.f;
                if (t < u.len) { const float v = dtr + dtb_l; dt = fmaxf(v, 0.f) + log1pf(__expf(-fabsf(v))); }
                float a = dt * A_l;
#pragma unroll
                for (int o = 1; o < 64; o <<= 1) { const float n = __shfl_up(a, o); if (lane >= o) a += n; }
                ((SSD_LAS float*)(lds + L_TAB))[wave * 64 + lane] = dt; ((SSD_LAS float*)(lds + L_TAB + 1024))[wave * 64 + lane] = a;
            }
            if (c + 1 < nchunks) SSD_ISSUE(c + 1);
        }
        if constexpr (PRE) SSD_BAR();
        else if (c + 1 < nchunks) { if (wave < 4) asm volatile("s_waitcnt vmcnt(39) lgkmcnt(0)\n\ts_barrier" ::: "memory"); else asm volatile("s_waitcnt vmcnt(38) lgkmcnt(0)\n\ts_barrier" ::: "memory"); }
        else asm volatile("s_waitcnt vmcnt(0) lgkmcnt(0)\n\ts_barrier" ::: "memory");
        if constexpr (!PRE) {
        {
#pragma unroll
            for (int rep = 0; rep < 2; ++rep) {
                const int ti = wave + 8 * rep;
                if (ti < 10) {
                    const int stq = ti < 4 ? 0 : ti < 7 ? 1 : ti < 9 ? 2 : 3, qtq = ti < 4 ? ti : ti < 7 ? ti - 3 : ti < 9 ? ti - 5 : 3;
                    f32x4 acc = (f32x4){0.f, 0.f, 0.f, 0.f};
#pragma unroll
                    for (int ks = 0; ks < 4; ++ks) {
                        const bf16x8 a = *(const SSD_LAS bf16x8*)(lds + L_BM + rowrd + 4096 * stq + 512 * ks);
                        const bf16x8 b = *(const SSD_LAS bf16x8*)(lds + L_CM + rowrd + 4096 * qtq + 512 * ks);
                        acc = MFMA16(a, b, acc);
                    }
                    *(SSD_LAS f32x4*)(lds + L_G + (stq * 4 + qtq) * 1024 + lane * 16) = acc;
                }
            }
        }
        SSD_BAR();
        const SSD_LAS float* dtt = (const SSD_LAS float*)(lds + L_TAB) + hh * 64;
        const SSD_LAS float* act = (const SSD_LAS float*)(lds + L_TAB + 1024) + hh * 64;
        f32x4 y[4][2];
        {
#pragma unroll
            for (int qt = 0; qt < 4; ++qt) { y[qt][0] = (f32x4){0.f, 0.f, 0.f, 0.f}; y[qt][1] = (f32x4){0.f, 0.f, 0.f, 0.f}; }
#pragma unroll
            for (int ks = 0; ks < 4; ++ks) {
                const bf16x8 sf0 = pack8(st[2 * ks][0], st[2 * ks + 1][0]), sf1 = pack8(st[2 * ks][1], st[2 * ks + 1][1]);
#pragma unroll
                for (int qt = 0; qt < 4; ++qt) {
                    const u32x2 lo = *(const SSD_LAS u32x2*)(lds + L_CM + c_lo + 4096 * qt + 512 * ks);
                    const u32x2 hi = *(const SSD_LAS u32x2*)(lds + L_CM + c_hi + 4096 * qt + 512 * ks);
                    const bf16x8 cf = __builtin_bit_cast(bf16x8, (u32x4){lo.x, lo.y, hi.x, hi.y});
                    y[qt][0] = MFMA16(cf, sf0, y[qt][0]); y[qt][1] = MFMA16(cf, sf1, y[qt][1]);
                }
            }
#pragma unroll
            for (int qt = 0; qt < 4; ++qt) {
                const f32x4 aq = *(const SSD_LAS f32x4*)(act + 16 * qt + 4 * g4);
#pragma unroll
                for (int r = 0; r < 4; ++r) { const float e = __expf(aq[r]); y[qt][0][r] *= e; y[qt][1][r] *= e; }
            }
#pragma unroll
            for (int qt = 0; qt < 4; ++qt) {
                const float aqc = act[16 * qt + c16];
                const int qcol = 16 * qt + c16;
#pragma unroll
                for (int ks = 0; ks <= (qt >> 1); ++ks) {
                    f32x4 m[2];
#pragma unroll
                    for (int e2 = 0; e2 < 2; ++e2) {
                        const int stt = 2 * ks + e2;
                        if (stt <= qt) {
                            const f32x4 gv = *(const SSD_LAS f32x4*)(lds + L_G + (stt * 4 + qt) * 1024 + lane * 16);
                            const f32x4 as = *(const SSD_LAS f32x4*)(act + 16 * stt + 4 * g4);
                            const f32x4 ds = *(const SSD_LAS f32x4*)(dtt + 16 * stt + 4 * g4);
#pragma unroll
                            for (int r = 0; r < 4; ++r) { const int s = 16 * stt + 4 * g4 + r; m[e2][r] = s <= qcol ? gv[r] * __expf(aqc - as[r]) * ds[r] : 0.f; }
                        } else m[e2] = (f32x4){0.f, 0.f, 0.f, 0.f};
                    }
                    const bf16x8 mf = pack8(m[0], m[1]);
#pragma unroll
                    for (int pt = 0; pt < 2; ++pt) {
                        const u32x2 lo = *(const SSD_LAS u32x2*)(lds + L_XT + xt_lane + 8 * g4 + 16 * XT_STRIDE * pt + 64 * ks);
                        const u32x2 hi = *(const SSD_LAS u32x2*)(lds + L_XT + xt_lane + 8 * g4 + 16 * XT_STRIDE * pt + 64 * ks + 32);
                        const bf16x8 xf = __builtin_bit_cast(bf16x8, (u32x4){lo.x, lo.y, hi.x, hi.y});
                        y[qt][pt] = MFMA16(mf, xf, y[qt][pt]);
                    }
                }
            }
#pragma unroll
            for (int qt = 0; qt < 4; ++qt) {
                f32x4 sq = (f32x4){0.f, 0.f, 0.f, 0.f};
#pragma unroll
                for (int pt = 0; pt < 2; ++pt) {
                    const u32x2 xv = *(const SSD_LAS u32x2*)(lds + L_XT + xt_lane + 8 * g4 + 16 * XT_STRIDE * pt + 32 * qt);
                    const SSD_LAS unsigned short* zp0 = (const SSD_LAS unsigned short*)(lds + L_ZT) + (4 * g4) * 256 + 64 * hh + 32 * ph + c16 + 16 * pt + (16 * qt) * 256;
                    const float xs[4] = {__uint_as_float(xv.x << 16), __uint_as_float(xv.x & 0xffff0000u), __uint_as_float(xv.y << 16), __uint_as_float(xv.y & 0xffff0000u)};
                    const float zs[4] = {bf2f(zp0[0]), bf2f(zp0[256]), bf2f(zp0[512]), bf2f(zp0[768])};
#pragma unroll
                    for (int r = 0; r < 4; ++r) { const float v = (y[qt][pt][r] + Dh * xs[r]) * silu(zs[r]); y[qt][pt][r] = v; sq[r] += v * v; }
                }
#pragma unroll
                for (int r = 0; r < 4; ++r) { sq[r] = row16_sum(sq[r]); }
                if (c16 == 0) *(SSD_LAS f32x4*)(lds + L_SSQ + wave * 256 + (16 * qt + 4 * g4) * 4) = sq;
            }
        }
        SSD_BAR();
        {
            float nw[2];
#pragma unroll
            for (int pt = 0; pt < 2; ++pt) nw[pt] = P.norm_w[256 * g + 64 * hh + 32 * ph + 16 * pt + c16];
#pragma unroll
            for (int qt = 0; qt < 4; ++qt) {
                f32x4 tot = (f32x4){0.f, 0.f, 0.f, 0.f};
#pragma unroll
                for (int w = 0; w < 8; ++w) tot += *(const SSD_LAS f32x4*)(lds + L_SSQ + w * 256 + (16 * qt + 4 * g4) * 4);
#pragma unroll
                for (int r = 0; r < 4; ++r) {
                    const int t = t0 + 16 * qt + 4 * g4 + r;
                    if (t < u.len) {
                        const float rn = __builtin_amdgcn_rsqf(tot[r] * (1.0f / 256.0f) + EPS);
#pragma unroll
                        for (int pt = 0; pt < 2; ++pt) {
                            const unsigned b = cvtpk(y[qt][pt][r] * rn * nw[pt], 0.f);
                            u.y[(size_t)t * 4096 + 256 * g + 64 * hh + 32 * ph + 16 * pt + c16] = (unsigned short)b;
                        }
                    }
                }
            }
        }
        if (c + 1 < nchunks) SSD_ISSUE_Z(c + 1);
        }
        {
            const SSD_LAS float* dtt = (const SSD_LAS float*)(lds + L_TAB) + hh * 64;
            const SSD_LAS float* act = (const SSD_LAS float*)(lds + L_TAB + 1024) + hh * 64;
            const float aend = act[63], cd = __expf(aend); asum += aend;
            bf16x8 xw[2][2];
#pragma unroll
            for (int ks = 0; ks < 2; ++ks) {
                const f32x4 a0 = *(const SSD_LAS f32x4*)(act + 32 * ks + 8 * g4), a1 = *(const SSD_LAS f32x4*)(act + 32 * ks + 8 * g4 + 4);
                const f32x4 d0 = *(const SSD_LAS f32x4*)(dtt + 32 * ks + 8 * g4), d1 = *(const SSD_LAS f32x4*)(dtt + 32 * ks + 8 * g4 + 4);
                float wv[8];
#pragma unroll
                for (int j = 0; j < 4; ++j) { wv[j] = d0[j] * __expf(aend - a0[j]); wv[4 + j] = d1[j] * __expf(aend - a1[j]); }
#pragma unroll
                for (int pt = 0; pt < 2; ++pt) {
                    const u32x4 xv = *(const SSD_LAS u32x4*)(lds + L_XT + xt_lane + 16 * g4 + 16 * XT_STRIDE * pt + 64 * ks);
                    u32x4 o;
                    o.x = cvtpk(__uint_as_float(xv.x << 16) * wv[0], __uint_as_float(xv.x & 0xffff0000u) * wv[1]);
                    o.y = cvtpk(__uint_as_float(xv.y << 16) * wv[2], __uint_as_float(xv.y & 0xffff0000u) * wv[3]);
                    o.z = cvtpk(__uint_as_float(xv.z << 16) * wv[4], __uint_as_float(xv.z & 0xffff0000u) * wv[5]);
                    o.w = cvtpk(__uint_as_float(xv.w << 16) * wv[6], __uint_as_float(xv.w & 0xffff0000u) * wv[7]);
                    xw[ks][pt] = __builtin_bit_cast(bf16x8, o);
                }
            }
            const unsigned bm00 = (unsigned)(uintptr_t)(lds + L_BM + tr00), bm01 = (unsigned)(uintptr_t)(lds + L_BM + tr01), bm10 = (unsigned)(uintptr_t)(lds + L_BM + tr10), bm11 = (unsigned)(uintptr_t)(lds + L_BM + tr11);
#pragma unroll
            for (int nt = 0; nt < 8; ++nt) {
                st[nt][0] *= cd; st[nt][1] *= cd;
                s16x4 t0v[2], t1v[2];
#pragma unroll
                for (int ks = 0; ks < 2; ++ks) {
                    asm volatile("ds_read_b64_tr_b16 %0, %1 offset:%c2" : "=&v"(t0v[ks]) : "v"((nt & 1) ? bm10 : bm00), "i"(8192 * ks + 512 * (nt >> 1)) : "memory");
                    asm volatile("ds_read_b64_tr_b16 %0, %1 offset:%c2" : "=&v"(t1v[ks]) : "v"((nt & 1) ? bm11 : bm01), "i"(8192 * ks + 512 * (nt >> 1) + 256) : "memory");
                }
                asm volatile("s_waitcnt lgkmcnt(0)" ::: "memory");
                __builtin_amdgcn_sched_barrier(0);
#pragma unroll
                for (int ks = 0; ks < 2; ++ks) {
                    const bf16x8 bt = (bf16x8){t0v[ks][0], t0v[ks][1], t0v[ks][2], t0v[ks][3], t1v[ks][0], t1v[ks][1], t1v[ks][2], t1v[ks][3]};
                    st[nt][0] = MFMA16(bt, xw[ks][0], st[nt][0]); st[nt][1] = MFMA16(bt, xw[ks][1], st[nt][1]);
                }
            }
        }
        SSD_BAR();
    }
#undef SSD_ISSUE
#undef SSD_ISSUE_Z
    if constexpr (PRE) {
        float* F = u.fseg + (size_t)u.seg * FSTRIDE;
#pragma unroll
        for (int nt = 0; nt < 8; ++nt)
#pragma unroll
            for (int pt = 0; pt < 2; ++pt) {
                unsigned long long* fp = (unsigned long long*)(F + ((size_t)hh * 64 + 32 * ph + 16 * pt + c16) * 128 + 16 * nt + 4 * g4);
                const f32x4 v = st[nt][pt];
                __hip_atomic_store(fp, ((unsigned long long)__float_as_uint(v[1]) << 32) | __float_as_uint(v[0]), SSD_RLX);
                __hip_atomic_store(fp + 1, ((unsigned long long)__float_as_uint(v[3]) << 32) | __float_as_uint(v[2]), SSD_RLX);
            }
        if (ph == 0 && lane == 0) __hip_atomic_store((unsigned*)(F + 4 * 64 * 128 + hh), __float_as_uint(__expf(asum)), SSD_RLX);
        asm volatile("s_waitcnt vmcnt(0)" ::: "memory");
        __syncthreads();
        if (tid == 0) __hip_atomic_fetch_or(u.flag, 1u << u.seg, SSD_RLX);
    } else if (u.last) {
#pragma unroll
        for (int nt = 0; nt < 8; ++nt)
#pragma unroll
            for (int pt = 0; pt < 2; ++pt) *(f32x4*)(u.fin + ((size_t)head * 64 + 32 * ph + 16 * pt + c16) * 128 + 16 * nt + 4 * g4) = st[nt][pt] * TEST_ALPHA;
    }
}
}

namespace sk {
typedef short bf16x8 __attribute__((ext_vector_type(8)));
typedef float f32x4 __attribute__((ext_vector_type(4)));
#define SK_LAS __attribute__((address_space(3)))
__device__ __forceinline__ unsigned cvtpk(float lo, float hi) { unsigned r; asm volatile("v_cvt_pk_bf16_f32 %0, %1, %2" : "=v"(r) : "v"(lo), "v"(hi)); return r; }
__device__ __forceinline__ unsigned short bf(float v) { return (unsigned short)cvtpk(v, 0.f); }

template <int NRT, int NB, bool DEEP = false, bool NTB = false  , class Epi>
__device__ __forceinline__ void skinny(SK_LAS unsigned char* lds, const unsigned short* A, int lda, int K, int njobs, const Epi& E, int wave, int lane, int wg, int nwg) {
    asm volatile("" : "+v"(lane));
    constexpr int RS = 528, BUF = 16 * NRT * RS;
    const int c16 = lane & 15, g4 = lane >> 4, tid = wave * 64 + lane;
    const int nch = K >> 8;
    const unsigned short* asrc = A + (size_t)(tid >> 5) * lda + 8 * (tid & 31);
    SK_LAS unsigned char* adst = lds + (tid >> 5) * RS + 16 * (tid & 31);
    const SK_LAS unsigned char* ard = lds + c16 * RS + 16 * g4;
    for (int base = wg * 8; base < njobs; base += nwg * 8) {
        const int job = base + wave; const bool valid = job < njobs; const int jobc = valid ? job : njobs - 1;
        const unsigned short* brow[NB];
#pragma unroll
        for (int nb = 0; nb < NB; ++nb) brow[nb] = E.brow(jobc, c16, nb) + 8 * g4;
        f32x4 acc[NB][NRT];
#pragma unroll
        for (int nb = 0; nb < NB; ++nb)
#pragma unroll
            for (int rt = 0; rt < NRT; ++rt) acc[nb][rt] = (f32x4){0.f, 0.f, 0.f, 0.f};
        bf16x8 an[NRT];
#pragma unroll
        for (int i = 0; i < NRT; ++i) an[i] = *(const bf16x8*)(asrc + (size_t)(16 * i) * lda);
#pragma unroll
        for (int i = 0; i < NRT; ++i) *(SK_LAS bf16x8*)(adst + 16 * i * RS) = an[i];
        __syncthreads();
        if constexpr (NB == 1 && DEEP) {
            bf16x8 q0[4], q1[4], q2[4], q3[4];
            const int nh = 2 * nch;
#define SK_LOADH(Q, h) { const int hh_ = (h) < nh ? (h) : nh - 1; \
            _Pragma("unroll") for (int ks = 0; ks < 4; ++ks) Q[ks] = NTB ? __builtin_nontemporal_load((const bf16x8*)(brow[0] + 128 * hh_ + 32 * ks)) : *(const bf16x8*)(brow[0] + 128 * hh_ + 32 * ks); __builtin_amdgcn_sched_barrier(0); }
#define SK_COMP(Q, bufo, kh) { \
            _Pragma("unroll") for (int ks = 0; ks < 4; ++ks) \
                _Pragma("unroll") for (int rt = 0; rt < NRT; ++rt) { \
                    const bf16x8 a = *(const SK_LAS bf16x8*)(ard + (bufo) + 16 * rt * RS + 64 * (4 * (kh) + ks)); \
                    acc[0][rt] = __builtin_amdgcn_mfma_f32_16x16x32_bf16(a, Q[ks], acc[0][rt], 0, 0, 0); \
                    if ((rt & 3) == 3) __builtin_amdgcn_sched_barrier(0); } }
#define SK_LOADA(cn) { const int cn_ = (cn) < nch ? (cn) : nch - 1; \
            _Pragma("unroll") for (int i = 0; i < NRT; ++i) an[i] = *(const bf16x8*)(asrc + (size_t)(16 * i) * lda + 256 * cn_); __builtin_amdgcn_sched_barrier(0); }
#define SK_PUTA(bufo) { _Pragma("unroll") for (int i = 0; i < NRT; ++i) *(SK_LAS bf16x8*)(adst + (bufo) + 16 * i * RS) = an[i]; __syncthreads(); }
            SK_LOADH(q0, 0); SK_LOADH(q1, 1); SK_LOADH(q2, 2);
#pragma unroll 1
            for (int c = 0;; c += 2) {
                SK_LOADA(c + 1); SK_LOADH(q3, 2 * c + 3); SK_COMP(q0, 0, 0); SK_LOADH(q0, 2 * c + 4); SK_COMP(q1, 0, 1); SK_PUTA(BUF);
                if (c + 1 >= nch) break;
                SK_LOADA(c + 2); SK_LOADH(q1, 2 * c + 5); SK_COMP(q2, BUF, 0); SK_LOADH(q2, 2 * c + 6); SK_COMP(q3, BUF, 1); SK_PUTA(0);
                if (c + 2 >= nch) break;
            }
#undef SK_LOADH
#undef SK_COMP
#undef SK_LOADA
#undef SK_PUTA
        } else {
        bf16x8 b[8][NB];
#pragma unroll
        for (int ks = 0; ks < 8; ++ks)
#pragma unroll
            for (int nb = 0; nb < NB; ++nb) b[ks][nb] = NTB ? __builtin_nontemporal_load((const bf16x8*)(brow[nb] + 32 * ks)) : *(const bf16x8*)(brow[nb] + 32 * ks);
#pragma unroll 1
        for (int c = 0; c < nch; ++c) {
            const int buf = (c & 1) * BUF;
            constexpr int PF = NB == 1 ? 8 : 4;
            bf16x8 bn[PF][NB];
            const int cn = c + 1 < nch ? c + 1 : c;
#pragma unroll
            for (int ks = 0; ks < PF; ++ks)
#pragma unroll
                for (int nb = 0; nb < NB; ++nb) bn[ks][nb] = NTB ? __builtin_nontemporal_load((const bf16x8*)(brow[nb] + 256 * cn + 32 * ks)) : *(const bf16x8*)(brow[nb] + 256 * cn + 32 * ks);
#pragma unroll
            for (int i = 0; i < NRT; ++i) an[i] = *(const bf16x8*)(asrc + (size_t)(16 * i) * lda + 256 * cn);
#pragma unroll
            for (int ks = 0; ks < 8; ++ks)
#pragma unroll
                for (int rt = 0; rt < NRT; ++rt) {
                    const bf16x8 a = *(const SK_LAS bf16x8*)(ard + buf + 16 * rt * RS + 64 * ks);
#pragma unroll
                    for (int nb = 0; nb < NB; ++nb) acc[nb][rt] = __builtin_amdgcn_mfma_f32_16x16x32_bf16(a, b[ks][nb], acc[nb][rt], 0, 0, 0);
                    if ((rt & 3) == 3) __builtin_amdgcn_sched_barrier(0);
                }
#pragma unroll
            for (int i = 0; i < NRT; ++i) *(SK_LAS bf16x8*)(adst + (BUF - buf) + 16 * i * RS) = an[i];
#pragma unroll
            for (int ks = 0; ks < PF; ++ks)
#pragma unroll
                for (int nb = 0; nb < NB; ++nb) b[ks][nb] = bn[ks][nb];
#pragma unroll
            for (int ks = PF; ks < 8; ++ks)
#pragma unroll
                for (int nb = 0; nb < NB; ++nb) b[ks][nb] = NTB ? __builtin_nontemporal_load((const bf16x8*)(brow[nb] + 256 * cn + 32 * ks)) : *(const bf16x8*)(brow[nb] + 256 * cn + 32 * ks);
            __syncthreads();
        }
        }
        if (valid) {
            int c16e = c16, g4e = g4; asm volatile("" : "+v"(c16e), "+v"(g4e));
#pragma unroll
            for (int rt = 0; rt < NRT; ++rt) { f32x4 v[NB];
#pragma unroll
                for (int nb = 0; nb < NB; ++nb) v[nb] = acc[nb][rt];
                E.store(job, rt, c16e, g4e, v); }
        }
    }
}

struct EpiInS {
    const unsigned short* WinT; unsigned short *Q, *Z, *XBC, *Kext, *Vext; float* DT; float* out;
    __device__ __forceinline__ const unsigned short* brow(int job, int n, int) const { return WinT + (size_t)(16 * job + n) * DM; }
    __device__ __forceinline__ void store(int job, int rt, int n, int g4, const f32x4 (&v)[1]) const {
        const int c0 = 16 * job, col = c0 + n, rs0 = 16 * rt + 4 * g4;
        if (c0 < 2048) {
#pragma unroll
            for (int r = 0; r < 4; ++r) Q[((size_t)MP + rs0 + r) * AW + col] = bf(v[0][r] * QSCALE);
        } else if (c0 < 6144) {
            const bool isk = c0 < 4096; const int c = col - (isk ? 2048 : 4096); float* o = out + (isk ? O_KS : O_VS); unsigned short* e = isk ? Kext : Vext;
#pragma unroll
            for (int r = 0; r < 4; ++r) { const int rs = rs0 + r; o[(size_t)rs * AW + c] = v[0][r] * TEST_ALPHA; e[((size_t)(rs >> 4) * KVROWS + PAST + (rs & 15)) * AW + c] = bf(v[0][r]); }
        } else if (c0 < 8192) {
#pragma unroll
            for (int r = 0; r < 4; ++r) Z[((size_t)MP + rs0 + r) * SSDI + col - 6144] = bf(v[0][r]);
        } else if (c0 < 12288) {
            const int c = col - 8192;
#pragma unroll
            for (int r = 0; r < 4; ++r) { const int rs = rs0 + r; XBC[((size_t)MP + rs) * CONVD + c] = bf(v[0][r]); const int t = (rs & 15) - 13; if (t >= 0) out[O_CS + (size_t)((rs >> 4) * 3 + t) * CONVD + c] = v[0][r] * TEST_ALPHA; }
        } else {
#pragma unroll
            for (int r = 0; r < 4; ++r) DT[((size_t)MP + rs0 + r) * SH + col - 12288] = v[0][r];
        }
    }
};
struct EpiDtP {
    const unsigned short* XN; float* DT;
    __device__ __forceinline__ const unsigned short* brow(int job, int n, int) const { return XN + (size_t)(16 * job + n) * DM; }
    __device__ __forceinline__ void store(int job, int rt, int n, int g4, const f32x4 (&v)[1]) const {
        *(f32x4*)(DT + (size_t)(16 * job + n) * SH + 16 * rt + 4 * g4) = v[0];
    }
};
struct EpiOutS {
    const unsigned short* WoT; const float* xs; float* out; unsigned short* X1B; float* ss;
    __device__ __forceinline__ const unsigned short* brow(int job, int n, int) const { return WoT + (size_t)(16 * job + n) * DM; }
    __device__ __forceinline__ void store(int job, int rt, int n, int g4, const f32x4 (&v)[1]) const {
        const int col = 16 * job + n;
#pragma unroll
        for (int r = 0; r < 4; ++r) {
            const int rs = 16 * rt + 4 * g4 + r; const float x1 = xs[(size_t)rs * DM + col] + v[0][r];
            X1B[((size_t)MP + rs) * DM + col] = bf(x1);
            float sq = x1 * x1; sq += __shfl_xor(sq, 1); sq += __shfl_xor(sq, 2); sq += __shfl_xor(sq, 4); sq += __shfl_xor(sq, 8);
            if (n == 0) atomicAdd(ss + MP + rs, sq);
        }
    }
};
struct EpiGuS {
    const unsigned short* WguT; unsigned short* H; const float* ss;
    __device__ __forceinline__ const unsigned short* brow(int job, int n, int nb) const { const int f = 16 * job + n; return WguT + (size_t)(256 * (f >> 7) + (f & 127) + 128 * nb) * DM; }
    __device__ __forceinline__ void store(int job, int rt, int n, int g4, const f32x4 (&v)[2]) const {
        const int f = 16 * job + n;
#pragma unroll
        for (int r = 0; r < 4; ++r) {
            const int rs = 16 * rt + 4 * g4 + r; const float rn = 1.0f / sqrtf(ss[MP + rs] * (1.0f / DM) + EPS);
            const float g = v[0][r] * rn, up = v[1][r] * rn;
            H[(size_t)rs * DFF + f] = bf(g * up * __builtin_amdgcn_rcpf(1.0f + __builtin_amdgcn_exp2f(-1.4426950408889634f * g)));
        }
    }
};
struct EpiDownS {
    const unsigned short* WdT; const unsigned short* X1B; unsigned short* X2B; float* ss;
    __device__ __forceinline__ const unsigned short* brow(int job, int n, int) const { return WdT + (size_t)(16 * job + n) * DFF; }
    __device__ __forceinline__ void store(int job, int rt, int n, int g4, const f32x4 (&v)[1]) const {
        const int col = 16 * job + n;
#pragma unroll
        for (int r = 0; r < 4; ++r) {
            const int rs = 16 * rt + 4 * g4 + r; const size_t idx = ((size_t)MP + rs) * DM + col; const float x2 = __uint_as_float((unsigned)X1B[idx] << 16) + v[0][r]; X2B[idx] = bf(x2);
            float sq = x2 * x2; sq += __shfl_xor(sq, 1); sq += __shfl_xor(sq, 2); sq += __shfl_xor(sq, 4); sq += __shfl_xor(sq, 8);
            if (n == 0) atomicAdd(ss + MP + rs, sq);
        }
    }
};
struct EpiOutPart {
    const unsigned short* WoT; float* part; int koff;
    __device__ __forceinline__ const unsigned short* brow(int job, int n, int) const { return WoT + (size_t)(16 * job + n) * DM + koff; }
    __device__ __forceinline__ void store(int job, int rt, int n, int g4, const f32x4 (&v)[1]) const {
#pragma unroll
        for (int r = 0; r < 4; ++r) part[(size_t)(16 * rt + 4 * g4 + r) * DM + 16 * job + n] = v[0][r];
    }
};
struct EpiDownPart {
    const unsigned short* WdT; float* part; int koff;
    __device__ __forceinline__ const unsigned short* brow(int job, int n, int) const { return WdT + (size_t)(16 * job + n) * DFF + koff; }
    __device__ __forceinline__ void store(int job, int rt, int n, int g4, const f32x4 (&v)[1]) const {
#pragma unroll
        for (int r = 0; r < 4; ++r) part[(size_t)(16 * rt + 4 * g4 + r) * DM + 16 * job + n] = v[0][r];
    }
};
}

struct Args { const float* in[25]; float* out; unsigned char* ws; int ph_lo, ph_hi; };
enum { I_XP = 0, I_XS, I_CK, I_CV, I_SCONV, I_SSSM, I_N1W, I_WIN, I_LQ1, I_LK1, I_LQ2, I_LK2, I_SUBLN, I_CONVW, I_CONVB, I_DTB, I_ALOG, I_DSKIP, I_SSDNW, I_WOUT, I_N2W, I_WG, I_WU, I_WD, I_FNW };

#ifndef P4_INT8
#define P4_INT8 1
#endif
constexpr bool WGU_BF16 = !P4_INT8;
constexpr int WQ_SAMPLE_ROWS = 48;
__device__ __forceinline__ float wq_scale(const unsigned char* ws, int t) { const float s = ((const float*)(ws + WS_CTL))[CW_WSTAT + t]; return pg8::W8I_CLIP / sqrtf(s * (1.0f / ((float)WQ_SAMPLE_ROWS * DFF)) + 1e-30f); }
__device__ __forceinline__ void p0_prologue(const Frame& F, const Args& a) {
    unsigned char* ws = a.ws;
    LAS float* scr = (LAS float*)(F.lds + RING_OFF + F.wave * 17408);
    const int gw = F.vcu * NWAVES + F.wave, NGW = F.G * NWAVES, lane = F.lane;
    bf16* WinT = (bf16*)(ws + WS_WIN); bf16* WoT = (bf16*)(ws + WS_WO); bf16* WguT = (bf16*)(ws + WS_WGU); bf16* WdT = (bf16*)(ws + WS_WD);
    constexpr int I_IN = (DM / 64) * (NIN / 32), I_O = (DM / 64) * (DM / 32), I_G = (DM / 64) * (DFF / 32), I_D = (DFF / 64) * (DM / 32);
    for (int it = 2 * gw; it < I_IN; it += 2 * NGW) p0_transpose_pair<0>(a.in[I_WIN], DM, NIN, WinT, nullptr, scr, it, I_IN, lane);
    { GAS v4u* z = (GAS v4u*)(WinT + (size_t)NIN * DM); const int n16 = (NINP - NIN) * DM * 2 / 16;
      for (int i = gw * 64 + lane; i < n16; i += NGW * 64) z[i] = (v4u){0u, 0u, 0u, 0u}; }
    bf16* XN = (bf16*)(ws + WS_XN);
    for (int m = gw; m < MPAD; m += 2 * NGW) {
        const int m1 = m + NGW;
        if (m1 < MR) rms_row2_to_bf16(lane, m < MP ? a.in[I_XP] + (size_t)m * DM : a.in[I_XS] + (size_t)(m - MP) * DM, m1 < MP ? a.in[I_XP] + (size_t)m1 * DM : a.in[I_XS] + (size_t)(m1 - MP) * DM,
                                      a.in[I_N1W], XN + (size_t)m * DM, XN + (size_t)m1 * DM);
        else {
            for (int mm = m; mm < MPAD; mm += NGW) {
                if (mm > m1) break;
                if (mm < MR) rms_row_to_bf16(lane, mm < MP ? a.in[I_XP] + (size_t)mm * DM : a.in[I_XS] + (size_t)(mm - MP) * DM, a.in[I_N1W], XN + (size_t)mm * DM);
                else { GAS v4u* z = (GAS v4u*)(XN + (size_t)mm * DM);
#pragma unroll
                    for (int j = 0; j < 8; ++j) z[lane + 64 * j] = (v4u){0u, 0u, 0u, 0u}; }
            }
        }
    }
    { float* wst = (float*)(ws + WS_CTL) + CW_WSTAT; constexpr int NV = WQ_SAMPLE_ROWS * (DFF / 4);
      float sg = 0.f, su = 0.f;
      for (int i = gw * 64 + lane; i < NV; i += NGW * 64) { const int k = i / (DFF / 4); const f32x4 x = *(const GAS f32x4*)(a.in[I_WG] + 4 * (size_t)i), y = *(const GAS f32x4*)(a.in[I_WU] + 4 * (size_t)i);
          const float n2 = a.in[I_N2W][k];
          sg += n2 * n2 * ((x.x * x.x + x.y * x.y) + (x.z * x.z + x.w * x.w)); su += n2 * n2 * ((y.x * y.x + y.y * y.y) + (y.z * y.z + y.w * y.w)); }
      sg = wave_sum(sg); su = wave_sum(su); if (lane == 0) { atomicAdd(wst + 0, sg); atomicAdd(wst + 1, su); } }
    {
        bf16* Kext = (bf16*)(ws + WS_KEXT); bf16* Vext = (bf16*)(ws + WS_VEXT);
        const int zvec = DEC_B * (KVROWS - PAST - DEC_T) * AW / 8;
        for (int i = gw * 64 + lane; i < 2 * zvec; i += NGW * 64) {
            const bool isv = i >= zvec; const int j = isv ? i - zvec : i; const int e = j * 8, per = (KVROWS - PAST - DEC_T) * AW, b = e / per, rem = e % per;
            *(GAS v4u*)((isv ? Vext : Kext) + ((size_t)b * KVROWS + PAST + DEC_T) * AW + rem) = (v4u){0u, 0u, 0u, 0u};
        }
    }
}

__device__ __forceinline__ void p2_cache_slice(const Frame& F, const Args& a, int b, int h) {
    int tid = F.tid; asm volatile("" : "+v"(tid));
    const int r0 = tid >> 5, c4 = (tid & 31) * 4;
    const float* ks = a.in[I_CK] + ((size_t)b * PAST + r0) * AW + h * HD + c4; const float* vs = a.in[I_CV] + ((size_t)b * PAST + r0) * AW + h * HD + c4;
    bf16* kd = (bf16*)(a.ws + WS_KEXT) + ((size_t)b * KVROWS + r0) * AW + h * HD + c4; bf16* vd = (bf16*)(a.ws + WS_VEXT) + ((size_t)b * KVROWS + r0) * AW + h * HD + c4;
    for (int i0 = 0; i0 < PAST / 16; i0 += 8) {
        f32x4 kx[8], vx[8];
#pragma unroll
        for (int q = 0; q < 8; ++q) { kx[q] = __builtin_nontemporal_load((const GAS f32x4*)(ks + (size_t)(i0 + q) * 16 * AW)); vx[q] = __builtin_nontemporal_load((const GAS f32x4*)(vs + (size_t)(i0 + q) * 16 * AW)); }
#pragma unroll
        for (int q = 0; q < 8; ++q) { typedef unsigned u32x2g __attribute__((ext_vector_type(2)));
            *(GAS u32x2g*)(kd + (size_t)(i0 + q) * 16 * AW) = (u32x2g){pk2(kx[q].x, kx[q].y), pk2(kx[q].z, kx[q].w)};
            *(GAS u32x2g*)(vd + (size_t)(i0 + q) * 16 * AW) = (u32x2g){pk2(vx[q].x, vx[q].y), pk2(vx[q].z, vx[q].w)}; }
    }
    asm volatile("s_waitcnt vmcnt(0)" ::: "memory");
    __syncthreads();
}

constexpr int CONV_PAIRS_O = (DM / 64) * (DM / 32) / 2, CONV_PAIRS_G = (DM / 64) * (DFF / 32) / 2, CONV_PAIRS_D = (DFF / 64) * (DM / 32) / 2;
constexpr int CONV_ITEMS = (CONV_PAIRS_O + 2 * CONV_PAIRS_G + CONV_PAIRS_D) / 64;
constexpr int CONV_ITEMS_A = (CONV_PAIRS_O + 2 * CONV_PAIRS_G) / 64;
static_assert(CONV_PAIRS_O % 64 == 0 && CONV_PAIRS_G % 64 == 0 && CONV_PAIRS_D % 64 == 0, "a queue item stays inside one matrix");
__device__ __forceinline__ void p0_deferred_item(const Frame& F, const Args& a, int k) {
    unsigned char* ws = a.ws;
    LAS float* scr = (LAS float*)(F.lds + RING_OFF + F.wave * 17408);
    bf16* WoT = (bf16*)(ws + WS_WO); bf16* WguT = (bf16*)(ws + WS_WGU); bf16* WdT = (bf16*)(ws + WS_WD);
    int lane = F.lane; asm volatile("" : "+v"(lane));
    int p = k * 64 + F.wave * 8;
    if (p < CONV_PAIRS_O) { for (int i = 0; i < 8; ++i) p0_transpose_pair<0>(a.in[I_WOUT], DM, DM, WoT, nullptr, scr, 2 * (p + i), 2 * CONV_PAIRS_O, lane); return; }
    p -= CONV_PAIRS_O;
    if (p < CONV_PAIRS_G) { const float sq = wq_scale(ws, 0); for (int i = 0; i < 8; ++i) p0_transpose_pair<1>(a.in[I_WG], DM, DFF, WGU_BF16 ? WguT : (bf16*)nullptr, a.in[I_N2W], scr, 2 * (p + i), 2 * CONV_PAIRS_G, lane, ws + WS_WGUQ, sq, true); return; }
    p -= CONV_PAIRS_G;
    if (p < CONV_PAIRS_G) { const float sq = wq_scale(ws, 1); for (int i = 0; i < 8; ++i) p0_transpose_pair<2>(a.in[I_WU], DM, DFF, WGU_BF16 ? WguT : (bf16*)nullptr, a.in[I_N2W], scr, 2 * (p + i), 2 * CONV_PAIRS_G, lane, ws + WS_WGUQ, sq, true); return; }
    p -= CONV_PAIRS_G;
    for (int i = 0; i < 8; ++i) p0_transpose_pair<0>(a.in[I_WD], DFF, DM, WdT, nullptr, scr, 2 * (p + i), 2 * CONV_PAIRS_D, lane, ws + WS_WD8, pg8::WD8_SCALE);
}

__device__ __forceinline__ void p3b_quant_rows(const Frame& F, const Args& a) {
    const int gw = F.vcu * NWAVES + F.wave, NGW = F.G * NWAVES; int lane = F.lane; asm volatile("" : "+v"(lane));
    const float* ss = (const float*)(a.ws + WS_CTL) + CW_SS2; float* RQ = (float*)(a.ws + WS_CTL) + CW_RQ;
    const bf16* X1B = (const bf16*)(a.ws + WS_KEXT); unsigned char* X1Q = a.ws + WS_X1Q;
    typedef unsigned u32x2g __attribute__((ext_vector_type(2)));
    for (int m0 = gw; m0 < MR; m0 += 2 * NGW) {
      v4u vv[2][8];
#pragma unroll
      for (int t = 0; t < 2; ++t) { const int mt = m0 + t * NGW < MR ? m0 + t * NGW : m0; const GAS v4u* xr = (const GAS v4u*)(X1B + (size_t)mt * DM) + lane;
#pragma unroll
          for (int j = 0; j < 8; ++j) vv[t][j] = xr[64 * j]; }
#pragma unroll
      for (int t = 0; t < 2; ++t) {
        const int m = m0 + t * NGW; if (m >= MR) break;
        v4u v[8]; float mx = 0.f;
#pragma unroll
        for (int j = 0; j < 8; ++j) v[j] = vv[t][j];
#pragma unroll
        for (int j = 0; j < 8; ++j) {
            mx = fmaxf(mx, fmaxf(fmaxf(fabsf(pg8::bflo(v[j].x)), fabsf(pg8::bfhi(v[j].x))), fmaxf(fabsf(pg8::bflo(v[j].y)), fabsf(pg8::bfhi(v[j].y)))));
            mx = fmaxf(mx, fmaxf(fmaxf(fabsf(pg8::bflo(v[j].z)), fabsf(pg8::bfhi(v[j].z))), fmaxf(fabsf(pg8::bflo(v[j].w)), fabsf(pg8::bfhi(v[j].w))))); }
#pragma unroll
        for (int o = 1; o < 64; o <<= 1) mx = fmaxf(mx, __shfl_xor(mx, o));
        mx = fmaxf(mx, 1e-30f);
        const float sc = 127.0f / mx;
        GAS u32x2g* o8 = (GAS u32x2g*)(X1Q + (size_t)m * DM) + lane;
#pragma unroll
        for (int j = 0; j < 8; ++j) { u32x2g o;
            o.x = pg8::pk4_i8(pg8::bflo(v[j].x) * sc, pg8::bfhi(v[j].x) * sc, pg8::bflo(v[j].y) * sc, pg8::bfhi(v[j].y) * sc);
            o.y = pg8::pk4_i8(pg8::bflo(v[j].z) * sc, pg8::bfhi(v[j].z) * sc, pg8::bflo(v[j].w) * sc, pg8::bfhi(v[j].w) * sc);
            o8[64 * j] = o; }
        if (lane == 0) RQ[m] = mx * (1.0f / 127.0f) / sqrtf(ss[m] * (1.0f / DM) + EPS);
      }
    }
}

__device__ __forceinline__ void p3_sample_final(const Frame& F, const Args& a, int row, const unsigned* cnt, unsigned want) {
    int lane = F.lane; asm volatile("" : "+v"(lane));
    { unsigned sp = 0; while (__hip_atomic_load(cnt, RLX_AGENT) < want) { __builtin_amdgcn_s_sleep(4); if (++sp > (1u << 22)) break; } }
    __builtin_amdgcn_fence(__ATOMIC_ACQUIRE, "agent");
    const float* xs = a.in[I_XS] + (size_t)row * DM; const float* part = (const float*)(a.ws + WS_PARK) + (size_t)row * DM;
    bf16* X1B = (bf16*)(a.ws + WS_KEXT) + ((size_t)MP + row) * DM;
    float s = 0.f;
#pragma unroll 4
    for (int j = 0; j < 16; ++j) { const int c = 4 * (lane + 64 * j);
        f32x4 t = *(const GAS f32x4*)(xs + c);
#pragma unroll
        for (int q = 0; q < 8; ++q) t += *(const GAS f32x4*)(part + (size_t)q * MS * DM + c);
        s += (t.x * t.x + t.y * t.y) + (t.z * t.z + t.w * t.w);
        typedef unsigned u32x2g __attribute__((ext_vector_type(2)));
        *(GAS u32x2g*)(X1B + c) = (u32x2g){pk2(t.x, t.y), pk2(t.z, t.w)}; }
    s = wave_sum(s);
    if (lane == 0) ((float*)(a.ws + WS_CTL))[CW_SS2 + MP + row] = s;
}

constexpr int SMP_SLICES = 8;
__device__ __forceinline__ void p5_sample_final(const Frame& F, const Args& a, int row, const unsigned* cnt, unsigned want) {
    int lane = F.lane; asm volatile("" : "+v"(lane));
    { unsigned sp = 0; while (__hip_atomic_load(cnt, RLX_AGENT) < want) { __builtin_amdgcn_s_sleep(4); if (++sp > (1u << 22)) break; } }
    __builtin_amdgcn_fence(__ATOMIC_ACQUIRE, "agent");
    const bf16* X1B = (const bf16*)(a.ws + WS_KEXT) + ((size_t)MP + row) * DM; const float* part = (const float*)(a.ws + WS_PARK) + (size_t)row * DM;
    f32x4 v[16]; float s = 0.f;
#pragma unroll
    for (int j = 0; j < 16; ++j) { const int c = 4 * (lane + 64 * j);
        typedef unsigned u32x2g __attribute__((ext_vector_type(2)));
        const u32x2g xw = *(const GAS u32x2g*)(X1B + c);
        f32x4 t = (f32x4){__uint_as_float(xw.x << 16), __uint_as_float(xw.x & 0xffff0000u), __uint_as_float(xw.y << 16), __uint_as_float(xw.y & 0xffff0000u)};
#pragma unroll
        for (int q = 0; q < SMP_SLICES; ++q) t += *(const GAS f32x4*)(part + (size_t)q * MS * DM + c);
        v[j] = t; s += (t.x * t.x + t.y * t.y) + (t.z * t.z + t.w * t.w); }
    const float r = 1.0f / sqrtf(wave_sum(s) * (1.0f / DM) + EPS);
    float* y = a.out + O_YS + (size_t)row * DM;
#pragma unroll
    for (int j = 0; j < 16; ++j) { const int c = 4 * (lane + 64 * j); const f32x4 g = *(const GAS f32x4*)(a.in[I_FNW] + c);
        *(GAS f32x4*)(y + c) = (f32x4){v[j].x * r * g.x, v[j].y * r * g.y, v[j].z * r * g.z, v[j].w * r * g.w}; }
}

__device__ __forceinline__ void p6_final_norm(const Frame& F, const Args& a) {
    const int gw = F.vcu * NWAVES + F.wave, NGW = F.G * NWAVES, lane = F.lane;
    const float* ss = (const float*)(a.ws + WS_CTL) + CW_SS3;
    const bf16* X2B = (const bf16*)(a.ws + WS_XN);
    for (int m = gw; m < MR; m += NGW) {
        const float r = 1.0f / sqrtf(__hip_atomic_load(ss + m, __ATOMIC_RELAXED, __HIP_MEMORY_SCOPE_AGENT) * (1.0f / DM) + EPS);
        const GAS v4u* xr = (const GAS v4u*)(X2B + (size_t)m * DM) + lane;
        GAS f32x4* y = (GAS f32x4*)(a.out + (m < MP ? O_YP + (size_t)m * DM : O_YS + (size_t)(m - MP) * DM)) + 2 * lane;
        const GAS f32x4* wv = (const GAS f32x4*)a.in[I_FNW] + 2 * lane;
#pragma unroll
        for (int j = 0; j < 8; ++j) { const v4u x = xr[64 * j]; const f32x4 g0 = wv[128 * j], g1 = wv[128 * j + 1];
            f32x4 o0, o1;
            o0.x = __uint_as_float(x.x << 16) * r * g0.x; o0.y = __uint_as_float(x.x & 0xffff0000u) * r * g0.y; o0.z = __uint_as_float(x.y << 16) * r * g0.z; o0.w = __uint_as_float(x.y & 0xffff0000u) * r * g0.w;
            o1.x = __uint_as_float(x.z << 16) * r * g1.x; o1.y = __uint_as_float(x.z & 0xffff0000u) * r * g1.y; o1.z = __uint_as_float(x.w << 16) * r * g1.z; o1.w = __uint_as_float(x.w & 0xffff0000u) * r * g1.w;
            y[128 * j] = o0; y[128 * j + 1] = o1; }
    }
}

__device__ __forceinline__ void p5_norm_own(const Frame& F, const Args& a, int pm, int col0, int ncols, int row0g, int nrows, unsigned* cnt, unsigned want) {
    int tid = F.tid; asm volatile("" : "+v"(tid));
    if (F.tid == 0) { unsigned sp = 0; while (__hip_atomic_load(cnt, RLX_AGENT) < want) { __builtin_amdgcn_s_sleep(4); if (++sp > (1u << 22)) break; } }
    asm volatile("s_waitcnt vmcnt(0)" ::: "memory");
    __syncthreads();
    LAS float* rs = (LAS float*)(F.lds + RING_OFF);
    const float* ss = (const float*)(a.ws + WS_CTL) + CW_SS3;
    if (tid < nrows) rs[tid] = 1.0f / sqrtf(__uint_as_float(__hip_atomic_load((const unsigned*)(ss + row0g + tid), RLX_AGENT)) * (1.0f / DM) + EPS);
    __syncthreads();
    const bf16* X2B = (const bf16*)(a.ws + WS_XN);
    const int pcs = ncols >> 3;
    if (ncols == 1024 && (nrows & 31) == 0) {
        const int cp = tid & 127, rb = tid >> 7, c = col0 + 8 * cp;
        const f32x4 g0 = *(const GAS f32x4*)(a.in[I_FNW] + c), g1 = *(const GAS f32x4*)(a.in[I_FNW] + c + 4);
        for (int j0 = 0; j0 < nrows / 4; j0 += 8) {
            v4u x[8];
#pragma unroll
            for (int q = 0; q < 8; ++q) x[q] = *(const GAS v4u*)(X2B + (size_t)(row0g + rb + 4 * (j0 + q)) * DM + c);
#pragma unroll
            for (int q = 0; q < 8; ++q) { const int r = rb + 4 * (j0 + q), row = row0g + r; const float rr = rs[r];
                f32x4 o0, o1;
                o0.x = __uint_as_float(x[q].x << 16) * rr * g0.x; o0.y = __uint_as_float(x[q].x & 0xffff0000u) * rr * g0.y; o0.z = __uint_as_float(x[q].y << 16) * rr * g0.z; o0.w = __uint_as_float(x[q].y & 0xffff0000u) * rr * g0.w;
                o1.x = __uint_as_float(x[q].z << 16) * rr * g1.x; o1.y = __uint_as_float(x[q].z & 0xffff0000u) * rr * g1.y; o1.z = __uint_as_float(x[q].w << 16) * rr * g1.z; o1.w = __uint_as_float(x[q].w & 0xffff0000u) * rr * g1.w;
                float* y = a.out + (row < MP ? O_YP + (size_t)row * DM : O_YS + (size_t)(row - MP) * DM) + c;
                *(GAS f32x4*)y = o0; *(GAS f32x4*)(y + 4) = o1; }
        }
    } else
    for (int i = tid; i < nrows * pcs; i += NWAVES * 64) {
        const int r = i / pcs, c = col0 + 8 * (i - r * pcs); const int row = row0g + r;
        const v4u x = *(const GAS v4u*)(X2B + (size_t)row * DM + c);
        const f32x4 g0 = *(const GAS f32x4*)(a.in[I_FNW] + c), g1 = *(const GAS f32x4*)(a.in[I_FNW] + c + 4); const float rr = rs[r];
        f32x4 o0, o1;
        o0.x = __uint_as_float(x.x << 16) * rr * g0.x; o0.y = __uint_as_float(x.x & 0xffff0000u) * rr * g0.y; o0.z = __uint_as_float(x.y << 16) * rr * g0.z; o0.w = __uint_as_float(x.y & 0xffff0000u) * rr * g0.w;
        o1.x = __uint_as_float(x.z << 16) * rr * g1.x; o1.y = __uint_as_float(x.z & 0xffff0000u) * rr * g1.y; o1.z = __uint_as_float(x.w << 16) * rr * g1.z; o1.w = __uint_as_float(x.w & 0xffff0000u) * rr * g1.w;
        float* y = a.out + (row < MP ? O_YP + (size_t)row * DM : O_YS + (size_t)(row - MP) * DM) + c;
        *(GAS f32x4*)y = o0; *(GAS f32x4*)(y + 4) = o1;
    }
    __syncthreads();
}

#ifndef P4_INT8
#define P4_INT8 1
#endif
#ifndef GEMM_ALIGN
#define GEMM_ALIGN true
#endif
#ifndef GEMM_SP2
#define GEMM_SP2 true
#endif
#ifndef GEMM_DIM16
#define GEMM_DIM16 false
#endif
#ifndef P4_WGM
#define P4_WGM 8
#endif
#ifndef P5_NT
#define P5_NT 0
#endif
#ifndef GEMM_DIM
#define GEMM_DIM false
#endif
#ifndef TEST_STAGE
#define TEST_STAGE 99
#endif
__global__ void __launch_bounds__(NWAVES * 64, 2) fwd(Args args) {
    extern __shared__ __attribute__((aligned(16))) unsigned char lds[];
    Frame F;
    F.lds = (LAS unsigned char*)lds;
    F.MISC = (volatile LAS unsigned*)(F.lds + MISC_OFF);
    F.tid = threadIdx.x; F.lane = F.tid & 63; F.wave = __builtin_amdgcn_readfirstlane(F.tid >> 6);
    F.G = gridDim.x; { const int bx = blockIdx.x; F.vcu = (F.G % 8 == 0) ? (bx % 8) * (F.G / 8) + bx / 8 : bx; }
    unsigned char* ws = args.ws;
    F.ctl = (gu32*)(ws + WS_CTL);
    for (int u = F.tid; u < (LDS_BYTES - LDSCTL_OFF) / 4; u += NWAVES * 64) ((LAS unsigned*)(F.lds + LDSCTL_OFF))[u] = 0u;
    __syncthreads();
    XcdBarrier bar = xcd_barrier_post((unsigned*)(F.ctl + CW_BAR), F.MISC + 8);
#define GRID_BAR() xcd_barrier(bar)
    bf16* WinT = (bf16*)(ws + WS_WIN); bf16* WoT = (bf16*)(ws + WS_WO); bf16* WguT = (bf16*)(ws + WS_WGU); bf16* WdT = (bf16*)(ws + WS_WD);
    bf16* XN = (bf16*)(ws + WS_XN); bf16* Qb = (bf16*)(ws + WS_Q); bf16* Kb = (bf16*)(ws + WS_KB); bf16* Vb = (bf16*)(ws + WS_VB); bf16* Zb = (bf16*)(ws + WS_Z);
    bf16* XBC = (bf16*)(ws + WS_XBC); float* DT = (float*)(ws + WS_DT); bf16* Kext = (bf16*)(ws + WS_KEXT); bf16* Vext = (bf16*)(ws + WS_VEXT);
    bf16* MIX = (bf16*)(ws + WS_MIX); bf16* X1B = (bf16*)(ws + WS_X1B); bf16* HB = (bf16*)(ws + WS_H); bf16* X2B = (bf16*)(ws + WS_XN);
    float* SS2 = (float*)(ws + WS_CTL) + CW_SS2; float* SS3 = (float*)(ws + WS_CTL) + CW_SS3;

#if defined(PROBE_SPIN_A) && !defined(PROBE_TIMING)
#define PROBE_TIMING 1
#endif
#ifdef PROBE_TIMING
#define STAMP(k) do { if (blockIdx.x == 0 && F.tid == 0) { const unsigned long long t_ = __builtin_amdgcn_s_memrealtime(); F.MISC[16 + 2 * (k)] = (unsigned)t_; F.MISC[17 + 2 * (k)] = (unsigned)(t_ >> 32); } } while (0)
#else
#define STAMP(k) do { } while (0)
#endif
    unsigned long long sp_t0 = 0; (void)sp_t0;
#ifdef PROBE_SPREAD
#define SPREAD_T0(k) do { if ((k) == PROBE_SPREAD) sp_t0 = __builtin_amdgcn_s_memrealtime(); } while (0)
#define SPREAD_T1(k) do { if ((k) == PROBE_SPREAD && F.tid == 0) { const unsigned d_ = (unsigned)(__builtin_amdgcn_s_memrealtime() - sp_t0); __hip_atomic_fetch_add(F.ctl + CW_TMO + 4, d_, RLX_AGENT); __hip_atomic_fetch_add(F.ctl + CW_TMO + 32 + (blockIdx.x & 7), d_, RLX_AGENT); } } while (0)
#define SPREAD_T2(k) do { if ((k) == PROBE_SPREAD && blockIdx.x == 0 && F.tid == 0) { F.MISC[16 + 2 * 21] = __hip_atomic_load(F.ctl + CW_TMO + 4, RLX_AGENT) / (unsigned)F.G; F.MISC[17 + 2 * 21] = 0u; \
        F.MISC[16 + 2 * 22] = (unsigned)(__builtin_amdgcn_s_memrealtime() - sp_t0); F.MISC[17 + 2 * 22] = 0u; \
        unsigned mx_ = 0u, mn_ = 0xffffffffu; for (int x_ = 0; x_ < 8; ++x_) { const unsigned v_ = __hip_atomic_load(F.ctl + CW_TMO + 32 + x_, RLX_AGENT) / (unsigned)(F.G / 8); mx_ = v_ > mx_ ? v_ : mx_; mn_ = v_ < mn_ ? v_ : mn_; } \
        F.MISC[16 + 2 * 23] = mn_; F.MISC[17 + 2 * 23] = 0u; F.MISC[16 + 2 * 24] = mx_; F.MISC[17 + 2 * 24] = 0u; } } while (0)
#else
#define SPREAD_T0(k) do { } while (0)
#define SPREAD_T1(k) do { } while (0)
#define SPREAD_T2(k) do { } while (0)
#endif
    STAMP(0);
    p0_prologue(F, args);
#ifdef PROBE_P0_REPS
    for (int rep = 1; rep < PROBE_P0_REPS; ++rep) { GRID_BAR(); p0_prologue(F, args); }
#endif
#if TEST_STAGE < 99
    {
        const size_t gt = (size_t)F.vcu * NWAVES * 64 + F.tid, NT = (size_t)F.G * NWAVES * 64;
        GAS f32x4* o = (GAS f32x4*)args.out;
        for (size_t i = gt; i < O_END / 4; i += NT) {
            const size_t e = i * 4;
            bool keep = false;
#if TEST_STAGE >= 1
            keep = (e >= O_KP && e < O_SP) || (e >= O_KS && e < O_SS);
#endif
#if TEST_STAGE >= 2
            keep = keep || (e >= O_SP && e < O_KS) || (e >= O_SS);
#endif
            if (!keep) o[i] = (f32x4){0.f, 0.f, 0.f, 0.f};
        }
    }
#endif
    GRID_BAR();
    STAMP(1); SPREAD_T0(1);

#ifndef PROBE_P1_REPS
#define PROBE_P1_REPS 1
#endif
#ifndef PROBE_P4_REPS
#define PROBE_P4_REPS 1
#endif
    for (int rep = 0; rep < PROBE_P1_REPS; ++rep) {
        if (rep > 0) GRID_BAR();
        pg8::Gemm g{XN, WinT, MP, 12288, DM}; pg8::StaticOrder S; S.init(MP, 12288, F.G, (int)blockIdx.x);
        pg8::EpiInProj E{Qb, Kb, Vb, Zb, XBC, Kext, Vext, DT, args.out};
#ifdef PROBE_P1_LIGHT
        if (rep > 0) { pg8::EpiProbe EP{(bf16*)(ws + WS_DUMMY), 12288}; pg8::gemm_phase<pg8::EpiProbe, pg8::StaticOrder, GEMM_ALIGN, GEMM_SP2, 0, GEMM_DIM16>(F.lds + RING_OFF, g, S, EP); } else
#endif
        pg8::gemm_phase<pg8::EpiInProj, pg8::StaticOrder, GEMM_ALIGN, GEMM_SP2, 0, GEMM_DIM16>(F.lds + RING_OFF, g, S, E);
    }
    STAMP(11); SPREAD_T1(1);
#ifndef PROBE_SK1_REPS
#define PROBE_SK1_REPS 1
#endif
#ifndef PROBE_SK4_REPS
#define PROBE_SK4_REPS 1
#endif
    if (F.G == 256) {
        if (F.tid == 0) F.MISC[2] = __hip_atomic_fetch_add(F.ctl + CW_P1T, 1u, RLX_AGENT);
        __syncthreads();
        const unsigned tk = F.MISC[2];
        __syncthreads();
        constexpr unsigned NSKS1 = (NIN / 16 + 7) / 8, NSKD1 = MP / 16 / 8;
        if (tk < NSKS1) { const sk::EpiInS E1{WinT, Qb, Zb, XBC, Kext, Vext, DT, args.out};
            sk::skinny<8, 1, true>(F.lds + RING_OFF, XN + (size_t)MP * DM, DM, DM, NIN / 16, E1, F.wave, F.lane, (int)tk, (int)NSKS1); }
        else if (tk < NSKS1 + NSKD1) { const sk::EpiDtP E2{XN, DT};
            sk::skinny<2, 1, true>(F.lds + RING_OFF, WinT + (size_t)12288 * DM, DM, DM, MP / 16, E2, F.wave, F.lane, (int)(tk - NSKS1), (int)NSKD1); }
    } else
    for (int rep = 0; rep < PROBE_SK1_REPS; ++rep) {
        const sk::EpiInS E1{WinT, Qb, Zb, XBC, Kext, Vext, DT, args.out};
        sk::skinny<8, 1, true>(F.lds + RING_OFF, XN + (size_t)MP * DM, DM, DM, NIN / 16, E1, F.wave, F.lane, (int)blockIdx.x, F.G);
        STAMP(13);
        const sk::EpiDtP E2{XN, DT};
        sk::skinny<2, 1, true>(F.lds + RING_OFF, WinT + (size_t)12288 * DM, DM, DM, MP / 16, E2, F.wave, F.lane, (int)((blockIdx.x + F.G / 2) % F.G), F.G);
    }
#if TEST_STAGE >= 2
    GRID_BAR();
    STAMP(2); SPREAD_T2(1);

    {
        float lam;
        { const float a = F.lane < 64 ? args.in[I_LQ1][F.lane] * args.in[I_LK1][F.lane] : 0.f, b = args.in[I_LQ2][F.lane] * args.in[I_LK2][F.lane];
          lam = __expf(wave_sum(a)) - __expf(wave_sum(b)) + LAM0; }
        const ssd::Params SP{args.in[I_CONVW], args.in[I_CONVB], args.in[I_DTB], args.in[I_ALOG], args.in[I_DSKIP], args.in[I_SSDNW]};
        constexpr int NSEG = 4, SEGLEN = SEQ / NSEG, NBG = NB * SG;
        constexpr int JS = 736  ;
        constexpr int E0 = (NSEG - 1) * NBG, E1 = E0 + NBG, E2 = E1 + 192, E3 = E2 + (NSEG - 1) * NBG, E4 = E3 + (JS - 192), E5 = E4 + DEC_B * NH, E6 = E5 + (1024 - JS), E7 = E6 + DEC_B * SG, NITEMS = E7;
        float* FSEG = (float*)(ws + WS_F);
#ifndef PROBE_MIX_REPS
#define PROBE_MIX_REPS 1
#define PROBE_MIX_SKIP 0
#endif
        for (int rep = 0; rep < PROBE_MIX_REPS; ++rep) {
        if (rep > 0) GRID_BAR();
        for (;;) {
            if (F.tid == 0) F.MISC[0] = __hip_atomic_fetch_add(F.ctl + CW_QUEUE + 64 * rep, 1u, RLX_AGENT);
            __syncthreads();
            const int pos = (int)F.MISC[0];
            __syncthreads();
            constexpr int NPOS = 256 + 3 * CONV_ITEMS;
            if (pos >= NPOS) break;
            int item = pos;
            if (pos >= 256) { const int q = pos - 256, grp = q / 3, r = q - 3 * grp;
                if (r == 2) { if (rep == 0) p0_deferred_item(F, args, grp); __syncthreads(); continue; }
                item = 256 + 2 * grp + r; }
            if (item >= NITEMS) continue;
            const bool is_ssd = item < E1 || (item >= E2 && item < E3) || item >= E6;
            if (rep > 0 && ((PROBE_MIX_SKIP == 1 && is_ssd) || (PROBE_MIX_SKIP == 2 && !is_ssd))) continue;
            if (is_ssd) {
                ssd::Unit u; bool pre = false;
                if (item < E6) {
                    int seg, bg;
                    if (item < E0) { pre = true; seg = item / NBG; bg = item % NBG; }
                    else if (item < E1) { seg = 0; bg = item - E0; }
                    else { const int k = item - E2; seg = 1 + k / NBG; bg = k % NBG; }
                    const int b = bg >> 3; u.g = bg & 7; const size_t r0 = (size_t)b * SEQ + (size_t)seg * SEGLEN;
                    u.xbc = XBC + r0 * CONVD; u.z = Zb + r0 * SSDI; u.dtraw = DT + r0 * SH; u.hist = nullptr; u.init = nullptr;
                    u.fin = args.out + O_SP + (size_t)b * SH * SHD * DS; u.y = MIX + r0 * DM + AW; u.len = SEGLEN;
                    u.prev = seg > 0; u.seg = seg; u.fseg = FSEG + (size_t)bg * (NSEG - 1) * ssd::FSTRIDE; u.flag = (unsigned*)(F.ctl + CW_SSDF + 64 * bg) + 16 * rep; u.last = seg == NSEG - 1;
                } else { const int j = item - E6; const int b = j >> 3; u.g = j & 7; const size_t r0 = (size_t)MP + (size_t)b * DEC_T;
                    u.xbc = XBC + r0 * CONVD; u.z = Zb + r0 * SSDI; u.dtraw = DT + r0 * SH; u.hist = args.in[I_SCONV] + (size_t)b * 3 * CONVD; u.init = args.in[I_SSSM] + (size_t)b * SH * SHD * DS;
                    u.fin = args.out + O_SS + (size_t)b * SH * SHD * DS; u.y = MIX + r0 * DM + AW; u.len = DEC_T;
                    u.prev = 0; u.seg = 0; u.fseg = nullptr; u.flag = nullptr; u.last = 1; }
                if (pre) ssd::ssd_unit<true>(F.lds + RING_OFF, u, SP, F.tid, F.wave, F.lane);
                else ssd::ssd_unit<false>(F.lds + RING_OFF, u, SP, F.tid, F.wave, F.lane);
            } else {
                att::Unit u;
                if (item < E4 || item >= E5) { const int j = item < E2 ? item - E1 : item < E4 ? item - E3 + 192 : item - E5 + JS; const int qb = 31 - (j >> 5), bh = j & 31, b = bh >> 4, h = bh & 15; const size_t r0 = (size_t)b * SEQ;
                    u.Q = Qb + (r0 + 256 * qb) * AW + h * HD; u.K = Kb + r0 * AW + h * HD; u.V = Vb + r0 * AW + h * HD; u.O = MIX + (r0 + 256 * qb) * DM + h * HD;
                    u.ntot = 4 * qb + 4; u.nvalid_last = 64; u.sample = 0; u.qb = qb; u.park = nullptr; u.variant = 0;
#ifdef PROBE_ATT_VARIANT
                    if (rep > 0) { u.variant = PROBE_ATT_VARIANT; u.O = (bf16*)(ws + WS_DUMMY) + (r0 + 256 * qb) * DM + h * HD; }
#endif
                    }
                else { const int j = item - E4; const int b = j >> 4, h = j & 15; const size_t r0 = (size_t)MP + (size_t)b * DEC_T;
                    u.Q = Qb + r0 * AW + h * HD; u.K = Kext + (size_t)b * KVROWS * AW + h * HD; u.V = Vext + (size_t)b * KVROWS * AW + h * HD; u.O = MIX + r0 * DM + h * HD;
                    u.ntot = KVROWS / 64; u.nvalid_last = PAST + DEC_T - (KVROWS / 64 - 1) * 64; u.sample = 1; u.qb = 0; u.park = nullptr; u.variant = 0;
                    p2_cache_slice(F, args, b, h);
#ifdef PROBE_ATT_VARIANT
                    if (rep > 0) { u.variant = PROBE_ATT_VARIANT; u.O = (bf16*)(ws + WS_DUMMY) + r0 * DM + h * HD; }
#endif
                    }
                att::attn_unit(F.lds + RING_OFF, u, lam, args.in[I_SUBLN], F.wave, F.lane);
            }
            __syncthreads();
        }
        }
    }
#endif
#if TEST_STAGE >= 3
#ifdef PROBE_TIMING
    if (F.tid == 0) __hip_atomic_fetch_max(F.ctl + CW_TMO + 2, ~(unsigned)__builtin_amdgcn_s_memrealtime(), RLX_AGENT);
#endif
    GRID_BAR();
    STAMP(3); SPREAD_T0(3);
#ifdef PROBE_TIMING
    if (blockIdx.x == 0 && F.tid == 0) { F.MISC[16 + 2 * 20] = ~__hip_atomic_load(F.ctl + CW_TMO + 2, RLX_AGENT); F.MISC[17 + 2 * 20] = F.MISC[17 + 2 * 3]; }
#endif
    {
        if (F.G == 256) {
            const int sl = (int)blockIdx.x & 7;
            const sk::EpiOutPart E1{WoT, (float*)(ws + WS_PARK) + (size_t)sl * MS * DM, 512 * sl};
            sk::skinny<8, 1>(F.lds + RING_OFF, MIX + (size_t)MP * DM + 512 * sl, DM, 512, DM / 16, E1, F.wave, F.lane, (int)blockIdx.x >> 3, 32);
            asm volatile("s_waitcnt vmcnt(0)" ::: "memory"); __syncthreads();
            if (F.tid == 0) { __builtin_amdgcn_fence(__ATOMIC_RELEASE, "agent"); __hip_atomic_fetch_add(F.ctl + CW_SMPC + 64, 1u, RLX_AGENT); }
        }
        pg8::Gemm g{MIX, WoT, MP, DM, DM}; pg8::StaticOrder S; S.init(MP, DM, F.G, (int)blockIdx.x);
        pg8::EpiOutProj E{args.in[I_XP], args.in[I_XS], args.out, X1B, SS2};
        pg8::gemm_phase<pg8::EpiOutProj, pg8::StaticOrder, GEMM_ALIGN, GEMM_SP2, 0, GEMM_DIM16>(F.lds + RING_OFF, g, S, E);
        STAMP(12); SPREAD_T1(3);
#ifdef PROBE_P3_REPS
        for (int rep = 1; rep < PROBE_P3_REPS; ++rep) { GRID_BAR(); pg8::EpiProbe EP{HB, DM}; pg8::gemm_phase<pg8::EpiProbe, pg8::StaticOrder, GEMM_ALIGN, GEMM_SP2, 0, GEMM_DIM16>(F.lds + RING_OFF, g, S, EP); }
#endif
        if (F.G == 256) {
            if (F.tid == 0) F.MISC[2] = __hip_atomic_fetch_add(F.ctl + CW_P1T + 16, 1u, RLX_AGENT);
            __syncthreads();
            const unsigned tk = F.MISC[2];
            if (tk < 16u) p3_sample_final(F, args, 8 * (int)tk + F.wave, (const unsigned*)(F.ctl + CW_SMPC + 64), 256u); }
        else {
            const sk::EpiOutS E1{WoT, args.in[I_XS], args.out, X1B, SS2};
            sk::skinny<8, 1>(F.lds + RING_OFF, MIX + (size_t)MP * DM, DM, DM, DM / 16, E1, F.wave, F.lane, (int)blockIdx.x, F.G);
        }
    }
    GRID_BAR();
#ifdef PROBE_EXTRA_BARS
    for (int i = 0; i < PROBE_EXTRA_BARS; ++i) GRID_BAR();
#endif
    STAMP(4); SPREAD_T2(3);
#if P4_INT8
    p3b_quant_rows(F, args);
    GRID_BAR();
    STAMP(7); SPREAD_T0(4);
#endif
    for (int rep = 0; rep < PROBE_P4_REPS; ++rep) {
        if (rep > 0) GRID_BAR();
#if P4_INT8
        pg8::Gemm g{(const bf16*)(ws + WS_X1Q), (const bf16*)(ws + WS_WGUQ), MPAD, 2 * DFF, DM / 2};
        pg8::EpiGateUpT<true> E{HB, (const float*)(F.ctl + CW_RQ), 1.0f / wq_scale(ws, 0), 1.0f / wq_scale(ws, 1), (bf16*)(ws + WS_HS)};
        if (F.G == 256 && rep == 0) {
            pg8::TailOrder S; S.init(MPAD, 2 * DFF, F.G, (int)blockIdx.x, (unsigned*)(F.ctl + CW_P4T), (volatile LAS unsigned*)(F.MISC + 2));
            pg8::gemm_phase<pg8::EpiGateUpT<true>, pg8::TailOrder, GEMM_ALIGN, GEMM_SP2, 2, GEMM_DIM>(F.lds + RING_OFF, g, S, E);
        } else {
            pg8::StaticOrder S; S.init(MPAD, 2 * DFF, F.G, (int)blockIdx.x);
            pg8::gemm_phase<pg8::EpiGateUpT<true>, pg8::StaticOrder, GEMM_ALIGN, GEMM_SP2, 2, GEMM_DIM>(F.lds + RING_OFF, g, S, E);
        }
#else
        pg8::Gemm g{X1B, WguT, MP, 2 * DFF, DM}; pg8::StaticOrder S; S.init(MP, 2 * DFF, F.G, (int)blockIdx.x);
        pg8::EpiGateUp E{HB, SS2};
        pg8::gemm_phase<pg8::EpiGateUp, pg8::StaticOrder, GEMM_ALIGN, GEMM_SP2, 0, GEMM_DIM16>(F.lds + RING_OFF, g, S, E);
#endif
    }
    SPREAD_T1(4);
#if !P4_INT8
    for (int rep = 0; rep < PROBE_SK4_REPS; ++rep) {
        const sk::EpiGuS E1{WguT, (bf16*)(ws + WS_HS), SS2};
        if (F.G == 256) { if (blockIdx.x >= 128) sk::skinny<8, 2>(F.lds + RING_OFF, X1B + (size_t)MP * DM, DM, DM, DFF / 16, E1, F.wave, F.lane, (int)blockIdx.x - 128, 128); }
        else sk::skinny<8, 2>(F.lds + RING_OFF, X1B + (size_t)MP * DM, DM, DM, DFF / 16, E1, F.wave, F.lane, (int)blockIdx.x, F.G);
    }
#endif
    GRID_BAR();
    STAMP(5); SPREAD_T2(4); SPREAD_T0(5);
    if (F.G == 256) {
        {
            const int sl = (int)blockIdx.x & 7, c0 = sl * 5 + (sl < 3 ? sl : 3), ncs = sl < 3 ? 6 : 5;
            const sk::EpiDownPart E1{WdT, (float*)(ws + WS_PARK) + (size_t)sl * MS * DM, 256 * c0};
            sk::skinny<8, 1>(F.lds + RING_OFF, (const bf16*)(ws + WS_HS) + 256 * c0, DFF, 256 * ncs, DM / 16, E1, F.wave, F.lane, (int)blockIdx.x >> 3, 32);
            asm volatile("s_waitcnt vmcnt(0)" ::: "memory"); __syncthreads();
            if (F.tid == 0) { __builtin_amdgcn_fence(__ATOMIC_RELEASE, "agent"); __hip_atomic_fetch_add(F.ctl + CW_SMPC, 1u, RLX_AGENT); }
        }
        STAMP(10);
        pg8::Gemm g{HB, (const bf16*)(ws + WS_WD8), MP, DM, DFF / 2}; pg8::PanelOrder S; S.init((int)blockIdx.x, (unsigned*)(F.ctl + CW_P5C));
        pg8::EpiDown E{X1B, X2B, SS3};
        pg8::gemm_phase<pg8::EpiDown, pg8::PanelOrder, GEMM_ALIGN, GEMM_SP2, 1, GEMM_DIM>(F.lds + RING_OFF, g, S, E);
        STAMP(8); SPREAD_T1(5);
        p5_norm_own(F, args, S.pm, 1024 * S.q4, 1024, 256 * S.pm, 256, (unsigned*)(F.ctl + CW_P5C) + 64 * S.pm, 128u);
        STAMP(9);
        {
            if (F.tid == 0) F.MISC[2] = __hip_atomic_fetch_add(F.ctl + CW_P1T + 32, 1u, RLX_AGENT);
            __syncthreads();
            const unsigned tk = F.MISC[2];
            if (tk < 16u) p5_sample_final(F, args, 8 * (int)tk + F.wave, (const unsigned*)(F.ctl + CW_SMPC), 256u); }
    } else {
        {
            pg8::Gemm g{HB, (const bf16*)(ws + WS_WD8), MP, DM, DFF / 2}; pg8::StaticOrder S; S.init(MP, DM, F.G, (int)blockIdx.x);
            pg8::EpiDown E{X1B, X2B, SS3};
            pg8::gemm_phase<pg8::EpiDown, pg8::StaticOrder, GEMM_ALIGN, GEMM_SP2, 1, GEMM_DIM>(F.lds + RING_OFF, g, S, E);
            const sk::EpiDownS E1{WdT, X1B, X2B, SS3};
            sk::skinny<8, 1>(F.lds + RING_OFF, (const bf16*)(ws + WS_HS), DFF, DFF, DM / 16, E1, F.wave, F.lane, (int)blockIdx.x, F.G);
        }
        GRID_BAR();
        p6_final_norm(F, args);
    }
#endif
#ifdef PROBE_SPIN_A
    STAMP(6);
    if (blockIdx.x == 0 && F.tid == 0) {
        const unsigned long long ta = (unsigned long long)F.MISC[16 + 2 * (PROBE_SPIN_A)] | ((unsigned long long)F.MISC[17 + 2 * (PROBE_SPIN_A)] << 32);
        const unsigned long long tb = (unsigned long long)F.MISC[16 + 2 * (PROBE_SPIN_B)] | ((unsigned long long)F.MISC[17 + 2 * (PROBE_SPIN_B)] << 32);
        const unsigned long long d = 4ull * (tb - ta), t0 = __builtin_amdgcn_s_memrealtime();
        while (__builtin_amdgcn_s_memrealtime() - t0 < d) __builtin_amdgcn_s_sleep(32);
    }
#endif
}

extern "C" void kernel_launch(void* const* d_in, const int* in_sizes, int n_in, void* d_out, int out_size, void* d_ws, size_t ws_size, hipStream_t stream) {
    static int grid = 0;
    if (grid == 0) {
        if (n_in != 25 || (size_t)out_size != O_END || ws_size < WS_END) { fprintf(stderr, "kernel_launch: unexpected shapes: n_in %d out %d ws %zu; nothing launched\n", n_in, out_size, ws_size); grid = -1; return; }
        int dev = 0, cus = 0, per_cu = 0;
        if (hipGetDevice(&dev) != hipSuccess || hipDeviceGetAttribute(&cus, hipDeviceAttributeMultiprocessorCount, dev) != hipSuccess) { grid = -1; return; }
        if (hipFuncSetAttribute((const void*)fwd, hipFuncAttributeMaxDynamicSharedMemorySize, LDS_BYTES) != hipSuccess) { fprintf(stderr, "kernel_launch: hipFuncSetAttribute failed\n"); grid = -1; return; }
        if (hipOccupancyMaxActiveBlocksPerMultiprocessor(&per_cu, (const void*)fwd, NWAVES * 64, LDS_BYTES) != hipSuccess || per_cu < 1)
            fprintf(stderr, "kernel_launch: note: occupancy query reports %d workgroups per CU\n", per_cu);
        (void)hipGetLastError();
        grid = cus;
    }
    if (grid < 0) return;
    if (hipMemsetAsync((char*)d_ws + WS_CTL, 0, CTL_ZERO_BYTES, stream) != hipSuccess) return;
    Args a{};
    for (int i = 0; i < 25; ++i) a.in[i] = (const float*)d_in[i];
    a.out = (float*)d_out; a.ws = (unsigned char*)d_ws; a.ph_lo = 0; a.ph_hi = 99;
    hipLaunchKernelGGL(fwd, dim3(grid), dim3(NWAVES * 64), LDS_BYTES, stream, a);
}
```
